# Optimizing an MI355X kernel written in HIP

```python
import jax
import jax.numpy as jnp
from jax import lax
import numpy as np


D_MODEL = 1024
BATCH = 8
SEQ = 2048
DEPTH = 1

CHUNK = 64
HG_HEADS = 8
HG_DK = 128
HG_DV = 128
HG_KEY_WIDTH = HG_HEADS * HG_DK
HG_WIDTH = HG_HEADS * HG_DV
SB_HEADS = 16
SB_DH = 64
SB_WIDTH = SB_HEADS * SB_DH
SB_BLOCK = 128
FF_HIDDEN = (8 * D_MODEL + 3 * 256 - 1) // (3 * 256) * 256
IN_SPLITS = (HG_KEY_WIDTH, HG_KEY_WIDTH, HG_WIDTH, HG_WIDTH, SB_WIDTH, SB_WIDTH, SB_WIDTH, D_MODEL, D_MODEL)
IN_WIDTH = sum(IN_SPLITS)
EPS = 1e-6

kernel_name = 'hybrid_hgrn2_stickbreaking_block'


def rms_norm(x, gain):
    x32 = x.astype(jnp.float32)
    y = x32 * lax.rsqrt(jnp.mean(x32 * x32, axis=-1, keepdims=True) + EPS) * gain.astype(jnp.float32)
    return y.astype(x.dtype)


def split_cols(t, widths):
    outs, start = [], 0
    for w in widths:
        outs.append(t[..., start:start + w])
        start += w
    return outs


def hgrn2_mixer(q, f_raw, i, lb):
    b, s, _ = q.shape
    n = s // CHUNK
    lb = lb.astype(jnp.float32)
    f = lb + (1.0 - lb) * jax.nn.sigmoid(f_raw.astype(jnp.float32))
    log_f = jnp.log(f)
    k = 1.0 - f

    def chunks(t, d):
        return t.astype(jnp.float32).reshape(b, n, CHUNK, HG_HEADS, d).transpose(1, 0, 3, 2, 4)

    qc, kc, gc = chunks(q, HG_DK), chunks(k, HG_DK), chunks(log_f, HG_DK)
    vc = chunks(i, HG_DV)
    causal = jnp.tril(jnp.ones((CHUNK, CHUNK), dtype=bool))[:, :, None]

    def step(state, inp):
        q_c, k_c, v_c, g_c = inp
        cum = jnp.cumsum(g_c, axis=-2)
        diff = cum[:, :, :, None, :] - cum[:, :, None, :, :]
        decay = jnp.exp(jnp.where(causal, diff, -jnp.inf))
        scores = jnp.einsum('bhtd,bhtsd,bhsd->bhts', q_c, decay, k_c)
        o = (jnp.einsum('bhts,bhsv->bhtv', scores, v_c)
             + jnp.einsum('bhtd,bhdv->bhtv', q_c * jnp.exp(cum), state))
        last = cum[:, :, -1:, :]
        state = (jnp.exp(last[:, :, 0, :, None]) * state
                 + jnp.einsum('bhsd,bhsv->bhdv', k_c * jnp.exp(last - cum), v_c))
        return state, o

    s0 = jnp.zeros((b, HG_HEADS, HG_DK, HG_DV), jnp.float32)
    _, o = lax.scan(step, s0, (qc, kc, vc, gc))
    return o.transpose(1, 0, 3, 2, 4).reshape(b, s, HG_HEADS, HG_DV)


def stick_breaking(q, k, v):
    s_len = q.shape[2]
    scale = 1.0 / float(np.sqrt(SB_DH))
    outs = []
    for blk in range(s_len // SB_BLOCK):
        q0 = blk * SB_BLOCK
        end = q0 + SB_BLOCK
        z = jnp.einsum('bhqd,bhkd->bhqk', q[:, :, q0:end], k[:, :, :end]) * scale
        qpos = q0 + jnp.arange(SB_BLOCK)
        kpos = jnp.arange(end)
        mask = kpos[None, :] < qpos[:, None]
        log_keep = jnp.where(mask, jax.nn.log_sigmoid(-z), 0.0)
        log_w = jax.nn.log_sigmoid(z) + lax.cumsum(log_keep, axis=3, reverse=True) - log_keep
        a = jnp.where(mask, jnp.exp(log_w), 0.0)
        outs.append(jnp.einsum('bhqk,bhkd->bhqd', a, v[:, :, :end]))
    return jnp.concatenate(outs, axis=2)


def setup_inputs(seed: int = 0) -> dict:
    key = jax.random.key(seed)
    ks = jax.random.split(key, 14)
    f32 = jnp.float32
    nrm = lambda k, shape, fan: jax.random.normal(k, shape, f32) * (fan ** -0.5)
    gain = lambda k, shape: 1.0 + 0.02 * jax.random.normal(k, shape, f32)
    return {
        'x': jax.random.normal(ks[0], (BATCH, SEQ, D_MODEL), f32),
        'norm1_gain': gain(ks[1], (DEPTH, D_MODEL)),
        'w_in': nrm(ks[2], (DEPTH, D_MODEL, IN_WIDTH), D_MODEL),
        'lb_logits': 0.5 * jax.random.normal(ks[3], (DEPTH + 1, HG_KEY_WIDTH), f32),
        'hg_out_norm': gain(ks[4], (DEPTH, HG_HEADS, HG_DV)),
        'sb_q_norm': gain(ks[5], (DEPTH, SB_HEADS, SB_DH)),
        'sb_k_norm': gain(ks[6], (DEPTH, SB_HEADS, SB_DH)),
        'w_hg_out': nrm(ks[7], (DEPTH, HG_WIDTH, D_MODEL), HG_WIDTH),
        'w_sb_out': nrm(ks[8], (DEPTH, SB_WIDTH, D_MODEL), SB_WIDTH),
        'w_o': nrm(ks[9], (DEPTH, D_MODEL, D_MODEL), D_MODEL),
        'norm2_gain': gain(ks[10], (DEPTH, D_MODEL)),
        'w_ffn_in': nrm(ks[11], (DEPTH, D_MODEL, 2 * FF_HIDDEN), D_MODEL),
        'w_ffn_out': nrm(ks[12], (DEPTH, FF_HIDDEN, D_MODEL), FF_HIDDEN),
    }


def reference(x, norm1_gain, w_in, lb_logits, hg_out_norm, sb_q_norm, sb_k_norm,
              w_hg_out, w_sb_out, w_o, norm2_gain, w_ffn_in, w_ffn_out):
    b, s, _ = x.shape
    lower_bounds = jnp.cumsum(jax.nn.softmax(lb_logits.astype(jnp.float32), axis=0), axis=0)
    for layer in range(DEPTH):
        h = rms_norm(x, norm1_gain[layer])
        proj = h @ w_in[layer]
        hq, hf, hi, hg, sq, sk, sv, ga, gb = split_cols(proj, IN_SPLITS)

        o_hg = hgrn2_mixer(hq, hf, hi, lower_bounds[layer])
        o_hg = rms_norm(o_hg, hg_out_norm[layer]).reshape(b, s, HG_WIDTH)
        o_hg = o_hg * jax.nn.sigmoid(hg.astype(jnp.float32))
        y_hg = o_hg.astype(x.dtype) @ w_hg_out[layer]

        def heads(t):
            return t.astype(jnp.float32).reshape(b, s, SB_HEADS, SB_DH)
        q = rms_norm(heads(sq), sb_q_norm[layer]).transpose(0, 2, 1, 3)
        k = rms_norm(heads(sk), sb_k_norm[layer]).transpose(0, 2, 1, 3)
        v = heads(sv).transpose(0, 2, 1, 3)
        o_sb = stick_breaking(q, k, v).transpose(0, 2, 1, 3).reshape(b, s, SB_WIDTH)
        y_sb = o_sb.astype(x.dtype) @ w_sb_out[layer]

        mixed = jax.nn.sigmoid(ga) * y_hg + jax.nn.sigmoid(gb) * y_sb
        x = x + mixed @ w_o[layer]

        h2 = rms_norm(x, norm2_gain[layer])
        gate, up = split_cols(h2 @ w_ffn_in[layer], (FF_HIDDEN, FF_HIDDEN))
        x = x + (jax.nn.silu(gate) * up) @ w_ffn_out[layer]
    return x
```

```cpp
#include <hip/hip_runtime.h>
#include <hip/hip_cooperative_groups.h>
#include <cstdio>
#include <cstdint>
namespace cg = cooperative_groups;
namespace pg8 {
#define PG8_LAS __attribute__((address_space(3)))
typedef unsigned short bf16_t;
typedef short bf16x8 __attribute__((ext_vector_type(8)));
typedef float f32x4 __attribute__((ext_vector_type(4)));
typedef unsigned u32x4 __attribute__((ext_vector_type(4)));
constexpr int BM = 256, BK = 64, HALF = 128, HTB = HALF * BK * 2  , STAGE_BYTES = 8 * HTB, NXCD = 8, WGM = 8;

__host__ __device__ __forceinline__ int lds_byte(int r, int c) { const int st = (r >> 4) * 2 + (c >> 5), rr = r & 15, cc = c & 31, ob = rr * 64 + cc * 2; return st * 1024 + (ob ^ (((ob >> 9) & 1) << 5)); }
__host__ __device__ __forceinline__ void stage_rc(int b, int& R, int& C) { const int st = b / 1024, sb = b % 1024, swz = sb ^ (((sb >> 9) & 1) << 5); R = (st >> 1) * 16 + swz / 64; C = (st & 1) * 32 + (swz % 64) / 2; }
__host__ __device__ __forceinline__ int perm32(int rho) { const int n = rho >> 4, i = rho & 15; return 8 * (i >> 2) + 4 * n + (i & 3); }

struct Unit { int pm, pn, kh; };
struct Gemm { const bf16_t* A; const bf16_t* Bt; int M, N, K, ld; };

struct StaticOrder {
    int nM, nN, nwg, G, c;
    __host__ __device__ void init(int M, int N, int G_, int c_) { nM = M / BM; nN = N / BM; nwg = nM * nN; G = G_; c = c_; }
    __host__ __device__ bool next(int i, Unit& u) const { const long L = (long)i * G + c; if (L >= nwg) return false; return unit_of((int)L, u); }
    __host__ __device__ bool unit_of(int L, Unit& u) const {
        int wgid = L; { const int q = nwg / NXCD, r = nwg % NXCD, xcd = wgid % NXCD, off = wgid / NXCD; wgid = (xcd < r ? xcd * (q + 1) : r * (q + 1) + (xcd - r) * q) + off; }
        const int nig = WGM * nN, gid = wgid / nig, fm = gid * WGM, gsz = (nM - fm) < WGM ? (nM - fm) : WGM;
        u.pm = fm + ((wgid % nig) % gsz); u.pn = (wgid % nig) / gsz; u.kh = 0; return true;
    }
    __device__ __forceinline__ void a_ready(const Unit&) const {}
    __device__ __forceinline__ void done(const Unit&) const {}
};
struct ListOrder {
    StaticOrder s; int l0, l1, l2;
    __host__ __device__ bool next(int i, Unit& u) const { const int L = i == 0 ? l0 : (i == 1 ? l1 : (i == 2 ? l2 : -1)); if (L < 0 || L >= s.nwg) return false; return s.unit_of(L, u); }
    __device__ __forceinline__ void a_ready(const Unit&) const {}
    __device__ __forceinline__ void done(const Unit&) const {}
};
struct SplitOrder {
    StaticOrder s;
    __host__ __device__ bool next(int i, Unit& u) const { const bool ok = s.next(i >> 1, u); u.kh = i & 1; return ok; }
    __device__ __forceinline__ void a_ready(const Unit&) const {}
    __device__ __forceinline__ void done(const Unit&) const {}
};
__device__ __forceinline__ unsigned cvt_pk_bf16(float lo, float hi) { unsigned r; asm volatile("v_cvt_pk_bf16_f32 %0, %1, %2" : "=v"(r) : "v"(lo), "v"(hi)); return r; }
typedef float f32x2 __attribute__((ext_vector_type(2)));
typedef _Float16 f16x8 __attribute__((ext_vector_type(8)));
typedef unsigned u32x2 __attribute__((ext_vector_type(2)));
__device__ __forceinline__ float sigm(float x) { return __builtin_amdgcn_rcpf(1.0f + __expf(-x)); }
__device__ __forceinline__ unsigned q8(float s) { float q = s * 255.0f + 0.5f; q = q < 1.0f ? 1.0f : (q > 255.0f ? 255.0f : q); return (unsigned)q; }
__device__ __forceinline__ u32x4 pack8_bf16(const float (&o)[8]) { u32x4 w; w.x = cvt_pk_bf16(o[0], o[1]); w.y = cvt_pk_bf16(o[2], o[3]); w.z = cvt_pk_bf16(o[4], o[5]); w.w = cvt_pk_bf16(o[6], o[7]); return w; }
__device__ __forceinline__ u32x2 pack8_u8(const float (&o)[8]) { u32x2 w; w.x = q8(o[0]) | (q8(o[1]) << 8) | (q8(o[2]) << 16) | (q8(o[3]) << 24); w.y = q8(o[4]) | (q8(o[5]) << 8) | (q8(o[6]) << 16) | (q8(o[7]) << 24); return w; }

struct EpiProj {
    static constexpr bool PERM = true, AFTER_DRAIN = false, KSPLIT = false;
    bf16_t* QS; bf16_t* VH; bf16_t* SK; bf16_t* SV; unsigned char* GH; unsigned char* GA; unsigned char* GB; _Float16* LOGF;
    const float* lbl; const float* qg; const float* kg; int pn0;
    __device__ __forceinline__ void operator()(const f32x4 (&acc)[2][2][4][2], const Unit& u, int wr, int wc, int fr, int fq) const {
        const int sec = (u.pn + pn0) >> 2, ct = (u.pn & 3) * 256;
        const int row0 = u.pm * BM + wr * 64 + fr;
        if (sec == 4 || sec == 5) {
            const int head = (u.pn & 3) * 4 + wc; const float* gp = (sec == 4 ? qg : kg) + head * 64 + 8 * fq;
            float gn[2][8];
#pragma unroll
            for (int bj = 0; bj < 2; ++bj) { const f32x4 a = *(const f32x4*)(gp + 32 * bj), b = *(const f32x4*)(gp + 32 * bj + 4);
                gn[bj][0] = a[0]; gn[bj][1] = a[1]; gn[bj][2] = a[2]; gn[bj][3] = a[3]; gn[bj][4] = b[0]; gn[bj][5] = b[1]; gn[bj][6] = b[2]; gn[bj][7] = b[3]; }
            const float sc = (sec == 4) ? 0.125f * 1.4426950408889634f : 1.0f;
#pragma unroll
            for (int ai = 0; ai < 2; ++ai)
#pragma unroll
                for (int m = 0; m < 4; ++m) {
                    float ss = 0.f;
#pragma unroll
                    for (int bj = 0; bj < 2; ++bj)
#pragma unroll
                        for (int n = 0; n < 2; ++n) { const f32x4 x = acc[ai][bj][m][n]; ss += (x[0] * x[0] + x[1] * x[1]) + (x[2] * x[2] + x[3] * x[3]); }
                    ss += __shfl_xor(ss, 16); ss += __shfl_xor(ss, 32);
                    const float rstd = __builtin_amdgcn_rsqf(ss * (1.0f / 64.0f) + 1e-6f) * sc;
                    const size_t row = (size_t)(row0 + ai * HALF + m * 16);
#pragma unroll
                    for (int bj = 0; bj < 2; ++bj) { float o[8];
#pragma unroll
                        for (int k = 0; k < 8; ++k) o[k] = acc[ai][bj][m][k >> 2][k & 3] * rstd * gn[bj][k];
                        bf16_t* dst = (sec == 4) ? (QS + row * 2048 + 1024 + head * 64 + 32 * bj + 8 * fq) : (SK + row * 1024 + head * 64 + 32 * bj + 8 * fq);
                        *(u32x4*)dst = pack8_bf16(o); }
                }
            return;
        }
#pragma unroll
        for (int bj = 0; bj < 2; ++bj) {
            const int col = ct + bj * HALF + wc * 32 + 8 * fq;
            float lb[8];
            if (sec == 1) {
#pragma unroll
                for (int k = 0; k < 8; ++k) lb[k] = 1.0f / (1.0f + __expf(lbl[1024 + col + k] - lbl[col + k]));
            }
#pragma unroll
            for (int ai = 0; ai < 2; ++ai)
#pragma unroll
                for (int m = 0; m < 4; ++m) {
                    const size_t row = (size_t)(row0 + ai * HALF + m * 16);
                    float o[8];
#pragma unroll
                    for (int k = 0; k < 8; ++k) o[k] = acc[ai][bj][m][k >> 2][k & 3];
                    if (sec == 0) { *(u32x4*)(QS + row * 2048 + col) = pack8_bf16(o); }
                    else if (sec == 2) { *(u32x4*)(VH + row * 1024 + col) = pack8_bf16(o); }
                    else if (sec == 6) { bf16_t* vt = SV + ((size_t)((row >> 11) * 16 + (col >> 6)) * 64 + (col & 63)) * 2048 + (row & 2047);
#pragma unroll
                        for (int k = 0; k < 8; ++k) vt[(size_t)k * 2048] = (bf16_t)(cvt_pk_bf16(o[k], o[k]) & 0xffffu); }
                    else if (sec == 1) { f16x8 g;
#pragma unroll
                        for (int k = 0; k < 8; ++k) g[k] = (_Float16)__logf(lb[k] + (1.0f - lb[k]) * sigm(o[k]));
                        *(f16x8*)(LOGF + row * 1024 + col) = g; }
                    else {
#pragma unroll
                        for (int k = 0; k < 8; ++k) o[k] = sigm(o[k]);
                        unsigned char* dst = (sec == 3) ? GH : (sec == 7 ? GA : GB);
                        *(u32x2*)(dst + row * 1024 + col) = pack8_u8(o); }
                }
        }
    }
};
struct EpiVT {
    static constexpr bool PERM = true, AFTER_DRAIN = false, KSPLIT = false;
    bf16_t* VT;
    __device__ __forceinline__ void operator()(const f32x4 (&acc)[2][2][4][2], const Unit& u, int wr, int wc, int fr, int fq) const {
        const int row0 = u.pm * BM + wr * 64 + fr;
#pragma unroll
        for (int ai = 0; ai < 2; ++ai)
#pragma unroll
            for (int m = 0; m < 4; ++m)
#pragma unroll
                for (int bj = 0; bj < 2; ++bj) {
                    const int r = row0 + ai * HALF + m * 16, c = u.pn * BM + bj * HALF + wc * 32 + 8 * fq;
                    float o[8];
#pragma unroll
                    for (int k = 0; k < 8; ++k) o[k] = acc[ai][bj][m][k >> 2][k & 3];
                    *(u32x4*)(VT + ((size_t)((c >> 11) * 16 + (r >> 6)) * 64 + (r & 63)) * 2048 + (c & 2047)) = pack8_bf16(o);
                }
    }
};
struct EpiMix {
    static constexpr bool PERM = true, AFTER_DRAIN = false, KSPLIT = true;
    const unsigned char* GA; const unsigned char* GB; bf16_t* MIXED;
    __device__ __forceinline__ void half0(f32x4 (&acc)[2][2][4][2], const Unit& u, int wr, int wc, int fr, int fq) const {
        const int row0 = u.pm * BM + wr * 64 + fr;
#pragma unroll
        for (int ai = 0; ai < 2; ++ai)
#pragma unroll
            for (int m = 0; m < 4; ++m)
#pragma unroll
                for (int bj = 0; bj < 2; ++bj) {
                    const size_t off = (size_t)(row0 + ai * HALF + m * 16) * 1024 + u.pn * BM + bj * HALF + wc * 32 + 8 * fq;
                    const u32x2 a = *(const u32x2*)(GA + off), b = *(const u32x2*)(GB + off);
#pragma unroll
                    for (int k = 0; k < 8; ++k) { const float qa = (float)((a[k >> 2] >> (8 * (k & 3))) & 255u), qb = (float)((b[k >> 2] >> (8 * (k & 3))) & 255u);
                        acc[ai][bj][m][k >> 2][k & 3] *= qa * __builtin_amdgcn_rcpf(qb); }
                    if (bj == 1 && (m & 1)) asm volatile("" ::: "memory");
                }
    }
    __device__ __forceinline__ void operator()(f32x4 (&acc)[2][2][4][2], const Unit& u, int wr, int wc, int fr, int fq) const {
        if (u.kh == 0) { half0(acc, u, wr, wc, fr, fq); return; }
        const int row0 = u.pm * BM + wr * 64 + fr;
#pragma unroll
        for (int ai = 0; ai < 2; ++ai)
#pragma unroll
            for (int m = 0; m < 4; ++m)
#pragma unroll
                for (int bj = 0; bj < 2; ++bj) {
                    const size_t off = (size_t)(row0 + ai * HALF + m * 16) * 1024 + u.pn * BM + bj * HALF + wc * 32 + 8 * fq;
                    const u32x2 b = *(const u32x2*)(GB + off); float o[8];
#pragma unroll
                    for (int k = 0; k < 8; ++k) { const float qb = (float)((b[k >> 2] >> (8 * (k & 3))) & 255u); o[k] = acc[ai][bj][m][k >> 2][k & 3] * (qb * (1.0f / 255.0f)); }
                    *(u32x4*)(MIXED + off) = pack8_bf16(o);
                }
    }
};
struct EpiRes1 {
    static constexpr bool PERM = true, AFTER_DRAIN = false, KSPLIT = false;
    const float* x; bf16_t* DL; bf16_t* X1B; float* SSQ;
    __device__ __forceinline__ void operator()(const f32x4 (&acc)[2][2][4][2], const Unit& u, int wr, int wc, int fr, int fq) const {
        const int row0 = u.pm * BM + wr * 64 + fr;
#pragma unroll
        for (int ai = 0; ai < 2; ++ai)
#pragma unroll
            for (int m = 0; m < 4; ++m) {
                const int row = row0 + ai * HALF + m * 16; float ss = 0.f;
#pragma unroll
                for (int bj = 0; bj < 2; ++bj) {
                    const size_t off = (size_t)row * 1024 + u.pn * BM + bj * HALF + wc * 32 + 8 * fq;
                    const f32x4 v0 = *(const f32x4*)(x + off) + acc[ai][bj][m][0], v1 = *(const f32x4*)(x + off + 4) + acc[ai][bj][m][1];
                    { const f32x4 a0 = acc[ai][bj][m][0], a1 = acc[ai][bj][m][1]; u32x4 dw; dw.x = cvt_pk_bf16(a0[0], a0[1]); dw.y = cvt_pk_bf16(a0[2], a0[3]); dw.z = cvt_pk_bf16(a1[0], a1[1]); dw.w = cvt_pk_bf16(a1[2], a1[3]); *(u32x4*)(DL + off) = dw; }
                    u32x4 w; w.x = cvt_pk_bf16(v0[0], v0[1]); w.y = cvt_pk_bf16(v0[2], v0[3]); w.z = cvt_pk_bf16(v1[0], v1[1]); w.w = cvt_pk_bf16(v1[2], v1[3]);
                    *(u32x4*)(X1B + off) = w;
                    ss += (v0[0] * v0[0] + v0[1] * v0[1]) + (v0[2] * v0[2] + v0[3] * v0[3]) + (v1[0] * v1[0] + v1[1] * v1[1]) + (v1[2] * v1[2] + v1[3] * v1[3]);
                }
                ss += __shfl_xor(ss, 16); ss += __shfl_xor(ss, 32);
                if (fq == 0) SSQ[(size_t)row * 16 + u.pn * 4 + wc] = ss;
            }
    }
};
struct EpiSwiglu {
    static constexpr bool PERM = true, AFTER_DRAIN = false, KSPLIT = false;
    const float* SSQ; bf16_t* ACT;
    __device__ __forceinline__ void operator()(const f32x4 (&acc)[2][2][4][2], const Unit& u, int wr, int wc, int fr, int fq) const {
        const int row0 = u.pm * BM + wr * 64 + fr;
#pragma unroll
        for (int ai = 0; ai < 2; ++ai)
#pragma unroll
            for (int m = 0; m < 4; ++m) {
                const int row = row0 + ai * HALF + m * 16;
                const f32x4* sp = (const f32x4*)(SSQ + (size_t)row * 16);
                const f32x4 s0 = sp[0], s1 = sp[1], s2 = sp[2], s3 = sp[3];
                const float ss = ((s0[0] + s0[1]) + (s0[2] + s0[3])) + ((s1[0] + s1[1]) + (s1[2] + s1[3])) + ((s2[0] + s2[1]) + (s2[2] + s2[3])) + ((s3[0] + s3[1]) + (s3[2] + s3[3]));
                const float rstd = __builtin_amdgcn_rsqf(ss * (1.0f / 1024.0f) + 1e-6f);
                float o[8];
#pragma unroll
                for (int k = 0; k < 8; ++k) { const float g = acc[ai][0][m][k >> 2][k & 3] * rstd, up = acc[ai][1][m][k >> 2][k & 3] * rstd; o[k] = g * sigm(g) * up; }
                *(u32x4*)(ACT + (size_t)row * 2816 + u.pn * 128 + wc * 32 + 8 * fq) = pack8_bf16(o);
            }
    }
};
struct EpiRes2 {
    static constexpr bool PERM = true, AFTER_DRAIN = false, KSPLIT = false;
    const float* x; const bf16_t* DL; float* out;
    __device__ __forceinline__ void operator()(const f32x4 (&acc)[2][2][4][2], const Unit& u, int wr, int wc, int fr, int fq) const {
        const int row0 = u.pm * BM + wr * 64 + fr;
#pragma unroll
        for (int ai = 0; ai < 2; ++ai)
#pragma unroll
            for (int m = 0; m < 4; ++m)
#pragma unroll
                for (int bj = 0; bj < 2; ++bj) {
                    const size_t off = (size_t)(row0 + ai * HALF + m * 16) * 1024 + u.pn * BM + bj * HALF + wc * 32 + 8 * fq;
                    const u32x4 dw = *(const u32x4*)(DL + off);
                    f32x4 d0, d1; d0[0] = __builtin_bit_cast(float, dw.x << 16); d0[1] = __builtin_bit_cast(float, dw.x & 0xffff0000u); d0[2] = __builtin_bit_cast(float, dw.y << 16); d0[3] = __builtin_bit_cast(float, dw.y & 0xffff0000u);
                    d1[0] = __builtin_bit_cast(float, dw.z << 16); d1[1] = __builtin_bit_cast(float, dw.z & 0xffff0000u); d1[2] = __builtin_bit_cast(float, dw.w << 16); d1[3] = __builtin_bit_cast(float, dw.w & 0xffff0000u);
                    const f32x4 v0 = (*(const f32x4*)(x + off) + d0) + acc[ai][bj][m][0], v1 = (*(const f32x4*)(x + off + 4) + d1) + acc[ai][bj][m][1];
                    *(f32x4*)(out + off) = v0; *(f32x4*)(out + off + 4) = v1;
                }
    }
};

template <class Epi, class Sched, bool ALIGN_EPI = false, bool SP2 = false>
__device__ __forceinline__ void gemm_phase(PG8_LAS unsigned char* lds, const Gemm g, const Sched& S, const Epi& E) {
    int tid_ = threadIdx.x; asm volatile("" : "+v"(tid_));
    const int tid = tid_, wid = __builtin_amdgcn_readfirstlane(tid >> 6), lane = tid & 63, wr = wid >> 2, wc = wid & 3, fr = lane & 15, fq = lane >> 4;
    const int K = g.K, nt = K / BK;
    unsigned voffA[2], voffB[2];
#pragma unroll
    for (int i = 0; i < 2; ++i) { int R, C; stage_rc(tid * 16 + i * 8192, R, C); const int Rb = Epi::PERM ? ((R & ~31) + perm32(R & 31)) : R;
        voffA[i] = (unsigned)(R * g.ld + C) * 2u; voffB[i] = (unsigned)(Rb * g.ld + C) * 2u; }
    const size_t kstep = (size_t)(BK * 2);
    const size_t hstep = (size_t)HALF * g.ld * 2; const size_t khb = (size_t)K * 2;
    const size_t tstep = 2 * hstep;
    const unsigned ldsw = (unsigned)wid * 1024u;
    const int aoff = lds_byte(wr * 64 + fr, fq * 8), boff = lds_byte(wc * 32 + fr, fq * 8);
#define PG8_SA(b, h) (((b) * 2 + (h)) * HTB)
#define PG8_SB(b, h) ((4 + (b) * 2 + (h)) * HTB)
#define PG8_STAGE(bufoff, gbase, voff) do { _Pragma("unroll") for (int _i = 0; _i < 2; ++_i) \
        __builtin_amdgcn_global_load_lds((const unsigned*)((const char*)(gbase) + (voff)[_i]), (PG8_LAS unsigned*)(lds + (bufoff) + ldsw + _i * 8192), 16, 0, 0); } while (0)
#define PG8_LDA(dst, b, h) do { _Pragma("unroll") for (int m = 0; m < 4; ++m) _Pragma("unroll") for (int k = 0; k < 2; ++k) dst[m][k] = *(const PG8_LAS bf16x8*)(lds + PG8_SA(b, h) + aoff + m * 2048 + k * 1024); } while (0)
#define PG8_LDB(dst, b, h) do { _Pragma("unroll") for (int n = 0; n < 2; ++n) _Pragma("unroll") for (int k = 0; k < 2; ++k) dst[n][k] = *(const PG8_LAS bf16x8*)(lds + PG8_SB(b, h) + boff + n * 2048 + k * 1024); } while (0)
#define PG8_MMA(ai, bj, At, Bt) do { __builtin_amdgcn_s_setprio(1); _Pragma("unroll") for (int m = 0; m < 4; ++m) _Pragma("unroll") for (int n = 0; n < 2; ++n) _Pragma("unroll") for (int k = 0; k < 2; ++k) \
        acc[ai][bj][m][n] = __builtin_amdgcn_mfma_f32_16x16x32_bf16(Bt[n][k], At[m][k], acc[ai][bj][m][n], 0, 0, 0); __builtin_amdgcn_s_setprio(0); } while (0)
#define PG8_WAIT_V(n) asm volatile("s_waitcnt vmcnt(" #n ")" ::: "memory")
#define PG8_WAIT_L(n) asm volatile("s_waitcnt lgkmcnt(" #n ")" ::: "memory")
#define PG8_BAR __builtin_amdgcn_s_barrier()
#define PG8_SCHED __builtin_amdgcn_sched_barrier(0)
    Unit cur, nxt; int ui = 0;
    if (!S.next(0, cur)) return;
    f32x4 acc[2][2][4][2];
#pragma unroll
    for (int a = 0; a < 2; ++a)
#pragma unroll
        for (int b = 0; b < 2; ++b)
#pragma unroll
            for (int m = 0; m < 4; ++m)
#pragma unroll
                for (int n = 0; n < 2; ++n) acc[a][b][m][n] = (f32x4){0.f, 0.f, 0.f, 0.f};
    bf16x8 At[4][2], B0[2][2], B1[2][2];
    const char* cA = (const char*)g.A + (size_t)cur.pm * tstep + cur.kh * khb; const char* cB = (const char*)g.Bt + (size_t)cur.pn * tstep + cur.kh * khb;
    S.a_ready(cur);
    if constexpr (SP2) {
        PG8_STAGE(PG8_SB(0, 0), cB, voffB); PG8_STAGE(PG8_SB(0, 1), cB + hstep, voffB); PG8_STAGE(PG8_SA(0, 0), cA, voffA); PG8_STAGE(PG8_SA(0, 1), cA + hstep, voffA);
        if (wr == 1) PG8_BAR;
        PG8_WAIT_V(2); PG8_BAR;
        PG8_STAGE(PG8_SB(1, 0), cB + kstep, voffB); PG8_STAGE(PG8_SA(1, 0), cA + kstep, voffA); PG8_STAGE(PG8_SB(1, 1), cB + hstep + kstep, voffB);
        PG8_WAIT_V(6); PG8_BAR;
    } else {
        PG8_STAGE(PG8_SB(0, 0), cB, voffB); PG8_STAGE(PG8_SA(0, 0), cA, voffA); PG8_STAGE(PG8_SB(0, 1), cB + hstep, voffB); PG8_STAGE(PG8_SA(0, 1), cA + hstep, voffA);
        if (wr == 1) PG8_BAR;
        PG8_WAIT_V(4); PG8_BAR;
        PG8_STAGE(PG8_SB(1, 0), cB + kstep, voffB); PG8_STAGE(PG8_SA(1, 0), cA + kstep, voffA); PG8_STAGE(PG8_SB(1, 1), cB + hstep + kstep, voffB);
        PG8_WAIT_V(6); PG8_BAR;
    }
    for (;;) {
        const bool has_next = S.next(ui + 1, nxt);
        const char* nA = has_next ? (const char*)g.A + (size_t)nxt.pm * tstep + nxt.kh * khb : cA; const char* nB = has_next ? (const char*)g.Bt + (size_t)nxt.pn * tstep + nxt.kh * khb : cB;
        for (int t = 0; t < nt; t += 2) {
            const bool last = (t == nt - 2);
            const char* a1 = cA + (size_t)(t + 1) * kstep;
            const char* a2 = last ? nA : cA + (size_t)(t + 2) * kstep; const char* b2 = last ? nB : cB + (size_t)(t + 2) * kstep;
            const char* a3 = a2 + kstep; const char* b3 = b2 + kstep;
            if (last && has_next) S.a_ready(nxt);
            if constexpr (SP2) {
            PG8_LDB(B0, 0, 0); PG8_LDB(B1, 0, 1); PG8_SCHED; PG8_LDA(At, 0, 0); PG8_STAGE(PG8_SA(1, 1), a1 + hstep, voffA);
            PG8_WAIT_V(8); PG8_WAIT_L(0); PG8_BAR; PG8_MMA(0, 0, At, B0); PG8_MMA(0, 1, At, B1); PG8_BAR; PG8_SCHED;
            PG8_LDA(At, 0, 1); PG8_STAGE(PG8_SB(0, 0), b2, voffB); PG8_STAGE(PG8_SB(0, 1), b2 + hstep, voffB); PG8_STAGE(PG8_SA(0, 0), a2, voffA);
            PG8_WAIT_V(8); PG8_WAIT_L(0); PG8_BAR; PG8_MMA(1, 0, At, B0); PG8_MMA(1, 1, At, B1); PG8_BAR; PG8_SCHED;
            PG8_LDB(B0, 1, 0); PG8_LDB(B1, 1, 1); PG8_SCHED; PG8_LDA(At, 1, 0); PG8_STAGE(PG8_SA(0, 1), a2 + hstep, voffA);
            PG8_WAIT_V(8); PG8_WAIT_L(0); PG8_BAR; PG8_MMA(0, 0, At, B0); PG8_MMA(0, 1, At, B1); PG8_BAR; PG8_SCHED;
            PG8_LDA(At, 1, 1); PG8_STAGE(PG8_SB(1, 0), b3, voffB); PG8_STAGE(PG8_SB(1, 1), b3 + hstep, voffB); PG8_STAGE(PG8_SA(1, 0), a3, voffA);
            PG8_WAIT_V(8); PG8_WAIT_L(0); PG8_BAR; PG8_MMA(1, 0, At, B0); PG8_MMA(1, 1, At, B1); PG8_BAR; PG8_SCHED;
            } else {
            PG8_LDB(B0, 0, 0); PG8_SCHED; PG8_LDA(At, 0, 0); PG8_STAGE(PG8_SA(1, 1), a1 + hstep, voffA);
            PG8_WAIT_L(8); PG8_BAR; PG8_WAIT_L(0); PG8_MMA(0, 0, At, B0); PG8_BAR; PG8_SCHED;
            PG8_LDB(B1, 0, 1); PG8_STAGE(PG8_SB(0, 0), b2, voffB);
            PG8_BAR; PG8_WAIT_L(0); PG8_MMA(0, 1, At, B1); PG8_BAR;
            PG8_LDA(At, 0, 1); PG8_STAGE(PG8_SA(0, 0), a2, voffA);
            PG8_BAR; PG8_WAIT_L(0); PG8_MMA(1, 0, At, B0); PG8_BAR; PG8_SCHED;
            PG8_STAGE(PG8_SB(0, 1), b2 + hstep, voffB);
            PG8_WAIT_V(6); PG8_BAR; PG8_MMA(1, 1, At, B1); PG8_BAR;
            PG8_LDB(B0, 1, 0); PG8_SCHED; PG8_LDA(At, 1, 0); PG8_STAGE(PG8_SA(0, 1), a2 + hstep, voffA);
            PG8_WAIT_L(8); PG8_BAR; PG8_WAIT_L(0); PG8_MMA(0, 0, At, B0); PG8_BAR; PG8_SCHED;
            PG8_LDB(B1, 1, 1); PG8_STAGE(PG8_SB(1, 0), b3, voffB);
            PG8_BAR; PG8_WAIT_L(0); PG8_MMA(0, 1, At, B1); PG8_BAR;
            PG8_LDA(At, 1, 1); PG8_STAGE(PG8_SA(1, 0), a3, voffA);
            PG8_BAR; PG8_WAIT_L(0); PG8_MMA(1, 0, At, B0); PG8_BAR; PG8_SCHED;
            PG8_STAGE(PG8_SB(1, 1), b3 + hstep, voffB);
            PG8_WAIT_V(6); PG8_BAR; PG8_MMA(1, 1, At, B1); PG8_BAR;
            }
        }
        if constexpr (ALIGN_EPI) { if (wr == 0) PG8_BAR; }
        if constexpr (!Epi::AFTER_DRAIN) { E(acc, cur, wr, wc, fr, fq); S.done(cur); }
        if (!has_next) break;
        if (!(Epi::KSPLIT && cur.kh == 0))
#pragma unroll
        for (int a = 0; a < 2; ++a)
#pragma unroll
            for (int b = 0; b < 2; ++b)
#pragma unroll
                for (int m = 0; m < 4; ++m)
#pragma unroll
                    for (int n = 0; n < 2; ++n) acc[a][b][m][n] = (f32x4){0.f, 0.f, 0.f, 0.f};
        cur = nxt; cA = nA; cB = nB; ++ui;
        if constexpr (ALIGN_EPI) { if (wr == 1) PG8_BAR; }
    }
    PG8_WAIT_V(0);
    if constexpr (!ALIGN_EPI) { if (wr == 0) PG8_BAR; }
    PG8_BAR;
    if constexpr (Epi::AFTER_DRAIN) { E.fused(acc, cur, wr, wc, fr, fq, lds, wid, lane); S.done(cur); }
#undef PG8_SA
#undef PG8_SB
#undef PG8_STAGE
#undef PG8_LDA
#undef PG8_LDB
#undef PG8_MMA
#undef PG8_WAIT_V
#undef PG8_WAIT_L
#undef PG8_BAR
#undef PG8_SCHED
}
}

constexpr int NWAVES = 8, NTHREADS = 512;
constexpr int BATCH = 8, SEQ = 2048, D = 1024, M = BATCH * SEQ, INW = 9216, FFH = 2816;
constexpr float EPS = 1e-6f;
constexpr size_t MiB = 1u << 20;
constexpr size_t WS_SSQ = 1 * MiB;
constexpr size_t WS_WIN = 2 * MiB;
constexpr size_t WS_WHS = 20 * MiB;
constexpr size_t WS_WO = 24 * MiB;
constexpr size_t WS_WF1 = 26 * MiB;
constexpr size_t WS_WF2 = 37 * MiB;
constexpr size_t WS_H = 43 * MiB;
constexpr size_t WS_MIXED = WS_H;
constexpr size_t WS_QS = 75 * MiB;
constexpr size_t WS_VH = 139 * MiB;
constexpr size_t WS_SK = 171 * MiB;
constexpr size_t WS_X1B = WS_SK;
constexpr size_t WS_GH = 203 * MiB, WS_GA = 219 * MiB, WS_GB = 235 * MiB;
constexpr size_t WS_ACT = 75 * MiB;
constexpr size_t WS_END = 251 * MiB;
static_assert(WS_ACT + (size_t)M * FFH * 2 <= WS_X1B, "ACT overlay");
constexpr int RING_BYTES = 131072, LDS_BYTES = 157696, MISC_OFF = LDS_BYTES - 256;

#define LAS __attribute__((address_space(3)))
typedef unsigned short bf16;
typedef unsigned v4u __attribute__((ext_vector_type(4)));
typedef float f32x4 __attribute__((ext_vector_type(4)));
__device__ __forceinline__ unsigned f2bf(float f) { unsigned u = __builtin_bit_cast(unsigned, f); return (u + 0x7fffu + ((u >> 16) & 1u)) >> 16; }
__device__ __forceinline__ unsigned pk2(float lo, float hi) { return f2bf(lo) | (f2bf(hi) << 16); }
__device__ __forceinline__ float bf2f(unsigned short b) { return __builtin_bit_cast(float, (unsigned)b << 16); }
__device__ __forceinline__ float wave_sum(float v) {
#pragma unroll
    for (int o = 1; o < 64; o <<= 1) v += __shfl_xor(v, o);
    return v;
}
struct Args { const float* in[13]; float* out; unsigned char* ws; int ph_lo, ph_hi; };

__device__ __forceinline__ void p0_transpose_item(const float* W, int N, bf16* WT, int ldT, int koff, LAS float* scr, int k0, int n0d, int n0s, const float* kscale, int lane) {
    float wv[32];
    const float* wp = W + (size_t)(k0 + (lane >> 5)) * N + n0s + (lane & 31);
#pragma unroll
    for (int i = 0; i < 32; ++i) wv[i] = wp[(size_t)(2 * i) * N];
    if (kscale) {
#pragma unroll
        for (int i = 0; i < 32; ++i) wv[i] *= kscale[k0 + 2 * i + (lane >> 5)];
    }
#pragma unroll
    for (int i = 0; i < 32; ++i) scr[(2 * i + (lane >> 5)) * 33 + (lane & 31)] = wv[i];
    asm volatile("s_waitcnt lgkmcnt(0)" ::: "memory");
    const int c = lane & 7;
#pragma unroll
    for (int j = 0; j < 4; ++j) { const int n = (lane >> 3) + 8 * j; const LAS float* s = scr + (8 * c) * 33 + n;
        v4u o; o.x = pk2(s[0 * 33], s[1 * 33]); o.y = pk2(s[2 * 33], s[3 * 33]); o.z = pk2(s[4 * 33], s[5 * 33]); o.w = pk2(s[6 * 33], s[7 * 33]);
        *(v4u*)(WT + (size_t)(n0d + n) * ldT + koff + k0 + 8 * c) = o; }
    asm volatile("s_waitcnt lgkmcnt(0)" ::: "memory");
}
template <int PART> __device__ __forceinline__ void p0_prologue(const Args& a, LAS unsigned char* lds, int wave, int lane, int gw, int NGW) {
    LAS float* scr = (LAS float*)(lds + wave * 16384);
    unsigned char* ws = a.ws;
    constexpr int I_IN = 16 * (INW / 32), I_SQ = 16 * 32, I_F1 = 16 * (2 * FFH / 32), I_F2 = (FFH / 64) * 32;
    constexpr int NITEMS = I_IN + 3 * I_SQ + I_F1 + I_F2;
    for (int it = (PART == 0 ? gw : I_IN + gw); it < (PART == 0 ? I_IN : NITEMS); it += NGW) {
        int r = it;
        if (r < I_IN) { const int nblk = INW / 32, kb = r / nblk, nb = r % nblk, n0d = 32 * nb; const int sec = n0d >> 10; int n0s = n0d;
            if (sec == 4 || sec == 5) { const int p = n0d & 255; n0s = (n0d - p) + 64 * ((p >> 5) & 3) + 32 * (p >> 7); }
            p0_transpose_item(a.in[2], INW, (bf16*)(ws + WS_WIN), 1024, 0, scr, 64 * kb, n0d, n0s, nullptr, lane); continue; } r -= I_IN;
        if (r < I_SQ) { p0_transpose_item(a.in[7], 1024, (bf16*)(ws + WS_WHS), 2048, 0, scr, 64 * (r / 32), 32 * (r % 32), 32 * (r % 32), nullptr, lane); continue; } r -= I_SQ;
        if (r < I_SQ) { p0_transpose_item(a.in[8], 1024, (bf16*)(ws + WS_WHS), 2048, 1024, scr, 64 * (r / 32), 32 * (r % 32), 32 * (r % 32), nullptr, lane); continue; } r -= I_SQ;
        if (r < I_SQ) { p0_transpose_item(a.in[9], 1024, (bf16*)(ws + WS_WO), 1024, 0, scr, 64 * (r / 32), 32 * (r % 32), 32 * (r % 32), nullptr, lane); continue; } r -= I_SQ;
        if (r < I_F1) { const int nblk = 2 * FFH / 32, kb = r / nblk, nb = r % nblk, n0d = 32 * nb, pn = n0d >> 8, p = n0d & 255; const int n0s = (p >> 7) * FFH + 128 * pn + (p & 127);
            p0_transpose_item(a.in[11], 2 * FFH, (bf16*)(ws + WS_WF1), 1024, 0, scr, 64 * kb, n0d, n0s, a.in[10], lane); continue; } r -= I_F1;
        p0_transpose_item(a.in[12], 1024, (bf16*)(ws + WS_WF2), FFH, 0, scr, 64 * (r / 32), 32 * (r % 32), 32 * (r % 32), nullptr, lane);
    }
    if (PART != 0) return;
    const float* g1 = a.in[1];
    f32x4 gv[4];
#pragma unroll
    for (int j = 0; j < 4; ++j) gv[j] = ((const f32x4*)g1)[lane + 64 * j];
    for (int m = gw; m < M; m += NGW) {
        const f32x4* xr = (const f32x4*)(a.in[0] + (size_t)m * D) + lane;
        f32x4 v[4]; float s = 0.f;
#pragma unroll
        for (int j = 0; j < 4; ++j) { v[j] = xr[64 * j]; s += (v[j].x * v[j].x + v[j].y * v[j].y) + (v[j].z * v[j].z + v[j].w * v[j].w); }
        const float rstd = __builtin_amdgcn_rsqf(wave_sum(s) * (1.f / D) + EPS);
        unsigned long long* o8 = (unsigned long long*)((bf16*)(ws + WS_H) + (size_t)m * D) + lane;
#pragma unroll
        for (int j = 0; j < 4; ++j) { const f32x4 y = v[j] * rstd * gv[j]; o8[64 * j] = (unsigned long long)pk2(y.x, y.y) | ((unsigned long long)pk2(y.z, y.w) << 32); }
    }
}

typedef short bf16x8_t __attribute__((ext_vector_type(8)));
typedef float f32x16 __attribute__((ext_vector_type(16)));
typedef unsigned u32x2_t __attribute__((ext_vector_type(2)));
typedef float f32x2_t __attribute__((ext_vector_type(2)));
typedef __bf16 bf16x2_cv __attribute__((ext_vector_type(2)));
__device__ __forceinline__ unsigned cvtpk(float lo, float hi) { const f32x2_t v = {lo, hi}; return __builtin_bit_cast(unsigned, __builtin_convertvector(v, bf16x2_cv)); }
__device__ __forceinline__ bf16x8_t pack_acc8(const f32x16& c, int p) {
    v4u w; if (p == 0) { w.x = cvtpk(c[0], c[1]); w.y = cvtpk(c[2], c[3]); w.z = cvtpk(c[4], c[5]); w.w = cvtpk(c[6], c[7]); }
    else { w.x = cvtpk(c[8], c[9]); w.y = cvtpk(c[10], c[11]); w.z = cvtpk(c[12], c[13]); w.w = cvtpk(c[14], c[15]); }
    return __builtin_bit_cast(bf16x8_t, w);
}
#define MFMA32(A, B, C) __builtin_amdgcn_mfma_f32_32x32x16_bf16((A), (B), (C), 0, 0, 0)
__device__ __forceinline__ void hgrn_mfma(const Args& a, LAS unsigned char* lds, int vblk, int nblk) {
    unsigned char* ws = a.ws;
    bf16* QS = (bf16*)(ws + WS_QS); const bf16* VH = (const bf16*)(ws + WS_VH); const unsigned char* GH = ws + WS_GH; const _Float16* LOGF = (const _Float16*)a.out;
    const float* ogain = a.in[4];
    constexpr int RS = 272, TS = 144;
    LAS unsigned char* L_QI = lds; LAS unsigned char* L_QA = lds + 64 * RS; LAS unsigned char* L_KA = lds + 2 * 64 * RS;
    LAS unsigned char* L_KST = lds + 3 * 64 * RS; LAS unsigned char* L_VT = L_KST + 128 * TS;
    LAS float* L_TQ = (LAS float*)(L_VT + 128 * TS); LAS float* L_DEC = L_TQ + 2048;     LAS float* L_SS = L_DEC + 128; LAS float* L_GN = L_SS + 256;
    const int tid = threadIdx.x, lane = tid & 63, wave = __builtin_amdgcn_readfirstlane(tid >> 6);
    const int dp = tid & 63, oct = wave, r32 = lane & 31, hi = lane >> 5, vt = wave & 3, tt = wave >> 2;
    const int kap = 16 * (r32 >> 4) + 8 * ((r32 >> 2) & 1) + 4 * ((r32 >> 3) & 1) + (r32 & 3);
    for (int item = vblk; item < BATCH * 8; item += nblk) {
        const int b = item >> 3, h = item & 7;
        f32x16 C[4];
#pragma unroll
        for (int i = 0; i < 4; ++i)
#pragma unroll
            for (int j = 0; j < 16; ++j) C[i][j] = 0.f;
        if (tid < 128) L_GN[tid] = ogain[h * 128 + tid];
        unsigned gN2[2][8], qN2[2][8], vN2[2][8];
#pragma unroll
        for (int c2 = 0; c2 < 2; ++c2) { const size_t row0 = (size_t)b * SEQ + 64 * c2 + 8 * oct;
#pragma unroll
          for (int i = 0; i < 8; ++i) { gN2[c2][i] = *(const unsigned*)(LOGF + (row0 + i) * 1024 + h * 128 + 2 * dp); qN2[c2][i] = *(const unsigned*)(QS + (row0 + i) * 2048 + h * 128 + 2 * dp); vN2[c2][i] = *(const unsigned*)(VH + (row0 + i) * 1024 + h * 128 + 2 * dp); } }
        { float run0 = 0.f, run1 = 0.f;
#pragma unroll
          for (int i = 0; i < 8; ++i) { run0 += (float)__builtin_bit_cast(_Float16, (unsigned short)(gN2[0][i] & 0xffffu)); run1 += (float)__builtin_bit_cast(_Float16, (unsigned short)(gN2[0][i] >> 16)); }
          *(LAS f32x2_t*)(L_TQ + oct * 128 + 2 * dp) = (f32x2_t){run0, run1}; }
        __syncthreads();
#pragma unroll 2
        for (int n = 0; n < SEQ / 64; ++n) {
            unsigned (&gN)[8] = gN2[n & 1]; unsigned (&qN)[8] = qN2[n & 1]; unsigned (&vN)[8] = vN2[n & 1];
            if (n + 1 < SEQ / 64) { float run0 = 0.f, run1 = 0.f;
#pragma unroll
                for (int i = 0; i < 8; ++i) { const unsigned gw_ = gN2[(n + 1) & 1][i]; run0 += (float)__builtin_bit_cast(_Float16, (unsigned short)(gw_ & 0xffffu)); run1 += (float)__builtin_bit_cast(_Float16, (unsigned short)(gw_ >> 16)); }
                *(LAS f32x2_t*)(L_TQ + ((n + 1) & 1) * 1024 + oct * 128 + 2 * dp) = (f32x2_t){run0, run1}; }
            float off0 = 0.f, off1 = 0.f, cref0 = 0.f, cref1 = 0.f, tot0 = 0.f, tot1 = 0.f;
#pragma unroll
            for (int o = 0; o < 8; ++o) { const f32x2_t tq = *(const LAS f32x2_t*)(L_TQ + (n & 1) * 1024 + o * 128 + 2 * dp);
                if (o < oct) { off0 += tq.x; off1 += tq.y; } if (o < 4) { cref0 += tq.x; cref1 += tq.y; } tot0 += tq.x; tot1 += tq.y; }
            const float xc0 = __expf(tot0), xc1 = __expf(tot1), xa0 = __expf(-cref0), xa1 = __expf(-cref1), xb0 = __expf(cref0), xb1 = __expf(cref1);
            if (oct == 0) *(LAS f32x2_t*)(L_DEC + 2 * dp) = (f32x2_t){xc0, xc1};
            float e0 = __expf(off0), e1 = __expf(off1);
            unsigned ksp0[4], ksp1[4], vsp0[4], vsp1[4];
#pragma unroll
            for (int i = 0; i < 8; ++i) {
                const float f0 = __expf((float)__builtin_bit_cast(_Float16, (unsigned short)(gN[i] & 0xffffu))), f1 = __expf((float)__builtin_bit_cast(_Float16, (unsigned short)(gN[i] >> 16)));
                e0 = fmaxf(e0 * f0, 1e-30f); e1 = fmaxf(e1 * f1, 1e-30f);
                const float r0 = __builtin_amdgcn_rcpf(e0), r1 = __builtin_amdgcn_rcpf(e1);
                const float k0 = 1.0f - f0, k1 = 1.0f - f1, q0 = __builtin_bit_cast(float, qN[i] << 16), q1 = __builtin_bit_cast(float, qN[i] & 0xffff0000u);
                const float qi0 = q0 * e0, qi1 = q1 * e1, kr0 = k0 * r0, kr1 = k1 * r1;
                const int t = 8 * oct + i;
                *(LAS unsigned*)(L_QI + t * RS + 4 * dp) = cvtpk(qi0, qi1);
                *(LAS unsigned*)(L_QA + t * RS + 4 * dp) = cvtpk(qi0 * xa0, qi1 * xa1);
                *(LAS unsigned*)(L_KA + t * RS + 4 * dp) = cvtpk(kr0 * xb0, kr1 * xb1);
                const unsigned ks = cvtpk(kr0 * xc0, kr1 * xc1);
                if (i & 1) { ksp0[i >> 1] |= ks << 16; ksp1[i >> 1] |= ks & 0xffff0000u; vsp0[i >> 1] |= vN[i] << 16; vsp1[i >> 1] |= vN[i] & 0xffff0000u; }
                else { ksp0[i >> 1] = ks & 0xffffu; ksp1[i >> 1] = ks >> 16; vsp0[i >> 1] = vN[i] & 0xffffu; vsp1[i >> 1] = vN[i] >> 16; }
            }
            *(LAS v4u*)(L_KST + (2 * dp) * TS + 16 * oct) = (v4u){ksp0[0], ksp0[1], ksp0[2], ksp0[3]}; *(LAS v4u*)(L_KST + (2 * dp + 1) * TS + 16 * oct) = (v4u){ksp1[0], ksp1[1], ksp1[2], ksp1[3]};
            *(LAS v4u*)(L_VT + (2 * dp) * TS + 16 * oct) = (v4u){vsp0[0], vsp0[1], vsp0[2], vsp0[3]}; *(LAS v4u*)(L_VT + (2 * dp + 1) * TS + 16 * oct) = (v4u){vsp1[0], vsp1[1], vsp1[2], vsp1[3]};
            __syncthreads();
            const size_t m = (size_t)b * SEQ + 64 * n + 32 * tt + r32;
            unsigned gt4[4];
#pragma unroll
            for (int a4 = 0; a4 < 4; ++a4) gt4[a4] = *(const unsigned*)(GH + m * 1024 + h * 128 + 32 * vt + 8 * a4 + 4 * hi);
            if (n + 2 < SEQ / 64) { const size_t row0 = (size_t)b * SEQ + 64 * (n + 2) + 8 * oct;
#pragma unroll
                for (int i = 0; i < 8; ++i) { gN[i] = *(const unsigned*)(LOGF + (row0 + i) * 1024 + h * 128 + 2 * dp); qN[i] = *(const unsigned*)(QS + (row0 + i) * 2048 + h * 128 + 2 * dp); vN[i] = *(const unsigned*)(VH + (row0 + i) * 1024 + h * 128 + 2 * dp); } }
#define SB() __builtin_amdgcn_sched_barrier(0)
            f32x16 O;
#pragma unroll
            for (int j = 0; j < 16; ++j) O[j] = 0.f;
            bf16x8_t Vt[4];
            {
                v4u qf[8];
#pragma unroll
                for (int i = 0; i < 8; ++i) { const LAS unsigned char* qp = L_QI + (32 * tt + r32) * RS + (32 * (i >> 1) + 16 * (i & 1) + 4 * hi) * 2;
                    const u32x2_t lo = *(const LAS u32x2_t*)qp, hi2 = *(const LAS u32x2_t*)(qp + 16); qf[i] = (v4u){lo.x, lo.y, hi2.x, hi2.y}; }
#pragma unroll
                for (int ks = 0; ks < 4; ++ks) Vt[ks] = *(const LAS bf16x8_t*)(L_VT + (32 * vt + r32) * TS + (16 * ks + 8 * hi) * 2);
                SB();
#pragma unroll
                for (int i = 0; i < 8; ++i) O = MFMA32(pack_acc8(C[i >> 1], i & 1), __builtin_bit_cast(bf16x8_t, qf[i]), O);
                SB();
            }
#pragma unroll
            for (int st = 0; st < 2; ++st) if (st <= tt) {
                f32x16 S;
#pragma unroll
                for (int j = 0; j < 16; ++j) S[j] = 0.f;
#pragma unroll
                for (int hb = 0; hb < 2; ++hb) {
                    bf16x8_t A[4], B[4];
#pragma unroll
                    for (int k4 = 0; k4 < 4; ++k4) { const int ks = 4 * hb + k4;
                        A[k4] = *(const LAS bf16x8_t*)(L_KA + (32 * st + kap) * RS + (16 * ks + 8 * hi) * 2);
                        B[k4] = *(const LAS bf16x8_t*)(L_QA + (32 * tt + r32) * RS + (16 * ks + 8 * hi) * 2); }
                    SB();
#pragma unroll
                    for (int k4 = 0; k4 < 4; ++k4) S = MFMA32(A[k4], B[k4], S);
                    SB();
                }
                if (st == tt) {
#pragma unroll
                    for (int j = 0; j < 16; ++j) { const int sl = 16 * (j >> 3) + 8 * hi + (j & 7); if (sl > r32) S[j] = 0.f; }
                }
                O = MFMA32(Vt[2 * st], pack_acc8(S, 0), O); O = MFMA32(Vt[2 * st + 1], pack_acc8(S, 1), O);
            }
#pragma unroll
            for (int dt = 0; dt < 4; ++dt) {
                f32x4 dc[4]; bf16x8_t A[4];
#pragma unroll
                for (int a4 = 0; a4 < 4; ++a4) dc[a4] = *(const LAS f32x4*)(L_DEC + 32 * dt + 8 * a4 + 4 * hi);
#pragma unroll
                for (int ks = 0; ks < 4; ++ks) A[ks] = *(const LAS bf16x8_t*)(L_KST + (32 * dt + r32) * TS + (16 * ks + 8 * hi) * 2);
                SB();
#pragma unroll
                for (int a4 = 0; a4 < 4; ++a4)
#pragma unroll
                    for (int cc = 0; cc < 4; ++cc) C[dt][4 * a4 + cc] *= dc[a4][cc];
#pragma unroll
                for (int ks = 0; ks < 4; ++ks) C[dt] = MFMA32(A[ks], Vt[ks], C[dt]);
                SB();
            }
#undef SB
            float ss = 0.f;
#pragma unroll
            for (int j = 0; j < 16; ++j) ss += O[j] * O[j];
            ss += __shfl_xor(ss, 32);
            if (hi == 0) L_SS[(tt * 4 + vt) * 32 + r32] = ss;
            __syncthreads();
            const float sst = (L_SS[(tt * 4 + 0) * 32 + r32] + L_SS[(tt * 4 + 1) * 32 + r32]) + (L_SS[(tt * 4 + 2) * 32 + r32] + L_SS[(tt * 4 + 3) * 32 + r32]);
            const float rstd = __builtin_amdgcn_rsqf(sst * (1.0f / 128.0f) + EPS);
#pragma unroll
            for (int a4 = 0; a4 < 4; ++a4) { const int v0 = h * 128 + 32 * vt + 8 * a4 + 4 * hi;
                const f32x4 gn = *(const LAS f32x4*)(L_GN + 32 * vt + 8 * a4 + 4 * hi); const unsigned gt = gt4[a4];
                float o[4];
#pragma unroll
                for (int cc = 0; cc < 4; ++cc) o[cc] = O[4 * a4 + cc] * rstd * gn[cc] * ((float)((gt >> (8 * cc)) & 255u) * (1.0f / 255.0f));
                u32x2_t w; w.x = cvtpk(o[0], o[1]); w.y = cvtpk(o[2], o[3]);
                *(u32x2_t*)(QS + m * 2048 + v0) = w; }
        }
        __syncthreads();
    }
}

__device__ __forceinline__ void hgrn_v2(const Args& a, LAS unsigned char* lds, int vblk, int nblk) {
    unsigned char* ws = a.ws;
    bf16* QS = (bf16*)(ws + WS_QS); const bf16* VH = (const bf16*)(ws + WS_VH); const unsigned char* GH = ws + WS_GH; const _Float16* LOGF = (const _Float16*)a.out;
    const float* ogain = a.in[4];
    constexpr int RS = 272, TS = 144, O_KA = 64 * RS, O_KAT = 2 * 64 * RS, O_VT = O_KAT + 128 * TS, BUFB = O_VT + 128 * TS;
    LAS float* L_TQ = (LAS float*)(lds + 2 * BUFB);
    LAS float* L_XS = L_TQ + 1024;
    LAS float* L_SS = L_XS + 512;
    LAS float* L_GN = L_SS + 512;
    const int tid = threadIdx.x, lane = tid & 63, wave = __builtin_amdgcn_readfirstlane(tid >> 6);
    const int r32 = lane & 31, hi = lane >> 5;
    const int kap = 16 * (r32 >> 4) + 8 * ((r32 >> 2) & 1) + 4 * ((r32 >> 3) & 1) + (r32 & 3);
    constexpr int NCH = SEQ / 64;
#define SB() __builtin_amdgcn_sched_barrier(0)
    for (int item = vblk; item < BATCH * 8; item += nblk) {
        const int b = item >> 3, h = item & 7;
        if (tid < 128) L_GN[tid] = ogain[h * 128 + tid];
        if (wave < 4) {
            const int vt = wave;
            f32x16 C[4];
#pragma unroll
            for (int i = 0; i < 4; ++i)
#pragma unroll
                for (int j = 0; j < 16; ++j) C[i][j] = 0.f;
            f32x16 O[2]; unsigned gt4[2][4];
#define HG_EPI(cn) do { _Pragma("unroll") for (int tt = 0; tt < 2; ++tt) { const LAS float* SSb = L_SS + ((cn) & 1) * 256; \
                const float sst = (SSb[(tt * 4 + 0) * 32 + r32] + SSb[(tt * 4 + 1) * 32 + r32]) + (SSb[(tt * 4 + 2) * 32 + r32] + SSb[(tt * 4 + 3) * 32 + r32]); \
                const float rstd = __builtin_amdgcn_rsqf(sst * (1.0f / 128.0f) + EPS); \
                const size_t m = (size_t)b * SEQ + 64 * (cn) + r32 + 32 * tt; \
                _Pragma("unroll") for (int a4 = 0; a4 < 4; ++a4) { const int v0 = h * 128 + 32 * vt + 8 * a4 + 4 * hi; \
                    const f32x4 gn = *(const LAS f32x4*)(L_GN + 32 * vt + 8 * a4 + 4 * hi); const unsigned gt = gt4[tt][a4]; float o[4]; \
                    _Pragma("unroll") for (int cc = 0; cc < 4; ++cc) o[cc] = O[tt][4 * a4 + cc] * rstd * gn[cc] * ((float)((gt >> (8 * cc)) & 255u) * (1.0f / 255.0f)); \
                    u32x2_t w; w.x = cvtpk(o[0], o[1]); w.y = cvtpk(o[2], o[3]); *(u32x2_t*)(QS + m * 2048 + v0) = w; } } } while (0)
            __syncthreads();
#pragma unroll 1
            for (int n = 0; n < NCH; ++n) {
                __syncthreads();
                if (n > 0) HG_EPI(n - 1);
                const LAS unsigned char* T = lds + (n & 1) * BUFB;
                const LAS float* XS = L_XS + (n & 1) * 256;
                const size_t m0 = (size_t)b * SEQ + 64 * n + r32;
#pragma unroll
                for (int tt = 0; tt < 2; ++tt)
#pragma unroll
                    for (int a4 = 0; a4 < 4; ++a4) gt4[tt][a4] = *(const unsigned*)(GH + (m0 + 32 * tt) * 1024 + h * 128 + 32 * vt + 8 * a4 + 4 * hi);
                bf16x8_t Cp[8]; bf16x8_t Vt[4];
#pragma unroll
                for (int ks = 0; ks < 4; ++ks) Vt[ks] = *(const LAS bf16x8_t*)(T + O_VT + (32 * vt + r32) * TS + (16 * ks + 8 * hi) * 2);
#pragma unroll
                for (int dt = 0; dt < 4; ++dt) {
#pragma unroll
                    for (int a4 = 0; a4 < 4; ++a4) { const f32x4 x1 = *(const LAS f32x4*)(XS + 32 * dt + 8 * a4 + 4 * hi);
#pragma unroll
                        for (int cc = 0; cc < 4; ++cc) C[dt][4 * a4 + cc] *= x1[cc]; }
                    Cp[2 * dt] = pack_acc8(C[dt], 0); Cp[2 * dt + 1] = pack_acc8(C[dt], 1);
                }
#pragma unroll
                for (int tt = 0; tt < 2; ++tt) {
#pragma unroll
                    for (int j = 0; j < 16; ++j) O[tt][j] = 0.f;
                    v4u qf[8];
#pragma unroll
                    for (int i = 0; i < 8; ++i) { const LAS unsigned char* qp = T + (32 * tt + r32) * RS + (32 * (i >> 1) + 16 * (i & 1) + 4 * hi) * 2;
                        const u32x2_t lo = *(const LAS u32x2_t*)qp, hi2 = *(const LAS u32x2_t*)(qp + 16); qf[i] = (v4u){lo.x, lo.y, hi2.x, hi2.y}; }
                    SB();
#pragma unroll
                    for (int i = 0; i < 8; ++i) O[tt] = MFMA32(Cp[i], __builtin_bit_cast(bf16x8_t, qf[i]), O[tt]);
                    SB();
#pragma unroll
                    for (int st = 0; st < 2; ++st) if (st <= tt) {
                        f32x16 S;
#pragma unroll
                        for (int j = 0; j < 16; ++j) S[j] = 0.f;
#pragma unroll
                        for (int hb = 0; hb < 2; ++hb) {
                            bf16x8_t A[4], B[4];
#pragma unroll
                            for (int k4 = 0; k4 < 4; ++k4) { const int ks = 4 * hb + k4;
                                A[k4] = *(const LAS bf16x8_t*)(T + O_KA + (32 * st + kap) * RS + (16 * ks + 8 * hi) * 2);
                                B[k4] = *(const LAS bf16x8_t*)(T + (32 * tt + r32) * RS + (16 * ks + 8 * hi) * 2); }
                            SB();
#pragma unroll
                            for (int k4 = 0; k4 < 4; ++k4) S = MFMA32(A[k4], B[k4], S);
                            SB();
                        }
                        if (st == tt) {
#pragma unroll
                            for (int j = 0; j < 16; ++j) { const int sl = 16 * (j >> 3) + 8 * hi + (j & 7); if (sl > r32) S[j] = 0.f; }
                        }
                        O[tt] = MFMA32(Vt[2 * st], pack_acc8(S, 0), O[tt]); O[tt] = MFMA32(Vt[2 * st + 1], pack_acc8(S, 1), O[tt]);
                    }
                    float ss = 0.f;
#pragma unroll
                    for (int j = 0; j < 16; ++j) ss += O[tt][j] * O[tt][j];
                    ss += __shfl_xor(ss, 32);
                    if (hi == 0) L_SS[(n & 1) * 256 + (tt * 4 + vt) * 32 + r32] = ss;
                }
#pragma unroll
                for (int dt = 0; dt < 4; ++dt) {
                    f32x4 x2[4]; bf16x8_t A[4];
#pragma unroll
                    for (int a4 = 0; a4 < 4; ++a4) x2[a4] = *(const LAS f32x4*)(XS + 128 + 32 * dt + 8 * a4 + 4 * hi);
#pragma unroll
                    for (int ks = 0; ks < 4; ++ks) A[ks] = *(const LAS bf16x8_t*)(T + O_KAT + (32 * dt + r32) * TS + (16 * ks + 8 * hi) * 2);
                    SB();
#pragma unroll
                    for (int ks = 0; ks < 4; ++ks) C[dt] = MFMA32(A[ks], Vt[ks], C[dt]);
#pragma unroll
                    for (int a4 = 0; a4 < 4; ++a4)
#pragma unroll
                        for (int cc = 0; cc < 4; ++cc) C[dt][4 * a4 + cc] *= x2[a4][cc];
                    SB();
                }
            }
            __syncthreads();
            HG_EPI(NCH - 1);
#undef HG_EPI
        } else {
            const int ptid = tid - 256, dp = ptid & 63, q4 = ptid >> 6;
            unsigned g2[2][16], q2[2][16], v2[2][16];
#define HG_LOAD(set, c) do { const size_t row0_ = (size_t)b * SEQ + 64 * (c) + 16 * q4; _Pragma("unroll") for (int i = 0; i < 16; ++i) { \
                g2[set][i] = *(const unsigned*)(LOGF + (row0_ + i) * 1024 + h * 128 + 2 * dp); q2[set][i] = *(const unsigned*)(QS + (row0_ + i) * 2048 + h * 128 + 2 * dp); \
                v2[set][i] = *(const unsigned*)(VH + (row0_ + i) * 1024 + h * 128 + 2 * dp); } } while (0)
#define HG_SUMS(set, c) do { float r0_ = 0.f, r1_ = 0.f; _Pragma("unroll") for (int i = 0; i < 16; ++i) { r0_ += (float)__builtin_bit_cast(_Float16, (unsigned short)(g2[set][i] & 0xffffu)); \
                r1_ += (float)__builtin_bit_cast(_Float16, (unsigned short)(g2[set][i] >> 16)); } *(LAS f32x2_t*)(L_TQ + ((c) & 1) * 512 + q4 * 128 + 2 * dp) = (f32x2_t){r0_, r1_}; } while (0)
            float e0, e1, xa0, xa1, xb0, xb1; unsigned kp0[8], kp1[8], vp0[8], vp1[8];
#define HG_BEGIN(c) do { float off0 = 0.f, off1 = 0.f, cref0 = 0.f, cref1 = 0.f, tot0 = 0.f, tot1 = 0.f; \
                _Pragma("unroll") for (int o = 0; o < 4; ++o) { const f32x2_t tq = *(const LAS f32x2_t*)(L_TQ + ((c) & 1) * 512 + o * 128 + 2 * dp); \
                    if (o < q4) { off0 += tq.x; off1 += tq.y; } if (o < 2) { cref0 += tq.x; cref1 += tq.y; } tot0 += tq.x; tot1 += tq.y; } \
                xa0 = __expf(-cref0); xa1 = __expf(-cref1); xb0 = __expf(cref0); xb1 = __expf(cref1); e0 = __expf(off0); e1 = __expf(off1); \
                if (q4 == 0) { *(LAS f32x2_t*)(L_XS + ((c) & 1) * 256 + 2 * dp) = (f32x2_t){xb0, xb1}; *(LAS f32x2_t*)(L_XS + ((c) & 1) * 256 + 128 + 2 * dp) = (f32x2_t){__expf(tot0 - cref0), __expf(tot1 - cref1)}; } } while (0)
#define HG_TOKENS(set, c, i0) do { LAS unsigned char* T_ = lds + ((c) & 1) * BUFB; _Pragma("unroll") for (int i = (i0); i < (i0) + 8; ++i) { \
                const unsigned gw_ = g2[set][i], qw_ = q2[set][i], vw_ = v2[set][i]; \
                const float f0 = __expf((float)__builtin_bit_cast(_Float16, (unsigned short)(gw_ & 0xffffu))), f1 = __expf((float)__builtin_bit_cast(_Float16, (unsigned short)(gw_ >> 16))); \
                e0 = fmaxf(e0 * f0, 1e-30f); e1 = fmaxf(e1 * f1, 1e-30f); \
                const float r0 = __builtin_amdgcn_rcpf(e0), r1 = __builtin_amdgcn_rcpf(e1); \
                const float qq0 = __builtin_bit_cast(float, qw_ << 16), qq1 = __builtin_bit_cast(float, qw_ & 0xffff0000u); \
                const int t = 16 * q4 + i; \
                *(LAS unsigned*)(T_ + t * RS + 4 * dp) = cvtpk(qq0 * e0 * xa0, qq1 * e1 * xa1); \
                const unsigned ka = cvtpk((1.0f - f0) * r0 * xb0, (1.0f - f1) * r1 * xb1); \
                *(LAS unsigned*)(T_ + O_KA + t * RS + 4 * dp) = ka; \
                if (i & 1) { kp0[i >> 1] |= ka << 16; kp1[i >> 1] |= ka & 0xffff0000u; vp0[i >> 1] |= vw_ << 16; vp1[i >> 1] |= vw_ & 0xffff0000u; } \
                else { kp0[i >> 1] = ka & 0xffffu; kp1[i >> 1] = ka >> 16; vp0[i >> 1] = vw_ & 0xffffu; vp1[i >> 1] = vw_ >> 16; } } } while (0)
#define HG_FINISH(c) do { LAS unsigned char* T_ = lds + ((c) & 1) * BUFB; \
                *(LAS v4u*)(T_ + O_KAT + (2 * dp) * TS + 32 * q4) = (v4u){kp0[0], kp0[1], kp0[2], kp0[3]}; *(LAS v4u*)(T_ + O_KAT + (2 * dp) * TS + 32 * q4 + 16) = (v4u){kp0[4], kp0[5], kp0[6], kp0[7]}; \
                *(LAS v4u*)(T_ + O_KAT + (2 * dp + 1) * TS + 32 * q4) = (v4u){kp1[0], kp1[1], kp1[2], kp1[3]}; *(LAS v4u*)(T_ + O_KAT + (2 * dp + 1) * TS + 32 * q4 + 16) = (v4u){kp1[4], kp1[5], kp1[6], kp1[7]}; \
                *(LAS v4u*)(T_ + O_VT + (2 * dp) * TS + 32 * q4) = (v4u){vp0[0], vp0[1], vp0[2], vp0[3]}; *(LAS v4u*)(T_ + O_VT + (2 * dp) * TS + 32 * q4 + 16) = (v4u){vp0[4], vp0[5], vp0[6], vp0[7]}; \
                *(LAS v4u*)(T_ + O_VT + (2 * dp + 1) * TS + 32 * q4) = (v4u){vp1[0], vp1[1], vp1[2], vp1[3]}; *(LAS v4u*)(T_ + O_VT + (2 * dp + 1) * TS + 32 * q4 + 16) = (v4u){vp1[4], vp1[5], vp1[6], vp1[7]}; } while (0)
            HG_LOAD(0, 0); HG_LOAD(1, 1);
            HG_SUMS(0, 0);
            __syncthreads();
            HG_SUMS(1, 1); HG_BEGIN(0); HG_TOKENS(0, 0, 0); HG_TOKENS(0, 0, 8); HG_FINISH(0); HG_LOAD(0, 2);
#pragma unroll 2
            for (int n = 0; n < NCH; ++n) {
                const int c = n + 1;
                __syncthreads();
                if (c < NCH) { if (c + 1 < NCH) HG_SUMS(n & 1, c + 1); HG_BEGIN(c); HG_TOKENS((n + 1) & 1, c, 0); HG_TOKENS((n + 1) & 1, c, 8); HG_FINISH(c); if (c + 2 < NCH) HG_LOAD((n + 1) & 1, c + 2); }
            }
            __syncthreads();
#undef HG_LOAD
#undef HG_SUMS
#undef HG_BEGIN
#undef HG_TOKENS
#undef HG_FINISH
        }
        __syncthreads();
    }
#undef SB
}

template <bool DIAG> __device__ __forceinline__ bool attn_tile(const bf16x8_t (&Kc)[4], const bf16x8_t (&Vc)[4], const bf16x8_t (&Qf)[4], f32x16& O0, f32x16& O1, float& carry, int r32, int hi) {
    f32x16 Sx;
#pragma unroll
    for (int j = 0; j < 16; ++j) Sx[j] = 0.f;
#pragma unroll
    for (int ks = 0; ks < 4; ++ks) Sx = MFMA32(Kc[ks], Qf[ks], Sx);
    float kp[16], sg[16];
#pragma unroll
    for (int j = 0; j < 16; ++j) {
        const float r = __builtin_amdgcn_rcpf(1.0f + __builtin_amdgcn_exp2f(Sx[j]));
        if (DIAG) { const int sl = 16 * (j >> 3) + 8 * hi + (j & 7); const bool valid = sl < r32; kp[j] = valid ? r : 1.f; sg[j] = valid ? 1.0f - r : 0.f; }
        else { kp[j] = r; sg[j] = 1.0f - r; }
    }
#pragma unroll
    for (int j = 6; j >= 0; --j) { sg[j] *= kp[j + 1]; kp[j] *= kp[j + 1]; sg[8 + j] *= kp[8 + j + 1]; kp[8 + j] *= kp[8 + j + 1]; }
    const float G0 = kp[0], G1 = kp[8];
    const float P0 = __shfl_xor(G0, 32), P1 = __shfl_xor(G1, 32);
    const float after0 = (hi == 0 ? P0 : 1.f) * P1 * G1 * carry, after1 = (hi == 0 ? P1 : 1.f) * carry;
#pragma unroll
    for (int j = 0; j < 16; ++j) sg[j] *= (j < 8 ? after0 : after1);
    carry *= (G0 * G1) * (P0 * P1);
    v4u w0, w1; w0.x = cvtpk(sg[0], sg[1]); w0.y = cvtpk(sg[2], sg[3]); w0.z = cvtpk(sg[4], sg[5]); w0.w = cvtpk(sg[6], sg[7]);
    w1.x = cvtpk(sg[8], sg[9]); w1.y = cvtpk(sg[10], sg[11]); w1.z = cvtpk(sg[12], sg[13]); w1.w = cvtpk(sg[14], sg[15]);
    const bf16x8_t Pb0 = __builtin_bit_cast(bf16x8_t, w0), Pb1 = __builtin_bit_cast(bf16x8_t, w1);
    O0 = MFMA32(Vc[0], Pb0, O0); O0 = MFMA32(Vc[1], Pb1, O0);
    O1 = MFMA32(Vc[2], Pb0, O1); O1 = MFMA32(Vc[3], Pb1, O1);
    return __all(carry == 0.f);
}
__device__ __forceinline__ void attn_mfma(const Args& a, int u0, int ucnt, int ustride) {
    unsigned char* ws = a.ws;
    bf16* QS = (bf16*)(ws + WS_QS); const bf16* SK = (const bf16*)(ws + WS_SK); const bf16* VT = (const bf16*)((unsigned char*)a.out + 32 * MiB);
    const int lane = threadIdx.x & 63, r32 = lane & 31, hi = lane >> 5;
    const int kap = 16 * (r32 >> 4) + 8 * ((r32 >> 2) & 1) + 4 * ((r32 >> 3) & 1) + (r32 & 3);
    for (int uk = 0; uk < ucnt; ++uk) { const int u = u0 + uk * ustride;
        const int qb = u & 63, bh = u >> 6, h = bh & 15, b = bh >> 4;
        const size_t rowq = (size_t)b * SEQ + 32 * qb + r32;
        bf16* qp = QS + rowq * 2048 + 1024 + 64 * h;
        const bf16* kbase = SK + ((size_t)b * SEQ + kap) * 1024 + 64 * h + 8 * hi;
        const bf16* vbase = VT + ((size_t)bh * 64 + r32) * 2048 + 8 * hi;
        bf16x8_t Qf[4];
#pragma unroll
        for (int ks = 0; ks < 4; ++ks) Qf[ks] = *(const bf16x8_t*)(qp + 16 * ks + 8 * hi);
        f32x16 O0, O1;
#pragma unroll
        for (int j = 0; j < 16; ++j) { O0[j] = 0.f; O1[j] = 0.f; }
        float carry = 1.f;
        bf16x8_t KA[4], VA[4], KB[4], VB[4];
#define ATT_LOAD(K_, V_, kb_) do { _Pragma("unroll") for (int ks = 0; ks < 4; ++ks) K_[ks] = *(const bf16x8_t*)(kbase + (size_t)(32 * (kb_)) * 1024 + 16 * ks); \
        _Pragma("unroll") for (int i = 0; i < 4; ++i) V_[i] = *(const bf16x8_t*)(vbase + (size_t)(32 * (i >> 1)) * 2048 + 32 * (kb_) + 16 * (i & 1)); } while (0)
        ATT_LOAD(KA, VA, qb);
        int kb = qb;
        ATT_LOAD(KB, VB, kb > 0 ? kb - 1 : 0);
        if (!(attn_tile<true>(KA, VA, Qf, O0, O1, carry, r32, hi) || kb == 0)) {
            --kb;
#pragma unroll 1
            for (;;) {
                ATT_LOAD(KA, VA, kb > 0 ? kb - 1 : 0);
                if (attn_tile<false>(KB, VB, Qf, O0, O1, carry, r32, hi) || kb == 0) break;
                --kb;
                ATT_LOAD(KB, VB, kb > 0 ? kb - 1 : 0);
                if (attn_tile<false>(KA, VA, Qf, O0, O1, carry, r32, hi) || kb == 0) break;
                --kb;
            }
        }
#undef ATT_LOAD
#pragma unroll
        for (int a4 = 0; a4 < 4; ++a4) {
            u32x2_t x0, x1; x0.x = cvtpk(O0[4 * a4], O0[4 * a4 + 1]); x0.y = cvtpk(O0[4 * a4 + 2], O0[4 * a4 + 3]); x1.x = cvtpk(O1[4 * a4], O1[4 * a4 + 1]); x1.y = cvtpk(O1[4 * a4 + 2], O1[4 * a4 + 3]);
            *(u32x2_t*)(qp + 8 * a4 + 4 * hi) = x0; *(u32x2_t*)(qp + 32 + 8 * a4 + 4 * hi) = x1; }
    }
}

#define XB_TMO      128
#define XB_XCNT(j)  (256  + 64 * (j))
#define XB_XSUB(j)  (1280 + 64 * (j))
#define XB_XGEN(j)  (2304 + 64 * (j))
#define XB_TOP      3328
#define XB_TOPGEN   3392
#define XCD_BAR_WORDS 3456
#define XB_SPIN_CAP (1u << 18)

__device__ __forceinline__ unsigned xb_ld(unsigned* p)              { return __hip_atomic_load(p, __ATOMIC_RELAXED, __HIP_MEMORY_SCOPE_AGENT); }
__device__ __forceinline__ unsigned xb_add(unsigned* p, unsigned v) { return __hip_atomic_fetch_add(p, v, __ATOMIC_RELAXED, __HIP_MEMORY_SCOPE_AGENT); }
__device__ __forceinline__ unsigned xb_xcc_id() { return (unsigned)__builtin_amdgcn_s_getreg((3 << 11) | 20) & 0xFu; }
#define XB_SPIN(cond, bar) do { unsigned _sp = 0; while (cond) { __builtin_amdgcn_s_sleep(1); \
    if ((++_sp & 255u) == 0u) { if (xb_ld(&(bar)[XB_TMO])) break; if (_sp > XB_SPIN_CAP) { atomicAdd(&(bar)[XB_TMO], 1u); break; } } } } while (0)

struct XcdBarrier {
    unsigned* bar; unsigned x;
    volatile LAS unsigned* st;
};

__device__ __forceinline__ XcdBarrier xcd_barrier_post(unsigned* bar, volatile LAS unsigned* st) {
    XcdBarrier b; b.bar = bar; b.x = xb_xcc_id(); b.st = st;
    if (threadIdx.x == 0) (void)xb_add(&bar[XB_XCNT(b.x)], 1u);
    return b;
}
__device__ __forceinline__ void xcd_barrier_complete(unsigned* bar, unsigned x, unsigned& nloc, unsigned& nx) {
    const unsigned G = gridDim.x * gridDim.y * gridDim.z;
    unsigned sum, cnt, mine, sp = 0u;
    for (;;) {
        sum = 0u; cnt = 0u; mine = 0u;
#pragma unroll
        for (unsigned j = 0; j < 16; ++j) { const unsigned c = xb_ld(&bar[XB_XCNT(j)]); sum += c; cnt += (c > 0u) ? 1u : 0u; mine = (j == x) ? c : mine; }
        if (sum == G) break;
        __builtin_amdgcn_s_sleep(1);
        if ((++sp & 255u) == 0u) { if (xb_ld(&bar[XB_TMO])) break; if (sp > XB_SPIN_CAP) { atomicAdd(&bar[XB_TMO], 1u); break; } }
    }
    nloc = mine > 0u ? mine : 1u; nx = cnt > 0u ? cnt : 1u;
}

__device__ __forceinline__ void xcd_barrier(const XcdBarrier& b) {
    asm volatile("s_waitcnt vmcnt(0)" ::: "memory");
    __syncthreads();
    if (threadIdx.x == 0) {
        unsigned* bar = b.bar;
        __builtin_amdgcn_s_waitcnt(0);
        unsigned nloc = b.st[0], nx = b.st[1];
        if (nloc == 0u) { xcd_barrier_complete(bar, b.x, nloc, nx); b.st[0] = nloc; b.st[1] = nx; }
        const unsigned old = xb_add(&bar[XB_XSUB(b.x)], 1u);
        const unsigned gen = old / nloc;
        if (old + 1u == (gen + 1u) * nloc) {
            __builtin_amdgcn_fence(__ATOMIC_RELEASE, "agent");
            asm volatile("s_waitcnt vmcnt(0)" ::: "memory");
            const unsigned og = xb_add(&bar[XB_TOP], 1u);
            const unsigned tg = og / nx;
            if (og + 1u == (tg + 1u) * nx) xb_add(&bar[XB_TOPGEN], 1u);
            else XB_SPIN(xb_ld(&bar[XB_TOPGEN]) == tg, bar);
            __builtin_amdgcn_fence(__ATOMIC_ACQUIRE, "agent");
            xb_add(&bar[XB_XGEN(b.x)], 1u);
            asm volatile("s_waitcnt vmcnt(0)" ::: "memory");
        } else {
            XB_SPIN(xb_ld(&bar[XB_XGEN(b.x)]) == gen, bar);
            __builtin_amdgcn_fence(__ATOMIC_ACQUIRE, "agent");
            asm volatile("s_waitcnt vmcnt(0)" ::: "memory");
        }
    }
    __syncthreads();
}

__global__ void __launch_bounds__(NTHREADS, 2) hybrid_fwd(Args args) {
    extern __shared__ __attribute__((aligned(16))) unsigned char lds_raw[];
    LAS unsigned char* lds = (LAS unsigned char*)lds_raw;
    cg::grid_group grid = cg::this_grid();
    const int tid = threadIdx.x, lane = tid & 63, wave = __builtin_amdgcn_readfirstlane(tid >> 6);
    const int G = gridDim.x;
    unsigned char* ws = args.ws;
    const int lo = args.ph_lo, hi = args.ph_hi;
    volatile LAS unsigned* MISC = (volatile LAS unsigned*)(lds + MISC_OFF);
    if (tid < 2) MISC[tid] = 0u;
    __syncthreads();
    const XcdBarrier bar = xcd_barrier_post((unsigned*)ws, MISC);
#define IN(k) (lo <= (k) && (k) < hi)
#define SEAM(k) do { if (IN(k) && IN((k) + 1)) { xcd_barrier(bar); } } while (0)
    if (lo < 0) grid.sync();
    if (IN(0)) { p0_prologue<0>(args, lds, wave, lane, (int)blockIdx.x * NWAVES + wave, G * NWAVES); asm volatile("s_waitcnt vmcnt(0) lgkmcnt(0)" ::: "memory"); __syncthreads(); }
    SEAM(0);
    if (IN(1)) {
        pg8::Gemm g{(const pg8::bf16_t*)(ws + WS_H), (const pg8::bf16_t*)(ws + WS_WIN), M, 6144, D, D}; pg8::StaticOrder S; S.init(M, 6144, G, (int)blockIdx.x);
        pg8::EpiProj E{(pg8::bf16_t*)(ws + WS_QS), (pg8::bf16_t*)(ws + WS_VH), (pg8::bf16_t*)(ws + WS_SK), (pg8::bf16_t*)((unsigned char*)args.out + 32 * MiB), ws + WS_GH, ws + WS_GA, ws + WS_GB, (_Float16*)args.out,
                       args.in[3], args.in[5], args.in[6], 0};
        pg8::gemm_phase<pg8::EpiProj, pg8::StaticOrder, true, true>(lds, g, S, E);
        pg8::Gemm g2{(const pg8::bf16_t*)(ws + WS_WIN) + (size_t)6144 * 1024, (const pg8::bf16_t*)(ws + WS_H), 1024, M, D, D}; pg8::StaticOrder S2; S2.init(1024, M, G, (int)blockIdx.x);
        pg8::EpiVT E2{(pg8::bf16_t*)((unsigned char*)args.out + 32 * MiB)};
        pg8::gemm_phase<pg8::EpiVT, pg8::StaticOrder, true, true>(lds, g2, S2, E2);
    }
    SEAM(1);
    if (IN(2)) {
        const pg8::Gemm gg{(const pg8::bf16_t*)(ws + WS_H), (const pg8::bf16_t*)(ws + WS_WIN) + (size_t)7168 * 1024, M, 2048, D, D};
        const pg8::EpiProj EG{(pg8::bf16_t*)(ws + WS_QS), (pg8::bf16_t*)(ws + WS_VH), (pg8::bf16_t*)(ws + WS_SK), (pg8::bf16_t*)((unsigned char*)args.out + 32 * MiB), ws + WS_GH, ws + WS_GA, ws + WS_GB, (_Float16*)args.out,
                              args.in[3], args.in[5], args.in[6], 28};
        constexpr int NUNITS = BATCH * 16 * (SEQ / 32);
        if (G == 256) {
            pg8::ListOrder S; S.s.init(M, 2048, 256, 0);
            if ((int)blockIdx.x < 64) { hgrn_v2(args, lds, (int)blockIdx.x, 64); if (wave < 6) p0_prologue<1>(args, lds, wave, lane, 1536 + (int)blockIdx.x * 6 + wave, 1920); S.l0 = -1; S.l1 = -1; S.l2 = -1; }
            else { const int idx = (int)blockIdx.x - 64;
                if (idx < 128) attn_mfma(args, idx * 40 + wave, 5, NWAVES); else attn_mfma(args, 5120 + (idx - 128) * 48 + wave, 6, NWAVES);
                p0_prologue<1>(args, lds, wave, lane, idx * NWAVES + wave, 1920);
                S.l0 = idx; S.l1 = 192 + idx; S.l2 = idx < 128 ? 384 + idx : -1; }
            asm volatile("s_waitcnt vmcnt(0) lgkmcnt(0)" ::: "memory"); __syncthreads();
            pg8::gemm_phase<pg8::EpiProj, pg8::ListOrder, true, true>(lds, gg, S, EG);
        } else {
            const int gw = (int)blockIdx.x * NWAVES + wave, ngw = G * NWAVES;
            hgrn_v2(args, lds, (int)blockIdx.x, G); attn_mfma(args, gw, (NUNITS - gw + ngw - 1) / ngw, ngw); p0_prologue<1>(args, lds, wave, lane, gw, ngw);
            asm volatile("s_waitcnt vmcnt(0) lgkmcnt(0)" ::: "memory"); __syncthreads();
            pg8::StaticOrder S; S.init(M, 2048, G, (int)blockIdx.x);
            pg8::gemm_phase<pg8::EpiProj, pg8::StaticOrder, true, true>(lds, gg, S, EG);
        }
        __syncthreads();
    }
    SEAM(2);
    if (IN(3)) {
        pg8::Gemm g{(const pg8::bf16_t*)(ws + WS_QS), (const pg8::bf16_t*)(ws + WS_WHS), M, D, 1024, 2048}; pg8::SplitOrder S; S.s.init(M, D, G, (int)blockIdx.x);
        pg8::EpiMix E{ws + WS_GA, ws + WS_GB, (pg8::bf16_t*)(ws + WS_MIXED)};
        pg8::gemm_phase<pg8::EpiMix, pg8::SplitOrder, true, true>(lds, g, S, E);
    }
    SEAM(3);
    if (IN(4)) {
        pg8::Gemm g{(const pg8::bf16_t*)(ws + WS_MIXED), (const pg8::bf16_t*)(ws + WS_WO), M, D, D, D}; pg8::StaticOrder S; S.init(M, D, G, (int)blockIdx.x);
        pg8::EpiRes1 E{args.in[0], (pg8::bf16_t*)(ws + WS_GA), (pg8::bf16_t*)(ws + WS_X1B), (float*)(ws + WS_SSQ)};
        pg8::gemm_phase<pg8::EpiRes1, pg8::StaticOrder, true, true>(lds, g, S, E);
    }
    SEAM(4);
    if (IN(5)) {
        pg8::Gemm g{(const pg8::bf16_t*)(ws + WS_X1B), (const pg8::bf16_t*)(ws + WS_WF1), M, 2 * FFH, D, D}; pg8::StaticOrder S; S.init(M, 2 * FFH, G, (int)blockIdx.x);
        pg8::EpiSwiglu E{(const float*)(ws + WS_SSQ), (pg8::bf16_t*)(ws + WS_ACT)};
        pg8::gemm_phase<pg8::EpiSwiglu, pg8::StaticOrder, true, true>(lds, g, S, E);
    }
    SEAM(5);
    if (IN(6)) {
        pg8::Gemm g{(const pg8::bf16_t*)(ws + WS_ACT), (const pg8::bf16_t*)(ws + WS_WF2), M, D, FFH, FFH}; pg8::StaticOrder S; S.init(M, D, G, (int)blockIdx.x);
        pg8::EpiRes2 E{args.in[0], (const pg8::bf16_t*)(ws + WS_GA), args.out};
        pg8::gemm_phase<pg8::EpiRes2, pg8::StaticOrder, true, true>(lds, g, S, E);
    }
#undef IN
#undef SEAM
}

#ifndef MK_N_LAUNCHES
#define MK_N_LAUNCHES 1
#endif
extern "C" void kernel_launch(void* const* d_in, const int* in_sizes, int n_in, void* d_out, int out_size, void* d_ws, size_t ws_size, hipStream_t stream) {
    static int grid = 0;
    if (grid == 0) {
        int dev = 0, cus = 0, per_cu = 0;
        if (n_in != 13 || ws_size < WS_END) { fprintf(stderr, "kernel_launch: unexpected inputs / workspace (%d, %zu)\n", n_in, ws_size); grid = -1; return; }
        hipGetDevice(&dev); hipDeviceGetAttribute(&cus, hipDeviceAttributeMultiprocessorCount, dev);
        if (hipFuncSetAttribute((const void*)hybrid_fwd, hipFuncAttributeMaxDynamicSharedMemorySize, LDS_BYTES) != hipSuccess) { fprintf(stderr, "kernel_launch: hipFuncSetAttribute failed\n"); grid = -1; return; }
        if (hipOccupancyMaxActiveBlocksPerMultiprocessor(&per_cu, (const void*)hybrid_fwd, NTHREADS, LDS_BYTES) != hipSuccess || per_cu < 1) { fprintf(stderr, "kernel_launch: occupancy query says %d\n", per_cu); per_cu = 1; }
        (void)hipGetLastError();
        grid = cus * per_cu;
    }
    if (grid < 0) return;
    if (hipMemsetAsync(d_ws, 0, 16384, stream) != hipSuccess) { fprintf(stderr, "kernel_launch: memset of the barrier words failed\n"); return; }
    Args a{};
    for (int i = 0; i < 13; ++i) a.in[i] = (const float*)d_in[i];
    a.out = (float*)d_out; a.ws = (unsigned char*)d_ws;
#if MK_N_LAUNCHES == 1
    a.ph_lo = 0; a.ph_hi = 7;
    void* kargs[] = {&a};
    hipError_t e = hipLaunchCooperativeKernel((const void*)hybrid_fwd, dim3(grid), dim3(NTHREADS), kargs, LDS_BYTES, stream);
    if (e != hipSuccess) fprintf(stderr, "cooperative launch failed: %s (grid %d)\n", hipGetErrorString(e), grid);
#else
    for (int p = 0; p < 7; ++p) { a.ph_lo = p; a.ph_hi = p + 1; hipLaunchKernelGGL(hybrid_fwd, dim3(grid), dim3(NTHREADS), LDS_BYTES, stream, a); }
#endif
}
```

```cpp
#include <hip/hip_runtime.h>
#include <hip/hip_cooperative_groups.h>
#include <cstdio>
#include <cstdint>
namespace cg = cooperative_groups;
namespace pg8 {
#define PG8_LAS __attribute__((address_space(3)))
typedef unsigned short bf16_t;
typedef short bf16x8 __attribute__((ext_vector_type(8)));
typedef float f32x4 __attribute__((ext_vector_type(4)));
typedef unsigned u32x4 __attribute__((ext_vector_type(4)));
constexpr int BM = 256, BK = 64, HALF = 128, HTB = HALF * BK * 2  , STAGE_BYTES = 8 * HTB, NXCD = 8, WGM = 8;

__host__ __device__ __forceinline__ int lds_byte(int r, int c) { const int st = (r >> 4) * 2 + (c >> 5), rr = r & 15, cc = c & 31, ob = rr * 64 + cc * 2; return st * 1024 + (ob ^ (((ob >> 9) & 1) << 5)); }
__host__ __device__ __forceinline__ void stage_rc(int b, int& R, int& C) { const int st = b / 1024, sb = b % 1024, swz = sb ^ (((sb >> 9) & 1) << 5); R = (st >> 1) * 16 + swz / 64; C = (st & 1) * 32 + (swz % 64) / 2; }
__host__ __device__ __forceinline__ int perm32(int rho) { const int n = rho >> 4, i = rho & 15; return 8 * (i >> 2) + 4 * n + (i & 3); }

struct Unit { int pm, pn, kh; };
struct Gemm { const bf16_t* A; const bf16_t* Bt; int M, N, K, ld; };

struct StaticOrder {
    int nM, nN, nwg, G, c;
    __host__ __device__ void init(int M, int N, int G_, int c_) { nM = M / BM; nN = N / BM; nwg = nM * nN; G = G_; c = c_; }
    __host__ __device__ bool next(int i, Unit& u) const { const long L = (long)i * G + c; if (L >= nwg) return false; return unit_of((int)L, u); }
    __host__ __device__ bool unit_of(int L, Unit& u) const {
        int wgid = L; { const int q = nwg / NXCD, r = nwg % NXCD, xcd = wgid % NXCD, off = wgid / NXCD; wgid = (xcd < r ? xcd * (q + 1) : r * (q + 1) + (xcd - r) * q) + off; }
        const int nig = WGM * nN, gid = wgid / nig, fm = gid * WGM, gsz = (nM - fm) < WGM ? (nM - fm) : WGM;
        u.pm = fm + ((wgid % nig) % gsz); u.pn = (wgid % nig) / gsz; u.kh = 0; return true;
    }
    __device__ __forceinline__ void a_ready(const Unit&) const {}
    __device__ __forceinline__ void done(const Unit&) const {}
};
struct ListOrder {
    StaticOrder s; int l0, l1, l2;
    __host__ __device__ bool next(int i, Unit& u) const { const int L = i == 0 ? l0 : (i == 1 ? l1 : (i == 2 ? l2 : -1)); if (L < 0 || L >= s.nwg) return false; return s.unit_of(L, u); }
    __device__ __forceinline__ void a_ready(const Unit&) const {}
    __device__ __forceinline__ void done(const Unit&) const {}
};
struct SplitOrder {
    StaticOrder s;
    __host__ __device__ bool next(int i, Unit& u) const { const bool ok = s.next(i >> 1, u); u.kh = i & 1; return ok; }
    __device__ __forceinline__ void a_ready(const Unit&) const {}
    __device__ __forceinline__ void done(const Unit&) const {}
};
typedef float f32x2_cv __attribute__((ext_vector_type(2))); typedef __bf16 bf16x2_cvv __attribute__((ext_vector_type(2)));
__device__ __forceinline__ unsigned cvt_pk_bf16(float lo, float hi) { const f32x2_cv v = {lo, hi}; return __builtin_bit_cast(unsigned, __builtin_convertvector(v, bf16x2_cvv)); }
typedef float f32x2 __attribute__((ext_vector_type(2)));
typedef _Float16 f16x8 __attribute__((ext_vector_type(8)));
typedef unsigned u32x2 __attribute__((ext_vector_type(2)));
__device__ __forceinline__ float sigm(float x) { return __builtin_amdgcn_rcpf(1.0f + __expf(-x)); }
__device__ __forceinline__ unsigned q8(float s) { float q = s * 255.0f + 0.5f; q = q < 1.0f ? 1.0f : (q > 255.0f ? 255.0f : q); return (unsigned)q; }
__device__ __forceinline__ u32x4 pack8_bf16(const float (&o)[8]) { u32x4 w; w.x = cvt_pk_bf16(o[0], o[1]); w.y = cvt_pk_bf16(o[2], o[3]); w.z = cvt_pk_bf16(o[4], o[5]); w.w = cvt_pk_bf16(o[6], o[7]); return w; }
__device__ __forceinline__ u32x2 pack8_u8(const float (&o)[8]) { u32x2 w; w.x = q8(o[0]) | (q8(o[1]) << 8) | (q8(o[2]) << 16) | (q8(o[3]) << 24); w.y = q8(o[4]) | (q8(o[5]) << 8) | (q8(o[6]) << 16) | (q8(o[7]) << 24); return w; }

struct EpiProj {
    static constexpr bool PERM = true, AFTER_DRAIN = false, KSPLIT = false;
    bf16_t* QS; bf16_t* VH; bf16_t* SK; bf16_t* SV; unsigned char* GH; unsigned char* GA; unsigned char* GB; _Float16* LOGF;
    const float* lbl; const float* qg; const float* kg; int pn0;
    __device__ __forceinline__ void operator()(const f32x4 (&acc)[2][2][4][2], const Unit& u, int wr, int wc, int fr, int fq) const {
        const int sec = (u.pn + pn0) >> 2, ct = (u.pn & 3) * 256;
        const int row0 = u.pm * BM + wr * 64 + fr;
        if (sec == 4 || sec == 5) {
            const int head = (u.pn & 3) * 4 + wc; const float* gp = (sec == 4 ? qg : kg) + head * 64 + 8 * fq;
            float gn[2][8];
#pragma unroll
            for (int bj = 0; bj < 2; ++bj) { const f32x4 a = *(const f32x4*)(gp + 32 * bj), b = *(const f32x4*)(gp + 32 * bj + 4);
                gn[bj][0] = a[0]; gn[bj][1] = a[1]; gn[bj][2] = a[2]; gn[bj][3] = a[3]; gn[bj][4] = b[0]; gn[bj][5] = b[1]; gn[bj][6] = b[2]; gn[bj][7] = b[3]; }
            const float sc = (sec == 4) ? 0.125f * 1.4426950408889634f : 1.0f;
#pragma unroll
            for (int ai = 0; ai < 2; ++ai)
#pragma unroll
                for (int m = 0; m < 4; ++m) {
                    float ss = 0.f;
#pragma unroll
                    for (int bj = 0; bj < 2; ++bj)
#pragma unroll
                        for (int n = 0; n < 2; ++n) { const f32x4 x = acc[ai][bj][m][n]; ss += (x[0] * x[0] + x[1] * x[1]) + (x[2] * x[2] + x[3] * x[3]); }
                    ss += __shfl_xor(ss, 16); ss += __shfl_xor(ss, 32);
                    const float rstd = __builtin_amdgcn_rsqf(ss * (1.0f / 64.0f) + 1e-6f) * sc;
                    const size_t row = (size_t)(row0 + ai * HALF + m * 16);
#pragma unroll
                    for (int bj = 0; bj < 2; ++bj) { float o[8];
#pragma unroll
                        for (int k = 0; k < 8; ++k) o[k] = acc[ai][bj][m][k >> 2][k & 3] * rstd * gn[bj][k];
                        bf16_t* dst = (sec == 4) ? (QS + row * 2048 + 1024 + head * 64 + 32 * bj + 8 * fq) : (SK + row * 1024 + head * 64 + 32 * bj + 8 * fq);
                        *(u32x4*)dst = pack8_bf16(o); }
                }
            return;
        }
#pragma unroll
        for (int bj = 0; bj < 2; ++bj) {
            const int col = ct + bj * HALF + wc * 32 + 8 * fq;
            float lb[8];
            if (sec == 1) {
#pragma unroll
                for (int k = 0; k < 8; ++k) lb[k] = 1.0f / (1.0f + __expf(lbl[1024 + col + k] - lbl[col + k]));
            }
#pragma unroll
            for (int ai = 0; ai < 2; ++ai)
#pragma unroll
                for (int m = 0; m < 4; ++m) {
                    const size_t row = (size_t)(row0 + ai * HALF + m * 16);
                    float o[8];
#pragma unroll
                    for (int k = 0; k < 8; ++k) o[k] = acc[ai][bj][m][k >> 2][k & 3];
                    if (sec == 0) { *(u32x4*)(QS + row * 2048 + col) = pack8_bf16(o); }
                    else if (sec == 2) { *(u32x4*)(VH + row * 1024 + col) = pack8_bf16(o); }
                    else if (sec == 6) { bf16_t* vt = SV + ((size_t)((row >> 11) * 16 + (col >> 6)) * 64 + (col & 63)) * 2048 + (row & 2047);
#pragma unroll
                        for (int k = 0; k < 8; ++k) vt[(size_t)k * 2048] = (bf16_t)(cvt_pk_bf16(o[k], o[k]) & 0xffffu); }
                    else if (sec == 1) { f16x8 g;
#pragma unroll
                        for (int k = 0; k < 8; ++k) g[k] = (_Float16)__logf(lb[k] + (1.0f - lb[k]) * sigm(o[k]));
                        *(f16x8*)(LOGF + row * 1024 + col) = g; }
                    else {
#pragma unroll
                        for (int k = 0; k < 8; ++k) o[k] = sigm(o[k]);
                        unsigned char* dst = (sec == 3) ? GH : (sec == 7 ? GA : GB);
                        *(u32x2*)(dst + row * 1024 + col) = pack8_u8(o); }
                }
        }
    }
};
struct EpiVT {
    static constexpr bool PERM = true, AFTER_DRAIN = false, KSPLIT = false;
    bf16_t* VT;
    __device__ __forceinline__ void operator()(const f32x4 (&acc)[2][2][4][2], const Unit& u, int wr, int wc, int fr, int fq) const {
        const int row0 = u.pm * BM + wr * 64 + fr;
#pragma unroll
        for (int ai = 0; ai < 2; ++ai)
#pragma unroll
            for (int m = 0; m < 4; ++m)
#pragma unroll
                for (int bj = 0; bj < 2; ++bj) {
                    const int r = row0 + ai * HALF + m * 16, c = u.pn * BM + bj * HALF + wc * 32 + 8 * fq;
                    float o[8];
#pragma unroll
                    for (int k = 0; k < 8; ++k) o[k] = acc[ai][bj][m][k >> 2][k & 3];
                    *(u32x4*)(VT + ((size_t)((c >> 11) * 16 + (r >> 6)) * 64 + (r & 63)) * 2048 + (c & 2047)) = pack8_bf16(o);
                }
    }
};
struct EpiMix {
    static constexpr bool PERM = true, AFTER_DRAIN = false, KSPLIT = true;
    const unsigned char* GA; const unsigned char* GB; bf16_t* MIXED;
    __device__ __forceinline__ void half0(f32x4 (&acc)[2][2][4][2], const Unit& u, int wr, int wc, int fr, int fq) const {
        const int row0 = u.pm * BM + wr * 64 + fr;
#pragma unroll
        for (int ai = 0; ai < 2; ++ai)
#pragma unroll
            for (int m = 0; m < 4; ++m)
#pragma unroll
                for (int bj = 0; bj < 2; ++bj) {
                    const size_t off = (size_t)(row0 + ai * HALF + m * 16) * 1024 + u.pn * BM + bj * HALF + wc * 32 + 8 * fq;
                    const u32x2 a = *(const u32x2*)(GA + off), b = *(const u32x2*)(GB + off);
#pragma unroll
                    for (int k = 0; k < 8; ++k) { const float qa = (float)((a[k >> 2] >> (8 * (k & 3))) & 255u), qb = (float)((b[k >> 2] >> (8 * (k & 3))) & 255u);
                        acc[ai][bj][m][k >> 2][k & 3] *= qa * __builtin_amdgcn_rcpf(qb); }
                    if (bj == 1 && (m & 1)) asm volatile("" ::: "memory");
                }
    }
    __device__ __forceinline__ void operator()(f32x4 (&acc)[2][2][4][2], const Unit& u, int wr, int wc, int fr, int fq) const {
        if (u.kh == 0) { half0(acc, u, wr, wc, fr, fq); return; }
        const int row0 = u.pm * BM + wr * 64 + fr;
#pragma unroll
        for (int ai = 0; ai < 2; ++ai)
#pragma unroll
            for (int m = 0; m < 4; ++m)
#pragma unroll
                for (int bj = 0; bj < 2; ++bj) {
                    const size_t off = (size_t)(row0 + ai * HALF + m * 16) * 1024 + u.pn * BM + bj * HALF + wc * 32 + 8 * fq;
                    const u32x2 b = *(const u32x2*)(GB + off); float o[8];
#pragma unroll
                    for (int k = 0; k < 8; ++k) { const float qb = (float)((b[k >> 2] >> (8 * (k & 3))) & 255u); o[k] = acc[ai][bj][m][k >> 2][k & 3] * (qb * (1.0f / 255.0f)); }
                    *(u32x4*)(MIXED + off) = pack8_bf16(o);
                }
    }
};
struct EpiRes1 {
    static constexpr bool PERM = true, AFTER_DRAIN = false, KSPLIT = false;
    const float* x; bf16_t* DL; bf16_t* X1B; float* SSQ;
    __device__ __forceinline__ void operator()(const f32x4 (&acc)[2][2][4][2], const Unit& u, int wr, int wc, int fr, int fq) const {
        const int row0 = u.pm * BM + wr * 64 + fr;
#pragma unroll
        for (int ai = 0; ai < 2; ++ai)
#pragma unroll
            for (int m = 0; m < 4; ++m) {
                const int row = row0 + ai * HALF + m * 16; float ss = 0.f;
#pragma unroll
                for (int bj = 0; bj < 2; ++bj) {
                    const size_t off = (size_t)row * 1024 + u.pn * BM + bj * HALF + wc * 32 + 8 * fq;
                    const f32x4 v0 = *(const f32x4*)(x + off) + acc[ai][bj][m][0], v1 = *(const f32x4*)(x + off + 4) + acc[ai][bj][m][1];
                    { const f32x4 a0 = acc[ai][bj][m][0], a1 = acc[ai][bj][m][1]; u32x4 dw; dw.x = cvt_pk_bf16(a0[0], a0[1]); dw.y = cvt_pk_bf16(a0[2], a0[3]); dw.z = cvt_pk_bf16(a1[0], a1[1]); dw.w = cvt_pk_bf16(a1[2], a1[3]); *(u32x4*)(DL + off) = dw; }
                    u32x4 w; w.x = cvt_pk_bf16(v0[0], v0[1]); w.y = cvt_pk_bf16(v0[2], v0[3]); w.z = cvt_pk_bf16(v1[0], v1[1]); w.w = cvt_pk_bf16(v1[2], v1[3]);
                    *(u32x4*)(X1B + off) = w;
                    ss += (v0[0] * v0[0] + v0[1] * v0[1]) + (v0[2] * v0[2] + v0[3] * v0[3]) + (v1[0] * v1[0] + v1[1] * v1[1]) + (v1[2] * v1[2] + v1[3] * v1[3]);
                }
                ss += __shfl_xor(ss, 16); ss += __shfl_xor(ss, 32);
                if (fq == 0) SSQ[(size_t)row * 16 + u.pn * 4 + wc] = ss;
            }
    }
};
struct EpiSwiglu {
    static constexpr bool PERM = true, AFTER_DRAIN = false, KSPLIT = false;
    const float* SSQ; bf16_t* ACT;
    __device__ __forceinline__ void operator()(const f32x4 (&acc)[2][2][4][2], const Unit& u, int wr, int wc, int fr, int fq) const {
        const int row0 = u.pm * BM + wr * 64 + fr;
#pragma unroll
        for (int ai = 0; ai < 2; ++ai)
#pragma unroll
            for (int m = 0; m < 4; ++m) {
                const int row = row0 + ai * HALF + m * 16;
                const f32x4* sp = (const f32x4*)(SSQ + (size_t)row * 16);
                const f32x4 s0 = sp[0], s1 = sp[1], s2 = sp[2], s3 = sp[3];
                const float ss = ((s0[0] + s0[1]) + (s0[2] + s0[3])) + ((s1[0] + s1[1]) + (s1[2] + s1[3])) + ((s2[0] + s2[1]) + (s2[2] + s2[3])) + ((s3[0] + s3[1]) + (s3[2] + s3[3]));
                const float rstd = __builtin_amdgcn_rsqf(ss * (1.0f / 1024.0f) + 1e-6f);
                float o[8];
#pragma unroll
                for (int k = 0; k < 8; ++k) { const float g = acc[ai][0][m][k >> 2][k & 3] * rstd, up = acc[ai][1][m][k >> 2][k & 3] * rstd; o[k] = g * sigm(g) * up; }
                *(u32x4*)(ACT + (size_t)row * 2816 + u.pn * 128 + wc * 32 + 8 * fq) = pack8_bf16(o);
            }
    }
};
struct EpiRes2 {
    static constexpr bool PERM = true, AFTER_DRAIN = false, KSPLIT = false;
    const float* x; const bf16_t* DL; float* out;
    __device__ __forceinline__ void operator()(const f32x4 (&acc)[2][2][4][2], const Unit& u, int wr, int wc, int fr, int fq) const {
        const int row0 = u.pm * BM + wr * 64 + fr;
#pragma unroll
        for (int ai = 0; ai < 2; ++ai)
#pragma unroll
            for (int m = 0; m < 4; ++m)
#pragma unroll
                for (int bj = 0; bj < 2; ++bj) {
                    const size_t off = (size_t)(row0 + ai * HALF + m * 16) * 1024 + u.pn * BM + bj * HALF + wc * 32 + 8 * fq;
                    const u32x4 dw = *(const u32x4*)(DL + off);
                    f32x4 d0, d1; d0[0] = __builtin_bit_cast(float, dw.x << 16); d0[1] = __builtin_bit_cast(float, dw.x & 0xffff0000u); d0[2] = __builtin_bit_cast(float, dw.y << 16); d0[3] = __builtin_bit_cast(float, dw.y & 0xffff0000u);
                    d1[0] = __builtin_bit_cast(float, dw.z << 16); d1[1] = __builtin_bit_cast(float, dw.z & 0xffff0000u); d1[2] = __builtin_bit_cast(float, dw.w << 16); d1[3] = __builtin_bit_cast(float, dw.w & 0xffff0000u);
                    const f32x4 v0 = (*(const f32x4*)(x + off) + d0) + acc[ai][bj][m][0], v1 = (*(const f32x4*)(x + off + 4) + d1) + acc[ai][bj][m][1];
                    *(f32x4*)(out + off) = v0; *(f32x4*)(out + off + 4) = v1;
                }
    }
};

template <class Epi, class Sched, bool ALIGN_EPI = false, bool SP2 = false>
__device__ __forceinline__ void gemm_phase(PG8_LAS unsigned char* lds, const Gemm g, const Sched& S, const Epi& E) {
    int tid_ = threadIdx.x; asm volatile("" : "+v"(tid_));
    const int tid = tid_, wid = __builtin_amdgcn_readfirstlane(tid >> 6), lane = tid & 63, wr = wid >> 2, wc = wid & 3, fr = lane & 15, fq = lane >> 4;
    const int K = g.K, nt = K / BK;
    unsigned voffA[2], voffB[2];
#pragma unroll
    for (int i = 0; i < 2; ++i) { int R, C; stage_rc(tid * 16 + i * 8192, R, C); const int Rb = Epi::PERM ? ((R & ~31) + perm32(R & 31)) : R;
        voffA[i] = (unsigned)(R * g.ld + C) * 2u; voffB[i] = (unsigned)(Rb * g.ld + C) * 2u; }
    const size_t kstep = (size_t)(BK * 2);
    const size_t hstep = (size_t)HALF * g.ld * 2; const size_t khb = (size_t)K * 2;
    const size_t tstep = 2 * hstep;
    const unsigned ldsw = (unsigned)wid * 1024u;
    const int aoff = lds_byte(wr * 64 + fr, fq * 8), boff = lds_byte(wc * 32 + fr, fq * 8);
#define PG8_SA(b, h) (((b) * 2 + (h)) * HTB)
#define PG8_SB(b, h) ((4 + (b) * 2 + (h)) * HTB)
#define PG8_STAGE(bufoff, gbase, voff) do { _Pragma("unroll") for (int _i = 0; _i < 2; ++_i) \
        __builtin_amdgcn_global_load_lds((const unsigned*)((const char*)(gbase) + (voff)[_i]), (PG8_LAS unsigned*)(lds + (bufoff) + ldsw + _i * 8192), 16, 0, 0); } while (0)
#define PG8_LDA(dst, b, h) do { _Pragma("unroll") for (int m = 0; m < 4; ++m) _Pragma("unroll") for (int k = 0; k < 2; ++k) dst[m][k] = *(const PG8_LAS bf16x8*)(lds + PG8_SA(b, h) + aoff + m * 2048 + k * 1024); } while (0)
#define PG8_LDB(dst, b, h) do { _Pragma("unroll") for (int n = 0; n < 2; ++n) _Pragma("unroll") for (int k = 0; k < 2; ++k) dst[n][k] = *(const PG8_LAS bf16x8*)(lds + PG8_SB(b, h) + boff + n * 2048 + k * 1024); } while (0)
#define PG8_MMA(ai, bj, At, Bt) do { __builtin_amdgcn_s_setprio(1); _Pragma("unroll") for (int m = 0; m < 4; ++m) _Pragma("unroll") for (int n = 0; n < 2; ++n) _Pragma("unroll") for (int k = 0; k < 2; ++k) \
        acc[ai][bj][m][n] = __builtin_amdgcn_mfma_f32_16x16x32_bf16(Bt[n][k], At[m][k], acc[ai][bj][m][n], 0, 0, 0); __builtin_amdgcn_s_setprio(0); } while (0)
#define PG8_WAIT_V(n) asm volatile("s_waitcnt vmcnt(" #n ")" ::: "memory")
#define PG8_WAIT_L(n) asm volatile("s_waitcnt lgkmcnt(" #n ")" ::: "memory")
#define PG8_BAR __builtin_amdgcn_s_barrier()
#define PG8_SCHED __builtin_amdgcn_sched_barrier(0)
    Unit cur, nxt; int ui = 0;
    if (!S.next(0, cur)) return;
    f32x4 acc[2][2][4][2];
#pragma unroll
    for (int a = 0; a < 2; ++a)
#pragma unroll
        for (int b = 0; b < 2; ++b)
#pragma unroll
            for (int m = 0; m < 4; ++m)
#pragma unroll
                for (int n = 0; n < 2; ++n) acc[a][b][m][n] = (f32x4){0.f, 0.f, 0.f, 0.f};
    bf16x8 At[4][2], B0[2][2], B1[2][2];
    const char* cA = (const char*)g.A + (size_t)cur.pm * tstep + cur.kh * khb; const char* cB = (const char*)g.Bt + (size_t)cur.pn * tstep + cur.kh * khb;
    S.a_ready(cur);
    if constexpr (SP2) {
        PG8_STAGE(PG8_SB(0, 0), cB, voffB); PG8_STAGE(PG8_SB(0, 1), cB + hstep, voffB); PG8_STAGE(PG8_SA(0, 0), cA, voffA); PG8_STAGE(PG8_SA(0, 1), cA + hstep, voffA);
        if (wr == 1) PG8_BAR;
        PG8_WAIT_V(2); PG8_BAR;
        PG8_STAGE(PG8_SB(1, 0), cB + kstep, voffB); PG8_STAGE(PG8_SA(1, 0), cA + kstep, voffA); PG8_STAGE(PG8_SB(1, 1), cB + hstep + kstep, voffB);
        PG8_WAIT_V(6); PG8_BAR;
    } else {
        PG8_STAGE(PG8_SB(0, 0), cB, voffB); PG8_STAGE(PG8_SA(0, 0), cA, voffA); PG8_STAGE(PG8_SB(0, 1), cB + hstep, voffB); PG8_STAGE(PG8_SA(0, 1), cA + hstep, voffA);
        if (wr == 1) PG8_BAR;
        PG8_WAIT_V(4); PG8_BAR;
        PG8_STAGE(PG8_SB(1, 0), cB + kstep, voffB); PG8_STAGE(PG8_SA(1, 0), cA + kstep, voffA); PG8_STAGE(PG8_SB(1, 1), cB + hstep + kstep, voffB);
        PG8_WAIT_V(6); PG8_BAR;
    }
    for (;;) {
        const bool has_next = S.next(ui + 1, nxt);
        const char* nA = has_next ? (const char*)g.A + (size_t)nxt.pm * tstep + nxt.kh * khb : cA; const char* nB = has_next ? (const char*)g.Bt + (size_t)nxt.pn * tstep + nxt.kh * khb : cB;
        for (int t = 0; t < nt; t += 2) {
            const bool last = (t == nt - 2);
            const char* a1 = cA + (size_t)(t + 1) * kstep;
            const char* a2 = last ? nA : cA + (size_t)(t + 2) * kstep; const char* b2 = last ? nB : cB + (size_t)(t + 2) * kstep;
            const char* a3 = a2 + kstep; const char* b3 = b2 + kstep;
            if (last && has_next) S.a_ready(nxt);
            if constexpr (SP2) {
            PG8_LDB(B0, 0, 0); PG8_LDB(B1, 0, 1); PG8_SCHED; PG8_LDA(At, 0, 0); PG8_STAGE(PG8_SA(1, 1), a1 + hstep, voffA);
            PG8_WAIT_V(8); PG8_WAIT_L(0); PG8_BAR; PG8_MMA(0, 0, At, B0); PG8_MMA(0, 1, At, B1); PG8_BAR; PG8_SCHED;
            PG8_LDA(At, 0, 1); PG8_STAGE(PG8_SB(0, 0), b2, voffB); PG8_STAGE(PG8_SB(0, 1), b2 + hstep, voffB); PG8_STAGE(PG8_SA(0, 0), a2, voffA);
            PG8_WAIT_V(8); PG8_WAIT_L(0); PG8_BAR; PG8_MMA(1, 0, At, B0); PG8_MMA(1, 1, At, B1); PG8_BAR; PG8_SCHED;
            PG8_LDB(B0, 1, 0); PG8_LDB(B1, 1, 1); PG8_SCHED; PG8_LDA(At, 1, 0); PG8_STAGE(PG8_SA(0, 1), a2 + hstep, voffA);
            PG8_WAIT_V(8); PG8_WAIT_L(0); PG8_BAR; PG8_MMA(0, 0, At, B0); PG8_MMA(0, 1, At, B1); PG8_BAR; PG8_SCHED;
            PG8_LDA(At, 1, 1); PG8_STAGE(PG8_SB(1, 0), b3, voffB); PG8_STAGE(PG8_SB(1, 1), b3 + hstep, voffB); PG8_STAGE(PG8_SA(1, 0), a3, voffA);
            PG8_WAIT_V(8); PG8_WAIT_L(0); PG8_BAR; PG8_MMA(1, 0, At, B0); PG8_MMA(1, 1, At, B1); PG8_BAR; PG8_SCHED;
            } else {
            PG8_LDB(B0, 0, 0); PG8_SCHED; PG8_LDA(At, 0, 0); PG8_STAGE(PG8_SA(1, 1), a1 + hstep, voffA);
            PG8_WAIT_L(8); PG8_BAR; PG8_WAIT_L(0); PG8_MMA(0, 0, At, B0); PG8_BAR; PG8_SCHED;
            PG8_LDB(B1, 0, 1); PG8_STAGE(PG8_SB(0, 0), b2, voffB);
            PG8_BAR; PG8_WAIT_L(0); PG8_MMA(0, 1, At, B1); PG8_BAR;
            PG8_LDA(At, 0, 1); PG8_STAGE(PG8_SA(0, 0), a2, voffA);
            PG8_BAR; PG8_WAIT_L(0); PG8_MMA(1, 0, At, B0); PG8_BAR; PG8_SCHED;
            PG8_STAGE(PG8_SB(0, 1), b2 + hstep, voffB);
            PG8_WAIT_V(6); PG8_BAR; PG8_MMA(1, 1, At, B1); PG8_BAR;
            PG8_LDB(B0, 1, 0); PG8_SCHED; PG8_LDA(At, 1, 0); PG8_STAGE(PG8_SA(0, 1), a2 + hstep, voffA);
            PG8_WAIT_L(8); PG8_BAR; PG8_WAIT_L(0); PG8_MMA(0, 0, At, B0); PG8_BAR; PG8_SCHED;
            PG8_LDB(B1, 1, 1); PG8_STAGE(PG8_SB(1, 0), b3, voffB);
            PG8_BAR; PG8_WAIT_L(0); PG8_MMA(0, 1, At, B1); PG8_BAR;
            PG8_LDA(At, 1, 1); PG8_STAGE(PG8_SA(1, 0), a3, voffA);
            PG8_BAR; PG8_WAIT_L(0); PG8_MMA(1, 0, At, B0); PG8_BAR; PG8_SCHED;
            PG8_STAGE(PG8_SB(1, 1), b3 + hstep, voffB);
            PG8_WAIT_V(6); PG8_BAR; PG8_MMA(1, 1, At, B1); PG8_BAR;
            }
        }
        if constexpr (ALIGN_EPI) { if (wr == 0) PG8_BAR; }
        if constexpr (!Epi::AFTER_DRAIN) { E(acc, cur, wr, wc, fr, fq); S.done(cur); }
        if (!has_next) break;
        if (!(Epi::KSPLIT && cur.kh == 0))
#pragma unroll
        for (int a = 0; a < 2; ++a)
#pragma unroll
            for (int b = 0; b < 2; ++b)
#pragma unroll
                for (int m = 0; m < 4; ++m)
#pragma unroll
                    for (int n = 0; n < 2; ++n) acc[a][b][m][n] = (f32x4){0.f, 0.f, 0.f, 0.f};
        cur = nxt; cA = nA; cB = nB; ++ui;
        if constexpr (ALIGN_EPI) { if (wr == 1) PG8_BAR; }
    }
    PG8_WAIT_V(0);
    if constexpr (!ALIGN_EPI) { if (wr == 0) PG8_BAR; }
    PG8_BAR;
    if constexpr (Epi::AFTER_DRAIN) { E.fused(acc, cur, wr, wc, fr, fq, lds, wid, lane); S.done(cur); }
#undef PG8_SA
#undef PG8_SB
#undef PG8_STAGE
#undef PG8_LDA
#undef PG8_LDB
#undef PG8_MMA
#undef PG8_WAIT_V
#undef PG8_WAIT_L
#undef PG8_BAR
#undef PG8_SCHED
}
}

constexpr int NWAVES = 8, NTHREADS = 512;
constexpr int BATCH = 8, SEQ = 2048, D = 1024, M = BATCH * SEQ, INW = 9216, FFH = 2816;
constexpr float EPS = 1e-6f;
constexpr size_t MiB = 1u << 20;
constexpr size_t WS_SSQ = 1 * MiB;
constexpr size_t WS_WIN = 2 * MiB;
constexpr size_t WS_WHS = 20 * MiB;
constexpr size_t WS_WO = 24 * MiB;
constexpr size_t WS_WF1 = 26 * MiB;
constexpr size_t WS_WF2 = 37 * MiB;
constexpr size_t WS_H = 43 * MiB;
constexpr size_t WS_MIXED = WS_H;
constexpr size_t WS_QS = 75 * MiB;
constexpr size_t WS_VH = 139 * MiB;
constexpr size_t WS_SK = 171 * MiB;
constexpr size_t WS_X1B = WS_SK;
constexpr size_t WS_GH = 203 * MiB, WS_GA = 219 * MiB, WS_GB = 235 * MiB;
constexpr size_t WS_ACT = 75 * MiB;
constexpr size_t WS_END = 251 * MiB;
static_assert(WS_ACT + (size_t)M * FFH * 2 <= WS_X1B, "ACT overlay");
constexpr int RING_BYTES = 131072, LDS_BYTES = 157696, MISC_OFF = LDS_BYTES - 256;

#define LAS __attribute__((address_space(3)))
typedef unsigned short bf16;
typedef unsigned v4u __attribute__((ext_vector_type(4)));
typedef float f32x4 __attribute__((ext_vector_type(4)));
__device__ __forceinline__ unsigned f2bf(float f) { unsigned u = __builtin_bit_cast(unsigned, f); return (u + 0x7fffu + ((u >> 16) & 1u)) >> 16; }
__device__ __forceinline__ unsigned pk2(float lo, float hi) { return f2bf(lo) | (f2bf(hi) << 16); }
__device__ __forceinline__ float bf2f(unsigned short b) { return __builtin_bit_cast(float, (unsigned)b << 16); }
__device__ __forceinline__ float wave_sum(float v) {
#pragma unroll
    for (int o = 1; o < 64; o <<= 1) v += __shfl_xor(v, o);
    return v;
}
struct Args { const float* in[13]; float* out; unsigned char* ws; int ph_lo, ph_hi; };

__device__ __forceinline__ void p0_transpose_item(const float* W, int N, bf16* WT, int ldT, int koff, LAS float* scr, int k0, int n0d, int n0s, const float* kscale, int lane) {
    float wv[32];
    const float* wp = W + (size_t)(k0 + (lane >> 5)) * N + n0s + (lane & 31);
#pragma unroll
    for (int i = 0; i < 32; ++i) wv[i] = wp[(size_t)(2 * i) * N];
    if (kscale) {
#pragma unroll
        for (int i = 0; i < 32; ++i) wv[i] *= kscale[k0 + 2 * i + (lane >> 5)];
    }
#pragma unroll
    for (int i = 0; i < 32; ++i) scr[(2 * i + (lane >> 5)) * 33 + (lane & 31)] = wv[i];
    asm volatile("s_waitcnt lgkmcnt(0)" ::: "memory");
    const int c = lane & 7;
#pragma unroll
    for (int j = 0; j < 4; ++j) { const int n = (lane >> 3) + 8 * j; const LAS float* s = scr + (8 * c) * 33 + n;
        v4u o; o.x = pk2(s[0 * 33], s[1 * 33]); o.y = pk2(s[2 * 33], s[3 * 33]); o.z = pk2(s[4 * 33], s[5 * 33]); o.w = pk2(s[6 * 33], s[7 * 33]);
        *(v4u*)(WT + (size_t)(n0d + n) * ldT + koff + k0 + 8 * c) = o; }
    asm volatile("s_waitcnt lgkmcnt(0)" ::: "memory");
}
template <int PART> __device__ __forceinline__ void p0_prologue(const Args& a, LAS unsigned char* lds, int wave, int lane, int gw, int NGW) {
    LAS float* scr = (LAS float*)(lds + wave * 16384);
    unsigned char* ws = a.ws;
    constexpr int I_IN = 16 * (INW / 32), I_SQ = 16 * 32, I_F1 = 16 * (2 * FFH / 32), I_F2 = (FFH / 64) * 32;
    constexpr int NITEMS = I_IN + 3 * I_SQ + I_F1 + I_F2;
    for (int it = (PART == 0 ? gw : I_IN + gw); it < (PART == 0 ? I_IN : NITEMS); it += NGW) {
        int r = it;
        if (r < I_IN) { const int nblk = INW / 32, kb = r / nblk, nb = r % nblk, n0d = 32 * nb; const int sec = n0d >> 10; int n0s = n0d;
            if (sec == 4 || sec == 5) { const int p = n0d & 255; n0s = (n0d - p) + 64 * ((p >> 5) & 3) + 32 * (p >> 7); }
            p0_transpose_item(a.in[2], INW, (bf16*)(ws + WS_WIN), 1024, 0, scr, 64 * kb, n0d, n0s, nullptr, lane); continue; } r -= I_IN;
        if (r < I_SQ) { p0_transpose_item(a.in[7], 1024, (bf16*)(ws + WS_WHS), 2048, 0, scr, 64 * (r / 32), 32 * (r % 32), 32 * (r % 32), nullptr, lane); continue; } r -= I_SQ;
        if (r < I_SQ) { p0_transpose_item(a.in[8], 1024, (bf16*)(ws + WS_WHS), 2048, 1024, scr, 64 * (r / 32), 32 * (r % 32), 32 * (r % 32), nullptr, lane); continue; } r -= I_SQ;
        if (r < I_SQ) { p0_transpose_item(a.in[9], 1024, (bf16*)(ws + WS_WO), 1024, 0, scr, 64 * (r / 32), 32 * (r % 32), 32 * (r % 32), nullptr, lane); continue; } r -= I_SQ;
        if (r < I_F1) { const int nblk = 2 * FFH / 32, kb = r / nblk, nb = r % nblk, n0d = 32 * nb, pn = n0d >> 8, p = n0d & 255; const int n0s = (p >> 7) * FFH + 128 * pn + (p & 127);
            p0_transpose_item(a.in[11], 2 * FFH, (bf16*)(ws + WS_WF1), 1024, 0, scr, 64 * kb, n0d, n0s, a.in[10], lane); continue; } r -= I_F1;
        p0_transpose_item(a.in[12], 1024, (bf16*)(ws + WS_WF2), FFH, 0, scr, 64 * (r / 32), 32 * (r % 32), 32 * (r % 32), nullptr, lane);
    }
    if (PART != 0) return;
    const float* g1 = a.in[1];
    f32x4 gv[4];
#pragma unroll
    for (int j = 0; j < 4; ++j) gv[j] = ((const f32x4*)g1)[lane + 64 * j];
    for (int m = gw; m < M; m += NGW) {
        const f32x4* xr = (const f32x4*)(a.in[0] + (size_t)m * D) + lane;
        f32x4 v[4]; float s = 0.f;
#pragma unroll
        for (int j = 0; j < 4; ++j) { v[j] = xr[64 * j]; s += (v[j].x * v[j].x + v[j].y * v[j].y) + (v[j].z * v[j].z + v[j].w * v[j].w); }
        const float rstd = __builtin_amdgcn_rsqf(wave_sum(s) * (1.f / D) + EPS);
        unsigned long long* o8 = (unsigned long long*)((bf16*)(ws + WS_H) + (size_t)m * D) + lane;
#pragma unroll
        for (int j = 0; j < 4; ++j) { const f32x4 y = v[j] * rstd * gv[j]; o8[64 * j] = (unsigned long long)pk2(y.x, y.y) | ((unsigned long long)pk2(y.z, y.w) << 32); }
    }
}

typedef short bf16x8_t __attribute__((ext_vector_type(8)));
typedef float f32x16 __attribute__((ext_vector_type(16)));
typedef unsigned u32x2_t __attribute__((ext_vector_type(2)));
typedef float f32x2_t __attribute__((ext_vector_type(2)));
typedef __bf16 bf16x2_cv __attribute__((ext_vector_type(2)));
__device__ __forceinline__ unsigned cvtpk(float lo, float hi) { const f32x2_t v = {lo, hi}; return __builtin_bit_cast(unsigned, __builtin_convertvector(v, bf16x2_cv)); }
__device__ __forceinline__ bf16x8_t pack_acc8(const f32x16& c, int p) {
    v4u w; if (p == 0) { w.x = cvtpk(c[0], c[1]); w.y = cvtpk(c[2], c[3]); w.z = cvtpk(c[4], c[5]); w.w = cvtpk(c[6], c[7]); }
    else { w.x = cvtpk(c[8], c[9]); w.y = cvtpk(c[10], c[11]); w.z = cvtpk(c[12], c[13]); w.w = cvtpk(c[14], c[15]); }
    return __builtin_bit_cast(bf16x8_t, w);
}
#define MFMA32(A, B, C) __builtin_amdgcn_mfma_f32_32x32x16_bf16((A), (B), (C), 0, 0, 0)
__device__ __forceinline__ void hgrn_mfma(const Args& a, LAS unsigned char* lds, int vblk, int nblk) {
    unsigned char* ws = a.ws;
    bf16* QS = (bf16*)(ws + WS_QS); const bf16* VH = (const bf16*)(ws + WS_VH); const unsigned char* GH = ws + WS_GH; const _Float16* LOGF = (const _Float16*)a.out;
    const float* ogain = a.in[4];
    constexpr int RS = 272, TS = 144;
    LAS unsigned char* L_QI = lds; LAS unsigned char* L_QA = lds + 64 * RS; LAS unsigned char* L_KA = lds + 2 * 64 * RS;
    LAS unsigned char* L_KST = lds + 3 * 64 * RS; LAS unsigned char* L_VT = L_KST + 128 * TS;
    LAS float* L_TQ = (LAS float*)(L_VT + 128 * TS); LAS float* L_DEC = L_TQ + 2048;     LAS float* L_SS = L_DEC + 128; LAS float* L_GN = L_SS + 256;
    const int tid = threadIdx.x, lane = tid & 63, wave = __builtin_amdgcn_readfirstlane(tid >> 6);
    const int dp = tid & 63, oct = wave, r32 = lane & 31, hi = lane >> 5, vt = wave & 3, tt = wave >> 2;
    const int kap = 16 * (r32 >> 4) + 8 * ((r32 >> 2) & 1) + 4 * ((r32 >> 3) & 1) + (r32 & 3);
    for (int item = vblk; item < BATCH * 8; item += nblk) {
        const int b = item >> 3, h = item & 7;
        f32x16 C[4];
#pragma unroll
        for (int i = 0; i < 4; ++i)
#pragma unroll
            for (int j = 0; j < 16; ++j) C[i][j] = 0.f;
        if (tid < 128) L_GN[tid] = ogain[h * 128 + tid];
        unsigned gN2[2][8], qN2[2][8], vN2[2][8];
#pragma unroll
        for (int c2 = 0; c2 < 2; ++c2) { const size_t row0 = (size_t)b * SEQ + 64 * c2 + 8 * oct;
#pragma unroll
          for (int i = 0; i < 8; ++i) { gN2[c2][i] = *(const unsigned*)(LOGF + (row0 + i) * 1024 + h * 128 + 2 * dp); qN2[c2][i] = *(const unsigned*)(QS + (row0 + i) * 2048 + h * 128 + 2 * dp); vN2[c2][i] = *(const unsigned*)(VH + (row0 + i) * 1024 + h * 128 + 2 * dp); } }
        { float run0 = 0.f, run1 = 0.f;
#pragma unroll
          for (int i = 0; i < 8; ++i) { run0 += (float)__builtin_bit_cast(_Float16, (unsigned short)(gN2[0][i] & 0xffffu)); run1 += (float)__builtin_bit_cast(_Float16, (unsigned short)(gN2[0][i] >> 16)); }
          *(LAS f32x2_t*)(L_TQ + oct * 128 + 2 * dp) = (f32x2_t){run0, run1}; }
        __syncthreads();
#pragma unroll 2
        for (int n = 0; n < SEQ / 64; ++n) {
            unsigned (&gN)[8] = gN2[n & 1]; unsigned (&qN)[8] = qN2[n & 1]; unsigned (&vN)[8] = vN2[n & 1];
            if (n + 1 < SEQ / 64) { float run0 = 0.f, run1 = 0.f;
#pragma unroll
                for (int i = 0; i < 8; ++i) { const unsigned gw_ = gN2[(n + 1) & 1][i]; run0 += (float)__builtin_bit_cast(_Float16, (unsigned short)(gw_ & 0xffffu)); run1 += (float)__builtin_bit_cast(_Float16, (unsigned short)(gw_ >> 16)); }
                *(LAS f32x2_t*)(L_TQ + ((n + 1) & 1) * 1024 + oct * 128 + 2 * dp) = (f32x2_t){run0, run1}; }
            float off0 = 0.f, off1 = 0.f, cref0 = 0.f, cref1 = 0.f, tot0 = 0.f, tot1 = 0.f;
#pragma unroll
            for (int o = 0; o < 8; ++o) { const f32x2_t tq = *(const LAS f32x2_t*)(L_TQ + (n & 1) * 1024 + o * 128 + 2 * dp);
                if (o < oct) { off0 += tq.x; off1 += tq.y; } if (o < 4) { cref0 += tq.x; cref1 += tq.y; } tot0 += tq.x; tot1 += tq.y; }
            const float xc0 = __expf(tot0), xc1 = __expf(tot1), xa0 = __expf(-cref0), xa1 = __expf(-cref1), xb0 = __expf(cref0), xb1 = __expf(cref1);
            if (oct == 0) *(LAS f32x2_t*)(L_DEC + 2 * dp) = (f32x2_t){xc0, xc1};
            float e0 = __expf(off0), e1 = __expf(off1);
            unsigned ksp0[4], ksp1[4], vsp0[4], vsp1[4];
#pragma unroll
            for (int i = 0; i < 8; ++i) {
                const float f0 = __expf((float)__builtin_bit_cast(_Float16, (unsigned short)(gN[i] & 0xffffu))), f1 = __expf((float)__builtin_bit_cast(_Float16, (unsigned short)(gN[i] >> 16)));
                e0 = fmaxf(e0 * f0, 1e-30f); e1 = fmaxf(e1 * f1, 1e-30f);
                const float r0 = __builtin_amdgcn_rcpf(e0), r1 = __builtin_amdgcn_rcpf(e1);
                const float k0 = 1.0f - f0, k1 = 1.0f - f1, q0 = __builtin_bit_cast(float, qN[i] << 16), q1 = __builtin_bit_cast(float, qN[i] & 0xffff0000u);
                const float qi0 = q0 * e0, qi1 = q1 * e1, kr0 = k0 * r0, kr1 = k1 * r1;
                const int t = 8 * oct + i;
                *(LAS unsigned*)(L_QI + t * RS + 4 * dp) = cvtpk(qi0, qi1);
                *(LAS unsigned*)(L_QA + t * RS + 4 * dp) = cvtpk(qi0 * xa0, qi1 * xa1);
                *(LAS unsigned*)(L_KA + t * RS + 4 * dp) = cvtpk(kr0 * xb0, kr1 * xb1);
                const unsigned ks = cvtpk(kr0 * xc0, kr1 * xc1);
                if (i & 1) { ksp0[i >> 1] |= ks << 16; ksp1[i >> 1] |= ks & 0xffff0000u; vsp0[i >> 1] |= vN[i] << 16; vsp1[i >> 1] |= vN[i] & 0xffff0000u; }
                else { ksp0[i >> 1] = ks & 0xffffu; ksp1[i >> 1] = ks >> 16; vsp0[i >> 1] = vN[i] & 0xffffu; vsp1[i >> 1] = vN[i] >> 16; }
            }
            *(LAS v4u*)(L_KST + (2 * dp) * TS + 16 * oct) = (v4u){ksp0[0], ksp0[1], ksp0[2], ksp0[3]}; *(LAS v4u*)(L_KST + (2 * dp + 1) * TS + 16 * oct) = (v4u){ksp1[0], ksp1[1], ksp1[2], ksp1[3]};
            *(LAS v4u*)(L_VT + (2 * dp) * TS + 16 * oct) = (v4u){vsp0[0], vsp0[1], vsp0[2], vsp0[3]}; *(LAS v4u*)(L_VT + (2 * dp + 1) * TS + 16 * oct) = (v4u){vsp1[0], vsp1[1], vsp1[2], vsp1[3]};
            __syncthreads();
            const size_t m = (size_t)b * SEQ + 64 * n + 32 * tt + r32;
            unsigned gt4[4];
#pragma unroll
            for (int a4 = 0; a4 < 4; ++a4) gt4[a4] = *(const unsigned*)(GH + m * 1024 + h * 128 + 32 * vt + 8 * a4 + 4 * hi);
            if (n + 2 < SEQ / 64) { const size_t row0 = (size_t)b * SEQ + 64 * (n + 2) + 8 * oct;
#pragma unroll
                for (int i = 0; i < 8; ++i) { gN[i] = *(const unsigned*)(LOGF + (row0 + i) * 1024 + h * 128 + 2 * dp); qN[i] = *(const unsigned*)(QS + (row0 + i) * 2048 + h * 128 + 2 * dp); vN[i] = *(const unsigned*)(VH + (row0 + i) * 1024 + h * 128 + 2 * dp); } }
#define SB() __builtin_amdgcn_sched_barrier(0)
            f32x16 O;
#pragma unroll
            for (int j = 0; j < 16; ++j) O[j] = 0.f;
            bf16x8_t Vt[4];
            {
                v4u qf[8];
#pragma unroll
                for (int i = 0; i < 8; ++i) { const LAS unsigned char* qp = L_QI + (32 * tt + r32) * RS + (32 * (i >> 1) + 16 * (i & 1) + 4 * hi) * 2;
                    const u32x2_t lo = *(const LAS u32x2_t*)qp, hi2 = *(const LAS u32x2_t*)(qp + 16); qf[i] = (v4u){lo.x, lo.y, hi2.x, hi2.y}; }
#pragma unroll
                for (int ks = 0; ks < 4; ++ks) Vt[ks] = *(const LAS bf16x8_t*)(L_VT + (32 * vt + r32) * TS + (16 * ks + 8 * hi) * 2);
                SB();
#pragma unroll
                for (int i = 0; i < 8; ++i) O = MFMA32(pack_acc8(C[i >> 1], i & 1), __builtin_bit_cast(bf16x8_t, qf[i]), O);
                SB();
            }
#pragma unroll
            for (int st = 0; st < 2; ++st) if (st <= tt) {
                f32x16 S;
#pragma unroll
                for (int j = 0; j < 16; ++j) S[j] = 0.f;
#pragma unroll
                for (int hb = 0; hb < 2; ++hb) {
                    bf16x8_t A[4], B[4];
#pragma unroll
                    for (int k4 = 0; k4 < 4; ++k4) { const int ks = 4 * hb + k4;
                        A[k4] = *(const LAS bf16x8_t*)(L_KA + (32 * st + kap) * RS + (16 * ks + 8 * hi) * 2);
                        B[k4] = *(const LAS bf16x8_t*)(L_QA + (32 * tt + r32) * RS + (16 * ks + 8 * hi) * 2); }
                    SB();
#pragma unroll
                    for (int k4 = 0; k4 < 4; ++k4) S = MFMA32(A[k4], B[k4], S);
                    SB();
                }
                if (st == tt) {
#pragma unroll
                    for (int j = 0; j < 16; ++j) { const int sl = 16 * (j >> 3) + 8 * hi + (j & 7); if (sl > r32) S[j] = 0.f; }
                }
                O = MFMA32(Vt[2 * st], pack_acc8(S, 0), O); O = MFMA32(Vt[2 * st + 1], pack_acc8(S, 1), O);
            }
#pragma unroll
            for (int dt = 0; dt < 4; ++dt) {
                f32x4 dc[4]; bf16x8_t A[4];
#pragma unroll
                for (int a4 = 0; a4 < 4; ++a4) dc[a4] = *(const LAS f32x4*)(L_DEC + 32 * dt + 8 * a4 + 4 * hi);
#pragma unroll
                for (int ks = 0; ks < 4; ++ks) A[ks] = *(const LAS bf16x8_t*)(L_KST + (32 * dt + r32) * TS + (16 * ks + 8 * hi) * 2);
                SB();
#pragma unroll
                for (int a4 = 0; a4 < 4; ++a4)
#pragma unroll
                    for (int cc = 0; cc < 4; ++cc) C[dt][4 * a4 + cc] *= dc[a4][cc];
#pragma unroll
                for (int ks = 0; ks < 4; ++ks) C[dt] = MFMA32(A[ks], Vt[ks], C[dt]);
                SB();
            }
#undef SB
            float ss = 0.f;
#pragma unroll
            for (int j = 0; j < 16; ++j) ss += O[j] * O[j];
            ss += __shfl_xor(ss, 32);
            if (hi == 0) L_SS[(tt * 4 + vt) * 32 + r32] = ss;
            __syncthreads();
            const float sst = (L_SS[(tt * 4 + 0) * 32 + r32] + L_SS[(tt * 4 + 1) * 32 + r32]) + (L_SS[(tt * 4 + 2) * 32 + r32] + L_SS[(tt * 4 + 3) * 32 + r32]);
            const float rstd = __builtin_amdgcn_rsqf(sst * (1.0f / 128.0f) + EPS);
#pragma unroll
            for (int a4 = 0; a4 < 4; ++a4) { const int v0 = h * 128 + 32 * vt + 8 * a4 + 4 * hi;
                const f32x4 gn = *(const LAS f32x4*)(L_GN + 32 * vt + 8 * a4 + 4 * hi); const unsigned gt = gt4[a4];
                float o[4];
#pragma unroll
                for (int cc = 0; cc < 4; ++cc) o[cc] = O[4 * a4 + cc] * rstd * gn[cc] * ((float)((gt >> (8 * cc)) & 255u) * (1.0f / 255.0f));
                u32x2_t w; w.x = cvtpk(o[0], o[1]); w.y = cvtpk(o[2], o[3]);
                *(u32x2_t*)(QS + m * 2048 + v0) = w; }
        }
        __syncthreads();
    }
}

__device__ __forceinline__ void hgrn_v2(const Args& a, LAS unsigned char* lds, int vblk, int nblk) {
    unsigned char* ws = a.ws;
    bf16* QS = (bf16*)(ws + WS_QS); const bf16* VH = (const bf16*)(ws + WS_VH); const unsigned char* GH = ws + WS_GH; const _Float16* LOGF = (const _Float16*)a.out;
    const float* ogain = a.in[4];
    constexpr int RS = 272, TS = 144, O_KA = 64 * RS, O_KAT = 2 * 64 * RS, O_VT = O_KAT + 128 * TS, BUFB = O_VT + 128 * TS;
    LAS float* L_TQ = (LAS float*)(lds + 2 * BUFB);
    LAS float* L_XS = L_TQ + 1024;
    LAS float* L_SS = L_XS + 512;
    LAS float* L_GN = L_SS + 512;
    const int tid = threadIdx.x, lane = tid & 63, wave = __builtin_amdgcn_readfirstlane(tid >> 6);
    const int r32 = lane & 31, hi = lane >> 5;
    const int kap = 16 * (r32 >> 4) + 8 * ((r32 >> 2) & 1) + 4 * ((r32 >> 3) & 1) + (r32 & 3);
    constexpr int NCH = SEQ / 64;
#define SB() __builtin_amdgcn_sched_barrier(0)
    for (int item = vblk; item < BATCH * 8; item += nblk) {
        const int b = item >> 3, h = item & 7;
        if (tid < 128) L_GN[tid] = ogain[h * 128 + tid];
        if (wave < 4) {
            const int vt = wave;
            f32x16 C[4];
#pragma unroll
            for (int i = 0; i < 4; ++i)
#pragma unroll
                for (int j = 0; j < 16; ++j) C[i][j] = 0.f;
            f32x16 O[2]; unsigned gt4[2][4];
#define HG_EPI(cn) do { _Pragma("unroll") for (int tt = 0; tt < 2; ++tt) { const LAS float* SSb = L_SS + ((cn) & 1) * 256; \
                const float sst = (SSb[(tt * 4 + 0) * 32 + r32] + SSb[(tt * 4 + 1) * 32 + r32]) + (SSb[(tt * 4 + 2) * 32 + r32] + SSb[(tt * 4 + 3) * 32 + r32]); \
                const float rstd = __builtin_amdgcn_rsqf(sst * (1.0f / 128.0f) + EPS); \
                const size_t m = (size_t)b * SEQ + 64 * (cn) + r32 + 32 * tt; \
                _Pragma("unroll") for (int a4 = 0; a4 < 4; ++a4) { const int v0 = h * 128 + 32 * vt + 8 * a4 + 4 * hi; \
                    const f32x4 gn = *(const LAS f32x4*)(L_GN + 32 * vt + 8 * a4 + 4 * hi); const unsigned gt = gt4[tt][a4]; float o[4]; \
                    _Pragma("unroll") for (int cc = 0; cc < 4; ++cc) o[cc] = O[tt][4 * a4 + cc] * rstd * gn[cc] * ((float)((gt >> (8 * cc)) & 255u) * (1.0f / 255.0f)); \
                    u32x2_t w; w.x = cvtpk(o[0], o[1]); w.y = cvtpk(o[2], o[3]); *(u32x2_t*)(QS + m * 2048 + v0) = w; } } } while (0)
            __syncthreads();
#pragma unroll 1
            for (int n = 0; n < NCH; ++n) {
                __syncthreads();
                if (n > 0) HG_EPI(n - 1);
                const LAS unsigned char* T = lds + (n & 1) * BUFB;
                const LAS float* XS = L_XS + (n & 1) * 256;
                const size_t m0 = (size_t)b * SEQ + 64 * n + r32;
#pragma unroll
                for (int tt = 0; tt < 2; ++tt)
#pragma unroll
                    for (int a4 = 0; a4 < 4; ++a4) gt4[tt][a4] = *(const unsigned*)(GH + (m0 + 32 * tt) * 1024 + h * 128 + 32 * vt + 8 * a4 + 4 * hi);
                bf16x8_t Cp[8]; bf16x8_t Vt[4];
#pragma unroll
                for (int ks = 0; ks < 4; ++ks) Vt[ks] = *(const LAS bf16x8_t*)(T + O_VT + (32 * vt + r32) * TS + (16 * ks + 8 * hi) * 2);
#pragma unroll
                for (int dt = 0; dt < 4; ++dt) {
#pragma unroll
                    for (int a4 = 0; a4 < 4; ++a4) { const f32x4 x1 = *(const LAS f32x4*)(XS + 32 * dt + 8 * a4 + 4 * hi);
#pragma unroll
                        for (int cc = 0; cc < 4; ++cc) C[dt][4 * a4 + cc] *= x1[cc]; }
                    Cp[2 * dt] = pack_acc8(C[dt], 0); Cp[2 * dt + 1] = pack_acc8(C[dt], 1);
                }
#pragma unroll
                for (int tt = 0; tt < 2; ++tt) {
#pragma unroll
                    for (int j = 0; j < 16; ++j) O[tt][j] = 0.f;
                    v4u qf[8];
#pragma unroll
                    for (int i = 0; i < 8; ++i) { const LAS unsigned char* qp = T + (32 * tt + r32) * RS + (32 * (i >> 1) + 16 * (i & 1) + 4 * hi) * 2;
                        const u32x2_t lo = *(const LAS u32x2_t*)qp, hi2 = *(const LAS u32x2_t*)(qp + 16); qf[i] = (v4u){lo.x, lo.y, hi2.x, hi2.y}; }
                    SB();
#pragma unroll
                    for (int i = 0; i < 8; ++i) O[tt] = MFMA32(Cp[i], __builtin_bit_cast(bf16x8_t, qf[i]), O[tt]);
                    SB();
#pragma unroll
                    for (int st = 0; st < 2; ++st) if (st <= tt) {
                        f32x16 S;
#pragma unroll
                        for (int j = 0; j < 16; ++j) S[j] = 0.f;
#pragma unroll
                        for (int hb = 0; hb < 2; ++hb) {
                            bf16x8_t A[4], B[4];
#pragma unroll
                            for (int k4 = 0; k4 < 4; ++k4) { const int ks = 4 * hb + k4;
                                A[k4] = *(const LAS bf16x8_t*)(T + O_KA + (32 * st + kap) * RS + (16 * ks + 8 * hi) * 2);
                                B[k4] = *(const LAS bf16x8_t*)(T + (32 * tt + r32) * RS + (16 * ks + 8 * hi) * 2); }
                            SB();
#pragma unroll
                            for (int k4 = 0; k4 < 4; ++k4) S = MFMA32(A[k4], B[k4], S);
                            SB();
                        }
                        if (st == tt) {
#pragma unroll
                            for (int j = 0; j < 16; ++j) { const int sl = 16 * (j >> 3) + 8 * hi + (j & 7); if (sl > r32) S[j] = 0.f; }
                        }
                        O[tt] = MFMA32(Vt[2 * st], pack_acc8(S, 0), O[tt]); O[tt] = MFMA32(Vt[2 * st + 1], pack_acc8(S, 1), O[tt]);
                    }
                    float ss = 0.f;
#pragma unroll
                    for (int j = 0; j < 16; ++j) ss += O[tt][j] * O[tt][j];
                    ss += __shfl_xor(ss, 32);
                    if (hi == 0) L_SS[(n & 1) * 256 + (tt * 4 + vt) * 32 + r32] = ss;
                }
#pragma unroll
                for (int dt = 0; dt < 4; ++dt) {
                    f32x4 x2[4]; bf16x8_t A[4];
#pragma unroll
                    for (int a4 = 0; a4 < 4; ++a4) x2[a4] = *(const LAS f32x4*)(XS + 128 + 32 * dt + 8 * a4 + 4 * hi);
#pragma unroll
                    for (int ks = 0; ks < 4; ++ks) A[ks] = *(const LAS bf16x8_t*)(T + O_KAT + (32 * dt + r32) * TS + (16 * ks + 8 * hi) * 2);
                    SB();
#pragma unroll
                    for (int ks = 0; ks < 4; ++ks) C[dt] = MFMA32(A[ks], Vt[ks], C[dt]);
#pragma unroll
                    for (int a4 = 0; a4 < 4; ++a4)
#pragma unroll
                        for (int cc = 0; cc < 4; ++cc) C[dt][4 * a4 + cc] *= x2[a4][cc];
                    SB();
                }
            }
            __syncthreads();
            HG_EPI(NCH - 1);
#undef HG_EPI
        } else {
            const int ptid = tid - 256, dp = ptid & 63, q4 = ptid >> 6;
            unsigned g2[2][16], q2[2][16], v2[2][16];
#define HG_LOAD(set, c) do { const size_t row0_ = (size_t)b * SEQ + 64 * (c) + 16 * q4; _Pragma("unroll") for (int i = 0; i < 16; ++i) { \
                g2[set][i] = *(const unsigned*)(LOGF + (row0_ + i) * 1024 + h * 128 + 2 * dp); q2[set][i] = *(const unsigned*)(QS + (row0_ + i) * 2048 + h * 128 + 2 * dp); \
                v2[set][i] = *(const unsigned*)(VH + (row0_ + i) * 1024 + h * 128 + 2 * dp); } } while (0)
#define HG_SUMS(set, c) do { float r0_ = 0.f, r1_ = 0.f; _Pragma("unroll") for (int i = 0; i < 16; ++i) { r0_ += (float)__builtin_bit_cast(_Float16, (unsigned short)(g2[set][i] & 0xffffu)); \
                r1_ += (float)__builtin_bit_cast(_Float16, (unsigned short)(g2[set][i] >> 16)); } *(LAS f32x2_t*)(L_TQ + ((c) & 1) * 512 + q4 * 128 + 2 * dp) = (f32x2_t){r0_, r1_}; } while (0)
            float e0, e1, xa0, xa1, xb0, xb1; unsigned kp0[8], kp1[8], vp0[8], vp1[8];
#define HG_BEGIN(c) do { float off0 = 0.f, off1 = 0.f, cref0 = 0.f, cref1 = 0.f, tot0 = 0.f, tot1 = 0.f; \
                _Pragma("unroll") for (int o = 0; o < 4; ++o) { const f32x2_t tq = *(const LAS f32x2_t*)(L_TQ + ((c) & 1) * 512 + o * 128 + 2 * dp); \
                    if (o < q4) { off0 += tq.x; off1 += tq.y; } if (o < 2) { cref0 += tq.x; cref1 += tq.y; } tot0 += tq.x; tot1 += tq.y; } \
                xa0 = __expf(-cref0); xa1 = __expf(-cref1); xb0 = __expf(cref0); xb1 = __expf(cref1); e0 = __expf(off0); e1 = __expf(off1); \
                if (q4 == 0) { *(LAS f32x2_t*)(L_XS + ((c) & 1) * 256 + 2 * dp) = (f32x2_t){xb0, xb1}; *(LAS f32x2_t*)(L_XS + ((c) & 1) * 256 + 128 + 2 * dp) = (f32x2_t){__expf(tot0 - cref0), __expf(tot1 - cref1)}; } } while (0)
#define HG_TOKENS(set, c, i0) do { LAS unsigned char* T_ = lds + ((c) & 1) * BUFB; _Pragma("unroll") for (int i = (i0); i < (i0) + 8; ++i) { \
                const unsigned gw_ = g2[set][i], qw_ = q2[set][i], vw_ = v2[set][i]; \
                const float f0 = __expf((float)__builtin_bit_cast(_Float16, (unsigned short)(gw_ & 0xffffu))), f1 = __expf((float)__builtin_bit_cast(_Float16, (unsigned short)(gw_ >> 16))); \
                e0 = fmaxf(e0 * f0, 1e-30f); e1 = fmaxf(e1 * f1, 1e-30f); \
                const float r0 = __builtin_amdgcn_rcpf(e0), r1 = __builtin_amdgcn_rcpf(e1); \
                const float qq0 = __builtin_bit_cast(float, qw_ << 16), qq1 = __builtin_bit_cast(float, qw_ & 0xffff0000u); \
                const int t = 16 * q4 + i; \
                *(LAS unsigned*)(T_ + t * RS + 4 * dp) = cvtpk(qq0 * e0 * xa0, qq1 * e1 * xa1); \
                const unsigned ka = cvtpk((1.0f - f0) * r0 * xb0, (1.0f - f1) * r1 * xb1); \
                *(LAS unsigned*)(T_ + O_KA + t * RS + 4 * dp) = ka; \
                if (i & 1) { kp0[i >> 1] |= ka << 16; kp1[i >> 1] |= ka & 0xffff0000u; vp0[i >> 1] |= vw_ << 16; vp1[i >> 1] |= vw_ & 0xffff0000u; } \
                else { kp0[i >> 1] = ka & 0xffffu; kp1[i >> 1] = ka >> 16; vp0[i >> 1] = vw_ & 0xffffu; vp1[i >> 1] = vw_ >> 16; } } } while (0)
#define HG_FINISH(c) do { LAS unsigned char* T_ = lds + ((c) & 1) * BUFB; \
                *(LAS v4u*)(T_ + O_KAT + (2 * dp) * TS + 32 * q4) = (v4u){kp0[0], kp0[1], kp0[2], kp0[3]}; *(LAS v4u*)(T_ + O_KAT + (2 * dp) * TS + 32 * q4 + 16) = (v4u){kp0[4], kp0[5], kp0[6], kp0[7]}; \
                *(LAS v4u*)(T_ + O_KAT + (2 * dp + 1) * TS + 32 * q4) = (v4u){kp1[0], kp1[1], kp1[2], kp1[3]}; *(LAS v4u*)(T_ + O_KAT + (2 * dp + 1) * TS + 32 * q4 + 16) = (v4u){kp1[4], kp1[5], kp1[6], kp1[7]}; \
                *(LAS v4u*)(T_ + O_VT + (2 * dp) * TS + 32 * q4) = (v4u){vp0[0], vp0[1], vp0[2], vp0[3]}; *(LAS v4u*)(T_ + O_VT + (2 * dp) * TS + 32 * q4 + 16) = (v4u){vp0[4], vp0[5], vp0[6], vp0[7]}; \
                *(LAS v4u*)(T_ + O_VT + (2 * dp + 1) * TS + 32 * q4) = (v4u){vp1[0], vp1[1], vp1[2], vp1[3]}; *(LAS v4u*)(T_ + O_VT + (2 * dp + 1) * TS + 32 * q4 + 16) = (v4u){vp1[4], vp1[5], vp1[6], vp1[7]}; } while (0)
            HG_LOAD(0, 0); HG_LOAD(1, 1);
            HG_SUMS(0, 0);
            __syncthreads();
            HG_SUMS(1, 1); HG_BEGIN(0); HG_TOKENS(0, 0, 0); HG_TOKENS(0, 0, 8); HG_FINISH(0); HG_LOAD(0, 2);
#pragma unroll 2
            for (int n = 0; n < NCH; ++n) {
                const int c = n + 1;
                __syncthreads();
                if (c < NCH) { if (c + 1 < NCH) HG_SUMS(n & 1, c + 1); HG_BEGIN(c); HG_TOKENS((n + 1) & 1, c, 0); HG_TOKENS((n + 1) & 1, c, 8); HG_FINISH(c); if (c + 2 < NCH) HG_LOAD((n + 1) & 1, c + 2); }
            }
            __syncthreads();
#undef HG_LOAD
#undef HG_SUMS
#undef HG_BEGIN
#undef HG_TOKENS
#undef HG_FINISH
        }
        __syncthreads();
    }
#undef SB
}

template <bool DIAG> __device__ __forceinline__ bool attn_tile(const bf16x8_t (&Kc)[4], const bf16x8_t (&Vc)[4], const bf16x8_t (&Qf)[4], f32x16& O0, f32x16& O1, float& carry, int r32, int hi) {
    f32x16 Sx;
#pragma unroll
    for (int j = 0; j < 16; ++j) Sx[j] = 0.f;
#pragma unroll
    for (int ks = 0; ks < 4; ++ks) Sx = MFMA32(Kc[ks], Qf[ks], Sx);
    float kp[16], sg[16];
#pragma unroll
    for (int j = 0; j < 16; ++j) {
        const float r = __builtin_amdgcn_rcpf(1.0f + __builtin_amdgcn_exp2f(Sx[j]));
        if (DIAG) { const int sl = 16 * (j >> 3) + 8 * hi + (j & 7); const bool valid = sl < r32; kp[j] = valid ? r : 1.f; sg[j] = valid ? 1.0f - r : 0.f; }
        else { kp[j] = r; sg[j] = 1.0f - r; }
    }
#pragma unroll
    for (int j = 6; j >= 0; --j) { sg[j] *= kp[j + 1]; kp[j] *= kp[j + 1]; sg[8 + j] *= kp[8 + j + 1]; kp[8 + j] *= kp[8 + j + 1]; }
    const float G0 = kp[0], G1 = kp[8];
    const float P0 = __shfl_xor(G0, 32), P1 = __shfl_xor(G1, 32);
    const float after0 = (hi == 0 ? P0 : 1.f) * P1 * G1 * carry, after1 = (hi == 0 ? P1 : 1.f) * carry;
#pragma unroll
    for (int j = 0; j < 16; ++j) sg[j] *= (j < 8 ? after0 : after1);
    carry *= (G0 * G1) * (P0 * P1);
    v4u w0, w1; w0.x = cvtpk(sg[0], sg[1]); w0.y = cvtpk(sg[2], sg[3]); w0.z = cvtpk(sg[4], sg[5]); w0.w = cvtpk(sg[6], sg[7]);
    w1.x = cvtpk(sg[8], sg[9]); w1.y = cvtpk(sg[10], sg[11]); w1.z = cvtpk(sg[12], sg[13]); w1.w = cvtpk(sg[14], sg[15]);
    const bf16x8_t Pb0 = __builtin_bit_cast(bf16x8_t, w0), Pb1 = __builtin_bit_cast(bf16x8_t, w1);
    O0 = MFMA32(Vc[0], Pb0, O0); O0 = MFMA32(Vc[1], Pb1, O0);
    O1 = MFMA32(Vc[2], Pb0, O1); O1 = MFMA32(Vc[3], Pb1, O1);
    return __all(carry == 0.f);
}
__device__ __forceinline__ void attn_mfma(const Args& a, int u0, int ucnt, int ustride) {
    unsigned char* ws = a.ws;
    bf16* QS = (bf16*)(ws + WS_QS); const bf16* SK = (const bf16*)(ws + WS_SK); const bf16* VT = (const bf16*)((unsigned char*)a.out + 32 * MiB);
    const int lane = threadIdx.x & 63, r32 = lane & 31, hi = lane >> 5;
    const int kap = 16 * (r32 >> 4) + 8 * ((r32 >> 2) & 1) + 4 * ((r32 >> 3) & 1) + (r32 & 3);
    for (int uk = 0; uk < ucnt; ++uk) { const int u = u0 + uk * ustride;
        const int qb = u & 63, bh = u >> 6, h = bh & 15, b = bh >> 4;
        const size_t rowq = (size_t)b * SEQ + 32 * qb + r32;
        bf16* qp = QS + rowq * 2048 + 1024 + 64 * h;
        const bf16* kbase = SK + ((size_t)b * SEQ + kap) * 1024 + 64 * h + 8 * hi;
        const bf16* vbase = VT + ((size_t)bh * 64 + r32) * 2048 + 8 * hi;
        bf16x8_t Qf[4];
#pragma unroll
        for (int ks = 0; ks < 4; ++ks) Qf[ks] = *(const bf16x8_t*)(qp + 16 * ks + 8 * hi);
        f32x16 O0, O1;
#pragma unroll
        for (int j = 0; j < 16; ++j) { O0[j] = 0.f; O1[j] = 0.f; }
        float carry = 1.f;
        bf16x8_t KA[4], VA[4], KB[4], VB[4];
#define ATT_LOAD(K_, V_, kb_) do { _Pragma("unroll") for (int ks = 0; ks < 4; ++ks) K_[ks] = *(const bf16x8_t*)(kbase + (size_t)(32 * (kb_)) * 1024 + 16 * ks); \
        _Pragma("unroll") for (int i = 0; i < 4; ++i) V_[i] = *(const bf16x8_t*)(vbase + (size_t)(32 * (i >> 1)) * 2048 + 32 * (kb_) + 16 * (i & 1)); } while (0)
        ATT_LOAD(KA, VA, qb);
        int kb = qb;
        ATT_LOAD(KB, VB, kb > 0 ? kb - 1 : 0);
        if (!(attn_tile<true>(KA, VA, Qf, O0, O1, carry, r32, hi) || kb == 0)) {
            --kb;
#pragma unroll 1
            for (;;) {
                ATT_LOAD(KA, VA, kb > 0 ? kb - 1 : 0);
                if (attn_tile<false>(KB, VB, Qf, O0, O1, carry, r32, hi) || kb == 0) break;
                --kb;
                ATT_LOAD(KB, VB, kb > 0 ? kb - 1 : 0);
                if (attn_tile<false>(KA, VA, Qf, O0, O1, carry, r32, hi) || kb == 0) break;
                --kb;
            }
        }
#undef ATT_LOAD
#pragma unroll
        for (int a4 = 0; a4 < 4; ++a4) {
            u32x2_t x0, x1; x0.x = cvtpk(O0[4 * a4], O0[4 * a4 + 1]); x0.y = cvtpk(O0[4 * a4 + 2], O0[4 * a4 + 3]); x1.x = cvtpk(O1[4 * a4], O1[4 * a4 + 1]); x1.y = cvtpk(O1[4 * a4 + 2], O1[4 * a4 + 3]);
            *(u32x2_t*)(qp + 8 * a4 + 4 * hi) = x0; *(u32x2_t*)(qp + 32 + 8 * a4 + 4 * hi) = x1; }
    }
}

#define XB_TMO      128
#define XB_XCNT(j)  (256  + 64 * (j))
#define XB_XSUB(j)  (1280 + 64 * (j))
#define XB_XGEN(j)  (2304 + 64 * (j))
#define XB_TOP      3328
#define XB_TOPGEN   3392
#define XCD_BAR_WORDS 3456
#define XB_SPIN_CAP (1u << 18)

__device__ __forceinline__ unsigned xb_ld(unsigned* p)              { return __hip_atomic_load(p, __ATOMIC_RELAXED, __HIP_MEMORY_SCOPE_AGENT); }
__device__ __forceinline__ unsigned xb_add(unsigned* p, unsigned v) { return __hip_atomic_fetch_add(p, v, __ATOMIC_RELAXED, __HIP_MEMORY_SCOPE_AGENT); }
__device__ __forceinline__ unsigned xb_xcc_id() { return (unsigned)__builtin_amdgcn_s_getreg((3 << 11) | 20) & 0xFu; }
#define XB_SPIN(cond, bar) do { unsigned _sp = 0; while (cond) { __builtin_amdgcn_s_sleep(1); \
    if ((++_sp & 255u) == 0u) { if (xb_ld(&(bar)[XB_TMO])) break; if (_sp > XB_SPIN_CAP) { atomicAdd(&(bar)[XB_TMO], 1u); break; } } } } while (0)

struct XcdBarrier {
    unsigned* bar; unsigned x;
    volatile LAS unsigned* st;
};

__device__ __forceinline__ XcdBarrier xcd_barrier_post(unsigned* bar, volatile LAS unsigned* st) {
    XcdBarrier b; b.bar = bar; b.x = xb_xcc_id(); b.st = st;
    if (threadIdx.x == 0) (void)xb_add(&bar[XB_XCNT(b.x)], 1u);
    return b;
}
__device__ __forceinline__ void xcd_barrier_complete(unsigned* bar, unsigned x, unsigned& nloc, unsigned& nx) {
    const unsigned G = gridDim.x * gridDim.y * gridDim.z;
    unsigned sum, cnt, mine, sp = 0u;
    for (;;) {
        sum = 0u; cnt = 0u; mine = 0u;
#pragma unroll
        for (unsigned j = 0; j < 16; ++j) { const unsigned c = xb_ld(&bar[XB_XCNT(j)]); sum += c; cnt += (c > 0u) ? 1u : 0u; mine = (j == x) ? c : mine; }
        if (sum == G) break;
        __builtin_amdgcn_s_sleep(1);
        if ((++sp & 255u) == 0u) { if (xb_ld(&bar[XB_TMO])) break; if (sp > XB_SPIN_CAP) { atomicAdd(&bar[XB_TMO], 1u); break; } }
    }
    nloc = mine > 0u ? mine : 1u; nx = cnt > 0u ? cnt : 1u;
}

__device__ __forceinline__ void xcd_barrier(const XcdBarrier& b) {
    asm volatile("s_waitcnt vmcnt(0)" ::: "memory");
    __syncthreads();
    if (threadIdx.x == 0) {
        unsigned* bar = b.bar;
        __builtin_amdgcn_s_waitcnt(0);
        unsigned nloc = b.st[0], nx = b.st[1];
        if (nloc == 0u) { xcd_barrier_complete(bar, b.x, nloc, nx); b.st[0] = nloc; b.st[1] = nx; }
        const unsigned old = xb_add(&bar[XB_XSUB(b.x)], 1u);
        const unsigned gen = old / nloc;
        if (old + 1u == (gen + 1u) * nloc) {
            __builtin_amdgcn_fence(__ATOMIC_RELEASE, "agent");
            asm volatile("s_waitcnt vmcnt(0)" ::: "memory");
            const unsigned og = xb_add(&bar[XB_TOP], 1u);
            const unsigned tg = og / nx;
            if (og + 1u == (tg + 1u) * nx) xb_add(&bar[XB_TOPGEN], 1u);
            else XB_SPIN(xb_ld(&bar[XB_TOPGEN]) == tg, bar);
            __builtin_amdgcn_fence(__ATOMIC_ACQUIRE, "agent");
            xb_add(&bar[XB_XGEN(b.x)], 1u);
            asm volatile("s_waitcnt vmcnt(0)" ::: "memory");
        } else {
            XB_SPIN(xb_ld(&bar[XB_XGEN(b.x)]) == gen, bar);
            __builtin_amdgcn_fence(__ATOMIC_ACQUIRE, "agent");
            asm volatile("s_waitcnt vmcnt(0)" ::: "memory");
        }
    }
    __syncthreads();
}

__global__ void __launch_bounds__(NTHREADS, 2) hybrid_fwd(Args args) {
    extern __shared__ __attribute__((aligned(16))) unsigned char lds_raw[];
    LAS unsigned char* lds = (LAS unsigned char*)lds_raw;
    cg::grid_group grid = cg::this_grid();
    const int tid = threadIdx.x, lane = tid & 63, wave = __builtin_amdgcn_readfirstlane(tid >> 6);
    const int G = gridDim.x;
    unsigned char* ws = args.ws;
    const int lo = args.ph_lo, hi = args.ph_hi;
    volatile LAS unsigned* MISC = (volatile LAS unsigned*)(lds + MISC_OFF);
    if (tid < 2) MISC[tid] = 0u;
    __syncthreads();
    const XcdBarrier bar = xcd_barrier_post((unsigned*)ws, MISC);
#define IN(k) (lo <= (k) && (k) < hi)
#define SEAM(k) do { if (IN(k) && IN((k) + 1)) { xcd_barrier(bar); } } while (0)
    if (lo < 0) grid.sync();
    if (IN(0)) { p0_prologue<0>(args, lds, wave, lane, (int)blockIdx.x * NWAVES + wave, G * NWAVES); asm volatile("s_waitcnt vmcnt(0) lgkmcnt(0)" ::: "memory"); __syncthreads(); }
    SEAM(0);
    if (IN(1)) {
        pg8::Gemm g{(const pg8::bf16_t*)(ws + WS_H), (const pg8::bf16_t*)(ws + WS_WIN), M, 6144, D, D}; pg8::StaticOrder S; S.init(M, 6144, G, (int)blockIdx.x);
        pg8::EpiProj E{(pg8::bf16_t*)(ws + WS_QS), (pg8::bf16_t*)(ws + WS_VH), (pg8::bf16_t*)(ws + WS_SK), (pg8::bf16_t*)((unsigned char*)args.out + 32 * MiB), ws + WS_GH, ws + WS_GA, ws + WS_GB, (_Float16*)args.out,
                       args.in[3], args.in[5], args.in[6], 0};
        pg8::gemm_phase<pg8::EpiProj, pg8::StaticOrder, true, true>(lds, g, S, E);
        pg8::Gemm g2{(const pg8::bf16_t*)(ws + WS_WIN) + (size_t)6144 * 1024, (const pg8::bf16_t*)(ws + WS_H), 1024, M, D, D}; pg8::StaticOrder S2; S2.init(1024, M, G, (int)blockIdx.x);
        pg8::EpiVT E2{(pg8::bf16_t*)((unsigned char*)args.out + 32 * MiB)};
        pg8::gemm_phase<pg8::EpiVT, pg8::StaticOrder, true, true>(lds, g2, S2, E2);
    }
    SEAM(1);
    if (IN(2)) {
        const pg8::Gemm gg{(const pg8::bf16_t*)(ws + WS_H), (const pg8::bf16_t*)(ws + WS_WIN) + (size_t)7168 * 1024, M, 2048, D, D};
        const pg8::EpiProj EG{(pg8::bf16_t*)(ws + WS_QS), (pg8::bf16_t*)(ws + WS_VH), (pg8::bf16_t*)(ws + WS_SK), (pg8::bf16_t*)((unsigned char*)args.out + 32 * MiB), ws + WS_GH, ws + WS_GA, ws + WS_GB, (_Float16*)args.out,
                              args.in[3], args.in[5], args.in[6], 28};
        constexpr int NUNITS = BATCH * 16 * (SEQ / 32);
        if (G == 256) {
            pg8::ListOrder S; S.s.init(M, 2048, 256, 0);
            if ((int)blockIdx.x < 64) { hgrn_v2(args, lds, (int)blockIdx.x, 64); if (wave < 6) p0_prologue<1>(args, lds, wave, lane, 1536 + (int)blockIdx.x * 6 + wave, 1920); S.l0 = -1; S.l1 = -1; S.l2 = -1; }
            else { const int idx = (int)blockIdx.x - 64;
                if (idx < 128) attn_mfma(args, idx * 40 + wave, 5, NWAVES); else attn_mfma(args, 5120 + (idx - 128) * 48 + wave, 6, NWAVES);
                p0_prologue<1>(args, lds, wave, lane, idx * NWAVES + wave, 1920);
                S.l0 = idx; S.l1 = 192 + idx; S.l2 = idx < 128 ? 384 + idx : -1; }
            asm volatile("s_waitcnt vmcnt(0) lgkmcnt(0)" ::: "memory"); __syncthreads();
            pg8::gemm_phase<pg8::EpiProj, pg8::ListOrder, true, true>(lds, gg, S, EG);
        } else {
            const int gw = (int)blockIdx.x * NWAVES + wave, ngw = G * NWAVES;
            hgrn_v2(args, lds, (int)blockIdx.x, G); attn_mfma(args, gw, (NUNITS - gw + ngw - 1) / ngw, ngw); p0_prologue<1>(args, lds, wave, lane, gw, ngw);
            asm volatile("s_waitcnt vmcnt(0) lgkmcnt(0)" ::: "memory"); __syncthreads();
            pg8::StaticOrder S; S.init(M, 2048, G, (int)blockIdx.x);
            pg8::gemm_phase<pg8::EpiProj, pg8::StaticOrder, true, true>(lds, gg, S, EG);
        }
        __syncthreads();
    }
    SEAM(2);
    if (IN(3)) {
        pg8::Gemm g{(const pg8::bf16_t*)(ws + WS_QS), (const pg8::bf16_t*)(ws + WS_WHS), M, D, 1024, 2048}; pg8::SplitOrder S; S.s.init(M, D, G, (int)blockIdx.x);
        pg8::EpiMix E{ws + WS_GA, ws + WS_GB, (pg8::bf16_t*)(ws + WS_MIXED)};
        pg8::gemm_phase<pg8::EpiMix, pg8::SplitOrder, true, true>(lds, g, S, E);
    }
    SEAM(3);
    if (IN(4)) {
        pg8::Gemm g{(const pg8::bf16_t*)(ws + WS_MIXED), (const pg8::bf16_t*)(ws + WS_WO), M, D, D, D}; pg8::StaticOrder S; S.init(M, D, G, (int)blockIdx.x);
        pg8::EpiRes1 E{args.in[0], (pg8::bf16_t*)(ws + WS_GA), (pg8::bf16_t*)(ws + WS_X1B), (float*)(ws + WS_SSQ)};
        pg8::gemm_phase<pg8::EpiRes1, pg8::StaticOrder, true, true>(lds, g, S, E);
    }
    SEAM(4);
    if (IN(5)) {
        pg8::Gemm g{(const pg8::bf16_t*)(ws + WS_X1B), (const pg8::bf16_t*)(ws + WS_WF1), M, 2 * FFH, D, D}; pg8::StaticOrder S; S.init(M, 2 * FFH, G, (int)blockIdx.x);
        pg8::EpiSwiglu E{(const float*)(ws + WS_SSQ), (pg8::bf16_t*)(ws + WS_ACT)};
        pg8::gemm_phase<pg8::EpiSwiglu, pg8::StaticOrder, true, true>(lds, g, S, E);
    }
    SEAM(5);
    if (IN(6)) {
        pg8::Gemm g{(const pg8::bf16_t*)(ws + WS_ACT), (const pg8::bf16_t*)(ws + WS_WF2), M, D, FFH, FFH}; pg8::StaticOrder S; S.init(M, D, G, (int)blockIdx.x);
        pg8::EpiRes2 E{args.in[0], (const pg8::bf16_t*)(ws + WS_GA), args.out};
        pg8::gemm_phase<pg8::EpiRes2, pg8::StaticOrder, true, true>(lds, g, S, E);
    }
#undef IN
#undef SEAM
}

#ifndef MK_N_LAUNCHES
#define MK_N_LAUNCHES 1
#endif
extern "C" void kernel_launch(void* const* d_in, const int* in_sizes, int n_in, void* d_out, int out_size, void* d_ws, size_t ws_size, hipStream_t stream) {
    static int grid = 0;
    if (grid == 0) {
        int dev = 0, cus = 0, per_cu = 0;
        if (n_in != 13 || ws_size < WS_END) { fprintf(stderr, "kernel_launch: unexpected inputs / workspace (%d, %zu)\n", n_in, ws_size); grid = -1; return; }
        hipGetDevice(&dev); hipDeviceGetAttribute(&cus, hipDeviceAttributeMultiprocessorCount, dev);
        if (hipFuncSetAttribute((const void*)hybrid_fwd, hipFuncAttributeMaxDynamicSharedMemorySize, LDS_BYTES) != hipSuccess) { fprintf(stderr, "kernel_launch: hipFuncSetAttribute failed\n"); grid = -1; return; }
        if (hipOccupancyMaxActiveBlocksPerMultiprocessor(&per_cu, (const void*)hybrid_fwd, NTHREADS, LDS_BYTES) != hipSuccess || per_cu < 1) { fprintf(stderr, "kernel_launch: occupancy query says %d\n", per_cu); per_cu = 1; }
        (void)hipGetLastError();
        grid = cus * per_cu;
    }
    if (grid < 0) return;
    if (hipMemsetAsync(d_ws, 0, 16384, stream) != hipSuccess) { fprintf(stderr, "kernel_launch: memset of the barrier words failed\n"); return; }
    Args a{};
    for (int i = 0; i < 13; ++i) a.in[i] = (const float*)d_in[i];
    a.out = (float*)d_out; a.ws = (unsigned char*)d_ws;
#if MK_N_LAUNCHES == 1
    a.ph_lo = 0; a.ph_hi = 7;
    void* kargs[] = {&a};
    hipError_t e = hipLaunchCooperativeKernel((const void*)hybrid_fwd, dim3(grid), dim3(NTHREADS), kargs, LDS_BYTES, stream);
    if (e != hipSuccess) fprintf(stderr, "cooperative launch failed: %s (grid %d)\n", hipGetErrorString(e), grid);
#else
    for (int p = 0; p < 7; ++p) { a.ph_lo = p; a.ph_hi = p + 1; hipLaunchKernelGGL(hybrid_fwd, dim3(grid), dim3(NTHREADS), LDS_BYTES, stream, a); }
#endif
}
```

```cpp
#include <hip/hip_runtime.h>
#include <hip/hip_cooperative_groups.h>
#include <cstdio>
#include <cstdint>
namespace cg = cooperative_groups;
namespace pg8 {
#define PG8_LAS __attribute__((address_space(3)))
typedef unsigned short bf16_t;
typedef short bf16x8 __attribute__((ext_vector_type(8)));
typedef float f32x4 __attribute__((ext_vector_type(4)));
typedef unsigned u32x4 __attribute__((ext_vector_type(4)));
constexpr int BM = 256, BK = 64, HALF = 128, HTB = HALF * BK * 2  , STAGE_BYTES = 8 * HTB, NXCD = 8, WGM = 8;

__host__ __device__ __forceinline__ int lds_byte(int r, int c) { const int st = (r >> 4) * 2 + (c >> 5), rr = r & 15, cc = c & 31, ob = rr * 64 + cc * 2; return st * 1024 + (ob ^ (((ob >> 9) & 1) << 5)); }
__host__ __device__ __forceinline__ void stage_rc(int b, int& R, int& C) { const int st = b / 1024, sb = b % 1024, swz = sb ^ (((sb >> 9) & 1) << 5); R = (st >> 1) * 16 + swz / 64; C = (st & 1) * 32 + (swz % 64) / 2; }
__host__ __device__ __forceinline__ int perm32(int rho) { const int n = rho >> 4, i = rho & 15; return 8 * (i >> 2) + 4 * n + (i & 3); }

struct Unit { int pm, pn, kh; };
struct Gemm { const bf16_t* A; const bf16_t* Bt; int M, N, K, ld; };

struct StaticOrder {
    int nM, nN, nwg, G, c;
    __host__ __device__ void init(int M, int N, int G_, int c_) { nM = M / BM; nN = N / BM; nwg = nM * nN; G = G_; c = c_; }
    __host__ __device__ bool next(int i, Unit& u) const { const long L = (long)i * G + c; if (L >= nwg) return false; return unit_of((int)L, u); }
    __host__ __device__ bool unit_of(int L, Unit& u) const {
        int wgid = L; { const int q = nwg / NXCD, r = nwg % NXCD, xcd = wgid % NXCD, off = wgid / NXCD; wgid = (xcd < r ? xcd * (q + 1) : r * (q + 1) + (xcd - r) * q) + off; }
        const int nig = WGM * nN, gid = wgid / nig, fm = gid * WGM, gsz = (nM - fm) < WGM ? (nM - fm) : WGM;
        u.pm = fm + ((wgid % nig) % gsz); u.pn = (wgid % nig) / gsz; u.kh = 0; return true;
    }
    __device__ __forceinline__ void a_ready(const Unit&) const {}
    __device__ __forceinline__ void done(const Unit&) const {}
};
struct ListOrder {
    StaticOrder s; int l0, l1, l2;
    __host__ __device__ bool next(int i, Unit& u) const { const int L = i == 0 ? l0 : (i == 1 ? l1 : (i == 2 ? l2 : -1)); if (L < 0 || L >= s.nwg) return false; return s.unit_of(L, u); }
    __device__ __forceinline__ void a_ready(const Unit&) const {}
    __device__ __forceinline__ void done(const Unit&) const {}
};
struct SplitOrder {
    StaticOrder s;
    __host__ __device__ bool next(int i, Unit& u) const { const bool ok = s.next(i >> 1, u); u.kh = i & 1; return ok; }
    __device__ __forceinline__ void a_ready(const Unit&) const {}
    __device__ __forceinline__ void done(const Unit&) const {}
};
typedef float f32x2_cv __attribute__((ext_vector_type(2))); typedef __bf16 bf16x2_cvv __attribute__((ext_vector_type(2)));
__device__ __forceinline__ unsigned cvt_pk_bf16(float lo, float hi) { const f32x2_cv v = {lo, hi}; return __builtin_bit_cast(unsigned, __builtin_convertvector(v, bf16x2_cvv)); }
typedef float f32x2 __attribute__((ext_vector_type(2)));
typedef _Float16 f16x8 __attribute__((ext_vector_type(8)));
typedef unsigned u32x2 __attribute__((ext_vector_type(2)));
__device__ __forceinline__ float sigm(float x) { return __builtin_amdgcn_rcpf(1.0f + __expf(-x)); }
__device__ __forceinline__ unsigned q8(float s) { float q = s * 255.0f + 0.5f; q = q < 1.0f ? 1.0f : (q > 255.0f ? 255.0f : q); return (unsigned)q; }
__device__ __forceinline__ u32x4 pack8_bf16(const float (&o)[8]) { u32x4 w; w.x = cvt_pk_bf16(o[0], o[1]); w.y = cvt_pk_bf16(o[2], o[3]); w.z = cvt_pk_bf16(o[4], o[5]); w.w = cvt_pk_bf16(o[6], o[7]); return w; }
__device__ __forceinline__ u32x2 pack8_u8(const float (&o)[8]) { u32x2 w; w.x = q8(o[0]) | (q8(o[1]) << 8) | (q8(o[2]) << 16) | (q8(o[3]) << 24); w.y = q8(o[4]) | (q8(o[5]) << 8) | (q8(o[6]) << 16) | (q8(o[7]) << 24); return w; }

struct EpiProj {
    static constexpr bool PERM = true, AFTER_DRAIN = false, KSPLIT = false;
    bf16_t* QS; bf16_t* VH; bf16_t* SK; bf16_t* SV; unsigned char* GH; unsigned char* GA; unsigned char* GB; _Float16* LOGF;
    const float* lbl; const float* qg; const float* kg; int pn0;
    __device__ __forceinline__ void operator()(const f32x4 (&acc)[2][2][4][2], const Unit& u, int wr, int wc, int fr, int fq) const {
        const int sec = (u.pn + pn0) >> 2, ct = (u.pn & 3) * 256;
        const int row0 = u.pm * BM + wr * 64 + fr;
        if (sec == 4 || sec == 5) {
            const int head = (u.pn & 3) * 4 + wc; const float* gp = (sec == 4 ? qg : kg) + head * 64 + 8 * fq;
            float gn[2][8];
#pragma unroll
            for (int bj = 0; bj < 2; ++bj) { const f32x4 a = *(const f32x4*)(gp + 32 * bj), b = *(const f32x4*)(gp + 32 * bj + 4);
                gn[bj][0] = a[0]; gn[bj][1] = a[1]; gn[bj][2] = a[2]; gn[bj][3] = a[3]; gn[bj][4] = b[0]; gn[bj][5] = b[1]; gn[bj][6] = b[2]; gn[bj][7] = b[3]; }
            const float sc = (sec == 4) ? 0.125f * 1.4426950408889634f : 1.0f;
#pragma unroll
            for (int ai = 0; ai < 2; ++ai)
#pragma unroll
                for (int m = 0; m < 4; ++m) {
                    float ss = 0.f;
#pragma unroll
                    for (int bj = 0; bj < 2; ++bj)
#pragma unroll
                        for (int n = 0; n < 2; ++n) { const f32x4 x = acc[ai][bj][m][n]; ss += (x[0] * x[0] + x[1] * x[1]) + (x[2] * x[2] + x[3] * x[3]); }
                    ss += __shfl_xor(ss, 16); ss += __shfl_xor(ss, 32);
                    const float rstd = __builtin_amdgcn_rsqf(ss * (1.0f / 64.0f) + 1e-6f) * sc;
                    const size_t row = (size_t)(row0 + ai * HALF + m * 16);
#pragma unroll
                    for (int bj = 0; bj < 2; ++bj) { float o[8];
#pragma unroll
                        for (int k = 0; k < 8; ++k) o[k] = acc[ai][bj][m][k >> 2][k & 3] * rstd * gn[bj][k];
                        bf16_t* dst = (sec == 4) ? (QS + row * 2048 + 1024 + head * 64 + 32 * bj + 8 * fq) : (SK + row * 1024 + head * 64 + 32 * bj + 8 * fq);
                        *(u32x4*)dst = pack8_bf16(o); }
                }
            return;
        }
#pragma unroll
        for (int bj = 0; bj < 2; ++bj) {
            const int col = ct + bj * HALF + wc * 32 + 8 * fq;
            float lb[8];
            if (sec == 1) {
#pragma unroll
                for (int k = 0; k < 8; ++k) lb[k] = 1.0f / (1.0f + __expf(lbl[1024 + col + k] - lbl[col + k]));
            }
#pragma unroll
            for (int ai = 0; ai < 2; ++ai)
#pragma unroll
                for (int m = 0; m < 4; ++m) {
                    const size_t row = (size_t)(row0 + ai * HALF + m * 16);
                    float o[8];
#pragma unroll
                    for (int k = 0; k < 8; ++k) o[k] = acc[ai][bj][m][k >> 2][k & 3];
                    if (sec == 0) { *(u32x4*)(QS + row * 2048 + col) = pack8_bf16(o); }
                    else if (sec == 2) { *(u32x4*)(VH + row * 1024 + col) = pack8_bf16(o); }
                    else if (sec == 6) { bf16_t* vt = SV + ((size_t)((row >> 11) * 16 + (col >> 6)) * 64 + (col & 63)) * 2048 + (row & 2047);
#pragma unroll
                        for (int k = 0; k < 8; ++k) vt[(size_t)k * 2048] = (bf16_t)(cvt_pk_bf16(o[k], o[k]) & 0xffffu); }
                    else if (sec == 1) { f16x8 g;
#pragma unroll
                        for (int k = 0; k < 8; ++k) g[k] = (_Float16)__logf(lb[k] + (1.0f - lb[k]) * sigm(o[k]));
                        *(f16x8*)(LOGF + row * 1024 + col) = g; }
                    else {
#pragma unroll
                        for (int k = 0; k < 8; ++k) o[k] = sigm(o[k]);
                        unsigned char* dst = (sec == 3) ? GH : (sec == 7 ? GA : GB);
                        *(u32x2*)(dst + row * 1024 + col) = pack8_u8(o); }
                }
        }
    }
};
struct EpiVT {
    static constexpr bool PERM = true, AFTER_DRAIN = false, KSPLIT = false;
    bf16_t* VT;
    __device__ __forceinline__ void operator()(const f32x4 (&acc)[2][2][4][2], const Unit& u, int wr, int wc, int fr, int fq) const {
        const int row0 = u.pm * BM + wr * 64 + fr;
#pragma unroll
        for (int ai = 0; ai < 2; ++ai)
#pragma unroll
            for (int m = 0; m < 4; ++m)
#pragma unroll
                for (int bj = 0; bj < 2; ++bj) {
                    const int r = row0 + ai * HALF + m * 16, c = u.pn * BM + bj * HALF + wc * 32 + 8 * fq;
                    float o[8];
#pragma unroll
                    for (int k = 0; k < 8; ++k) o[k] = acc[ai][bj][m][k >> 2][k & 3];
                    *(u32x4*)(VT + ((size_t)((c >> 11) * 16 + (r >> 6)) * 64 + (r & 63)) * 2048 + (c & 2047)) = pack8_bf16(o);
                }
    }
};
struct EpiMix {
    static constexpr bool PERM = true, AFTER_DRAIN = false, KSPLIT = true;
    const unsigned char* GA; const unsigned char* GB; bf16_t* MIXED;
    __device__ __forceinline__ void half0(f32x4 (&acc)[2][2][4][2], const Unit& u, int wr, int wc, int fr, int fq) const {
        const int row0 = u.pm * BM + wr * 64 + fr;
#pragma unroll
        for (int ai = 0; ai < 2; ++ai)
#pragma unroll
            for (int m = 0; m < 4; ++m)
#pragma unroll
                for (int bj = 0; bj < 2; ++bj) {
                    const size_t off = (size_t)(row0 + ai * HALF + m * 16) * 1024 + u.pn * BM + bj * HALF + wc * 32 + 8 * fq;
                    const u32x2 a = *(const u32x2*)(GA + off), b = *(const u32x2*)(GB + off);
#pragma unroll
                    for (int k = 0; k < 8; ++k) { const float qa = (float)((a[k >> 2] >> (8 * (k & 3))) & 255u), qb = (float)((b[k >> 2] >> (8 * (k & 3))) & 255u);
                        acc[ai][bj][m][k >> 2][k & 3] *= qa * __builtin_amdgcn_rcpf(qb); }
                    if (bj == 1 && (m & 1)) asm volatile("" ::: "memory");
                }
    }
    __device__ __forceinline__ void operator()(f32x4 (&acc)[2][2][4][2], const Unit& u, int wr, int wc, int fr, int fq) const {
        if (u.kh == 0) { half0(acc, u, wr, wc, fr, fq); return; }
        const int row0 = u.pm * BM + wr * 64 + fr;
        u32x2 gbv[2][4][2];
#pragma unroll
        for (int ai = 0; ai < 2; ++ai)
#pragma unroll
            for (int m = 0; m < 4; ++m)
#pragma unroll
                for (int bj = 0; bj < 2; ++bj) gbv[ai][m][bj] = *(const u32x2*)(GB + (size_t)(row0 + ai * HALF + m * 16) * 1024 + u.pn * BM + bj * HALF + wc * 32 + 8 * fq);
#pragma unroll
        for (int ai = 0; ai < 2; ++ai)
#pragma unroll
            for (int m = 0; m < 4; ++m)
#pragma unroll
                for (int bj = 0; bj < 2; ++bj) {
                    const size_t off = (size_t)(row0 + ai * HALF + m * 16) * 1024 + u.pn * BM + bj * HALF + wc * 32 + 8 * fq;
                    const u32x2 b = gbv[ai][m][bj]; float o[8];
#pragma unroll
                    for (int k = 0; k < 8; ++k) { const float qb = (float)((b[k >> 2] >> (8 * (k & 3))) & 255u); o[k] = acc[ai][bj][m][k >> 2][k & 3] * (qb * (1.0f / 255.0f)); }
                    *(u32x4*)(MIXED + off) = pack8_bf16(o);
                }
    }
};
struct EpiRes1 {
    static constexpr bool PERM = true, AFTER_DRAIN = false, KSPLIT = false;
    const float* x; bf16_t* DL; bf16_t* X1B; float* SSQ;
    __device__ __forceinline__ void operator()(const f32x4 (&acc)[2][2][4][2], const Unit& u, int wr, int wc, int fr, int fq) const {
        const int row0 = u.pm * BM + wr * 64 + fr;
#pragma unroll
        for (int ai = 0; ai < 2; ++ai)
#pragma unroll
            for (int mp = 0; mp < 2; ++mp) {
                f32x4 xv[2][2][2];
#pragma unroll
                for (int mm = 0; mm < 2; ++mm)
#pragma unroll
                    for (int bj = 0; bj < 2; ++bj) { const size_t off = (size_t)(row0 + ai * HALF + (2 * mp + mm) * 16) * 1024 + u.pn * BM + bj * HALF + wc * 32 + 8 * fq;
                        xv[mm][bj][0] = *(const f32x4*)(x + off); xv[mm][bj][1] = *(const f32x4*)(x + off + 4); }
#pragma unroll
                for (int mm = 0; mm < 2; ++mm) {
                    const int m = 2 * mp + mm; const int row = row0 + ai * HALF + m * 16; float ss = 0.f;
#pragma unroll
                    for (int bj = 0; bj < 2; ++bj) {
                        const size_t off = (size_t)row * 1024 + u.pn * BM + bj * HALF + wc * 32 + 8 * fq;
                        const f32x4 a0 = acc[ai][bj][m][0], a1 = acc[ai][bj][m][1];
                        const f32x4 v0 = xv[mm][bj][0] + a0, v1 = xv[mm][bj][1] + a1;
                        u32x4 dw; dw.x = cvt_pk_bf16(a0[0], a0[1]); dw.y = cvt_pk_bf16(a0[2], a0[3]); dw.z = cvt_pk_bf16(a1[0], a1[1]); dw.w = cvt_pk_bf16(a1[2], a1[3]); *(u32x4*)(DL + off) = dw;
                        u32x4 w; w.x = cvt_pk_bf16(v0[0], v0[1]); w.y = cvt_pk_bf16(v0[2], v0[3]); w.z = cvt_pk_bf16(v1[0], v1[1]); w.w = cvt_pk_bf16(v1[2], v1[3]);
                        *(u32x4*)(X1B + off) = w;
                        ss += (v0[0] * v0[0] + v0[1] * v0[1]) + (v0[2] * v0[2] + v0[3] * v0[3]) + (v1[0] * v1[0] + v1[1] * v1[1]) + (v1[2] * v1[2] + v1[3] * v1[3]);
                    }
                    ss += __shfl_xor(ss, 16); ss += __shfl_xor(ss, 32);
                    if (fq == 0) SSQ[(size_t)row * 16 + u.pn * 4 + wc] = ss;
                }
            }
    }
};
struct EpiSwiglu {
    static constexpr bool PERM = true, AFTER_DRAIN = false, KSPLIT = false;
    const float* SSQ; bf16_t* ACT;
    __device__ __forceinline__ void operator()(const f32x4 (&acc)[2][2][4][2], const Unit& u, int wr, int wc, int fr, int fq) const {
        const int row0 = u.pm * BM + wr * 64 + fr;
        f32x4 sq[2][4];
#pragma unroll
        for (int ai = 0; ai < 2; ++ai)
#pragma unroll
            for (int m = 0; m < 4; ++m) sq[ai][m] = *(const f32x4*)(SSQ + (size_t)(row0 + ai * HALF + m * 16) * 16 + 4 * fq);
#pragma unroll
        for (int ai = 0; ai < 2; ++ai)
#pragma unroll
            for (int m = 0; m < 4; ++m) {
                const int row = row0 + ai * HALF + m * 16;
                float ss = (sq[ai][m][0] + sq[ai][m][1]) + (sq[ai][m][2] + sq[ai][m][3]);
                ss += __shfl_xor(ss, 16); ss += __shfl_xor(ss, 32);
                const float rstd = __builtin_amdgcn_rsqf(ss * (1.0f / 1024.0f) + 1e-6f);
                float o[8];
#pragma unroll
                for (int k = 0; k < 8; ++k) { const float g = acc[ai][0][m][k >> 2][k & 3] * rstd, up = acc[ai][1][m][k >> 2][k & 3] * rstd; o[k] = g * sigm(g) * up; }
                *(u32x4*)(ACT + (size_t)row * 2816 + u.pn * 128 + wc * 32 + 8 * fq) = pack8_bf16(o);
            }
    }
};
struct EpiRes2 {
    static constexpr bool PERM = true, AFTER_DRAIN = false, KSPLIT = false;
    const float* x; const bf16_t* DL; float* out;
    __device__ __forceinline__ void operator()(const f32x4 (&acc)[2][2][4][2], const Unit& u, int wr, int wc, int fr, int fq) const {
        const int row0 = u.pm * BM + wr * 64 + fr;
#pragma unroll
        for (int ai = 0; ai < 2; ++ai)
#pragma unroll
            for (int mp = 0; mp < 2; ++mp) {
                f32x4 xv[2][2][2]; u32x4 dv[2][2];
#pragma unroll
                for (int mm = 0; mm < 2; ++mm)
#pragma unroll
                    for (int bj = 0; bj < 2; ++bj) { const size_t off = (size_t)(row0 + ai * HALF + (2 * mp + mm) * 16) * 1024 + u.pn * BM + bj * HALF + wc * 32 + 8 * fq;
                        xv[mm][bj][0] = *(const f32x4*)(x + off); xv[mm][bj][1] = *(const f32x4*)(x + off + 4); dv[mm][bj] = *(const u32x4*)(DL + off); }
#pragma unroll
                for (int mm = 0; mm < 2; ++mm)
#pragma unroll
                    for (int bj = 0; bj < 2; ++bj) { const int m = 2 * mp + mm;
                        const size_t off = (size_t)(row0 + ai * HALF + m * 16) * 1024 + u.pn * BM + bj * HALF + wc * 32 + 8 * fq;
                        const u32x4 dw = dv[mm][bj];
                        f32x4 d0, d1; d0[0] = __builtin_bit_cast(float, dw.x << 16); d0[1] = __builtin_bit_cast(float, dw.x & 0xffff0000u); d0[2] = __builtin_bit_cast(float, dw.y << 16); d0[3] = __builtin_bit_cast(float, dw.y & 0xffff0000u);
                        d1[0] = __builtin_bit_cast(float, dw.z << 16); d1[1] = __builtin_bit_cast(float, dw.z & 0xffff0000u); d1[2] = __builtin_bit_cast(float, dw.w << 16); d1[3] = __builtin_bit_cast(float, dw.w & 0xffff0000u);
                        const f32x4 v0 = (xv[mm][bj][0] + d0) + acc[ai][bj][m][0], v1 = (xv[mm][bj][1] + d1) + acc[ai][bj][m][1];
                        *(f32x4*)(out + off) = v0; *(f32x4*)(out + off + 4) = v1; }
            }
    }
};

template <class Epi, class Sched, bool ALIGN_EPI = false, bool SP2 = false>
__device__ __forceinline__ void gemm_phase(PG8_LAS unsigned char* lds, const Gemm g, const Sched& S, const Epi& E) {
    int tid_ = threadIdx.x; asm volatile("" : "+v"(tid_));
    const int tid = tid_, wid = __builtin_amdgcn_readfirstlane(tid >> 6), lane = tid & 63, wr = wid >> 2, wc = wid & 3, fr = lane & 15, fq = lane >> 4;
    const int K = g.K, nt = K / BK;
    unsigned voffA[2], voffB[2];
#pragma unroll
    for (int i = 0; i < 2; ++i) { int R, C; stage_rc(tid * 16 + i * 8192, R, C); const int Rb = Epi::PERM ? ((R & ~31) + perm32(R & 31)) : R;
        voffA[i] = (unsigned)(R * g.ld + C) * 2u; voffB[i] = (unsigned)(Rb * g.ld + C) * 2u; }
    const size_t kstep = (size_t)(BK * 2);
    const size_t hstep = (size_t)HALF * g.ld * 2; const size_t khb = (size_t)K * 2;
    const size_t tstep = 2 * hstep;
    const unsigned ldsw = (unsigned)wid * 1024u;
    const int aoff = lds_byte(wr * 64 + fr, fq * 8), boff = lds_byte(wc * 32 + fr, fq * 8);
#define PG8_SA(b, h) (((b) * 2 + (h)) * HTB)
#define PG8_SB(b, h) ((4 + (b) * 2 + (h)) * HTB)
#define PG8_STAGE(bufoff, gbase, voff) do { _Pragma("unroll") for (int _i = 0; _i < 2; ++_i) \
        __builtin_amdgcn_global_load_lds((const unsigned*)((const char*)(gbase) + (voff)[_i]), (PG8_LAS unsigned*)(lds + (bufoff) + ldsw + _i * 8192), 16, 0, 0); } while (0)
#define PG8_LDA(dst, b, h) do { _Pragma("unroll") for (int m = 0; m < 4; ++m) _Pragma("unroll") for (int k = 0; k < 2; ++k) dst[m][k] = *(const PG8_LAS bf16x8*)(lds + PG8_SA(b, h) + aoff + m * 2048 + k * 1024); } while (0)
#define PG8_LDB(dst, b, h) do { _Pragma("unroll") for (int n = 0; n < 2; ++n) _Pragma("unroll") for (int k = 0; k < 2; ++k) dst[n][k] = *(const PG8_LAS bf16x8*)(lds + PG8_SB(b, h) + boff + n * 2048 + k * 1024); } while (0)
#define PG8_MMA(ai, bj, At, Bt) do { __builtin_amdgcn_s_setprio(1); _Pragma("unroll") for (int m = 0; m < 4; ++m) _Pragma("unroll") for (int n = 0; n < 2; ++n) _Pragma("unroll") for (int k = 0; k < 2; ++k) \
        acc[ai][bj][m][n] = __builtin_amdgcn_mfma_f32_16x16x32_bf16(Bt[n][k], At[m][k], acc[ai][bj][m][n], 0, 0, 0); __builtin_amdgcn_s_setprio(0); } while (0)
#define PG8_WAIT_V(n) asm volatile("s_waitcnt vmcnt(" #n ")" ::: "memory")
#define PG8_WAIT_L(n) asm volatile("s_waitcnt lgkmcnt(" #n ")" ::: "memory")
#define PG8_BAR __builtin_amdgcn_s_barrier()
#define PG8_SCHED __builtin_amdgcn_sched_barrier(0)
    Unit cur, nxt; int ui = 0;
    if (!S.next(0, cur)) return;
    f32x4 acc[2][2][4][2];
#pragma unroll
    for (int a = 0; a < 2; ++a)
#pragma unroll
        for (int b = 0; b < 2; ++b)
#pragma unroll
            for (int m = 0; m < 4; ++m)
#pragma unroll
                for (int n = 0; n < 2; ++n) acc[a][b][m][n] = (f32x4){0.f, 0.f, 0.f, 0.f};
    bf16x8 At[4][2], B0[2][2], B1[2][2];
    const char* cA = (const char*)g.A + (size_t)cur.pm * tstep + cur.kh * khb; const char* cB = (const char*)g.Bt + (size_t)cur.pn * tstep + cur.kh * khb;
    S.a_ready(cur);
    if constexpr (SP2) {
        PG8_STAGE(PG8_SB(0, 0), cB, voffB); PG8_STAGE(PG8_SB(0, 1), cB + hstep, voffB); PG8_STAGE(PG8_SA(0, 0), cA, voffA); PG8_STAGE(PG8_SA(0, 1), cA + hstep, voffA);
        if (wr == 1) PG8_BAR;
        PG8_WAIT_V(2); PG8_BAR;
        PG8_STAGE(PG8_SB(1, 0), cB + kstep, voffB); PG8_STAGE(PG8_SA(1, 0), cA + kstep, voffA); PG8_STAGE(PG8_SB(1, 1), cB + hstep + kstep, voffB);
        PG8_WAIT_V(6); PG8_BAR;
    } else {
        PG8_STAGE(PG8_SB(0, 0), cB, voffB); PG8_STAGE(PG8_SA(0, 0), cA, voffA); PG8_STAGE(PG8_SB(0, 1), cB + hstep, voffB); PG8_STAGE(PG8_SA(0, 1), cA + hstep, voffA);
        if (wr == 1) PG8_BAR;
        PG8_WAIT_V(4); PG8_BAR;
        PG8_STAGE(PG8_SB(1, 0), cB + kstep, voffB); PG8_STAGE(PG8_SA(1, 0), cA + kstep, voffA); PG8_STAGE(PG8_SB(1, 1), cB + hstep + kstep, voffB);
        PG8_WAIT_V(6); PG8_BAR;
    }
    for (;;) {
        const bool has_next = S.next(ui + 1, nxt);
        const char* nA = has_next ? (const char*)g.A + (size_t)nxt.pm * tstep + nxt.kh * khb : cA; const char* nB = has_next ? (const char*)g.Bt + (size_t)nxt.pn * tstep + nxt.kh * khb : cB;
        for (int t = 0; t < nt; t += 2) {
            const bool last = (t == nt - 2);
            const char* a1 = cA + (size_t)(t + 1) * kstep;
            const char* a2 = last ? nA : cA + (size_t)(t + 2) * kstep; const char* b2 = last ? nB : cB + (size_t)(t + 2) * kstep;
            const char* a3 = a2 + kstep; const char* b3 = b2 + kstep;
            if (last && has_next) S.a_ready(nxt);
            if constexpr (SP2) {
            PG8_LDB(B0, 0, 0); PG8_LDB(B1, 0, 1); PG8_SCHED; PG8_LDA(At, 0, 0); PG8_STAGE(PG8_SA(1, 1), a1 + hstep, voffA);
            PG8_WAIT_V(8); PG8_WAIT_L(0); PG8_BAR; PG8_MMA(0, 0, At, B0); PG8_MMA(0, 1, At, B1); PG8_BAR; PG8_SCHED;
            PG8_LDA(At, 0, 1); PG8_STAGE(PG8_SB(0, 0), b2, voffB); PG8_STAGE(PG8_SB(0, 1), b2 + hstep, voffB); PG8_STAGE(PG8_SA(0, 0), a2, voffA);
            PG8_WAIT_V(8); PG8_WAIT_L(0); PG8_BAR; PG8_MMA(1, 0, At, B0); PG8_MMA(1, 1, At, B1); PG8_BAR; PG8_SCHED;
            PG8_LDB(B0, 1, 0); PG8_LDB(B1, 1, 1); PG8_SCHED; PG8_LDA(At, 1, 0); PG8_STAGE(PG8_SA(0, 1), a2 + hstep, voffA);
            PG8_WAIT_V(8); PG8_WAIT_L(0); PG8_BAR; PG8_MMA(0, 0, At, B0); PG8_MMA(0, 1, At, B1); PG8_BAR; PG8_SCHED;
            PG8_LDA(At, 1, 1); PG8_STAGE(PG8_SB(1, 0), b3, voffB); PG8_STAGE(PG8_SB(1, 1), b3 + hstep, voffB); PG8_STAGE(PG8_SA(1, 0), a3, voffA);
            PG8_WAIT_V(8); PG8_WAIT_L(0); PG8_BAR; PG8_MMA(1, 0, At, B0); PG8_MMA(1, 1, At, B1); PG8_BAR; PG8_SCHED;
            } else {
            PG8_LDB(B0, 0, 0); PG8_SCHED; PG8_LDA(At, 0, 0); PG8_STAGE(PG8_SA(1, 1), a1 + hstep, voffA);
            PG8_WAIT_L(8); PG8_BAR; PG8_WAIT_L(0); PG8_MMA(0, 0, At, B0); PG8_BAR; PG8_SCHED;
            PG8_LDB(B1, 0, 1); PG8_STAGE(PG8_SB(0, 0), b2, voffB);
            PG8_BAR; PG8_WAIT_L(0); PG8_MMA(0, 1, At, B1); PG8_BAR;
            PG8_LDA(At, 0, 1); PG8_STAGE(PG8_SA(0, 0), a2, voffA);
            PG8_BAR; PG8_WAIT_L(0); PG8_MMA(1, 0, At, B0); PG8_BAR; PG8_SCHED;
            PG8_STAGE(PG8_SB(0, 1), b2 + hstep, voffB);
            PG8_WAIT_V(6); PG8_BAR; PG8_MMA(1, 1, At, B1); PG8_BAR;
            PG8_LDB(B0, 1, 0); PG8_SCHED; PG8_LDA(At, 1, 0); PG8_STAGE(PG8_SA(0, 1), a2 + hstep, voffA);
            PG8_WAIT_L(8); PG8_BAR; PG8_WAIT_L(0); PG8_MMA(0, 0, At, B0); PG8_BAR; PG8_SCHED;
            PG8_LDB(B1, 1, 1); PG8_STAGE(PG8_SB(1, 0), b3, voffB);
            PG8_BAR; PG8_WAIT_L(0); PG8_MMA(0, 1, At, B1); PG8_BAR;
            PG8_LDA(At, 1, 1); PG8_STAGE(PG8_SA(1, 0), a3, voffA);
            PG8_BAR; PG8_WAIT_L(0); PG8_MMA(1, 0, At, B0); PG8_BAR; PG8_SCHED;
            PG8_STAGE(PG8_SB(1, 1), b3 + hstep, voffB);
            PG8_WAIT_V(6); PG8_BAR; PG8_MMA(1, 1, At, B1); PG8_BAR;
            }
        }
        if constexpr (ALIGN_EPI) { if (wr == 0) PG8_BAR; }
        if constexpr (!Epi::AFTER_DRAIN) { E(acc, cur, wr, wc, fr, fq); S.done(cur); }
        if (!has_next) break;
        if (!(Epi::KSPLIT && cur.kh == 0))
#pragma unroll
        for (int a = 0; a < 2; ++a)
#pragma unroll
            for (int b = 0; b < 2; ++b)
#pragma unroll
                for (int m = 0; m < 4; ++m)
#pragma unroll
                    for (int n = 0; n < 2; ++n) acc[a][b][m][n] = (f32x4){0.f, 0.f, 0.f, 0.f};
        cur = nxt; cA = nA; cB = nB; ++ui;
        if constexpr (ALIGN_EPI) { if (wr == 1) PG8_BAR; }
    }
    PG8_WAIT_V(0);
    if constexpr (!ALIGN_EPI) { if (wr == 0) PG8_BAR; }
    PG8_BAR;
    if constexpr (Epi::AFTER_DRAIN) { E.fused(acc, cur, wr, wc, fr, fq, lds, wid, lane); S.done(cur); }
#undef PG8_SA
#undef PG8_SB
#undef PG8_STAGE
#undef PG8_LDA
#undef PG8_LDB
#undef PG8_MMA
#undef PG8_WAIT_V
#undef PG8_WAIT_L
#undef PG8_BAR
#undef PG8_SCHED
}
}

constexpr int NWAVES = 8, NTHREADS = 512;
constexpr int BATCH = 8, SEQ = 2048, D = 1024, M = BATCH * SEQ, INW = 9216, FFH = 2816;
constexpr float EPS = 1e-6f;
constexpr size_t MiB = 1u << 20;
constexpr size_t WS_SSQ = 1 * MiB;
constexpr size_t WS_WIN = 2 * MiB;
constexpr size_t WS_WHS = 20 * MiB;
constexpr size_t WS_WO = 24 * MiB;
constexpr size_t WS_WF1 = 26 * MiB;
constexpr size_t WS_WF2 = 37 * MiB;
constexpr size_t WS_H = 43 * MiB;
constexpr size_t WS_MIXED = WS_H;
constexpr size_t WS_QS = 75 * MiB;
constexpr size_t WS_VH = 139 * MiB;
constexpr size_t WS_SK = 171 * MiB;
constexpr size_t WS_X1B = WS_SK;
constexpr size_t WS_GH = 203 * MiB, WS_GA = 219 * MiB, WS_GB = 235 * MiB;
constexpr size_t WS_ACT = 75 * MiB;
constexpr size_t WS_END = 251 * MiB;
static_assert(WS_ACT + (size_t)M * FFH * 2 <= WS_X1B, "ACT overlay");
constexpr int RING_BYTES = 131072, LDS_BYTES = 157696, MISC_OFF = LDS_BYTES - 256;

#define LAS __attribute__((address_space(3)))
typedef unsigned short bf16;
typedef unsigned v4u __attribute__((ext_vector_type(4)));
typedef float f32x4 __attribute__((ext_vector_type(4)));
__device__ __forceinline__ unsigned f2bf(float f) { unsigned u = __builtin_bit_cast(unsigned, f); return (u + 0x7fffu + ((u >> 16) & 1u)) >> 16; }
__device__ __forceinline__ unsigned pk2(float lo, float hi) { return f2bf(lo) | (f2bf(hi) << 16); }
__device__ __forceinline__ float bf2f(unsigned short b) { return __builtin_bit_cast(float, (unsigned)b << 16); }
__device__ __forceinline__ float wave_sum(float v) {
#pragma unroll
    for (int o = 1; o < 64; o <<= 1) v += __shfl_xor(v, o);
    return v;
}
struct Args { const float* in[13]; float* out; unsigned char* ws; int ph_lo, ph_hi; };

__device__ __forceinline__ void p0_transpose_item(const float* W, int N, bf16* WT, int ldT, int koff, LAS float* scr, int k0, int n0d, int n0s, const float* kscale, int lane) {
    float wv[32];
    const float* wp = W + (size_t)(k0 + (lane >> 5)) * N + n0s + (lane & 31);
#pragma unroll
    for (int i = 0; i < 32; ++i) wv[i] = wp[(size_t)(2 * i) * N];
    if (kscale) {
#pragma unroll
        for (int i = 0; i < 32; ++i) wv[i] *= kscale[k0 + 2 * i + (lane >> 5)];
    }
#pragma unroll
    for (int i = 0; i < 32; ++i) scr[(2 * i + (lane >> 5)) * 33 + (lane & 31)] = wv[i];
    asm volatile("s_waitcnt lgkmcnt(0)" ::: "memory");
    const int c = lane & 7;
#pragma unroll
    for (int j = 0; j < 4; ++j) { const int n = (lane >> 3) + 8 * j; const LAS float* s = scr + (8 * c) * 33 + n;
        v4u o; o.x = pk2(s[0 * 33], s[1 * 33]); o.y = pk2(s[2 * 33], s[3 * 33]); o.z = pk2(s[4 * 33], s[5 * 33]); o.w = pk2(s[6 * 33], s[7 * 33]);
        *(v4u*)(WT + (size_t)(n0d + n) * ldT + koff + k0 + 8 * c) = o; }
    asm volatile("s_waitcnt lgkmcnt(0)" ::: "memory");
}
template <int PART> __device__ __forceinline__ void p0_prologue(const Args& a, LAS unsigned char* lds, int wave, int lane, int gw, int NGW) {
    LAS float* scr = (LAS float*)(lds + wave * 16384);
    unsigned char* ws = a.ws;
    constexpr int I_IN = 16 * (INW / 32), I_SQ = 16 * 32, I_F1 = 16 * (2 * FFH / 32), I_F2 = (FFH / 64) * 32;
    constexpr int NITEMS = I_IN + 3 * I_SQ + I_F1 + I_F2;
    for (int it = (PART == 0 ? gw : I_IN + gw); it < (PART == 0 ? I_IN : NITEMS); it += NGW) {
        int r = it;
        if (r < I_IN) { const int nblk = INW / 32, kb = r / nblk, nb = r % nblk, n0d = 32 * nb; const int sec = n0d >> 10; int n0s = n0d;
            if (sec == 4 || sec == 5) { const int p = n0d & 255; n0s = (n0d - p) + 64 * ((p >> 5) & 3) + 32 * (p >> 7); }
            p0_transpose_item(a.in[2], INW, (bf16*)(ws + WS_WIN), 1024, 0, scr, 64 * kb, n0d, n0s, nullptr, lane); continue; } r -= I_IN;
        if (r < I_SQ) { p0_transpose_item(a.in[7], 1024, (bf16*)(ws + WS_WHS), 2048, 0, scr, 64 * (r / 32), 32 * (r % 32), 32 * (r % 32), nullptr, lane); continue; } r -= I_SQ;
        if (r < I_SQ) { p0_transpose_item(a.in[8], 1024, (bf16*)(ws + WS_WHS), 2048, 1024, scr, 64 * (r / 32), 32 * (r % 32), 32 * (r % 32), nullptr, lane); continue; } r -= I_SQ;
        if (r < I_SQ) { p0_transpose_item(a.in[9], 1024, (bf16*)(ws + WS_WO), 1024, 0, scr, 64 * (r / 32), 32 * (r % 32), 32 * (r % 32), nullptr, lane); continue; } r -= I_SQ;
        if (r < I_F1) { const int nblk = 2 * FFH / 32, kb = r / nblk, nb = r % nblk, n0d = 32 * nb, pn = n0d >> 8, p = n0d & 255; const int n0s = (p >> 7) * FFH + 128 * pn + (p & 127);
            p0_transpose_item(a.in[11], 2 * FFH, (bf16*)(ws + WS_WF1), 1024, 0, scr, 64 * kb, n0d, n0s, a.in[10], lane); continue; } r -= I_F1;
        p0_transpose_item(a.in[12], 1024, (bf16*)(ws + WS_WF2), FFH, 0, scr, 64 * (r / 32), 32 * (r % 32), 32 * (r % 32), nullptr, lane);
    }
    if (PART != 0) return;
    const float* g1 = a.in[1];
    f32x4 gv[4];
#pragma unroll
    for (int j = 0; j < 4; ++j) gv[j] = ((const f32x4*)g1)[lane + 64 * j];
    for (int m = gw; m < M; m += NGW) {
        const f32x4* xr = (const f32x4*)(a.in[0] + (size_t)m * D) + lane;
        f32x4 v[4]; float s = 0.f;
#pragma unroll
        for (int j = 0; j < 4; ++j) { v[j] = xr[64 * j]; s += (v[j].x * v[j].x + v[j].y * v[j].y) + (v[j].z * v[j].z + v[j].w * v[j].w); }
        const float rstd = __builtin_amdgcn_rsqf(wave_sum(s) * (1.f / D) + EPS);
        unsigned long long* o8 = (unsigned long long*)((bf16*)(ws + WS_H) + (size_t)m * D) + lane;
#pragma unroll
        for (int j = 0; j < 4; ++j) { const f32x4 y = v[j] * rstd * gv[j]; o8[64 * j] = (unsigned long long)pk2(y.x, y.y) | ((unsigned long long)pk2(y.z, y.w) << 32); }
    }
}

typedef short bf16x8_t __attribute__((ext_vector_type(8)));
typedef float f32x16 __attribute__((ext_vector_type(16)));
typedef unsigned u32x2_t __attribute__((ext_vector_type(2)));
typedef float f32x2_t __attribute__((ext_vector_type(2)));
typedef __bf16 bf16x2_cv __attribute__((ext_vector_type(2)));
__device__ __forceinline__ unsigned cvtpk(float lo, float hi) { const f32x2_t v = {lo, hi}; return __builtin_bit_cast(unsigned, __builtin_convertvector(v, bf16x2_cv)); }
__device__ __forceinline__ bf16x8_t pack_acc8(const f32x16& c, int p) {
    v4u w; if (p == 0) { w.x = cvtpk(c[0], c[1]); w.y = cvtpk(c[2], c[3]); w.z = cvtpk(c[4], c[5]); w.w = cvtpk(c[6], c[7]); }
    else { w.x = cvtpk(c[8], c[9]); w.y = cvtpk(c[10], c[11]); w.z = cvtpk(c[12], c[13]); w.w = cvtpk(c[14], c[15]); }
    return __builtin_bit_cast(bf16x8_t, w);
}
#define MFMA32(A, B, C) __builtin_amdgcn_mfma_f32_32x32x16_bf16((A), (B), (C), 0, 0, 0)
__device__ __forceinline__ void hgrn_mfma(const Args& a, LAS unsigned char* lds, int vblk, int nblk) {
    unsigned char* ws = a.ws;
    bf16* QS = (bf16*)(ws + WS_QS); const bf16* VH = (const bf16*)(ws + WS_VH); const unsigned char* GH = ws + WS_GH; const _Float16* LOGF = (const _Float16*)a.out;
    const float* ogain = a.in[4];
    constexpr int RS = 272, TS = 144;
    LAS unsigned char* L_QI = lds; LAS unsigned char* L_QA = lds + 64 * RS; LAS unsigned char* L_KA = lds + 2 * 64 * RS;
    LAS unsigned char* L_KST = lds + 3 * 64 * RS; LAS unsigned char* L_VT = L_KST + 128 * TS;
    LAS float* L_TQ = (LAS float*)(L_VT + 128 * TS); LAS float* L_DEC = L_TQ + 2048;     LAS float* L_SS = L_DEC + 128; LAS float* L_GN = L_SS + 256;
    const int tid = threadIdx.x, lane = tid & 63, wave = __builtin_amdgcn_readfirstlane(tid >> 6);
    const int dp = tid & 63, oct = wave, r32 = lane & 31, hi = lane >> 5, vt = wave & 3, tt = wave >> 2;
    const int kap = 16 * (r32 >> 4) + 8 * ((r32 >> 2) & 1) + 4 * ((r32 >> 3) & 1) + (r32 & 3);
    for (int item = vblk; item < BATCH * 8; item += nblk) {
        const int b = item >> 3, h = item & 7;
        f32x16 C[4];
#pragma unroll
        for (int i = 0; i < 4; ++i)
#pragma unroll
            for (int j = 0; j < 16; ++j) C[i][j] = 0.f;
        if (tid < 128) L_GN[tid] = ogain[h * 128 + tid];
        unsigned gN2[2][8], qN2[2][8], vN2[2][8];
#pragma unroll
        for (int c2 = 0; c2 < 2; ++c2) { const size_t row0 = (size_t)b * SEQ + 64 * c2 + 8 * oct;
#pragma unroll
          for (int i = 0; i < 8; ++i) { gN2[c2][i] = *(const unsigned*)(LOGF + (row0 + i) * 1024 + h * 128 + 2 * dp); qN2[c2][i] = *(const unsigned*)(QS + (row0 + i) * 2048 + h * 128 + 2 * dp); vN2[c2][i] = *(const unsigned*)(VH + (row0 + i) * 1024 + h * 128 + 2 * dp); } }
        { float run0 = 0.f, run1 = 0.f;
#pragma unroll
          for (int i = 0; i < 8; ++i) { run0 += (float)__builtin_bit_cast(_Float16, (unsigned short)(gN2[0][i] & 0xffffu)); run1 += (float)__builtin_bit_cast(_Float16, (unsigned short)(gN2[0][i] >> 16)); }
          *(LAS f32x2_t*)(L_TQ + oct * 128 + 2 * dp) = (f32x2_t){run0, run1}; }
        __syncthreads();
#pragma unroll 2
        for (int n = 0; n < SEQ / 64; ++n) {
            unsigned (&gN)[8] = gN2[n & 1]; unsigned (&qN)[8] = qN2[n & 1]; unsigned (&vN)[8] = vN2[n & 1];
            if (n + 1 < SEQ / 64) { float run0 = 0.f, run1 = 0.f;
#pragma unroll
                for (int i = 0; i < 8; ++i) { const unsigned gw_ = gN2[(n + 1) & 1][i]; run0 += (float)__builtin_bit_cast(_Float16, (unsigned short)(gw_ & 0xffffu)); run1 += (float)__builtin_bit_cast(_Float16, (unsigned short)(gw_ >> 16)); }
                *(LAS f32x2_t*)(L_TQ + ((n + 1) & 1) * 1024 + oct * 128 + 2 * dp) = (f32x2_t){run0, run1}; }
            float off0 = 0.f, off1 = 0.f, cref0 = 0.f, cref1 = 0.f, tot0 = 0.f, tot1 = 0.f;
#pragma unroll
            for (int o = 0; o < 8; ++o) { const f32x2_t tq = *(const LAS f32x2_t*)(L_TQ + (n & 1) * 1024 + o * 128 + 2 * dp);
                if (o < oct) { off0 += tq.x; off1 += tq.y; } if (o < 4) { cref0 += tq.x; cref1 += tq.y; } tot0 += tq.x; tot1 += tq.y; }
            const float xc0 = __expf(tot0), xc1 = __expf(tot1), xa0 = __expf(-cref0), xa1 = __expf(-cref1), xb0 = __expf(cref0), xb1 = __expf(cref1);
            if (oct == 0) *(LAS f32x2_t*)(L_DEC + 2 * dp) = (f32x2_t){xc0, xc1};
            float e0 = __expf(off0), e1 = __expf(off1);
            unsigned ksp0[4], ksp1[4], vsp0[4], vsp1[4];
#pragma unroll
            for (int i = 0; i < 8; ++i) {
                const float f0 = __expf((float)__builtin_bit_cast(_Float16, (unsigned short)(gN[i] & 0xffffu))), f1 = __expf((float)__builtin_bit_cast(_Float16, (unsigned short)(gN[i] >> 16)));
                e0 = fmaxf(e0 * f0, 1e-30f); e1 = fmaxf(e1 * f1, 1e-30f);
                const float r0 = __builtin_amdgcn_rcpf(e0), r1 = __builtin_amdgcn_rcpf(e1);
                const float k0 = 1.0f - f0, k1 = 1.0f - f1, q0 = __builtin_bit_cast(float, qN[i] << 16), q1 = __builtin_bit_cast(float, qN[i] & 0xffff0000u);
                const float qi0 = q0 * e0, qi1 = q1 * e1, kr0 = k0 * r0, kr1 = k1 * r1;
                const int t = 8 * oct + i;
                *(LAS unsigned*)(L_QI + t * RS + 4 * dp) = cvtpk(qi0, qi1);
                *(LAS unsigned*)(L_QA + t * RS + 4 * dp) = cvtpk(qi0 * xa0, qi1 * xa1);
                *(LAS unsigned*)(L_KA + t * RS + 4 * dp) = cvtpk(kr0 * xb0, kr1 * xb1);
                const unsigned ks = cvtpk(kr0 * xc0, kr1 * xc1);
                if (i & 1) { ksp0[i >> 1] |= ks << 16; ksp1[i >> 1] |= ks & 0xffff0000u; vsp0[i >> 1] |= vN[i] << 16; vsp1[i >> 1] |= vN[i] & 0xffff0000u; }
                else { ksp0[i >> 1] = ks & 0xffffu; ksp1[i >> 1] = ks >> 16; vsp0[i >> 1] = vN[i] & 0xffffu; vsp1[i >> 1] = vN[i] >> 16; }
            }
            *(LAS v4u*)(L_KST + (2 * dp) * TS + 16 * oct) = (v4u){ksp0[0], ksp0[1], ksp0[2], ksp0[3]}; *(LAS v4u*)(L_KST + (2 * dp + 1) * TS + 16 * oct) = (v4u){ksp1[0], ksp1[1], ksp1[2], ksp1[3]};
            *(LAS v4u*)(L_VT + (2 * dp) * TS + 16 * oct) = (v4u){vsp0[0], vsp0[1], vsp0[2], vsp0[3]}; *(LAS v4u*)(L_VT + (2 * dp + 1) * TS + 16 * oct) = (v4u){vsp1[0], vsp1[1], vsp1[2], vsp1[3]};
            __syncthreads();
            const size_t m = (size_t)b * SEQ + 64 * n + 32 * tt + r32;
            unsigned gt4[4];
#pragma unroll
            for (int a4 = 0; a4 < 4; ++a4) gt4[a4] = *(const unsigned*)(GH + m * 1024 + h * 128 + 32 * vt + 8 * a4 + 4 * hi);
            if (n + 2 < SEQ / 64) { const size_t row0 = (size_t)b * SEQ + 64 * (n + 2) + 8 * oct;
#pragma unroll
                for (int i = 0; i < 8; ++i) { gN[i] = *(const unsigned*)(LOGF + (row0 + i) * 1024 + h * 128 + 2 * dp); qN[i] = *(const unsigned*)(QS + (row0 + i) * 2048 + h * 128 + 2 * dp); vN[i] = *(const unsigned*)(VH + (row0 + i) * 1024 + h * 128 + 2 * dp); } }
#define SB() __builtin_amdgcn_sched_barrier(0)
            f32x16 O;
#pragma unroll
            for (int j = 0; j < 16; ++j) O[j] = 0.f;
            bf16x8_t Vt[4];
            {
                v4u qf[8];
#pragma unroll
                for (int i = 0; i < 8; ++i) { const LAS unsigned char* qp = L_QI + (32 * tt + r32) * RS + (32 * (i >> 1) + 16 * (i & 1) + 4 * hi) * 2;
                    const u32x2_t lo = *(const LAS u32x2_t*)qp, hi2 = *(const LAS u32x2_t*)(qp + 16); qf[i] = (v4u){lo.x, lo.y, hi2.x, hi2.y}; }
#pragma unroll
                for (int ks = 0; ks < 4; ++ks) Vt[ks] = *(const LAS bf16x8_t*)(L_VT + (32 * vt + r32) * TS + (16 * ks + 8 * hi) * 2);
                SB();
#pragma unroll
                for (int i = 0; i < 8; ++i) O = MFMA32(pack_acc8(C[i >> 1], i & 1), __builtin_bit_cast(bf16x8_t, qf[i]), O);
                SB();
            }
#pragma unroll
            for (int st = 0; st < 2; ++st) if (st <= tt) {
                f32x16 S;
#pragma unroll
                for (int j = 0; j < 16; ++j) S[j] = 0.f;
#pragma unroll
                for (int hb = 0; hb < 2; ++hb) {
                    bf16x8_t A[4], B[4];
#pragma unroll
                    for (int k4 = 0; k4 < 4; ++k4) { const int ks = 4 * hb + k4;
                        A[k4] = *(const LAS bf16x8_t*)(L_KA + (32 * st + kap) * RS + (16 * ks + 8 * hi) * 2);
                        B[k4] = *(const LAS bf16x8_t*)(L_QA + (32 * tt + r32) * RS + (16 * ks + 8 * hi) * 2); }
                    SB();
#pragma unroll
                    for (int k4 = 0; k4 < 4; ++k4) S = MFMA32(A[k4], B[k4], S);
                    SB();
                }
                if (st == tt) {
#pragma unroll
                    for (int j = 0; j < 16; ++j) { const int sl = 16 * (j >> 3) + 8 * hi + (j & 7); if (sl > r32) S[j] = 0.f; }
                }
                O = MFMA32(Vt[2 * st], pack_acc8(S, 0), O); O = MFMA32(Vt[2 * st + 1], pack_acc8(S, 1), O);
            }
#pragma unroll
            for (int dt = 0; dt < 4; ++dt) {
                f32x4 dc[4]; bf16x8_t A[4];
#pragma unroll
                for (int a4 = 0; a4 < 4; ++a4) dc[a4] = *(const LAS f32x4*)(L_DEC + 32 * dt + 8 * a4 + 4 * hi);
#pragma unroll
                for (int ks = 0; ks < 4; ++ks) A[ks] = *(const LAS bf16x8_t*)(L_KST + (32 * dt + r32) * TS + (16 * ks + 8 * hi) * 2);
                SB();
#pragma unroll
                for (int a4 = 0; a4 < 4; ++a4)
#pragma unroll
                    for (int cc = 0; cc < 4; ++cc) C[dt][4 * a4 + cc] *= dc[a4][cc];
#pragma unroll
                for (int ks = 0; ks < 4; ++ks) C[dt] = MFMA32(A[ks], Vt[ks], C[dt]);
                SB();
            }
#undef SB
            float ss = 0.f;
#pragma unroll
            for (int j = 0; j < 16; ++j) ss += O[j] * O[j];
            ss += __shfl_xor(ss, 32);
            if (hi == 0) L_SS[(tt * 4 + vt) * 32 + r32] = ss;
            __syncthreads();
            const float sst = (L_SS[(tt * 4 + 0) * 32 + r32] + L_SS[(tt * 4 + 1) * 32 + r32]) + (L_SS[(tt * 4 + 2) * 32 + r32] + L_SS[(tt * 4 + 3) * 32 + r32]);
            const float rstd = __builtin_amdgcn_rsqf(sst * (1.0f / 128.0f) + EPS);
#pragma unroll
            for (int a4 = 0; a4 < 4; ++a4) { const int v0 = h * 128 + 32 * vt + 8 * a4 + 4 * hi;
                const f32x4 gn = *(const LAS f32x4*)(L_GN + 32 * vt + 8 * a4 + 4 * hi); const unsigned gt = gt4[a4];
                float o[4];
#pragma unroll
                for (int cc = 0; cc < 4; ++cc) o[cc] = O[4 * a4 + cc] * rstd * gn[cc] * ((float)((gt >> (8 * cc)) & 255u) * (1.0f / 255.0f));
                u32x2_t w; w.x = cvtpk(o[0], o[1]); w.y = cvtpk(o[2], o[3]);
                *(u32x2_t*)(QS + m * 2048 + v0) = w; }
        }
        __syncthreads();
    }
}

__device__ __forceinline__ void hgrn_v2(const Args& a, LAS unsigned char* lds, int vblk, int nblk) {
    unsigned char* ws = a.ws;
    bf16* QS = (bf16*)(ws + WS_QS); const bf16* VH = (const bf16*)(ws + WS_VH); const unsigned char* GH = ws + WS_GH; const _Float16* LOGF = (const _Float16*)a.out;
    const float* ogain = a.in[4];
    constexpr int RS = 272, TS = 144, O_KA = 64 * RS, O_KAT = 2 * 64 * RS, O_VT = O_KAT + 128 * TS, BUFB = O_VT + 128 * TS;
    LAS float* L_TQ = (LAS float*)(lds + 2 * BUFB);
    LAS float* L_XS = L_TQ + 1024;
    LAS float* L_SS = L_XS + 512;
    LAS float* L_GN = L_SS + 512;
    const int tid = threadIdx.x, lane = tid & 63, wave = __builtin_amdgcn_readfirstlane(tid >> 6);
    const int r32 = lane & 31, hi = lane >> 5;
    const int kap = 16 * (r32 >> 4) + 8 * ((r32 >> 2) & 1) + 4 * ((r32 >> 3) & 1) + (r32 & 3);
    constexpr int NCH = SEQ / 64;
#define SB() __builtin_amdgcn_sched_barrier(0)
    for (int item = vblk; item < BATCH * 8; item += nblk) {
        const int b = item >> 3, h = item & 7;
        if (tid < 128) L_GN[tid] = ogain[h * 128 + tid];
        if (wave < 4) {
            const int vt = wave;
            f32x16 C[4];
#pragma unroll
            for (int i = 0; i < 4; ++i)
#pragma unroll
                for (int j = 0; j < 16; ++j) C[i][j] = 0.f;
            f32x16 O[2]; unsigned gt4[2][4];
#define HG_EPI(cn) do { _Pragma("unroll") for (int tt = 0; tt < 2; ++tt) { const LAS float* SSb = L_SS + ((cn) & 1) * 256; \
                const float sst = (SSb[(tt * 4 + 0) * 32 + r32] + SSb[(tt * 4 + 1) * 32 + r32]) + (SSb[(tt * 4 + 2) * 32 + r32] + SSb[(tt * 4 + 3) * 32 + r32]); \
                const float rstd = __builtin_amdgcn_rsqf(sst * (1.0f / 128.0f) + EPS); \
                const size_t m = (size_t)b * SEQ + 64 * (cn) + r32 + 32 * tt; \
                _Pragma("unroll") for (int a4 = 0; a4 < 4; ++a4) { const int v0 = h * 128 + 32 * vt + 8 * a4 + 4 * hi; \
                    const f32x4 gn = *(const LAS f32x4*)(L_GN + 32 * vt + 8 * a4 + 4 * hi); const unsigned gt = gt4[tt][a4]; float o[4]; \
                    _Pragma("unroll") for (int cc = 0; cc < 4; ++cc) o[cc] = O[tt][4 * a4 + cc] * rstd * gn[cc] * ((float)((gt >> (8 * cc)) & 255u) * (1.0f / 255.0f)); \
                    u32x2_t w; w.x = cvtpk(o[0], o[1]); w.y = cvtpk(o[2], o[3]); *(u32x2_t*)(QS + m * 2048 + v0) = w; } } } while (0)
            __syncthreads();
#pragma unroll 1
            for (int n = 0; n < NCH; ++n) {
                __syncthreads();
                if (n > 0) HG_EPI(n - 1);
                const LAS unsigned char* T = lds + (n & 1) * BUFB;
                const LAS float* XS = L_XS + (n & 1) * 256;
                const size_t m0 = (size_t)b * SEQ + 64 * n + r32;
#pragma unroll
                for (int tt = 0; tt < 2; ++tt)
#pragma unroll
                    for (int a4 = 0; a4 < 4; ++a4) gt4[tt][a4] = *(const unsigned*)(GH + (m0 + 32 * tt) * 1024 + h * 128 + 32 * vt + 8 * a4 + 4 * hi);
                bf16x8_t Cp[8]; bf16x8_t Vt[4];
#pragma unroll
                for (int ks = 0; ks < 4; ++ks) Vt[ks] = *(const LAS bf16x8_t*)(T + O_VT + (32 * vt + r32) * TS + (16 * ks + 8 * hi) * 2);
#pragma unroll
                for (int dt = 0; dt < 4; ++dt) {
#pragma unroll
                    for (int a4 = 0; a4 < 4; ++a4) { const f32x4 x1 = *(const LAS f32x4*)(XS + 32 * dt + 8 * a4 + 4 * hi);
#pragma unroll
                        for (int cc = 0; cc < 4; ++cc) C[dt][4 * a4 + cc] *= x1[cc]; }
                    Cp[2 * dt] = pack_acc8(C[dt], 0); Cp[2 * dt + 1] = pack_acc8(C[dt], 1);
                }
#pragma unroll
                for (int tt = 0; tt < 2; ++tt) {
#pragma unroll
                    for (int j = 0; j < 16; ++j) O[tt][j] = 0.f;
                    v4u qf[8];
#pragma unroll
                    for (int i = 0; i < 8; ++i) { const LAS unsigned char* qp = T + (32 * tt + r32) * RS + (32 * (i >> 1) + 16 * (i & 1) + 4 * hi) * 2;
                        const u32x2_t lo = *(const LAS u32x2_t*)qp, hi2 = *(const LAS u32x2_t*)(qp + 16); qf[i] = (v4u){lo.x, lo.y, hi2.x, hi2.y}; }
                    SB();
#pragma unroll
                    for (int i = 0; i < 8; ++i) O[tt] = MFMA32(Cp[i], __builtin_bit_cast(bf16x8_t, qf[i]), O[tt]);
                    SB();
#pragma unroll
                    for (int st = 0; st < 2; ++st) if (st <= tt) {
                        f32x16 S;
#pragma unroll
                        for (int j = 0; j < 16; ++j) S[j] = 0.f;
#pragma unroll
                        for (int hb = 0; hb < 2; ++hb) {
                            bf16x8_t A[4], B[4];
#pragma unroll
                            for (int k4 = 0; k4 < 4; ++k4) { const int ks = 4 * hb + k4;
                                A[k4] = *(const LAS bf16x8_t*)(T + O_KA + (32 * st + kap) * RS + (16 * ks + 8 * hi) * 2);
                                B[k4] = *(const LAS bf16x8_t*)(T + (32 * tt + r32) * RS + (16 * ks + 8 * hi) * 2); }
                            SB();
#pragma unroll
                            for (int k4 = 0; k4 < 4; ++k4) S = MFMA32(A[k4], B[k4], S);
                            SB();
                        }
                        if (st == tt) {
#pragma unroll
                            for (int j = 0; j < 16; ++j) { const int sl = 16 * (j >> 3) + 8 * hi + (j & 7); if (sl > r32) S[j] = 0.f; }
                        }
                        O[tt] = MFMA32(Vt[2 * st], pack_acc8(S, 0), O[tt]); O[tt] = MFMA32(Vt[2 * st + 1], pack_acc8(S, 1), O[tt]);
                    }
                    float ss = 0.f;
#pragma unroll
                    for (int j = 0; j < 16; ++j) ss += O[tt][j] * O[tt][j];
                    ss += __shfl_xor(ss, 32);
                    if (hi == 0) L_SS[(n & 1) * 256 + (tt * 4 + vt) * 32 + r32] = ss;
                }
#pragma unroll
                for (int dt = 0; dt < 4; ++dt) {
                    f32x4 x2[4]; bf16x8_t A[4];
#pragma unroll
                    for (int a4 = 0; a4 < 4; ++a4) x2[a4] = *(const LAS f32x4*)(XS + 128 + 32 * dt + 8 * a4 + 4 * hi);
#pragma unroll
                    for (int ks = 0; ks < 4; ++ks) A[ks] = *(const LAS bf16x8_t*)(T + O_KAT + (32 * dt + r32) * TS + (16 * ks + 8 * hi) * 2);
                    SB();
#pragma unroll
                    for (int ks = 0; ks < 4; ++ks) C[dt] = MFMA32(A[ks], Vt[ks], C[dt]);
#pragma unroll
                    for (int a4 = 0; a4 < 4; ++a4)
#pragma unroll
                        for (int cc = 0; cc < 4; ++cc) C[dt][4 * a4 + cc] *= x2[a4][cc];
                    SB();
                }
            }
            __syncthreads();
            HG_EPI(NCH - 1);
#undef HG_EPI
        } else {
            const int ptid = tid - 256, dp = ptid & 63, q4 = ptid >> 6;
            unsigned g2[2][16], q2[2][16], v2[2][16];
#define HG_LOAD(set, c) do { const size_t row0_ = (size_t)b * SEQ + 64 * (c) + 16 * q4; _Pragma("unroll") for (int i = 0; i < 16; ++i) { \
                g2[set][i] = *(const unsigned*)(LOGF + (row0_ + i) * 1024 + h * 128 + 2 * dp); q2[set][i] = *(const unsigned*)(QS + (row0_ + i) * 2048 + h * 128 + 2 * dp); \
                v2[set][i] = *(const unsigned*)(VH + (row0_ + i) * 1024 + h * 128 + 2 * dp); } } while (0)
#define HG_SUMS(set, c) do { float r0_ = 0.f, r1_ = 0.f; _Pragma("unroll") for (int i = 0; i < 16; ++i) { r0_ += (float)__builtin_bit_cast(_Float16, (unsigned short)(g2[set][i] & 0xffffu)); \
                r1_ += (float)__builtin_bit_cast(_Float16, (unsigned short)(g2[set][i] >> 16)); } *(LAS f32x2_t*)(L_TQ + ((c) & 1) * 512 + q4 * 128 + 2 * dp) = (f32x2_t){r0_, r1_}; } while (0)
            float e0, e1, xa0, xa1, xb0, xb1; unsigned kp0[8], kp1[8], vp0[8], vp1[8];
#define HG_BEGIN(c) do { float off0 = 0.f, off1 = 0.f, cref0 = 0.f, cref1 = 0.f, tot0 = 0.f, tot1 = 0.f; \
                _Pragma("unroll") for (int o = 0; o < 4; ++o) { const f32x2_t tq = *(const LAS f32x2_t*)(L_TQ + ((c) & 1) * 512 + o * 128 + 2 * dp); \
                    if (o < q4) { off0 += tq.x; off1 += tq.y; } if (o < 2) { cref0 += tq.x; cref1 += tq.y; } tot0 += tq.x; tot1 += tq.y; } \
                xa0 = __expf(-cref0); xa1 = __expf(-cref1); xb0 = __expf(cref0); xb1 = __expf(cref1); e0 = __expf(off0); e1 = __expf(off1); \
                if (q4 == 0) { *(LAS f32x2_t*)(L_XS + ((c) & 1) * 256 + 2 * dp) = (f32x2_t){xb0, xb1}; *(LAS f32x2_t*)(L_XS + ((c) & 1) * 256 + 128 + 2 * dp) = (f32x2_t){__expf(tot0 - cref0), __expf(tot1 - cref1)}; } } while (0)
#define HG_TOKENS(set, c, i0) do { LAS unsigned char* T_ = lds + ((c) & 1) * BUFB; _Pragma("unroll") for (int i = (i0); i < (i0) + 8; ++i) { \
                const unsigned gw_ = g2[set][i], qw_ = q2[set][i], vw_ = v2[set][i]; \
                const float f0 = __expf((float)__builtin_bit_cast(_Float16, (unsigned short)(gw_ & 0xffffu))), f1 = __expf((float)__builtin_bit_cast(_Float16, (unsigned short)(gw_ >> 16))); \
                e0 = fmaxf(e0 * f0, 1e-30f); e1 = fmaxf(e1 * f1, 1e-30f); \
                const float r0 = __builtin_amdgcn_rcpf(e0), r1 = __builtin_amdgcn_rcpf(e1); \
                const float qq0 = __builtin_bit_cast(float, qw_ << 16), qq1 = __builtin_bit_cast(float, qw_ & 0xffff0000u); \
                const int t = 16 * q4 + i; \
                *(LAS unsigned*)(T_ + t * RS + 4 * dp) = cvtpk(qq0 * e0 * xa0, qq1 * e1 * xa1); \
                const unsigned ka = cvtpk((1.0f - f0) * r0 * xb0, (1.0f - f1) * r1 * xb1); \
                *(LAS unsigned*)(T_ + O_KA + t * RS + 4 * dp) = ka; \
                if (i & 1) { kp0[i >> 1] |= ka << 16; kp1[i >> 1] |= ka & 0xffff0000u; vp0[i >> 1] |= vw_ << 16; vp1[i >> 1] |= vw_ & 0xffff0000u; } \
                else { kp0[i >> 1] = ka & 0xffffu; kp1[i >> 1] = ka >> 16; vp0[i >> 1] = vw_ & 0xffffu; vp1[i >> 1] = vw_ >> 16; } } } while (0)
#define HG_FINISH(c) do { LAS unsigned char* T_ = lds + ((c) & 1) * BUFB; \
                *(LAS v4u*)(T_ + O_KAT + (2 * dp) * TS + 32 * q4) = (v4u){kp0[0], kp0[1], kp0[2], kp0[3]}; *(LAS v4u*)(T_ + O_KAT + (2 * dp) * TS + 32 * q4 + 16) = (v4u){kp0[4], kp0[5], kp0[6], kp0[7]}; \
                *(LAS v4u*)(T_ + O_KAT + (2 * dp + 1) * TS + 32 * q4) = (v4u){kp1[0], kp1[1], kp1[2], kp1[3]}; *(LAS v4u*)(T_ + O_KAT + (2 * dp + 1) * TS + 32 * q4 + 16) = (v4u){kp1[4], kp1[5], kp1[6], kp1[7]}; \
                *(LAS v4u*)(T_ + O_VT + (2 * dp) * TS + 32 * q4) = (v4u){vp0[0], vp0[1], vp0[2], vp0[3]}; *(LAS v4u*)(T_ + O_VT + (2 * dp) * TS + 32 * q4 + 16) = (v4u){vp0[4], vp0[5], vp0[6], vp0[7]}; \
                *(LAS v4u*)(T_ + O_VT + (2 * dp + 1) * TS + 32 * q4) = (v4u){vp1[0], vp1[1], vp1[2], vp1[3]}; *(LAS v4u*)(T_ + O_VT + (2 * dp + 1) * TS + 32 * q4 + 16) = (v4u){vp1[4], vp1[5], vp1[6], vp1[7]}; } while (0)
            HG_LOAD(0, 0); HG_LOAD(1, 1);
            HG_SUMS(0, 0);
            __syncthreads();
            HG_SUMS(1, 1); HG_BEGIN(0); HG_TOKENS(0, 0, 0); HG_TOKENS(0, 0, 8); HG_FINISH(0); HG_LOAD(0, 2);
#pragma unroll 2
            for (int n = 0; n < NCH; ++n) {
                const int c = n + 1;
                __syncthreads();
                if (c < NCH) { if (c + 1 < NCH) HG_SUMS(n & 1, c + 1); HG_BEGIN(c); HG_TOKENS((n + 1) & 1, c, 0); HG_TOKENS((n + 1) & 1, c, 8); HG_FINISH(c); if (c + 2 < NCH) HG_LOAD((n + 1) & 1, c + 2); }
            }
            __syncthreads();
#undef HG_LOAD
#undef HG_SUMS
#undef HG_BEGIN
#undef HG_TOKENS
#undef HG_FINISH
        }
        __syncthreads();
    }
#undef SB
}

template <bool DIAG> __device__ __forceinline__ bool attn_tile(const bf16x8_t (&Kc)[4], const bf16x8_t (&Vc)[4], const bf16x8_t (&Qf)[4], f32x16& O0, f32x16& O1, float& carry, int r32, int hi) {
    f32x16 Sx;
#pragma unroll
    for (int j = 0; j < 16; ++j) Sx[j] = 0.f;
#pragma unroll
    for (int ks = 0; ks < 4; ++ks) Sx = MFMA32(Kc[ks], Qf[ks], Sx);
    float kp[16], sg[16];
#pragma unroll
    for (int j = 0; j < 16; ++j) {
        const float r = __builtin_amdgcn_rcpf(1.0f + __builtin_amdgcn_exp2f(Sx[j]));
        if (DIAG) { const int sl = 16 * (j >> 3) + 8 * hi + (j & 7); const bool valid = sl < r32; kp[j] = valid ? r : 1.f; sg[j] = valid ? 1.0f - r : 0.f; }
        else { kp[j] = r; sg[j] = 1.0f - r; }
    }
#pragma unroll
    for (int j = 6; j >= 0; --j) { sg[j] *= kp[j + 1]; kp[j] *= kp[j + 1]; sg[8 + j] *= kp[8 + j + 1]; kp[8 + j] *= kp[8 + j + 1]; }
    const float G0 = kp[0], G1 = kp[8];
    const float P0 = __shfl_xor(G0, 32), P1 = __shfl_xor(G1, 32);
    const float after0 = (hi == 0 ? P0 : 1.f) * P1 * G1 * carry, after1 = (hi == 0 ? P1 : 1.f) * carry;
#pragma unroll
    for (int j = 0; j < 16; ++j) sg[j] *= (j < 8 ? after0 : after1);
    carry *= (G0 * G1) * (P0 * P1);
    v4u w0, w1; w0.x = cvtpk(sg[0], sg[1]); w0.y = cvtpk(sg[2], sg[3]); w0.z = cvtpk(sg[4], sg[5]); w0.w = cvtpk(sg[6], sg[7]);
    w1.x = cvtpk(sg[8], sg[9]); w1.y = cvtpk(sg[10], sg[11]); w1.z = cvtpk(sg[12], sg[13]); w1.w = cvtpk(sg[14], sg[15]);
    const bf16x8_t Pb0 = __builtin_bit_cast(bf16x8_t, w0), Pb1 = __builtin_bit_cast(bf16x8_t, w1);
    O0 = MFMA32(Vc[0], Pb0, O0); O0 = MFMA32(Vc[1], Pb1, O0);
    O1 = MFMA32(Vc[2], Pb0, O1); O1 = MFMA32(Vc[3], Pb1, O1);
    return __all(carry == 0.f);
}
__device__ __forceinline__ void attn_mfma(const Args& a, int u0, int ucnt, int ustride) {
    unsigned char* ws = a.ws;
    bf16* QS = (bf16*)(ws + WS_QS); const bf16* SK = (const bf16*)(ws + WS_SK); const bf16* VT = (const bf16*)((unsigned char*)a.out + 32 * MiB);
    const int lane = threadIdx.x & 63, r32 = lane & 31, hi = lane >> 5;
    const int kap = 16 * (r32 >> 4) + 8 * ((r32 >> 2) & 1) + 4 * ((r32 >> 3) & 1) + (r32 & 3);
    for (int uk = 0; uk < ucnt; ++uk) { const int u = u0 + uk * ustride;
        const int qb = u & 63, bh = u >> 6, h = bh & 15, b = bh >> 4;
        const size_t rowq = (size_t)b * SEQ + 32 * qb + r32;
        bf16* qp = QS + rowq * 2048 + 1024 + 64 * h;
        const bf16* kbase = SK + ((size_t)b * SEQ + kap) * 1024 + 64 * h + 8 * hi;
        const bf16* vbase = VT + ((size_t)bh * 64 + r32) * 2048 + 8 * hi;
        bf16x8_t Qf[4];
#pragma unroll
        for (int ks = 0; ks < 4; ++ks) Qf[ks] = *(const bf16x8_t*)(qp + 16 * ks + 8 * hi);
        f32x16 O0, O1;
#pragma unroll
        for (int j = 0; j < 16; ++j) { O0[j] = 0.f; O1[j] = 0.f; }
        float carry = 1.f;
        bf16x8_t KA[4], VA[4], KB[4], VB[4];
#define ATT_LOAD(K_, V_, kb_) do { _Pragma("unroll") for (int ks = 0; ks < 4; ++ks) K_[ks] = *(const bf16x8_t*)(kbase + (size_t)(32 * (kb_)) * 1024 + 16 * ks); \
        _Pragma("unroll") for (int i = 0; i < 4; ++i) V_[i] = *(const bf16x8_t*)(vbase + (size_t)(32 * (i >> 1)) * 2048 + 32 * (kb_) + 16 * (i & 1)); } while (0)
        ATT_LOAD(KA, VA, qb);
        int kb = qb;
        ATT_LOAD(KB, VB, kb > 0 ? kb - 1 : 0);
        if (!(attn_tile<true>(KA, VA, Qf, O0, O1, carry, r32, hi) || kb == 0)) {
            --kb;
#pragma unroll 1
            for (;;) {
                ATT_LOAD(KA, VA, kb > 0 ? kb - 1 : 0);
                if (attn_tile<false>(KB, VB, Qf, O0, O1, carry, r32, hi) || kb == 0) break;
                --kb;
                ATT_LOAD(KB, VB, kb > 0 ? kb - 1 : 0);
                if (attn_tile<false>(KA, VA, Qf, O0, O1, carry, r32, hi) || kb == 0) break;
                --kb;
            }
        }
#undef ATT_LOAD
#pragma unroll
        for (int a4 = 0; a4 < 4; ++a4) {
            u32x2_t x0, x1; x0.x = cvtpk(O0[4 * a4], O0[4 * a4 + 1]); x0.y = cvtpk(O0[4 * a4 + 2], O0[4 * a4 + 3]); x1.x = cvtpk(O1[4 * a4], O1[4 * a4 + 1]); x1.y = cvtpk(O1[4 * a4 + 2], O1[4 * a4 + 3]);
            *(u32x2_t*)(qp + 8 * a4 + 4 * hi) = x0; *(u32x2_t*)(qp + 32 + 8 * a4 + 4 * hi) = x1; }
    }
}

#define XB_TMO      128
#define XB_XCNT(j)  (256  + 64 * (j))
#define XB_XSUB(j)  (1280 + 64 * (j))
#define XB_XGEN(j)  (2304 + 64 * (j))
#define XB_TOP      3328
#define XB_TOPGEN   3392
#define XCD_BAR_WORDS 3456
#define XB_SPIN_CAP (1u << 18)

__device__ __forceinline__ unsigned xb_ld(unsigned* p)              { return __hip_atomic_load(p, __ATOMIC_RELAXED, __HIP_MEMORY_SCOPE_AGENT); }
__device__ __forceinline__ unsigned xb_add(unsigned* p, unsigned v) { return __hip_atomic_fetch_add(p, v, __ATOMIC_RELAXED, __HIP_MEMORY_SCOPE_AGENT); }
__device__ __forceinline__ unsigned xb_xcc_id() { return (unsigned)__builtin_amdgcn_s_getreg((3 << 11) | 20) & 0xFu; }
#define XB_SPIN(cond, bar) do { unsigned _sp = 0; while (cond) { __builtin_amdgcn_s_sleep(1); \
    if ((++_sp & 255u) == 0u) { if (xb_ld(&(bar)[XB_TMO])) break; if (_sp > XB_SPIN_CAP) { atomicAdd(&(bar)[XB_TMO], 1u); break; } } } } while (0)

struct XcdBarrier {
    unsigned* bar; unsigned x;
    volatile LAS unsigned* st;
};

__device__ __forceinline__ XcdBarrier xcd_barrier_post(unsigned* bar, volatile LAS unsigned* st) {
    XcdBarrier b; b.bar = bar; b.x = xb_xcc_id(); b.st = st;
    if (threadIdx.x == 0) (void)xb_add(&bar[XB_XCNT(b.x)], 1u);
    return b;
}
__device__ __forceinline__ void xcd_barrier_complete(unsigned* bar, unsigned x, unsigned& nloc, unsigned& nx) {
    const unsigned G = gridDim.x * gridDim.y * gridDim.z;
    unsigned sum, cnt, mine, sp = 0u;
    for (;;) {
        sum = 0u; cnt = 0u; mine = 0u;
#pragma unroll
        for (unsigned j = 0; j < 16; ++j) { const unsigned c = xb_ld(&bar[XB_XCNT(j)]); sum += c; cnt += (c > 0u) ? 1u : 0u; mine = (j == x) ? c : mine; }
        if (sum == G) break;
        __builtin_amdgcn_s_sleep(1);
        if ((++sp & 255u) == 0u) { if (xb_ld(&bar[XB_TMO])) break; if (sp > XB_SPIN_CAP) { atomicAdd(&bar[XB_TMO], 1u); break; } }
    }
    nloc = mine > 0u ? mine : 1u; nx = cnt > 0u ? cnt : 1u;
}

__device__ __forceinline__ void xcd_barrier(const XcdBarrier& b) {
    asm volatile("s_waitcnt vmcnt(0)" ::: "memory");
    __syncthreads();
    if (threadIdx.x == 0) {
        unsigned* bar = b.bar;
        __builtin_amdgcn_s_waitcnt(0);
        unsigned nloc = b.st[0], nx = b.st[1];
        if (nloc == 0u) { xcd_barrier_complete(bar, b.x, nloc, nx); b.st[0] = nloc; b.st[1] = nx; }
        const unsigned old = xb_add(&bar[XB_XSUB(b.x)], 1u);
        const unsigned gen = old / nloc;
        if (old + 1u == (gen + 1u) * nloc) {
            __builtin_amdgcn_fence(__ATOMIC_RELEASE, "agent");
            asm volatile("s_waitcnt vmcnt(0)" ::: "memory");
            const unsigned og = xb_add(&bar[XB_TOP], 1u);
            const unsigned tg = og / nx;
            if (og + 1u == (tg + 1u) * nx) xb_add(&bar[XB_TOPGEN], 1u);
            else XB_SPIN(xb_ld(&bar[XB_TOPGEN]) == tg, bar);
            __builtin_amdgcn_fence(__ATOMIC_ACQUIRE, "agent");
            xb_add(&bar[XB_XGEN(b.x)], 1u);
            asm volatile("s_waitcnt vmcnt(0)" ::: "memory");
        } else {
            XB_SPIN(xb_ld(&bar[XB_XGEN(b.x)]) == gen, bar);
            __builtin_amdgcn_fence(__ATOMIC_ACQUIRE, "agent");
            asm volatile("s_waitcnt vmcnt(0)" ::: "memory");
        }
    }
    __syncthreads();
}

__global__ void __launch_bounds__(NTHREADS, 2) hybrid_fwd(Args args) {
    extern __shared__ __attribute__((aligned(16))) unsigned char lds_raw[];
    LAS unsigned char* lds = (LAS unsigned char*)lds_raw;
    cg::grid_group grid = cg::this_grid();
    const int tid = threadIdx.x, lane = tid & 63, wave = __builtin_amdgcn_readfirstlane(tid >> 6);
    const int G = gridDim.x;
    unsigned char* ws = args.ws;
    const int lo = args.ph_lo, hi = args.ph_hi;
    volatile LAS unsigned* MISC = (volatile LAS unsigned*)(lds + MISC_OFF);
    if (tid < 2) MISC[tid] = 0u;
    __syncthreads();
    const XcdBarrier bar = xcd_barrier_post((unsigned*)ws, MISC);
#define IN(k) (lo <= (k) && (k) < hi)
#define SEAM(k) do { if (IN(k) && IN((k) + 1)) { xcd_barrier(bar); } } while (0)
    if (lo < 0) grid.sync();
    if (IN(0)) { p0_prologue<0>(args, lds, wave, lane, (int)blockIdx.x * NWAVES + wave, G * NWAVES); asm volatile("s_waitcnt vmcnt(0) lgkmcnt(0)" ::: "memory"); __syncthreads(); }
    SEAM(0);
    if (IN(1)) {
        pg8::Gemm g{(const pg8::bf16_t*)(ws + WS_H), (const pg8::bf16_t*)(ws + WS_WIN), M, 6144, D, D}; pg8::StaticOrder S; S.init(M, 6144, G, (int)blockIdx.x);
        pg8::EpiProj E{(pg8::bf16_t*)(ws + WS_QS), (pg8::bf16_t*)(ws + WS_VH), (pg8::bf16_t*)(ws + WS_SK), (pg8::bf16_t*)((unsigned char*)args.out + 32 * MiB), ws + WS_GH, ws + WS_GA, ws + WS_GB, (_Float16*)args.out,
                       args.in[3], args.in[5], args.in[6], 0};
        pg8::gemm_phase<pg8::EpiProj, pg8::StaticOrder, true, true>(lds, g, S, E);
        pg8::Gemm g2{(const pg8::bf16_t*)(ws + WS_WIN) + (size_t)6144 * 1024, (const pg8::bf16_t*)(ws + WS_H), 1024, M, D, D}; pg8::StaticOrder S2; S2.init(1024, M, G, (int)blockIdx.x);
        pg8::EpiVT E2{(pg8::bf16_t*)((unsigned char*)args.out + 32 * MiB)};
        pg8::gemm_phase<pg8::EpiVT, pg8::StaticOrder, true, true>(lds, g2, S2, E2);
    }
    SEAM(1);
    if (IN(2)) {
        const pg8::Gemm gg{(const pg8::bf16_t*)(ws + WS_H), (const pg8::bf16_t*)(ws + WS_WIN) + (size_t)7168 * 1024, M, 2048, D, D};
        const pg8::EpiProj EG{(pg8::bf16_t*)(ws + WS_QS), (pg8::bf16_t*)(ws + WS_VH), (pg8::bf16_t*)(ws + WS_SK), (pg8::bf16_t*)((unsigned char*)args.out + 32 * MiB), ws + WS_GH, ws + WS_GA, ws + WS_GB, (_Float16*)args.out,
                              args.in[3], args.in[5], args.in[6], 28};
        constexpr int NUNITS = BATCH * 16 * (SEQ / 32);
        if (G == 256) {
            pg8::ListOrder S; S.s.init(M, 2048, 256, 0);
            if ((int)blockIdx.x < 64) { hgrn_v2(args, lds, (int)blockIdx.x, 64); if (wave < 6) p0_prologue<1>(args, lds, wave, lane, 1536 + (int)blockIdx.x * 6 + wave, 1920); S.l0 = -1; S.l1 = -1; S.l2 = -1; }
            else { const int idx = (int)blockIdx.x - 64;
                if (idx < 128) attn_mfma(args, idx * 40 + wave, 5, NWAVES); else attn_mfma(args, 5120 + (idx - 128) * 48 + wave, 6, NWAVES);
                p0_prologue<1>(args, lds, wave, lane, idx * NWAVES + wave, 1920);
                S.l0 = idx; S.l1 = 192 + idx; S.l2 = idx < 128 ? 384 + idx : -1; }
            asm volatile("s_waitcnt vmcnt(0) lgkmcnt(0)" ::: "memory"); __syncthreads();
            pg8::gemm_phase<pg8::EpiProj, pg8::ListOrder, true, true>(lds, gg, S, EG);
        } else {
            const int gw = (int)blockIdx.x * NWAVES + wave, ngw = G * NWAVES;
            hgrn_v2(args, lds, (int)blockIdx.x, G); attn_mfma(args, gw, (NUNITS - gw + ngw - 1) / ngw, ngw); p0_prologue<1>(args, lds, wave, lane, gw, ngw);
            asm volatile("s_waitcnt vmcnt(0) lgkmcnt(0)" ::: "memory"); __syncthreads();
            pg8::StaticOrder S; S.init(M, 2048, G, (int)blockIdx.x);
            pg8::gemm_phase<pg8::EpiProj, pg8::StaticOrder, true, true>(lds, gg, S, EG);
        }
        __syncthreads();
    }
    SEAM(2);
    if (IN(3)) {
        pg8::Gemm g{(const pg8::bf16_t*)(ws + WS_QS), (const pg8::bf16_t*)(ws + WS_WHS), M, D, 1024, 2048}; pg8::SplitOrder S; S.s.init(M, D, G, (int)blockIdx.x);
        pg8::EpiMix E{ws + WS_GA, ws + WS_GB, (pg8::bf16_t*)(ws + WS_MIXED)};
        pg8::gemm_phase<pg8::EpiMix, pg8::SplitOrder, true, true>(lds, g, S, E);
    }
    SEAM(3);
    if (IN(4)) {
        pg8::Gemm g{(const pg8::bf16_t*)(ws + WS_MIXED), (const pg8::bf16_t*)(ws + WS_WO), M, D, D, D}; pg8::StaticOrder S; S.init(M, D, G, (int)blockIdx.x);
        pg8::EpiRes1 E{args.in[0], (pg8::bf16_t*)(ws + WS_GA), (pg8::bf16_t*)(ws + WS_X1B), (float*)(ws + WS_SSQ)};
        pg8::gemm_phase<pg8::EpiRes1, pg8::StaticOrder, true, true>(lds, g, S, E);
    }
    SEAM(4);
    if (IN(5)) {
        pg8::Gemm g{(const pg8::bf16_t*)(ws + WS_X1B), (const pg8::bf16_t*)(ws + WS_WF1), M, 2 * FFH, D, D}; pg8::StaticOrder S; S.init(M, 2 * FFH, G, (int)blockIdx.x);
        pg8::EpiSwiglu E{(const float*)(ws + WS_SSQ), (pg8::bf16_t*)(ws + WS_ACT)};
        pg8::gemm_phase<pg8::EpiSwiglu, pg8::StaticOrder, true, true>(lds, g, S, E);
    }
    SEAM(5);
    if (IN(6)) {
        pg8::Gemm g{(const pg8::bf16_t*)(ws + WS_ACT), (const pg8::bf16_t*)(ws + WS_WF2), M, D, FFH, FFH}; pg8::StaticOrder S; S.init(M, D, G, (int)blockIdx.x);
        pg8::EpiRes2 E{args.in[0], (const pg8::bf16_t*)(ws + WS_GA), args.out};
        pg8::gemm_phase<pg8::EpiRes2, pg8::StaticOrder, true, true>(lds, g, S, E);
    }
#undef IN
#undef SEAM
}

#ifndef MK_N_LAUNCHES
#define MK_N_LAUNCHES 1
#endif
extern "C" void kernel_launch(void* const* d_in, const int* in_sizes, int n_in, void* d_out, int out_size, void* d_ws, size_t ws_size, hipStream_t stream) {
    static int grid = 0;
    if (grid == 0) {
        int dev = 0, cus = 0, per_cu = 0;
        if (n_in != 13 || ws_size < WS_END) { fprintf(stderr, "kernel_launch: unexpected inputs / workspace (%d, %zu)\n", n_in, ws_size); grid = -1; return; }
        hipGetDevice(&dev); hipDeviceGetAttribute(&cus, hipDeviceAttributeMultiprocessorCount, dev);
        if (hipFuncSetAttribute((const void*)hybrid_fwd, hipFuncAttributeMaxDynamicSharedMemorySize, LDS_BYTES) != hipSuccess) { fprintf(stderr, "kernel_launch: hipFuncSetAttribute failed\n"); grid = -1; return; }
        if (hipOccupancyMaxActiveBlocksPerMultiprocessor(&per_cu, (const void*)hybrid_fwd, NTHREADS, LDS_BYTES) != hipSuccess || per_cu < 1) { fprintf(stderr, "kernel_launch: occupancy query says %d\n", per_cu); per_cu = 1; }
        (void)hipGetLastError();
        grid = cus * per_cu;
    }
    if (grid < 0) return;
    if (hipMemsetAsync(d_ws, 0, 16384, stream) != hipSuccess) { fprintf(stderr, "kernel_launch: memset of the barrier words failed\n"); return; }
    Args a{};
    for (int i = 0; i < 13; ++i) a.in[i] = (const float*)d_in[i];
    a.out = (float*)d_out; a.ws = (unsigned char*)d_ws;
#if MK_N_LAUNCHES == 1
    a.ph_lo = 0; a.ph_hi = 7;
    void* kargs[] = {&a};
    hipError_t e = hipLaunchCooperativeKernel((const void*)hybrid_fwd, dim3(grid), dim3(NTHREADS), kargs, LDS_BYTES, stream);
    if (e != hipSuccess) fprintf(stderr, "cooperative launch failed: %s (grid %d)\n", hipGetErrorString(e), grid);
#else
    for (int p = 0; p < 7; ++p) { a.ph_lo = p; a.ph_hi = p + 1; hipLaunchKernelGGL(hybrid_fwd, dim3(grid), dim3(NTHREADS), LDS_BYTES, stream, a); }
#endif
}
```

```cpp
#include <hip/hip_runtime.h>
#include <hip/hip_cooperative_groups.h>
#include <cstdio>
#include <cstdint>
namespace cg = cooperative_groups;
namespace pg8 {
#define PG8_LAS __attribute__((address_space(3)))
typedef unsigned short bf16_t;
typedef short bf16x8 __attribute__((ext_vector_type(8)));
typedef float f32x4 __attribute__((ext_vector_type(4)));
typedef unsigned u32x4 __attribute__((ext_vector_type(4)));
constexpr int BM = 256, BK = 64, HALF = 128, HTB = HALF * BK * 2  , STAGE_BYTES = 8 * HTB, NXCD = 8, WGM = 8;

__host__ __device__ __forceinline__ int lds_byte(int r, int c) { const int st = (r >> 4) * 2 + (c >> 5), rr = r & 15, cc = c & 31, ob = rr * 64 + cc * 2; return st * 1024 + (ob ^ (((ob >> 9) & 1) << 5)); }
__host__ __device__ __forceinline__ void stage_rc(int b, int& R, int& C) { const int st = b / 1024, sb = b % 1024, swz = sb ^ (((sb >> 9) & 1) << 5); R = (st >> 1) * 16 + swz / 64; C = (st & 1) * 32 + (swz % 64) / 2; }
__host__ __device__ __forceinline__ int perm32(int rho) { const int n = rho >> 4, i = rho & 15; return 8 * (i >> 2) + 4 * n + (i & 3); }

struct Unit { int pm, pn, kh; };
struct Gemm { const bf16_t* A; const bf16_t* Bt; int M, N, K, ld; };

struct StaticOrder {
    int nM, nN, nwg, G, c;
    __host__ __device__ void init(int M, int N, int G_, int c_) { nM = M / BM; nN = N / BM; nwg = nM * nN; G = G_; c = c_; }
    __host__ __device__ bool next(int i, Unit& u) const { const long L = (long)i * G + c; if (L >= nwg) return false; return unit_of((int)L, u); }
    __host__ __device__ bool unit_of(int L, Unit& u) const {
        int wgid = L; { const int q = nwg / NXCD, r = nwg % NXCD, xcd = wgid % NXCD, off = wgid / NXCD; wgid = (xcd < r ? xcd * (q + 1) : r * (q + 1) + (xcd - r) * q) + off; }
        const int nig = WGM * nN, gid = wgid / nig, fm = gid * WGM, gsz = (nM - fm) < WGM ? (nM - fm) : WGM;
        u.pm = fm + ((wgid % nig) % gsz); u.pn = (wgid % nig) / gsz; u.kh = 0; return true;
    }
    __device__ __forceinline__ void a_ready(const Unit&) const {}
    __device__ __forceinline__ void done(const Unit&) const {}
};
struct ListOrder {
    StaticOrder s; int l0, l1, l2;
    __host__ __device__ bool next(int i, Unit& u) const { const int L = i == 0 ? l0 : (i == 1 ? l1 : (i == 2 ? l2 : -1)); if (L < 0 || L >= s.nwg) return false; return s.unit_of(L, u); }
    __device__ __forceinline__ void a_ready(const Unit&) const {}
    __device__ __forceinline__ void done(const Unit&) const {}
};
struct SplitOrder {
    StaticOrder s;
    __host__ __device__ bool next(int i, Unit& u) const { const bool ok = s.next(i >> 1, u); u.kh = i & 1; return ok; }
    __device__ __forceinline__ void a_ready(const Unit&) const {}
    __device__ __forceinline__ void done(const Unit&) const {}
};
typedef float f32x2_cv __attribute__((ext_vector_type(2))); typedef __bf16 bf16x2_cvv __attribute__((ext_vector_type(2)));
__device__ __forceinline__ unsigned cvt_pk_bf16(float lo, float hi) { const f32x2_cv v = {lo, hi}; return __builtin_bit_cast(unsigned, __builtin_convertvector(v, bf16x2_cvv)); }
typedef float f32x2 __attribute__((ext_vector_type(2)));
typedef _Float16 f16x8 __attribute__((ext_vector_type(8)));
typedef unsigned u32x2 __attribute__((ext_vector_type(2)));
__device__ __forceinline__ float sigm(float x) { return __builtin_amdgcn_rcpf(1.0f + __expf(-x)); }
__device__ __forceinline__ unsigned q8(float s) { float q = s * 255.0f + 0.5f; q = q < 1.0f ? 1.0f : (q > 255.0f ? 255.0f : q); return (unsigned)q; }
__device__ __forceinline__ u32x4 pack8_bf16(const float (&o)[8]) { u32x4 w; w.x = cvt_pk_bf16(o[0], o[1]); w.y = cvt_pk_bf16(o[2], o[3]); w.z = cvt_pk_bf16(o[4], o[5]); w.w = cvt_pk_bf16(o[6], o[7]); return w; }
__device__ __forceinline__ u32x2 pack8_u8(const float (&o)[8]) { u32x2 w; unsigned a = 0u, c = 0u;
#pragma unroll
    for (int k = 0; k < 4; ++k) { a = __builtin_amdgcn_cvt_pk_u8_f32(fmaxf(o[k] * 255.0f, 1.0f), k, a); c = __builtin_amdgcn_cvt_pk_u8_f32(fmaxf(o[4 + k] * 255.0f, 1.0f), k, c); }
    w.x = a; w.y = c; return w; }

struct EpiProj {
    static constexpr bool PERM = true, AFTER_DRAIN = false, KSPLIT = false;
    bf16_t* QS; bf16_t* VH; bf16_t* SK; bf16_t* SV; unsigned char* GH; unsigned char* GA; unsigned char* GB; _Float16* LOGF;
    const float* lbl; const float* qg; const float* kg; int pn0;
    __device__ __forceinline__ void operator()(const f32x4 (&acc)[2][2][4][2], const Unit& u, int wr, int wc, int fr, int fq) const {
        const int sec = (u.pn + pn0) >> 2, ct = (u.pn & 3) * 256;
        const int row0 = u.pm * BM + wr * 64 + fr;
        if (sec == 4 || sec == 5) {
            const int head = (u.pn & 3) * 4 + wc; const float* gp = (sec == 4 ? qg : kg) + head * 64 + 8 * fq;
            float gn[2][8];
#pragma unroll
            for (int bj = 0; bj < 2; ++bj) { const f32x4 a = *(const f32x4*)(gp + 32 * bj), b = *(const f32x4*)(gp + 32 * bj + 4);
                gn[bj][0] = a[0]; gn[bj][1] = a[1]; gn[bj][2] = a[2]; gn[bj][3] = a[3]; gn[bj][4] = b[0]; gn[bj][5] = b[1]; gn[bj][6] = b[2]; gn[bj][7] = b[3]; }
            const float sc = (sec == 4) ? 0.125f * 1.4426950408889634f : 1.0f;
#pragma unroll
            for (int ai = 0; ai < 2; ++ai)
#pragma unroll
                for (int m = 0; m < 4; ++m) {
                    float ss = 0.f;
#pragma unroll
                    for (int bj = 0; bj < 2; ++bj)
#pragma unroll
                        for (int n = 0; n < 2; ++n) { const f32x4 x = acc[ai][bj][m][n]; ss += (x[0] * x[0] + x[1] * x[1]) + (x[2] * x[2] + x[3] * x[3]); }
                    ss += __shfl_xor(ss, 16); ss += __shfl_xor(ss, 32);
                    const float rstd = __builtin_amdgcn_rsqf(ss * (1.0f / 64.0f) + 1e-6f) * sc;
                    const size_t row = (size_t)(row0 + ai * HALF + m * 16);
#pragma unroll
                    for (int bj = 0; bj < 2; ++bj) { float o[8];
#pragma unroll
                        for (int k = 0; k < 8; ++k) o[k] = acc[ai][bj][m][k >> 2][k & 3] * rstd * gn[bj][k];
                        bf16_t* dst = (sec == 4) ? (QS + row * 2048 + 1024 + head * 64 + 32 * bj + 8 * fq) : (SK + row * 1024 + head * 64 + 32 * bj + 8 * fq);
                        *(u32x4*)dst = pack8_bf16(o); }
                }
            return;
        }
#pragma unroll
        for (int bj = 0; bj < 2; ++bj) {
            const int col = ct + bj * HALF + wc * 32 + 8 * fq;
            float lb[8];
            if (sec == 1) {
#pragma unroll
                for (int k = 0; k < 8; ++k) lb[k] = 1.0f / (1.0f + __expf(lbl[1024 + col + k] - lbl[col + k]));
            }
#pragma unroll
            for (int ai = 0; ai < 2; ++ai)
#pragma unroll
                for (int m = 0; m < 4; ++m) {
                    const size_t row = (size_t)(row0 + ai * HALF + m * 16);
                    float o[8];
#pragma unroll
                    for (int k = 0; k < 8; ++k) o[k] = acc[ai][bj][m][k >> 2][k & 3];
                    if (sec == 0) { *(u32x4*)(QS + row * 2048 + col) = pack8_bf16(o); }
                    else if (sec == 2) { *(u32x4*)(VH + row * 1024 + col) = pack8_bf16(o); }
                    else if (sec == 6) { bf16_t* vt = SV + ((size_t)((row >> 11) * 16 + (col >> 6)) * 64 + (col & 63)) * 2048 + (row & 2047);
#pragma unroll
                        for (int k = 0; k < 8; ++k) vt[(size_t)k * 2048] = (bf16_t)(cvt_pk_bf16(o[k], o[k]) & 0xffffu); }
                    else if (sec == 1) { f16x8 g;
#pragma unroll
                        for (int k = 0; k < 8; ++k) g[k] = (_Float16)__logf(lb[k] + (1.0f - lb[k]) * sigm(o[k]));
                        *(f16x8*)(LOGF + row * 1024 + col) = g; }
                    else {
#pragma unroll
                        for (int k = 0; k < 8; ++k) o[k] = sigm(o[k]);
                        unsigned char* dst = (sec == 3) ? GH : (sec == 7 ? GA : GB);
                        *(u32x2*)(dst + row * 1024 + col) = pack8_u8(o); }
                }
        }
    }
};
struct EpiVT {
    static constexpr bool PERM = true, AFTER_DRAIN = false, KSPLIT = false;
    bf16_t* VT;
    __device__ __forceinline__ void operator()(const f32x4 (&acc)[2][2][4][2], const Unit& u, int wr, int wc, int fr, int fq) const {
        const int row0 = u.pm * BM + wr * 64 + fr;
#pragma unroll
        for (int ai = 0; ai < 2; ++ai)
#pragma unroll
            for (int m = 0; m < 4; ++m)
#pragma unroll
                for (int bj = 0; bj < 2; ++bj) {
                    const int r = row0 + ai * HALF + m * 16, c = u.pn * BM + bj * HALF + wc * 32 + 8 * fq;
                    float o[8];
#pragma unroll
                    for (int k = 0; k < 8; ++k) o[k] = acc[ai][bj][m][k >> 2][k & 3];
                    *(u32x4*)(VT + ((size_t)((c >> 11) * 16 + (r >> 6)) * 64 + (r & 63)) * 2048 + (c & 2047)) = pack8_bf16(o);
                }
    }
};
struct EpiMix {
    static constexpr bool PERM = true, AFTER_DRAIN = false, KSPLIT = true;
    const unsigned char* GA; const unsigned char* GB; bf16_t* MIXED;
    __device__ __forceinline__ void half0(f32x4 (&acc)[2][2][4][2], const Unit& u, int wr, int wc, int fr, int fq) const {
        const int row0 = u.pm * BM + wr * 64 + fr;
#pragma unroll
        for (int ai = 0; ai < 2; ++ai)
#pragma unroll
            for (int m = 0; m < 4; ++m)
#pragma unroll
                for (int bj = 0; bj < 2; ++bj) {
                    const size_t off = (size_t)(row0 + ai * HALF + m * 16) * 1024 + u.pn * BM + bj * HALF + wc * 32 + 8 * fq;
                    const u32x2 a = *(const u32x2*)(GA + off), b = *(const u32x2*)(GB + off);
#pragma unroll
                    for (int k = 0; k < 8; ++k) { const float qa = (float)((a[k >> 2] >> (8 * (k & 3))) & 255u), qb = (float)((b[k >> 2] >> (8 * (k & 3))) & 255u);
                        acc[ai][bj][m][k >> 2][k & 3] *= qa * __builtin_amdgcn_rcpf(qb); }
                    if (bj == 1 && (m & 1)) asm volatile("" ::: "memory");
                }
    }
    __device__ __forceinline__ void operator()(f32x4 (&acc)[2][2][4][2], const Unit& u, int wr, int wc, int fr, int fq) const {
        if (u.kh == 0) { half0(acc, u, wr, wc, fr, fq); return; }
        const int row0 = u.pm * BM + wr * 64 + fr;
        u32x2 gbv[2][4][2];
#pragma unroll
        for (int ai = 0; ai < 2; ++ai)
#pragma unroll
            for (int m = 0; m < 4; ++m)
#pragma unroll
                for (int bj = 0; bj < 2; ++bj) gbv[ai][m][bj] = *(const u32x2*)(GB + (size_t)(row0 + ai * HALF + m * 16) * 1024 + u.pn * BM + bj * HALF + wc * 32 + 8 * fq);
#pragma unroll
        for (int ai = 0; ai < 2; ++ai)
#pragma unroll
            for (int m = 0; m < 4; ++m)
#pragma unroll
                for (int bj = 0; bj < 2; ++bj) {
                    const size_t off = (size_t)(row0 + ai * HALF + m * 16) * 1024 + u.pn * BM + bj * HALF + wc * 32 + 8 * fq;
                    const u32x2 b = gbv[ai][m][bj]; float o[8];
#pragma unroll
                    for (int k = 0; k < 8; ++k) { const float qb = (float)((b[k >> 2] >> (8 * (k & 3))) & 255u); o[k] = acc[ai][bj][m][k >> 2][k & 3] * (qb * (1.0f / 255.0f)); }
                    *(u32x4*)(MIXED + off) = pack8_bf16(o);
                }
    }
};
struct EpiRes1 {
    static constexpr bool PERM = true, AFTER_DRAIN = false, KSPLIT = false;
    const float* x; bf16_t* DL; bf16_t* X1B; float* SSQ;
    __device__ __forceinline__ void operator()(const f32x4 (&acc)[2][2][4][2], const Unit& u, int wr, int wc, int fr, int fq) const {
        const int row0 = u.pm * BM + wr * 64 + fr;
#pragma unroll
        for (int ai = 0; ai < 2; ++ai)
#pragma unroll
            for (int mp = 0; mp < 2; ++mp) {
                f32x4 xv[2][2][2];
#pragma unroll
                for (int mm = 0; mm < 2; ++mm)
#pragma unroll
                    for (int bj = 0; bj < 2; ++bj) { const size_t off = (size_t)(row0 + ai * HALF + (2 * mp + mm) * 16) * 1024 + u.pn * BM + bj * HALF + wc * 32 + 8 * fq;
                        xv[mm][bj][0] = *(const f32x4*)(x + off); xv[mm][bj][1] = *(const f32x4*)(x + off + 4); }
#pragma unroll
                for (int mm = 0; mm < 2; ++mm) {
                    const int m = 2 * mp + mm; const int row = row0 + ai * HALF + m * 16; float ss = 0.f;
#pragma unroll
                    for (int bj = 0; bj < 2; ++bj) {
                        const size_t off = (size_t)row * 1024 + u.pn * BM + bj * HALF + wc * 32 + 8 * fq;
                        const f32x4 a0 = acc[ai][bj][m][0], a1 = acc[ai][bj][m][1];
                        const f32x4 v0 = xv[mm][bj][0] + a0, v1 = xv[mm][bj][1] + a1;
                        u32x4 dw; dw.x = cvt_pk_bf16(a0[0], a0[1]); dw.y = cvt_pk_bf16(a0[2], a0[3]); dw.z = cvt_pk_bf16(a1[0], a1[1]); dw.w = cvt_pk_bf16(a1[2], a1[3]); *(u32x4*)(DL + off) = dw;
                        u32x4 w; w.x = cvt_pk_bf16(v0[0], v0[1]); w.y = cvt_pk_bf16(v0[2], v0[3]); w.z = cvt_pk_bf16(v1[0], v1[1]); w.w = cvt_pk_bf16(v1[2], v1[3]);
                        *(u32x4*)(X1B + off) = w;
                        ss += (v0[0] * v0[0] + v0[1] * v0[1]) + (v0[2] * v0[2] + v0[3] * v0[3]) + (v1[0] * v1[0] + v1[1] * v1[1]) + (v1[2] * v1[2] + v1[3] * v1[3]);
                    }
                    ss += __shfl_xor(ss, 16); ss += __shfl_xor(ss, 32);
                    if (fq == 0) SSQ[(size_t)row * 16 + u.pn * 4 + wc] = ss;
                }
            }
    }
};
struct EpiSwiglu {
    static constexpr bool PERM = true, AFTER_DRAIN = false, KSPLIT = false;
    const float* SSQ; bf16_t* ACT;
    __device__ __forceinline__ void operator()(const f32x4 (&acc)[2][2][4][2], const Unit& u, int wr, int wc, int fr, int fq) const {
        const int row0 = u.pm * BM + wr * 64 + fr;
        f32x4 sq[2][4];
#pragma unroll
        for (int ai = 0; ai < 2; ++ai)
#pragma unroll
            for (int m = 0; m < 4; ++m) sq[ai][m] = *(const f32x4*)(SSQ + (size_t)(row0 + ai * HALF + m * 16) * 16 + 4 * fq);
#pragma unroll
        for (int ai = 0; ai < 2; ++ai)
#pragma unroll
            for (int m = 0; m < 4; ++m) {
                const int row = row0 + ai * HALF + m * 16;
                float ss = (sq[ai][m][0] + sq[ai][m][1]) + (sq[ai][m][2] + sq[ai][m][3]);
                ss += __shfl_xor(ss, 16); ss += __shfl_xor(ss, 32);
                const float rstd = __builtin_amdgcn_rsqf(ss * (1.0f / 1024.0f) + 1e-6f);
                float o[8];
#pragma unroll
                for (int k = 0; k < 8; ++k) { const float g = acc[ai][0][m][k >> 2][k & 3] * rstd, up = acc[ai][1][m][k >> 2][k & 3] * rstd; o[k] = g * sigm(g) * up; }
                *(u32x4*)(ACT + (size_t)row * 2816 + u.pn * 128 + wc * 32 + 8 * fq) = pack8_bf16(o);
            }
    }
};
struct EpiRes2 {
    static constexpr bool PERM = true, AFTER_DRAIN = false, KSPLIT = false;
    const float* x; const bf16_t* DL; float* out;
    __device__ __forceinline__ void operator()(const f32x4 (&acc)[2][2][4][2], const Unit& u, int wr, int wc, int fr, int fq) const {
        const int row0 = u.pm * BM + wr * 64 + fr;
#pragma unroll
        for (int ai = 0; ai < 2; ++ai)
#pragma unroll
            for (int mp = 0; mp < 2; ++mp) {
                f32x4 xv[2][2][2]; u32x4 dv[2][2];
#pragma unroll
                for (int mm = 0; mm < 2; ++mm)
#pragma unroll
                    for (int bj = 0; bj < 2; ++bj) { const size_t off = (size_t)(row0 + ai * HALF + (2 * mp + mm) * 16) * 1024 + u.pn * BM + bj * HALF + wc * 32 + 8 * fq;
                        xv[mm][bj][0] = *(const f32x4*)(x + off); xv[mm][bj][1] = *(const f32x4*)(x + off + 4); dv[mm][bj] = *(const u32x4*)(DL + off); }
#pragma unroll
                for (int mm = 0; mm < 2; ++mm)
#pragma unroll
                    for (int bj = 0; bj < 2; ++bj) { const int m = 2 * mp + mm;
                        const size_t off = (size_t)(row0 + ai * HALF + m * 16) * 1024 + u.pn * BM + bj * HALF + wc * 32 + 8 * fq;
                        const u32x4 dw = dv[mm][bj];
                        f32x4 d0, d1; d0[0] = __builtin_bit_cast(float, dw.x << 16); d0[1] = __builtin_bit_cast(float, dw.x & 0xffff0000u); d0[2] = __builtin_bit_cast(float, dw.y << 16); d0[3] = __builtin_bit_cast(float, dw.y & 0xffff0000u);
                        d1[0] = __builtin_bit_cast(float, dw.z << 16); d1[1] = __builtin_bit_cast(float, dw.z & 0xffff0000u); d1[2] = __builtin_bit_cast(float, dw.w << 16); d1[3] = __builtin_bit_cast(float, dw.w & 0xffff0000u);
                        const f32x4 v0 = (xv[mm][bj][0] + d0) + acc[ai][bj][m][0], v1 = (xv[mm][bj][1] + d1) + acc[ai][bj][m][1];
                        *(f32x4*)(out + off) = v0; *(f32x4*)(out + off + 4) = v1; }
            }
    }
};

template <class Epi, class Sched, bool ALIGN_EPI = false, bool SP2 = false>
__device__ __forceinline__ void gemm_phase(PG8_LAS unsigned char* lds, const Gemm g, const Sched& S, const Epi& E) {
    int tid_ = threadIdx.x; asm volatile("" : "+v"(tid_));
    const int tid = tid_, wid = __builtin_amdgcn_readfirstlane(tid >> 6), lane = tid & 63, wr = wid >> 2, wc = wid & 3, fr = lane & 15, fq = lane >> 4;
    const int K = g.K, nt = K / BK;
    unsigned voffA[2], voffB[2];
#pragma unroll
    for (int i = 0; i < 2; ++i) { int R, C; stage_rc(tid * 16 + i * 8192, R, C); const int Rb = Epi::PERM ? ((R & ~31) + perm32(R & 31)) : R;
        voffA[i] = (unsigned)(R * g.ld + C) * 2u; voffB[i] = (unsigned)(Rb * g.ld + C) * 2u; }
    const size_t kstep = (size_t)(BK * 2);
    const size_t hstep = (size_t)HALF * g.ld * 2; const size_t khb = (size_t)K * 2;
    const size_t tstep = 2 * hstep;
    const unsigned ldsw = (unsigned)wid * 1024u;
    const int aoff = lds_byte(wr * 64 + fr, fq * 8), boff = lds_byte(wc * 32 + fr, fq * 8);
#define PG8_SA(b, h) (((b) * 2 + (h)) * HTB)
#define PG8_SB(b, h) ((4 + (b) * 2 + (h)) * HTB)
#define PG8_STAGE(bufoff, gbase, voff) do { _Pragma("unroll") for (int _i = 0; _i < 2; ++_i) \
        __builtin_amdgcn_global_load_lds((const unsigned*)((const char*)(gbase) + (voff)[_i]), (PG8_LAS unsigned*)(lds + (bufoff) + ldsw + _i * 8192), 16, 0, 0); } while (0)
#define PG8_LDA(dst, b, h) do { _Pragma("unroll") for (int m = 0; m < 4; ++m) _Pragma("unroll") for (int k = 0; k < 2; ++k) dst[m][k] = *(const PG8_LAS bf16x8*)(lds + PG8_SA(b, h) + aoff + m * 2048 + k * 1024); } while (0)
#define PG8_LDB(dst, b, h) do { _Pragma("unroll") for (int n = 0; n < 2; ++n) _Pragma("unroll") for (int k = 0; k < 2; ++k) dst[n][k] = *(const PG8_LAS bf16x8*)(lds + PG8_SB(b, h) + boff + n * 2048 + k * 1024); } while (0)
#define PG8_MMA(ai, bj, At, Bt) do { __builtin_amdgcn_s_setprio(1); _Pragma("unroll") for (int m = 0; m < 4; ++m) _Pragma("unroll") for (int n = 0; n < 2; ++n) _Pragma("unroll") for (int k = 0; k < 2; ++k) \
        acc[ai][bj][m][n] = __builtin_amdgcn_mfma_f32_16x16x32_bf16(Bt[n][k], At[m][k], acc[ai][bj][m][n], 0, 0, 0); __builtin_amdgcn_s_setprio(0); } while (0)
#define PG8_WAIT_V(n) asm volatile("s_waitcnt vmcnt(" #n ")" ::: "memory")
#define PG8_WAIT_L(n) asm volatile("s_waitcnt lgkmcnt(" #n ")" ::: "memory")
#define PG8_BAR __builtin_amdgcn_s_barrier()
#define PG8_SCHED __builtin_amdgcn_sched_barrier(0)
    Unit cur, nxt; int ui = 0;
    if (!S.next(0, cur)) return;
    f32x4 acc[2][2][4][2];
#pragma unroll
    for (int a = 0; a < 2; ++a)
#pragma unroll
        for (int b = 0; b < 2; ++b)
#pragma unroll
            for (int m = 0; m < 4; ++m)
#pragma unroll
                for (int n = 0; n < 2; ++n) acc[a][b][m][n] = (f32x4){0.f, 0.f, 0.f, 0.f};
    bf16x8 At[4][2], B0[2][2], B1[2][2];
    const char* cA = (const char*)g.A + (size_t)cur.pm * tstep + cur.kh * khb; const char* cB = (const char*)g.Bt + (size_t)cur.pn * tstep + cur.kh * khb;
    S.a_ready(cur);
    if constexpr (SP2) {
        PG8_STAGE(PG8_SB(0, 0), cB, voffB); PG8_STAGE(PG8_SB(0, 1), cB + hstep, voffB); PG8_STAGE(PG8_SA(0, 0), cA, voffA); PG8_STAGE(PG8_SA(0, 1), cA + hstep, voffA);
        if (wr == 1) PG8_BAR;
        PG8_WAIT_V(2); PG8_BAR;
        PG8_STAGE(PG8_SB(1, 0), cB + kstep, voffB); PG8_STAGE(PG8_SA(1, 0), cA + kstep, voffA); PG8_STAGE(PG8_SB(1, 1), cB + hstep + kstep, voffB);
        PG8_WAIT_V(6); PG8_BAR;
    } else {
        PG8_STAGE(PG8_SB(0, 0), cB, voffB); PG8_STAGE(PG8_SA(0, 0), cA, voffA); PG8_STAGE(PG8_SB(0, 1), cB + hstep, voffB); PG8_STAGE(PG8_SA(0, 1), cA + hstep, voffA);
        if (wr == 1) PG8_BAR;
        PG8_WAIT_V(4); PG8_BAR;
        PG8_STAGE(PG8_SB(1, 0), cB + kstep, voffB); PG8_STAGE(PG8_SA(1, 0), cA + kstep, voffA); PG8_STAGE(PG8_SB(1, 1), cB + hstep + kstep, voffB);
        PG8_WAIT_V(6); PG8_BAR;
    }
    for (;;) {
        const bool has_next = S.next(ui + 1, nxt);
        const char* nA = has_next ? (const char*)g.A + (size_t)nxt.pm * tstep + nxt.kh * khb : cA; const char* nB = has_next ? (const char*)g.Bt + (size_t)nxt.pn * tstep + nxt.kh * khb : cB;
        for (int t = 0; t < nt; t += 2) {
            const bool last = (t == nt - 2);
            const char* a1 = cA + (size_t)(t + 1) * kstep;
            const char* a2 = last ? nA : cA + (size_t)(t + 2) * kstep; const char* b2 = last ? nB : cB + (size_t)(t + 2) * kstep;
            const char* a3 = a2 + kstep; const char* b3 = b2 + kstep;
            if (last && has_next) S.a_ready(nxt);
            if constexpr (SP2) {
            PG8_LDB(B0, 0, 0); PG8_LDB(B1, 0, 1); PG8_SCHED; PG8_LDA(At, 0, 0); PG8_STAGE(PG8_SA(1, 1), a1 + hstep, voffA);
            PG8_WAIT_V(8); PG8_WAIT_L(0); PG8_BAR; PG8_MMA(0, 0, At, B0); PG8_MMA(0, 1, At, B1); PG8_BAR; PG8_SCHED;
            PG8_LDA(At, 0, 1); PG8_STAGE(PG8_SB(0, 0), b2, voffB); PG8_STAGE(PG8_SB(0, 1), b2 + hstep, voffB); PG8_STAGE(PG8_SA(0, 0), a2, voffA);
            PG8_WAIT_V(8); PG8_WAIT_L(0); PG8_BAR; PG8_MMA(1, 0, At, B0); PG8_MMA(1, 1, At, B1); PG8_BAR; PG8_SCHED;
            PG8_LDB(B0, 1, 0); PG8_LDB(B1, 1, 1); PG8_SCHED; PG8_LDA(At, 1, 0); PG8_STAGE(PG8_SA(0, 1), a2 + hstep, voffA);
            PG8_WAIT_V(8); PG8_WAIT_L(0); PG8_BAR; PG8_MMA(0, 0, At, B0); PG8_MMA(0, 1, At, B1); PG8_BAR; PG8_SCHED;
            PG8_LDA(At, 1, 1); PG8_STAGE(PG8_SB(1, 0), b3, voffB); PG8_STAGE(PG8_SB(1, 1), b3 + hstep, voffB); PG8_STAGE(PG8_SA(1, 0), a3, voffA);
            PG8_WAIT_V(8); PG8_WAIT_L(0); PG8_BAR; PG8_MMA(1, 0, At, B0); PG8_MMA(1, 1, At, B1); PG8_BAR; PG8_SCHED;
            } else {
            PG8_LDB(B0, 0, 0); PG8_SCHED; PG8_LDA(At, 0, 0); PG8_STAGE(PG8_SA(1, 1), a1 + hstep, voffA);
            PG8_WAIT_L(8); PG8_BAR; PG8_WAIT_L(0); PG8_MMA(0, 0, At, B0); PG8_BAR; PG8_SCHED;
            PG8_LDB(B1, 0, 1); PG8_STAGE(PG8_SB(0, 0), b2, voffB);
            PG8_BAR; PG8_WAIT_L(0); PG8_MMA(0, 1, At, B1); PG8_BAR;
            PG8_LDA(At, 0, 1); PG8_STAGE(PG8_SA(0, 0), a2, voffA);
            PG8_BAR; PG8_WAIT_L(0); PG8_MMA(1, 0, At, B0); PG8_BAR; PG8_SCHED;
            PG8_STAGE(PG8_SB(0, 1), b2 + hstep, voffB);
            PG8_WAIT_V(6); PG8_BAR; PG8_MMA(1, 1, At, B1); PG8_BAR;
            PG8_LDB(B0, 1, 0); PG8_SCHED; PG8_LDA(At, 1, 0); PG8_STAGE(PG8_SA(0, 1), a2 + hstep, voffA);
            PG8_WAIT_L(8); PG8_BAR; PG8_WAIT_L(0); PG8_MMA(0, 0, At, B0); PG8_BAR; PG8_SCHED;
            PG8_LDB(B1, 1, 1); PG8_STAGE(PG8_SB(1, 0), b3, voffB);
            PG8_BAR; PG8_WAIT_L(0); PG8_MMA(0, 1, At, B1); PG8_BAR;
            PG8_LDA(At, 1, 1); PG8_STAGE(PG8_SA(1, 0), a3, voffA);
            PG8_BAR; PG8_WAIT_L(0); PG8_MMA(1, 0, At, B0); PG8_BAR; PG8_SCHED;
            PG8_STAGE(PG8_SB(1, 1), b3 + hstep, voffB);
            PG8_WAIT_V(6); PG8_BAR; PG8_MMA(1, 1, At, B1); PG8_BAR;
            }
        }
        if constexpr (ALIGN_EPI) { if (wr == 0) PG8_BAR; }
        if constexpr (!Epi::AFTER_DRAIN) { E(acc, cur, wr, wc, fr, fq); S.done(cur); }
        if (!has_next) break;
        if (!(Epi::KSPLIT && cur.kh == 0))
#pragma unroll
        for (int a = 0; a < 2; ++a)
#pragma unroll
            for (int b = 0; b < 2; ++b)
#pragma unroll
                for (int m = 0; m < 4; ++m)
#pragma unroll
                    for (int n = 0; n < 2; ++n) acc[a][b][m][n] = (f32x4){0.f, 0.f, 0.f, 0.f};
        cur = nxt; cA = nA; cB = nB; ++ui;
        if constexpr (ALIGN_EPI) { if (wr == 1) PG8_BAR; }
    }
    PG8_WAIT_V(0);
    if constexpr (!ALIGN_EPI) { if (wr == 0) PG8_BAR; }
    PG8_BAR;
    if constexpr (Epi::AFTER_DRAIN) { E.fused(acc, cur, wr, wc, fr, fq, lds, wid, lane); S.done(cur); }
#undef PG8_SA
#undef PG8_SB
#undef PG8_STAGE
#undef PG8_LDA
#undef PG8_LDB
#undef PG8_MMA
#undef PG8_WAIT_V
#undef PG8_WAIT_L
#undef PG8_BAR
#undef PG8_SCHED
}
}

constexpr int NWAVES = 8, NTHREADS = 512;
constexpr int BATCH = 8, SEQ = 2048, D = 1024, M = BATCH * SEQ, INW = 9216, FFH = 2816;
constexpr float EPS = 1e-6f;
constexpr size_t MiB = 1u << 20;
constexpr size_t WS_SSQ = 1 * MiB;
constexpr size_t WS_WIN = 2 * MiB;
constexpr size_t WS_WHS = 20 * MiB;
constexpr size_t WS_WO = 24 * MiB;
constexpr size_t WS_WF1 = 26 * MiB;
constexpr size_t WS_WF2 = 37 * MiB;
constexpr size_t WS_H = 43 * MiB;
constexpr size_t WS_MIXED = WS_H;
constexpr size_t WS_QS = 75 * MiB;
constexpr size_t WS_VH = 139 * MiB;
constexpr size_t WS_SK = 171 * MiB;
constexpr size_t WS_X1B = WS_SK;
constexpr size_t WS_GH = 203 * MiB, WS_GA = 219 * MiB, WS_GB = 235 * MiB;
constexpr size_t WS_ACT = 75 * MiB;
constexpr size_t WS_END = 251 * MiB;
static_assert(WS_ACT + (size_t)M * FFH * 2 <= WS_X1B, "ACT overlay");
constexpr int RING_BYTES = 131072, LDS_BYTES = 157696, MISC_OFF = LDS_BYTES - 256;

#define LAS __attribute__((address_space(3)))
typedef unsigned short bf16;
typedef unsigned v4u __attribute__((ext_vector_type(4)));
typedef float f32x4 __attribute__((ext_vector_type(4)));
__device__ __forceinline__ unsigned f2bf(float f) { unsigned u = __builtin_bit_cast(unsigned, f); return (u + 0x7fffu + ((u >> 16) & 1u)) >> 16; }
__device__ __forceinline__ unsigned pk2(float lo, float hi) { return f2bf(lo) | (f2bf(hi) << 16); }
__device__ __forceinline__ float bf2f(unsigned short b) { return __builtin_bit_cast(float, (unsigned)b << 16); }
__device__ __forceinline__ float wave_sum(float v) {
#pragma unroll
    for (int o = 1; o < 64; o <<= 1) v += __shfl_xor(v, o);
    return v;
}
struct Args { const float* in[13]; float* out; unsigned char* ws; int ph_lo, ph_hi; };

__device__ __forceinline__ void p0_transpose_item(const float* W, int N, bf16* WT, int ldT, int koff, LAS float* scr, int k0, int n0d, int n0s, const float* kscale, int lane) {
    float wv[32];
    const float* wp = W + (size_t)(k0 + (lane >> 5)) * N + n0s + (lane & 31);
#pragma unroll
    for (int i = 0; i < 32; ++i) wv[i] = wp[(size_t)(2 * i) * N];
    if (kscale) {
#pragma unroll
        for (int i = 0; i < 32; ++i) wv[i] *= kscale[k0 + 2 * i + (lane >> 5)];
    }
#pragma unroll
    for (int i = 0; i < 32; ++i) scr[(2 * i + (lane >> 5)) * 33 + (lane & 31)] = wv[i];
    asm volatile("s_waitcnt lgkmcnt(0)" ::: "memory");
    const int c = lane & 7;
#pragma unroll
    for (int j = 0; j < 4; ++j) { const int n = (lane >> 3) + 8 * j; const LAS float* s = scr + (8 * c) * 33 + n;
        v4u o; o.x = pk2(s[0 * 33], s[1 * 33]); o.y = pk2(s[2 * 33], s[3 * 33]); o.z = pk2(s[4 * 33], s[5 * 33]); o.w = pk2(s[6 * 33], s[7 * 33]);
        *(v4u*)(WT + (size_t)(n0d + n) * ldT + koff + k0 + 8 * c) = o; }
    asm volatile("s_waitcnt lgkmcnt(0)" ::: "memory");
}
template <int PART> __device__ __forceinline__ void p0_prologue(const Args& a, LAS unsigned char* lds, int wave, int lane, int gw, int NGW) {
    LAS float* scr = (LAS float*)(lds + wave * 16384);
    unsigned char* ws = a.ws;
    constexpr int I_IN = 16 * (INW / 32), I_SQ = 16 * 32, I_F1 = 16 * (2 * FFH / 32), I_F2 = (FFH / 64) * 32;
    constexpr int NITEMS = I_IN + 3 * I_SQ + I_F1 + I_F2;
    for (int it = (PART == 0 ? gw : I_IN + gw); it < (PART == 0 ? I_IN : NITEMS); it += NGW) {
        int r = it;
        if (r < I_IN) { const int nblk = INW / 32, kb = r / nblk, nb = r % nblk, n0d = 32 * nb; const int sec = n0d >> 10; int n0s = n0d;
            if (sec == 4 || sec == 5) { const int p = n0d & 255; n0s = (n0d - p) + 64 * ((p >> 5) & 3) + 32 * (p >> 7); }
            p0_transpose_item(a.in[2], INW, (bf16*)(ws + WS_WIN), 1024, 0, scr, 64 * kb, n0d, n0s, nullptr, lane); continue; } r -= I_IN;
        if (r < I_SQ) { p0_transpose_item(a.in[7], 1024, (bf16*)(ws + WS_WHS), 2048, 0, scr, 64 * (r / 32), 32 * (r % 32), 32 * (r % 32), nullptr, lane); continue; } r -= I_SQ;
        if (r < I_SQ) { p0_transpose_item(a.in[8], 1024, (bf16*)(ws + WS_WHS), 2048, 1024, scr, 64 * (r / 32), 32 * (r % 32), 32 * (r % 32), nullptr, lane); continue; } r -= I_SQ;
        if (r < I_SQ) { p0_transpose_item(a.in[9], 1024, (bf16*)(ws + WS_WO), 1024, 0, scr, 64 * (r / 32), 32 * (r % 32), 32 * (r % 32), nullptr, lane); continue; } r -= I_SQ;
        if (r < I_F1) { const int nblk = 2 * FFH / 32, kb = r / nblk, nb = r % nblk, n0d = 32 * nb, pn = n0d >> 8, p = n0d & 255; const int n0s = (p >> 7) * FFH + 128 * pn + (p & 127);
            p0_transpose_item(a.in[11], 2 * FFH, (bf16*)(ws + WS_WF1), 1024, 0, scr, 64 * kb, n0d, n0s, a.in[10], lane); continue; } r -= I_F1;
        p0_transpose_item(a.in[12], 1024, (bf16*)(ws + WS_WF2), FFH, 0, scr, 64 * (r / 32), 32 * (r % 32), 32 * (r % 32), nullptr, lane);
    }
    if (PART != 0) return;
    const float* g1 = a.in[1];
    f32x4 gv[4];
#pragma unroll
    for (int j = 0; j < 4; ++j) gv[j] = ((const f32x4*)g1)[lane + 64 * j];
    for (int m = gw; m < M; m += NGW) {
        const f32x4* xr = (const f32x4*)(a.in[0] + (size_t)m * D) + lane;
        f32x4 v[4]; float s = 0.f;
#pragma unroll
        for (int j = 0; j < 4; ++j) { v[j] = xr[64 * j]; s += (v[j].x * v[j].x + v[j].y * v[j].y) + (v[j].z * v[j].z + v[j].w * v[j].w); }
        const float rstd = __builtin_amdgcn_rsqf(wave_sum(s) * (1.f / D) + EPS);
        unsigned long long* o8 = (unsigned long long*)((bf16*)(ws + WS_H) + (size_t)m * D) + lane;
#pragma unroll
        for (int j = 0; j < 4; ++j) { const f32x4 y = v[j] * rstd * gv[j]; o8[64 * j] = (unsigned long long)pk2(y.x, y.y) | ((unsigned long long)pk2(y.z, y.w) << 32); }
    }
}

typedef short bf16x8_t __attribute__((ext_vector_type(8)));
typedef float f32x16 __attribute__((ext_vector_type(16)));
typedef unsigned u32x2_t __attribute__((ext_vector_type(2)));
typedef float f32x2_t __attribute__((ext_vector_type(2)));
typedef __bf16 bf16x2_cv __attribute__((ext_vector_type(2)));
__device__ __forceinline__ unsigned cvtpk(float lo, float hi) { const f32x2_t v = {lo, hi}; return __builtin_bit_cast(unsigned, __builtin_convertvector(v, bf16x2_cv)); }
__device__ __forceinline__ bf16x8_t pack_acc8(const f32x16& c, int p) {
    v4u w; if (p == 0) { w.x = cvtpk(c[0], c[1]); w.y = cvtpk(c[2], c[3]); w.z = cvtpk(c[4], c[5]); w.w = cvtpk(c[6], c[7]); }
    else { w.x = cvtpk(c[8], c[9]); w.y = cvtpk(c[10], c[11]); w.z = cvtpk(c[12], c[13]); w.w = cvtpk(c[14], c[15]); }
    return __builtin_bit_cast(bf16x8_t, w);
}
#define MFMA32(A, B, C) __builtin_amdgcn_mfma_f32_32x32x16_bf16((A), (B), (C), 0, 0, 0)
__device__ __forceinline__ void hgrn_mfma(const Args& a, LAS unsigned char* lds, int vblk, int nblk) {
    unsigned char* ws = a.ws;
    bf16* QS = (bf16*)(ws + WS_QS); const bf16* VH = (const bf16*)(ws + WS_VH); const unsigned char* GH = ws + WS_GH; const _Float16* LOGF = (const _Float16*)a.out;
    const float* ogain = a.in[4];
    constexpr int RS = 272, TS = 144;
    LAS unsigned char* L_QI = lds; LAS unsigned char* L_QA = lds + 64 * RS; LAS unsigned char* L_KA = lds + 2 * 64 * RS;
    LAS unsigned char* L_KST = lds + 3 * 64 * RS; LAS unsigned char* L_VT = L_KST + 128 * TS;
    LAS float* L_TQ = (LAS float*)(L_VT + 128 * TS); LAS float* L_DEC = L_TQ + 2048;     LAS float* L_SS = L_DEC + 128; LAS float* L_GN = L_SS + 256;
    const int tid = threadIdx.x, lane = tid & 63, wave = __builtin_amdgcn_readfirstlane(tid >> 6);
    const int dp = tid & 63, oct = wave, r32 = lane & 31, hi = lane >> 5, vt = wave & 3, tt = wave >> 2;
    const int kap = 16 * (r32 >> 4) + 8 * ((r32 >> 2) & 1) + 4 * ((r32 >> 3) & 1) + (r32 & 3);
    for (int item = vblk; item < BATCH * 8; item += nblk) {
        const int b = item >> 3, h = item & 7;
        f32x16 C[4];
#pragma unroll
        for (int i = 0; i < 4; ++i)
#pragma unroll
            for (int j = 0; j < 16; ++j) C[i][j] = 0.f;
        if (tid < 128) L_GN[tid] = ogain[h * 128 + tid];
        unsigned gN2[2][8], qN2[2][8], vN2[2][8];
#pragma unroll
        for (int c2 = 0; c2 < 2; ++c2) { const size_t row0 = (size_t)b * SEQ + 64 * c2 + 8 * oct;
#pragma unroll
          for (int i = 0; i < 8; ++i) { gN2[c2][i] = *(const unsigned*)(LOGF + (row0 + i) * 1024 + h * 128 + 2 * dp); qN2[c2][i] = *(const unsigned*)(QS + (row0 + i) * 2048 + h * 128 + 2 * dp); vN2[c2][i] = *(const unsigned*)(VH + (row0 + i) * 1024 + h * 128 + 2 * dp); } }
        { float run0 = 0.f, run1 = 0.f;
#pragma unroll
          for (int i = 0; i < 8; ++i) { run0 += (float)__builtin_bit_cast(_Float16, (unsigned short)(gN2[0][i] & 0xffffu)); run1 += (float)__builtin_bit_cast(_Float16, (unsigned short)(gN2[0][i] >> 16)); }
          *(LAS f32x2_t*)(L_TQ + oct * 128 + 2 * dp) = (f32x2_t){run0, run1}; }
        __syncthreads();
#pragma unroll 2
        for (int n = 0; n < SEQ / 64; ++n) {
            unsigned (&gN)[8] = gN2[n & 1]; unsigned (&qN)[8] = qN2[n & 1]; unsigned (&vN)[8] = vN2[n & 1];
            if (n + 1 < SEQ / 64) { float run0 = 0.f, run1 = 0.f;
#pragma unroll
                for (int i = 0; i < 8; ++i) { const unsigned gw_ = gN2[(n + 1) & 1][i]; run0 += (float)__builtin_bit_cast(_Float16, (unsigned short)(gw_ & 0xffffu)); run1 += (float)__builtin_bit_cast(_Float16, (unsigned short)(gw_ >> 16)); }
                *(LAS f32x2_t*)(L_TQ + ((n + 1) & 1) * 1024 + oct * 128 + 2 * dp) = (f32x2_t){run0, run1}; }
            float off0 = 0.f, off1 = 0.f, cref0 = 0.f, cref1 = 0.f, tot0 = 0.f, tot1 = 0.f;
#pragma unroll
            for (int o = 0; o < 8; ++o) { const f32x2_t tq = *(const LAS f32x2_t*)(L_TQ + (n & 1) * 1024 + o * 128 + 2 * dp);
                if (o < oct) { off0 += tq.x; off1 += tq.y; } if (o < 4) { cref0 += tq.x; cref1 += tq.y; } tot0 += tq.x; tot1 += tq.y; }
            const float xc0 = __expf(tot0), xc1 = __expf(tot1), xa0 = __expf(-cref0), xa1 = __expf(-cref1), xb0 = __expf(cref0), xb1 = __expf(cref1);
            if (oct == 0) *(LAS f32x2_t*)(L_DEC + 2 * dp) = (f32x2_t){xc0, xc1};
            float e0 = __expf(off0), e1 = __expf(off1);
            unsigned ksp0[4], ksp1[4], vsp0[4], vsp1[4];
#pragma unroll
            for (int i = 0; i < 8; ++i) {
                const float f0 = __expf((float)__builtin_bit_cast(_Float16, (unsigned short)(gN[i] & 0xffffu))), f1 = __expf((float)__builtin_bit_cast(_Float16, (unsigned short)(gN[i] >> 16)));
                e0 = fmaxf(e0 * f0, 1e-30f); e1 = fmaxf(e1 * f1, 1e-30f);
                const float r0 = __builtin_amdgcn_rcpf(e0), r1 = __builtin_amdgcn_rcpf(e1);
                const float k0 = 1.0f - f0, k1 = 1.0f - f1, q0 = __builtin_bit_cast(float, qN[i] << 16), q1 = __builtin_bit_cast(float, qN[i] & 0xffff0000u);
                const float qi0 = q0 * e0, qi1 = q1 * e1, kr0 = k0 * r0, kr1 = k1 * r1;
                const int t = 8 * oct + i;
                *(LAS unsigned*)(L_QI + t * RS + 4 * dp) = cvtpk(qi0, qi1);
                *(LAS unsigned*)(L_QA + t * RS + 4 * dp) = cvtpk(qi0 * xa0, qi1 * xa1);
                *(LAS unsigned*)(L_KA + t * RS + 4 * dp) = cvtpk(kr0 * xb0, kr1 * xb1);
                const unsigned ks = cvtpk(kr0 * xc0, kr1 * xc1);
                if (i & 1) { ksp0[i >> 1] |= ks << 16; ksp1[i >> 1] |= ks & 0xffff0000u; vsp0[i >> 1] |= vN[i] << 16; vsp1[i >> 1] |= vN[i] & 0xffff0000u; }
                else { ksp0[i >> 1] = ks & 0xffffu; ksp1[i >> 1] = ks >> 16; vsp0[i >> 1] = vN[i] & 0xffffu; vsp1[i >> 1] = vN[i] >> 16; }
            }
            *(LAS v4u*)(L_KST + (2 * dp) * TS + 16 * oct) = (v4u){ksp0[0], ksp0[1], ksp0[2], ksp0[3]}; *(LAS v4u*)(L_KST + (2 * dp + 1) * TS + 16 * oct) = (v4u){ksp1[0], ksp1[1], ksp1[2], ksp1[3]};
            *(LAS v4u*)(L_VT + (2 * dp) * TS + 16 * oct) = (v4u){vsp0[0], vsp0[1], vsp0[2], vsp0[3]}; *(LAS v4u*)(L_VT + (2 * dp + 1) * TS + 16 * oct) = (v4u){vsp1[0], vsp1[1], vsp1[2], vsp1[3]};
            __syncthreads();
            const size_t m = (size_t)b * SEQ + 64 * n + 32 * tt + r32;
            unsigned gt4[4];
#pragma unroll
            for (int a4 = 0; a4 < 4; ++a4) gt4[a4] = *(const unsigned*)(GH + m * 1024 + h * 128 + 32 * vt + 8 * a4 + 4 * hi);
            if (n + 2 < SEQ / 64) { const size_t row0 = (size_t)b * SEQ + 64 * (n + 2) + 8 * oct;
#pragma unroll
                for (int i = 0; i < 8; ++i) { gN[i] = *(const unsigned*)(LOGF + (row0 + i) * 1024 + h * 128 + 2 * dp); qN[i] = *(const unsigned*)(QS + (row0 + i) * 2048 + h * 128 + 2 * dp); vN[i] = *(const unsigned*)(VH + (row0 + i) * 1024 + h * 128 + 2 * dp); } }
#define SB() __builtin_amdgcn_sched_barrier(0)
            f32x16 O;
#pragma unroll
            for (int j = 0; j < 16; ++j) O[j] = 0.f;
            bf16x8_t Vt[4];
            {
                v4u qf[8];
#pragma unroll
                for (int i = 0; i < 8; ++i) { const LAS unsigned char* qp = L_QI + (32 * tt + r32) * RS + (32 * (i >> 1) + 16 * (i & 1) + 4 * hi) * 2;
                    const u32x2_t lo = *(const LAS u32x2_t*)qp, hi2 = *(const LAS u32x2_t*)(qp + 16); qf[i] = (v4u){lo.x, lo.y, hi2.x, hi2.y}; }
#pragma unroll
                for (int ks = 0; ks < 4; ++ks) Vt[ks] = *(const LAS bf16x8_t*)(L_VT + (32 * vt + r32) * TS + (16 * ks + 8 * hi) * 2);
                SB();
#pragma unroll
                for (int i = 0; i < 8; ++i) O = MFMA32(pack_acc8(C[i >> 1], i & 1), __builtin_bit_cast(bf16x8_t, qf[i]), O);
                SB();
            }
#pragma unroll
            for (int st = 0; st < 2; ++st) if (st <= tt) {
                f32x16 S;
#pragma unroll
                for (int j = 0; j < 16; ++j) S[j] = 0.f;
#pragma unroll
                for (int hb = 0; hb < 2; ++hb) {
                    bf16x8_t A[4], B[4];
#pragma unroll
                    for (int k4 = 0; k4 < 4; ++k4) { const int ks = 4 * hb + k4;
                        A[k4] = *(const LAS bf16x8_t*)(L_KA + (32 * st + kap) * RS + (16 * ks + 8 * hi) * 2);
                        B[k4] = *(const LAS bf16x8_t*)(L_QA + (32 * tt + r32) * RS + (16 * ks + 8 * hi) * 2); }
                    SB();
#pragma unroll
                    for (int k4 = 0; k4 < 4; ++k4) S = MFMA32(A[k4], B[k4], S);
                    SB();
                }
                if (st == tt) {
#pragma unroll
                    for (int j = 0; j < 16; ++j) { const int sl = 16 * (j >> 3) + 8 * hi + (j & 7); if (sl > r32) S[j] = 0.f; }
                }
                O = MFMA32(Vt[2 * st], pack_acc8(S, 0), O); O = MFMA32(Vt[2 * st + 1], pack_acc8(S, 1), O);
            }
#pragma unroll
            for (int dt = 0; dt < 4; ++dt) {
                f32x4 dc[4]; bf16x8_t A[4];
#pragma unroll
                for (int a4 = 0; a4 < 4; ++a4) dc[a4] = *(const LAS f32x4*)(L_DEC + 32 * dt + 8 * a4 + 4 * hi);
#pragma unroll
                for (int ks = 0; ks < 4; ++ks) A[ks] = *(const LAS bf16x8_t*)(L_KST + (32 * dt + r32) * TS + (16 * ks + 8 * hi) * 2);
                SB();
#pragma unroll
                for (int a4 = 0; a4 < 4; ++a4)
#pragma unroll
                    for (int cc = 0; cc < 4; ++cc) C[dt][4 * a4 + cc] *= dc[a4][cc];
#pragma unroll
                for (int ks = 0; ks < 4; ++ks) C[dt] = MFMA32(A[ks], Vt[ks], C[dt]);
                SB();
            }
#undef SB
            float ss = 0.f;
#pragma unroll
            for (int j = 0; j < 16; ++j) ss += O[j] * O[j];
            ss += __shfl_xor(ss, 32);
            if (hi == 0) L_SS[(tt * 4 + vt) * 32 + r32] = ss;
            __syncthreads();
            const float sst = (L_SS[(tt * 4 + 0) * 32 + r32] + L_SS[(tt * 4 + 1) * 32 + r32]) + (L_SS[(tt * 4 + 2) * 32 + r32] + L_SS[(tt * 4 + 3) * 32 + r32]);
            const float rstd = __builtin_amdgcn_rsqf(sst * (1.0f / 128.0f) + EPS);
#pragma unroll
            for (int a4 = 0; a4 < 4; ++a4) { const int v0 = h * 128 + 32 * vt + 8 * a4 + 4 * hi;
                const f32x4 gn = *(const LAS f32x4*)(L_GN + 32 * vt + 8 * a4 + 4 * hi); const unsigned gt = gt4[a4];
                float o[4];
#pragma unroll
                for (int cc = 0; cc < 4; ++cc) o[cc] = O[4 * a4 + cc] * rstd * gn[cc] * ((float)((gt >> (8 * cc)) & 255u) * (1.0f / 255.0f));
                u32x2_t w; w.x = cvtpk(o[0], o[1]); w.y = cvtpk(o[2], o[3]);
                *(u32x2_t*)(QS + m * 2048 + v0) = w; }
        }
        __syncthreads();
    }
}

__device__ __forceinline__ void hgrn_v2(const Args& a, LAS unsigned char* lds, int vblk, int nblk) {
    unsigned char* ws = a.ws;
    bf16* QS = (bf16*)(ws + WS_QS); const bf16* VH = (const bf16*)(ws + WS_VH); const unsigned char* GH = ws + WS_GH; const _Float16* LOGF = (const _Float16*)a.out;
    const float* ogain = a.in[4];
    constexpr int RS = 272, TS = 144, O_KA = 64 * RS, O_KAT = 2 * 64 * RS, O_VT = O_KAT + 128 * TS, BUFB = O_VT + 128 * TS;
    LAS float* L_TQ = (LAS float*)(lds + 2 * BUFB);
    LAS float* L_XS = L_TQ + 1024;
    LAS float* L_SS = L_XS + 512;
    LAS float* L_GN = L_SS + 512;
    const int tid = threadIdx.x, lane = tid & 63, wave = __builtin_amdgcn_readfirstlane(tid >> 6);
    const int r32 = lane & 31, hi = lane >> 5;
    const int kap = 16 * (r32 >> 4) + 8 * ((r32 >> 2) & 1) + 4 * ((r32 >> 3) & 1) + (r32 & 3);
    constexpr int NCH = SEQ / 64;
#define SB() __builtin_amdgcn_sched_barrier(0)
    for (int item = vblk; item < BATCH * 8; item += nblk) {
        const int b = item >> 3, h = item & 7;
        if (tid < 128) L_GN[tid] = ogain[h * 128 + tid];
        if (wave < 4) {
            const int vt = wave;
            f32x16 C[4];
#pragma unroll
            for (int i = 0; i < 4; ++i)
#pragma unroll
                for (int j = 0; j < 16; ++j) C[i][j] = 0.f;
            f32x16 O[2]; unsigned gt4[2][4];
#define HG_EPI(cn) do { _Pragma("unroll") for (int tt = 0; tt < 2; ++tt) { const LAS float* SSb = L_SS + ((cn) & 1) * 256; \
                const float sst = (SSb[(tt * 4 + 0) * 32 + r32] + SSb[(tt * 4 + 1) * 32 + r32]) + (SSb[(tt * 4 + 2) * 32 + r32] + SSb[(tt * 4 + 3) * 32 + r32]); \
                const float rstd = __builtin_amdgcn_rsqf(sst * (1.0f / 128.0f) + EPS); \
                const size_t m = (size_t)b * SEQ + 64 * (cn) + r32 + 32 * tt; \
                _Pragma("unroll") for (int a4 = 0; a4 < 4; ++a4) { const int v0 = h * 128 + 32 * vt + 8 * a4 + 4 * hi; \
                    const f32x4 gn = *(const LAS f32x4*)(L_GN + 32 * vt + 8 * a4 + 4 * hi); const unsigned gt = gt4[tt][a4]; float o[4]; \
                    _Pragma("unroll") for (int cc = 0; cc < 4; ++cc) o[cc] = O[tt][4 * a4 + cc] * rstd * gn[cc] * ((float)((gt >> (8 * cc)) & 255u) * (1.0f / 255.0f)); \
                    u32x2_t w; w.x = cvtpk(o[0], o[1]); w.y = cvtpk(o[2], o[3]); *(u32x2_t*)(QS + m * 2048 + v0) = w; } } } while (0)
            __syncthreads();
#pragma unroll 1
            for (int n = 0; n < NCH; ++n) {
                __syncthreads();
                if (n > 0) HG_EPI(n - 1);
                const LAS unsigned char* T = lds + (n & 1) * BUFB;
                const LAS float* XS = L_XS + (n & 1) * 256;
                const size_t m0 = (size_t)b * SEQ + 64 * n + r32;
#pragma unroll
                for (int tt = 0; tt < 2; ++tt)
#pragma unroll
                    for (int a4 = 0; a4 < 4; ++a4) gt4[tt][a4] = *(const unsigned*)(GH + (m0 + 32 * tt) * 1024 + h * 128 + 32 * vt + 8 * a4 + 4 * hi);
                bf16x8_t Cp[8]; bf16x8_t Vt[4];
#pragma unroll
                for (int ks = 0; ks < 4; ++ks) Vt[ks] = *(const LAS bf16x8_t*)(T + O_VT + (32 * vt + r32) * TS + (16 * ks + 8 * hi) * 2);
#pragma unroll
                for (int dt = 0; dt < 4; ++dt) {
#pragma unroll
                    for (int a4 = 0; a4 < 4; ++a4) { const f32x4 x1 = *(const LAS f32x4*)(XS + 32 * dt + 8 * a4 + 4 * hi);
#pragma unroll
                        for (int cc = 0; cc < 4; ++cc) C[dt][4 * a4 + cc] *= x1[cc]; }
                    Cp[2 * dt] = pack_acc8(C[dt], 0); Cp[2 * dt + 1] = pack_acc8(C[dt], 1);
                }
#pragma unroll
                for (int tt = 0; tt < 2; ++tt) {
#pragma unroll
                    for (int j = 0; j < 16; ++j) O[tt][j] = 0.f;
                    v4u qf[8];
#pragma unroll
                    for (int i = 0; i < 8; ++i) { const LAS unsigned char* qp = T + (32 * tt + r32) * RS + (32 * (i >> 1) + 16 * (i & 1) + 4 * hi) * 2;
                        const u32x2_t lo = *(const LAS u32x2_t*)qp, hi2 = *(const LAS u32x2_t*)(qp + 16); qf[i] = (v4u){lo.x, lo.y, hi2.x, hi2.y}; }
                    SB();
#pragma unroll
                    for (int i = 0; i < 8; ++i) O[tt] = MFMA32(Cp[i], __builtin_bit_cast(bf16x8_t, qf[i]), O[tt]);
                    SB();
#pragma unroll
                    for (int st = 0; st < 2; ++st) if (st <= tt) {
                        f32x16 S;
#pragma unroll
                        for (int j = 0; j < 16; ++j) S[j] = 0.f;
#pragma unroll
                        for (int hb = 0; hb < 2; ++hb) {
                            bf16x8_t A[4], B[4];
#pragma unroll
                            for (int k4 = 0; k4 < 4; ++k4) { const int ks = 4 * hb + k4;
                                A[k4] = *(const LAS bf16x8_t*)(T + O_KA + (32 * st + kap) * RS + (16 * ks + 8 * hi) * 2);
                                B[k4] = *(const LAS bf16x8_t*)(T + (32 * tt + r32) * RS + (16 * ks + 8 * hi) * 2); }
                            SB();
#pragma unroll
                            for (int k4 = 0; k4 < 4; ++k4) S = MFMA32(A[k4], B[k4], S);
                            SB();
                        }
                        if (st == tt) {
#pragma unroll
                            for (int j = 0; j < 16; ++j) { const int sl = 16 * (j >> 3) + 8 * hi + (j & 7); if (sl > r32) S[j] = 0.f; }
                        }
                        O[tt] = MFMA32(Vt[2 * st], pack_acc8(S, 0), O[tt]); O[tt] = MFMA32(Vt[2 * st + 1], pack_acc8(S, 1), O[tt]);
                    }
                    float ss = 0.f;
#pragma unroll
                    for (int j = 0; j < 16; ++j) ss += O[tt][j] * O[tt][j];
                    ss += __shfl_xor(ss, 32);
                    if (hi == 0) L_SS[(n & 1) * 256 + (tt * 4 + vt) * 32 + r32] = ss;
                }
#pragma unroll
                for (int dt = 0; dt < 4; ++dt) {
                    f32x4 x2[4]; bf16x8_t A[4];
#pragma unroll
                    for (int a4 = 0; a4 < 4; ++a4) x2[a4] = *(const LAS f32x4*)(XS + 128 + 32 * dt + 8 * a4 + 4 * hi);
#pragma unroll
                    for (int ks = 0; ks < 4; ++ks) A[ks] = *(const LAS bf16x8_t*)(T + O_KAT + (32 * dt + r32) * TS + (16 * ks + 8 * hi) * 2);
                    SB();
#pragma unroll
                    for (int ks = 0; ks < 4; ++ks) C[dt] = MFMA32(A[ks], Vt[ks], C[dt]);
#pragma unroll
                    for (int a4 = 0; a4 < 4; ++a4)
#pragma unroll
                        for (int cc = 0; cc < 4; ++cc) C[dt][4 * a4 + cc] *= x2[a4][cc];
                    SB();
                }
            }
            __syncthreads();
            HG_EPI(NCH - 1);
#undef HG_EPI
        } else {
            const int ptid = tid - 256, dp = ptid & 63, q4 = ptid >> 6;
            unsigned g2[2][16], q2[2][16], v2[2][16];
#define HG_LOAD(set, c) do { const size_t row0_ = (size_t)b * SEQ + 64 * (c) + 16 * q4; _Pragma("unroll") for (int i = 0; i < 16; ++i) { \
                g2[set][i] = *(const unsigned*)(LOGF + (row0_ + i) * 1024 + h * 128 + 2 * dp); q2[set][i] = *(const unsigned*)(QS + (row0_ + i) * 2048 + h * 128 + 2 * dp); \
                v2[set][i] = *(const unsigned*)(VH + (row0_ + i) * 1024 + h * 128 + 2 * dp); } } while (0)
#define HG_SUMS(set, c) do { float r0_ = 0.f, r1_ = 0.f; _Pragma("unroll") for (int i = 0; i < 16; ++i) { r0_ += (float)__builtin_bit_cast(_Float16, (unsigned short)(g2[set][i] & 0xffffu)); \
                r1_ += (float)__builtin_bit_cast(_Float16, (unsigned short)(g2[set][i] >> 16)); } *(LAS f32x2_t*)(L_TQ + ((c) & 1) * 512 + q4 * 128 + 2 * dp) = (f32x2_t){r0_, r1_}; } while (0)
            float e0, e1, xa0, xa1, xb0, xb1; unsigned kp0[8], kp1[8], vp0[8], vp1[8];
#define HG_BEGIN(c) do { float off0 = 0.f, off1 = 0.f, cref0 = 0.f, cref1 = 0.f, tot0 = 0.f, tot1 = 0.f; \
                _Pragma("unroll") for (int o = 0; o < 4; ++o) { const f32x2_t tq = *(const LAS f32x2_t*)(L_TQ + ((c) & 1) * 512 + o * 128 + 2 * dp); \
                    if (o < q4) { off0 += tq.x; off1 += tq.y; } if (o < 2) { cref0 += tq.x; cref1 += tq.y; } tot0 += tq.x; tot1 += tq.y; } \
                xa0 = __expf(-cref0); xa1 = __expf(-cref1); xb0 = __expf(cref0); xb1 = __expf(cref1); e0 = __expf(off0); e1 = __expf(off1); \
                if (q4 == 0) { *(LAS f32x2_t*)(L_XS + ((c) & 1) * 256 + 2 * dp) = (f32x2_t){xb0, xb1}; *(LAS f32x2_t*)(L_XS + ((c) & 1) * 256 + 128 + 2 * dp) = (f32x2_t){__expf(tot0 - cref0), __expf(tot1 - cref1)}; } } while (0)
#define HG_TOKENS(set, c, i0) do { LAS unsigned char* T_ = lds + ((c) & 1) * BUFB; _Pragma("unroll") for (int i = (i0); i < (i0) + 8; ++i) { \
                const unsigned gw_ = g2[set][i], qw_ = q2[set][i], vw_ = v2[set][i]; \
                const float f0 = __expf((float)__builtin_bit_cast(_Float16, (unsigned short)(gw_ & 0xffffu))), f1 = __expf((float)__builtin_bit_cast(_Float16, (unsigned short)(gw_ >> 16))); \
                e0 = fmaxf(e0 * f0, 1e-30f); e1 = fmaxf(e1 * f1, 1e-30f); \
                const float r0 = __builtin_amdgcn_rcpf(e0), r1 = __builtin_amdgcn_rcpf(e1); \
                const float qq0 = __builtin_bit_cast(float, qw_ << 16), qq1 = __builtin_bit_cast(float, qw_ & 0xffff0000u); \
                const int t = 16 * q4 + i; \
                *(LAS unsigned*)(T_ + t * RS + 4 * dp) = cvtpk(qq0 * e0 * xa0, qq1 * e1 * xa1); \
                const unsigned ka = cvtpk((1.0f - f0) * r0 * xb0, (1.0f - f1) * r1 * xb1); \
                *(LAS unsigned*)(T_ + O_KA + t * RS + 4 * dp) = ka; \
                if (i & 1) { kp0[i >> 1] |= ka << 16; kp1[i >> 1] |= ka & 0xffff0000u; vp0[i >> 1] |= vw_ << 16; vp1[i >> 1] |= vw_ & 0xffff0000u; } \
                else { kp0[i >> 1] = ka & 0xffffu; kp1[i >> 1] = ka >> 16; vp0[i >> 1] = vw_ & 0xffffu; vp1[i >> 1] = vw_ >> 16; } } } while (0)
#define HG_FINISH(c) do { LAS unsigned char* T_ = lds + ((c) & 1) * BUFB; \
                *(LAS v4u*)(T_ + O_KAT + (2 * dp) * TS + 32 * q4) = (v4u){kp0[0], kp0[1], kp0[2], kp0[3]}; *(LAS v4u*)(T_ + O_KAT + (2 * dp) * TS + 32 * q4 + 16) = (v4u){kp0[4], kp0[5], kp0[6], kp0[7]}; \
                *(LAS v4u*)(T_ + O_KAT + (2 * dp + 1) * TS + 32 * q4) = (v4u){kp1[0], kp1[1], kp1[2], kp1[3]}; *(LAS v4u*)(T_ + O_KAT + (2 * dp + 1) * TS + 32 * q4 + 16) = (v4u){kp1[4], kp1[5], kp1[6], kp1[7]}; \
                *(LAS v4u*)(T_ + O_VT + (2 * dp) * TS + 32 * q4) = (v4u){vp0[0], vp0[1], vp0[2], vp0[3]}; *(LAS v4u*)(T_ + O_VT + (2 * dp) * TS + 32 * q4 + 16) = (v4u){vp0[4], vp0[5], vp0[6], vp0[7]}; \
                *(LAS v4u*)(T_ + O_VT + (2 * dp + 1) * TS + 32 * q4) = (v4u){vp1[0], vp1[1], vp1[2], vp1[3]}; *(LAS v4u*)(T_ + O_VT + (2 * dp + 1) * TS + 32 * q4 + 16) = (v4u){vp1[4], vp1[5], vp1[6], vp1[7]}; } while (0)
            HG_LOAD(0, 0); HG_LOAD(1, 1);
            HG_SUMS(0, 0);
            __syncthreads();
            HG_SUMS(1, 1); HG_BEGIN(0); HG_TOKENS(0, 0, 0); HG_TOKENS(0, 0, 8); HG_FINISH(0); HG_LOAD(0, 2);
#pragma unroll 2
            for (int n = 0; n < NCH; ++n) {
                const int c = n + 1;
                __syncthreads();
                if (c < NCH) { if (c + 1 < NCH) HG_SUMS(n & 1, c + 1); HG_BEGIN(c); HG_TOKENS((n + 1) & 1, c, 0); HG_TOKENS((n + 1) & 1, c, 8); HG_FINISH(c); if (c + 2 < NCH) HG_LOAD((n + 1) & 1, c + 2); }
            }
            __syncthreads();
#undef HG_LOAD
#undef HG_SUMS
#undef HG_BEGIN
#undef HG_TOKENS
#undef HG_FINISH
        }
        __syncthreads();
    }
#undef SB
}

template <bool DIAG> __device__ __forceinline__ bool attn_tile(const bf16x8_t (&Kc)[4], const bf16x8_t (&Vc)[4], const bf16x8_t (&Qf)[4], f32x16& O0, f32x16& O1, float& carry, int r32, int hi) {
    f32x16 Sx;
#pragma unroll
    for (int j = 0; j < 16; ++j) Sx[j] = 0.f;
#pragma unroll
    for (int ks = 0; ks < 4; ++ks) Sx = MFMA32(Kc[ks], Qf[ks], Sx);
    float kp[16], sg[16];
#pragma unroll
    for (int j = 0; j < 16; ++j) {
        const float r = __builtin_amdgcn_rcpf(1.0f + __builtin_amdgcn_exp2f(Sx[j]));
        if (DIAG) { const int sl = 16 * (j >> 3) + 8 * hi + (j & 7); const bool valid = sl < r32; kp[j] = valid ? r : 1.f; sg[j] = valid ? 1.0f - r : 0.f; }
        else { kp[j] = r; sg[j] = 1.0f - r; }
    }
#pragma unroll
    for (int j = 6; j >= 0; --j) { sg[j] *= kp[j + 1]; kp[j] *= kp[j + 1]; sg[8 + j] *= kp[8 + j + 1]; kp[8 + j] *= kp[8 + j + 1]; }
    const float G0 = kp[0], G1 = kp[8];
    const float P0 = __shfl_xor(G0, 32), P1 = __shfl_xor(G1, 32);
    const float after0 = (hi == 0 ? P0 : 1.f) * P1 * G1 * carry, after1 = (hi == 0 ? P1 : 1.f) * carry;
#pragma unroll
    for (int j = 0; j < 16; ++j) sg[j] *= (j < 8 ? after0 : after1);
    carry *= (G0 * G1) * (P0 * P1);
    v4u w0, w1; w0.x = cvtpk(sg[0], sg[1]); w0.y = cvtpk(sg[2], sg[3]); w0.z = cvtpk(sg[4], sg[5]); w0.w = cvtpk(sg[6], sg[7]);
    w1.x = cvtpk(sg[8], sg[9]); w1.y = cvtpk(sg[10], sg[11]); w1.z = cvtpk(sg[12], sg[13]); w1.w = cvtpk(sg[14], sg[15]);
    const bf16x8_t Pb0 = __builtin_bit_cast(bf16x8_t, w0), Pb1 = __builtin_bit_cast(bf16x8_t, w1);
    O0 = MFMA32(Vc[0], Pb0, O0); O0 = MFMA32(Vc[1], Pb1, O0);
    O1 = MFMA32(Vc[2], Pb0, O1); O1 = MFMA32(Vc[3], Pb1, O1);
    return __all(carry == 0.f);
}
__device__ __forceinline__ void attn_mfma(const Args& a, int u0, int ucnt, int ustride) {
    unsigned char* ws = a.ws;
    bf16* QS = (bf16*)(ws + WS_QS); const bf16* SK = (const bf16*)(ws + WS_SK); const bf16* VT = (const bf16*)((unsigned char*)a.out + 32 * MiB);
    const int lane = threadIdx.x & 63, r32 = lane & 31, hi = lane >> 5;
    const int kap = 16 * (r32 >> 4) + 8 * ((r32 >> 2) & 1) + 4 * ((r32 >> 3) & 1) + (r32 & 3);
    for (int uk = 0; uk < ucnt; ++uk) { const int u = u0 + uk * ustride;
        const int qb = u & 63, bh = u >> 6, h = bh & 15, b = bh >> 4;
        const size_t rowq = (size_t)b * SEQ + 32 * qb + r32;
        bf16* qp = QS + rowq * 2048 + 1024 + 64 * h;
        const bf16* kbase = SK + ((size_t)b * SEQ + kap) * 1024 + 64 * h + 8 * hi;
        const bf16* vbase = VT + ((size_t)bh * 64 + r32) * 2048 + 8 * hi;
        bf16x8_t Qf[4];
#pragma unroll
        for (int ks = 0; ks < 4; ++ks) Qf[ks] = *(const bf16x8_t*)(qp + 16 * ks + 8 * hi);
        f32x16 O0, O1;
#pragma unroll
        for (int j = 0; j < 16; ++j) { O0[j] = 0.f; O1[j] = 0.f; }
        float carry = 1.f;
        bf16x8_t KA[4], VA[4], KB[4], VB[4];
#define ATT_LOAD(K_, V_, kb_) do { _Pragma("unroll") for (int ks = 0; ks < 4; ++ks) K_[ks] = *(const bf16x8_t*)(kbase + (size_t)(32 * (kb_)) * 1024 + 16 * ks); \
        _Pragma("unroll") for (int i = 0; i < 4; ++i) V_[i] = *(const bf16x8_t*)(vbase + (size_t)(32 * (i >> 1)) * 2048 + 32 * (kb_) + 16 * (i & 1)); } while (0)
        ATT_LOAD(KA, VA, qb);
        int kb = qb;
        ATT_LOAD(KB, VB, kb > 0 ? kb - 1 : 0);
        if (!(attn_tile<true>(KA, VA, Qf, O0, O1, carry, r32, hi) || kb == 0)) {
            --kb;
#pragma unroll 1
            for (;;) {
                ATT_LOAD(KA, VA, kb > 0 ? kb - 1 : 0);
                if (attn_tile<false>(KB, VB, Qf, O0, O1, carry, r32, hi) || kb == 0) break;
                --kb;
                ATT_LOAD(KB, VB, kb > 0 ? kb - 1 : 0);
                if (attn_tile<false>(KA, VA, Qf, O0, O1, carry, r32, hi) || kb == 0) break;
                --kb;
            }
        }
#undef ATT_LOAD
#pragma unroll
        for (int a4 = 0; a4 < 4; ++a4) {
            u32x2_t x0, x1; x0.x = cvtpk(O0[4 * a4], O0[4 * a4 + 1]); x0.y = cvtpk(O0[4 * a4 + 2], O0[4 * a4 + 3]); x1.x = cvtpk(O1[4 * a4], O1[4 * a4 + 1]); x1.y = cvtpk(O1[4 * a4 + 2], O1[4 * a4 + 3]);
            *(u32x2_t*)(qp + 8 * a4 + 4 * hi) = x0; *(u32x2_t*)(qp + 32 + 8 * a4 + 4 * hi) = x1; }
    }
}

#define XB_TMO      128
#define XB_XCNT(j)  (256  + 64 * (j))
#define XB_XSUB(j)  (1280 + 64 * (j))
#define XB_XGEN(j)  (2304 + 64 * (j))
#define XB_TOP      3328
#define XB_TOPGEN   3392
#define XCD_BAR_WORDS 3456
#define XB_SPIN_CAP (1u << 18)

__device__ __forceinline__ unsigned xb_ld(unsigned* p)              { return __hip_atomic_load(p, __ATOMIC_RELAXED, __HIP_MEMORY_SCOPE_AGENT); }
__device__ __forceinline__ unsigned xb_add(unsigned* p, unsigned v) { return __hip_atomic_fetch_add(p, v, __ATOMIC_RELAXED, __HIP_MEMORY_SCOPE_AGENT); }
__device__ __forceinline__ unsigned xb_xcc_id() { return (unsigned)__builtin_amdgcn_s_getreg((3 << 11) | 20) & 0xFu; }
#define XB_SPIN(cond, bar) do { unsigned _sp = 0; while (cond) { __builtin_amdgcn_s_sleep(1); \
    if ((++_sp & 255u) == 0u) { if (xb_ld(&(bar)[XB_TMO])) break; if (_sp > XB_SPIN_CAP) { atomicAdd(&(bar)[XB_TMO], 1u); break; } } } } while (0)

struct XcdBarrier {
    unsigned* bar; unsigned x;
    volatile LAS unsigned* st;
};

__device__ __forceinline__ XcdBarrier xcd_barrier_post(unsigned* bar, volatile LAS unsigned* st) {
    XcdBarrier b; b.bar = bar; b.x = xb_xcc_id(); b.st = st;
    if (threadIdx.x == 0) (void)xb_add(&bar[XB_XCNT(b.x)], 1u);
    return b;
}
__device__ __forceinline__ void xcd_barrier_complete(unsigned* bar, unsigned x, unsigned& nloc, unsigned& nx) {
    const unsigned G = gridDim.x * gridDim.y * gridDim.z;
    unsigned sum, cnt, mine, sp = 0u;
    for (;;) {
        sum = 0u; cnt = 0u; mine = 0u;
#pragma unroll
        for (unsigned j = 0; j < 16; ++j) { const unsigned c = xb_ld(&bar[XB_XCNT(j)]); sum += c; cnt += (c > 0u) ? 1u : 0u; mine = (j == x) ? c : mine; }
        if (sum == G) break;
        __builtin_amdgcn_s_sleep(1);
        if ((++sp & 255u) == 0u) { if (xb_ld(&bar[XB_TMO])) break; if (sp > XB_SPIN_CAP) { atomicAdd(&bar[XB_TMO], 1u); break; } }
    }
    nloc = mine > 0u ? mine : 1u; nx = cnt > 0u ? cnt : 1u;
}

__device__ __forceinline__ void xcd_barrier(const XcdBarrier& b) {
    asm volatile("s_waitcnt vmcnt(0)" ::: "memory");
    __syncthreads();
    if (threadIdx.x == 0) {
        unsigned* bar = b.bar;
        __builtin_amdgcn_s_waitcnt(0);
        unsigned nloc = b.st[0], nx = b.st[1];
        if (nloc == 0u) { xcd_barrier_complete(bar, b.x, nloc, nx); b.st[0] = nloc; b.st[1] = nx; }
        const unsigned old = xb_add(&bar[XB_XSUB(b.x)], 1u);
        const unsigned gen = old / nloc;
        if (old + 1u == (gen + 1u) * nloc) {
            __builtin_amdgcn_fence(__ATOMIC_RELEASE, "agent");
            asm volatile("s_waitcnt vmcnt(0)" ::: "memory");
            const unsigned og = xb_add(&bar[XB_TOP], 1u);
            const unsigned tg = og / nx;
            if (og + 1u == (tg + 1u) * nx) xb_add(&bar[XB_TOPGEN], 1u);
            else XB_SPIN(xb_ld(&bar[XB_TOPGEN]) == tg, bar);
            __builtin_amdgcn_fence(__ATOMIC_ACQUIRE, "agent");
            xb_add(&bar[XB_XGEN(b.x)], 1u);
            asm volatile("s_waitcnt vmcnt(0)" ::: "memory");
        } else {
            XB_SPIN(xb_ld(&bar[XB_XGEN(b.x)]) == gen, bar);
            __builtin_amdgcn_fence(__ATOMIC_ACQUIRE, "agent");
            asm volatile("s_waitcnt vmcnt(0)" ::: "memory");
        }
    }
    __syncthreads();
}

__global__ void __launch_bounds__(NTHREADS, 2) hybrid_fwd(Args args) {
    extern __shared__ __attribute__((aligned(16))) unsigned char lds_raw[];
    LAS unsigned char* lds = (LAS unsigned char*)lds_raw;
    cg::grid_group grid = cg::this_grid();
    const int tid = threadIdx.x, lane = tid & 63, wave = __builtin_amdgcn_readfirstlane(tid >> 6);
    const int G = gridDim.x;
    unsigned char* ws = args.ws;
    const int lo = args.ph_lo, hi = args.ph_hi;
    volatile LAS unsigned* MISC = (volatile LAS unsigned*)(lds + MISC_OFF);
    if (tid < 2) MISC[tid] = 0u;
    __syncthreads();
    const XcdBarrier bar = xcd_barrier_post((unsigned*)ws, MISC);
#define IN(k) (lo <= (k) && (k) < hi)
#define SEAM(k) do { if (IN(k) && IN((k) + 1)) { xcd_barrier(bar); } } while (0)
    if (lo < 0) grid.sync();
    if (IN(0)) { p0_prologue<0>(args, lds, wave, lane, (int)blockIdx.x * NWAVES + wave, G * NWAVES); asm volatile("s_waitcnt vmcnt(0) lgkmcnt(0)" ::: "memory"); __syncthreads(); }
    SEAM(0);
    if (IN(1)) {
        pg8::Gemm g{(const pg8::bf16_t*)(ws + WS_H), (const pg8::bf16_t*)(ws + WS_WIN), M, 6144, D, D}; pg8::StaticOrder S; S.init(M, 6144, G, (int)blockIdx.x);
        pg8::EpiProj E{(pg8::bf16_t*)(ws + WS_QS), (pg8::bf16_t*)(ws + WS_VH), (pg8::bf16_t*)(ws + WS_SK), (pg8::bf16_t*)((unsigned char*)args.out + 32 * MiB), ws + WS_GH, ws + WS_GA, ws + WS_GB, (_Float16*)args.out,
                       args.in[3], args.in[5], args.in[6], 0};
        pg8::gemm_phase<pg8::EpiProj, pg8::StaticOrder, true, true>(lds, g, S, E);
        pg8::Gemm g2{(const pg8::bf16_t*)(ws + WS_WIN) + (size_t)6144 * 1024, (const pg8::bf16_t*)(ws + WS_H), 1024, M, D, D}; pg8::StaticOrder S2; S2.init(1024, M, G, (int)blockIdx.x);
        pg8::EpiVT E2{(pg8::bf16_t*)((unsigned char*)args.out + 32 * MiB)};
        pg8::gemm_phase<pg8::EpiVT, pg8::StaticOrder, true, true>(lds, g2, S2, E2);
    }
    SEAM(1);
    if (IN(2)) {
        const pg8::Gemm gg{(const pg8::bf16_t*)(ws + WS_H), (const pg8::bf16_t*)(ws + WS_WIN) + (size_t)7168 * 1024, M, 2048, D, D};
        const pg8::EpiProj EG{(pg8::bf16_t*)(ws + WS_QS), (pg8::bf16_t*)(ws + WS_VH), (pg8::bf16_t*)(ws + WS_SK), (pg8::bf16_t*)((unsigned char*)args.out + 32 * MiB), ws + WS_GH, ws + WS_GA, ws + WS_GB, (_Float16*)args.out,
                              args.in[3], args.in[5], args.in[6], 28};
        constexpr int NUNITS = BATCH * 16 * (SEQ / 32);
        if (G == 256) {
            pg8::ListOrder S; S.s.init(M, 2048, 256, 0);
            if ((int)blockIdx.x < 64) { hgrn_v2(args, lds, (int)blockIdx.x, 64); if (wave < 6) p0_prologue<1>(args, lds, wave, lane, 1536 + (int)blockIdx.x * 6 + wave, 1920); S.l0 = -1; S.l1 = -1; S.l2 = -1; }
            else { const int idx = (int)blockIdx.x - 64;
                if (idx < 128) attn_mfma(args, idx * 40 + wave, 5, NWAVES); else attn_mfma(args, 5120 + (idx - 128) * 48 + wave, 6, NWAVES);
                p0_prologue<1>(args, lds, wave, lane, idx * NWAVES + wave, 1920);
                S.l0 = idx; S.l1 = 192 + idx; S.l2 = idx < 128 ? 384 + idx : -1; }
            asm volatile("s_waitcnt vmcnt(0) lgkmcnt(0)" ::: "memory"); __syncthreads();
            pg8::gemm_phase<pg8::EpiProj, pg8::ListOrder, true, true>(lds, gg, S, EG);
        } else {
            const int gw = (int)blockIdx.x * NWAVES + wave, ngw = G * NWAVES;
            hgrn_v2(args, lds, (int)blockIdx.x, G); attn_mfma(args, gw, (NUNITS - gw + ngw - 1) / ngw, ngw); p0_prologue<1>(args, lds, wave, lane, gw, ngw);
            asm volatile("s_waitcnt vmcnt(0) lgkmcnt(0)" ::: "memory"); __syncthreads();
            pg8::StaticOrder S; S.init(M, 2048, G, (int)blockIdx.x);
            pg8::gemm_phase<pg8::EpiProj, pg8::StaticOrder, true, true>(lds, gg, S, EG);
        }
        __syncthreads();
    }
    SEAM(2);
    if (IN(3)) {
        pg8::Gemm g{(const pg8::bf16_t*)(ws + WS_QS), (const pg8::bf16_t*)(ws + WS_WHS), M, D, 1024, 2048}; pg8::SplitOrder S; S.s.init(M, D, G, (int)blockIdx.x);
        pg8::EpiMix E{ws + WS_GA, ws + WS_GB, (pg8::bf16_t*)(ws + WS_MIXED)};
        pg8::gemm_phase<pg8::EpiMix, pg8::SplitOrder, true, true>(lds, g, S, E);
    }
    SEAM(3);
    if (IN(4)) {
        pg8::Gemm g{(const pg8::bf16_t*)(ws + WS_MIXED), (const pg8::bf16_t*)(ws + WS_WO), M, D, D, D}; pg8::StaticOrder S; S.init(M, D, G, (int)blockIdx.x);
        pg8::EpiRes1 E{args.in[0], (pg8::bf16_t*)(ws + WS_GA), (pg8::bf16_t*)(ws + WS_X1B), (float*)(ws + WS_SSQ)};
        pg8::gemm_phase<pg8::EpiRes1, pg8::StaticOrder, true, true>(lds, g, S, E);
    }
    SEAM(4);
    if (IN(5)) {
        pg8::Gemm g{(const pg8::bf16_t*)(ws + WS_X1B), (const pg8::bf16_t*)(ws + WS_WF1), M, 2 * FFH, D, D}; pg8::StaticOrder S; S.init(M, 2 * FFH, G, (int)blockIdx.x);
        pg8::EpiSwiglu E{(const float*)(ws + WS_SSQ), (pg8::bf16_t*)(ws + WS_ACT)};
        pg8::gemm_phase<pg8::EpiSwiglu, pg8::StaticOrder, true, true>(lds, g, S, E);
    }
    SEAM(5);
    if (IN(6)) {
        pg8::Gemm g{(const pg8::bf16_t*)(ws + WS_ACT), (const pg8::bf16_t*)(ws + WS_WF2), M, D, FFH, FFH}; pg8::StaticOrder S; S.init(M, D, G, (int)blockIdx.x);
        pg8::EpiRes2 E{args.in[0], (const pg8::bf16_t*)(ws + WS_GA), args.out};
        pg8::gemm_phase<pg8::EpiRes2, pg8::StaticOrder, true, true>(lds, g, S, E);
    }
#undef IN
#undef SEAM
}

#ifndef MK_N_LAUNCHES
#define MK_N_LAUNCHES 1
#endif
extern "C" void kernel_launch(void* const* d_in, const int* in_sizes, int n_in, void* d_out, int out_size, void* d_ws, size_t ws_size, hipStream_t stream) {
    static int grid = 0;
    if (grid == 0) {
        int dev = 0, cus = 0, per_cu = 0;
        if (n_in != 13 || ws_size < WS_END) { fprintf(stderr, "kernel_launch: unexpected inputs / workspace (%d, %zu)\n", n_in, ws_size); grid = -1; return; }
        hipGetDevice(&dev); hipDeviceGetAttribute(&cus, hipDeviceAttributeMultiprocessorCount, dev);
        if (hipFuncSetAttribute((const void*)hybrid_fwd, hipFuncAttributeMaxDynamicSharedMemorySize, LDS_BYTES) != hipSuccess) { fprintf(stderr, "kernel_launch: hipFuncSetAttribute failed\n"); grid = -1; return; }
        if (hipOccupancyMaxActiveBlocksPerMultiprocessor(&per_cu, (const void*)hybrid_fwd, NTHREADS, LDS_BYTES) != hipSuccess || per_cu < 1) { fprintf(stderr, "kernel_launch: occupancy query says %d\n", per_cu); per_cu = 1; }
        (void)hipGetLastError();
        grid = cus * per_cu;
    }
    if (grid < 0) return;
    if (hipMemsetAsync(d_ws, 0, 16384, stream) != hipSuccess) { fprintf(stderr, "kernel_launch: memset of the barrier words failed\n"); return; }
    Args a{};
    for (int i = 0; i < 13; ++i) a.in[i] = (const float*)d_in[i];
    a.out = (float*)d_out; a.ws = (unsigned char*)d_ws;
#if MK_N_LAUNCHES == 1
    a.ph_lo = 0; a.ph_hi = 7;
    void* kargs[] = {&a};
    hipError_t e = hipLaunchCooperativeKernel((const void*)hybrid_fwd, dim3(grid), dim3(NTHREADS), kargs, LDS_BYTES, stream);
    if (e != hipSuccess) fprintf(stderr, "cooperative launch failed: %s (grid %d)\n", hipGetErrorString(e), grid);
#else
    for (int p = 0; p < 7; ++p) { a.ph_lo = p; a.ph_hi = p + 1; hipLaunchKernelGGL(hybrid_fwd, dim3(grid), dim3(NTHREADS), LDS_BYTES, stream, a); }
#endif
}
```

```cpp
#include <hip/hip_runtime.h>
#include <hip/hip_cooperative_groups.h>
#include <cstdio>
#include <cstdint>
namespace cg = cooperative_groups;
namespace pg8 {
#define PG8_LAS __attribute__((address_space(3)))
typedef unsigned short bf16_t;
typedef short bf16x8 __attribute__((ext_vector_type(8)));
typedef float f32x4 __attribute__((ext_vector_type(4)));
typedef unsigned u32x4 __attribute__((ext_vector_type(4)));
constexpr int BM = 256, BK = 64, HALF = 128, HTB = HALF * BK * 2  , STAGE_BYTES = 8 * HTB, NXCD = 8, WGM = 8;

__host__ __device__ __forceinline__ int lds_byte(int r, int c) { const int st = (r >> 4) * 2 + (c >> 5), rr = r & 15, cc = c & 31, ob = rr * 64 + cc * 2; return st * 1024 + (ob ^ (((ob >> 9) & 1) << 5)); }
__host__ __device__ __forceinline__ void stage_rc(int b, int& R, int& C) { const int st = b / 1024, sb = b % 1024, swz = sb ^ (((sb >> 9) & 1) << 5); R = (st >> 1) * 16 + swz / 64; C = (st & 1) * 32 + (swz % 64) / 2; }
__host__ __device__ __forceinline__ int perm32(int rho) { const int n = rho >> 4, i = rho & 15; return 8 * (i >> 2) + 4 * n + (i & 3); }

struct Unit { int pm, pn, kh; };
struct Gemm { const bf16_t* A; const bf16_t* Bt; int M, N, K, ld; };

struct StaticOrder {
    int nM, nN, nwg, G, c;
    __host__ __device__ void init(int M, int N, int G_, int c_) { nM = M / BM; nN = N / BM; nwg = nM * nN; G = G_; c = c_; }
    __host__ __device__ bool next(int i, Unit& u) const { const long L = (long)i * G + c; if (L >= nwg) return false; return unit_of((int)L, u); }
    __host__ __device__ bool unit_of(int L, Unit& u) const {
        int wgid = L; { const int q = nwg / NXCD, r = nwg % NXCD, xcd = wgid % NXCD, off = wgid / NXCD; wgid = (xcd < r ? xcd * (q + 1) : r * (q + 1) + (xcd - r) * q) + off; }
        const int nig = WGM * nN, gid = wgid / nig, fm = gid * WGM, gsz = (nM - fm) < WGM ? (nM - fm) : WGM;
        u.pm = fm + ((wgid % nig) % gsz); u.pn = (wgid % nig) / gsz; u.kh = 0; return true;
    }
    __device__ __forceinline__ void a_ready(const Unit&) const {}
    __device__ __forceinline__ void done(const Unit&) const {}
};
struct ListOrder {
    StaticOrder s; int l0, l1, l2;
    __host__ __device__ bool next(int i, Unit& u) const { const int L = i == 0 ? l0 : (i == 1 ? l1 : (i == 2 ? l2 : -1)); if (L < 0 || L >= s.nwg) return false; return s.unit_of(L, u); }
    __device__ __forceinline__ void a_ready(const Unit&) const {}
    __device__ __forceinline__ void done(const Unit&) const {}
};
struct SplitOrder {
    StaticOrder s;
    __host__ __device__ bool next(int i, Unit& u) const { const bool ok = s.next(i >> 1, u); u.kh = i & 1; return ok; }
    __device__ __forceinline__ void a_ready(const Unit&) const {}
    __device__ __forceinline__ void done(const Unit&) const {}
};
typedef float f32x2_cv __attribute__((ext_vector_type(2))); typedef __bf16 bf16x2_cvv __attribute__((ext_vector_type(2)));
__device__ __forceinline__ unsigned cvt_pk_bf16(float lo, float hi) { const f32x2_cv v = {lo, hi}; return __builtin_bit_cast(unsigned, __builtin_convertvector(v, bf16x2_cvv)); }
typedef float f32x2 __attribute__((ext_vector_type(2)));
typedef _Float16 f16x8 __attribute__((ext_vector_type(8)));
typedef unsigned u32x2 __attribute__((ext_vector_type(2)));
__device__ __forceinline__ float sigm(float x) { return __builtin_amdgcn_rcpf(1.0f + __expf(-x)); }
__device__ __forceinline__ unsigned q8(float s) { float q = s * 255.0f + 0.5f; q = q < 1.0f ? 1.0f : (q > 255.0f ? 255.0f : q); return (unsigned)q; }
__device__ __forceinline__ u32x4 pack8_bf16(const float (&o)[8]) { u32x4 w; w.x = cvt_pk_bf16(o[0], o[1]); w.y = cvt_pk_bf16(o[2], o[3]); w.z = cvt_pk_bf16(o[4], o[5]); w.w = cvt_pk_bf16(o[6], o[7]); return w; }
__device__ __forceinline__ u32x2 pack8_u8(const float (&o)[8]) { u32x2 w; unsigned a = 0u, c = 0u;
#pragma unroll
    for (int k = 0; k < 4; ++k) { a = __builtin_amdgcn_cvt_pk_u8_f32(fmaxf(o[k] * 255.0f, 1.0f), k, a); c = __builtin_amdgcn_cvt_pk_u8_f32(fmaxf(o[4 + k] * 255.0f, 1.0f), k, c); }
    w.x = a; w.y = c; return w; }

struct EpiProj {
    static constexpr bool PERM = true, AFTER_DRAIN = false, KSPLIT = false;
    bf16_t* QS; bf16_t* VH; bf16_t* SK; bf16_t* SV; unsigned char* GH; unsigned char* GA; unsigned char* GB; _Float16* LOGF;
    const float* lbl; const float* qg; const float* kg; int pn0;
    __device__ __forceinline__ void operator()(const f32x4 (&acc)[2][2][4][2], const Unit& u, int wr, int wc, int fr, int fq) const {
        const int sec = (u.pn + pn0) >> 2, ct = (u.pn & 3) * 256;
        const int row0 = u.pm * BM + wr * 64 + fr;
        if (sec == 4 || sec == 5) {
            const int head = (u.pn & 3) * 4 + wc; const float* gp = (sec == 4 ? qg : kg) + head * 64 + 8 * fq;
            float gn[2][8];
#pragma unroll
            for (int bj = 0; bj < 2; ++bj) { const f32x4 a = *(const f32x4*)(gp + 32 * bj), b = *(const f32x4*)(gp + 32 * bj + 4);
                gn[bj][0] = a[0]; gn[bj][1] = a[1]; gn[bj][2] = a[2]; gn[bj][3] = a[3]; gn[bj][4] = b[0]; gn[bj][5] = b[1]; gn[bj][6] = b[2]; gn[bj][7] = b[3]; }
            const float sc = (sec == 4) ? 0.125f * 1.4426950408889634f : 1.0f;
#pragma unroll
            for (int ai = 0; ai < 2; ++ai)
#pragma unroll
                for (int m = 0; m < 4; ++m) {
                    float ss = 0.f;
#pragma unroll
                    for (int bj = 0; bj < 2; ++bj)
#pragma unroll
                        for (int n = 0; n < 2; ++n) { const f32x4 x = acc[ai][bj][m][n]; ss += (x[0] * x[0] + x[1] * x[1]) + (x[2] * x[2] + x[3] * x[3]); }
                    ss += __shfl_xor(ss, 16); ss += __shfl_xor(ss, 32);
                    const float rstd = __builtin_amdgcn_rsqf(ss * (1.0f / 64.0f) + 1e-6f) * sc;
                    const size_t row = (size_t)(row0 + ai * HALF + m * 16);
#pragma unroll
                    for (int bj = 0; bj < 2; ++bj) { float o[8];
#pragma unroll
                        for (int k = 0; k < 8; ++k) o[k] = acc[ai][bj][m][k >> 2][k & 3] * rstd * gn[bj][k];
                        bf16_t* dst = (sec == 4) ? (QS + row * 2048 + 1024 + head * 64 + 32 * bj + 8 * fq) : (SK + row * 1024 + head * 64 + 32 * bj + 8 * fq);
                        *(u32x4*)dst = pack8_bf16(o); }
                }
            return;
        }
#pragma unroll
        for (int bj = 0; bj < 2; ++bj) {
            const int col = ct + bj * HALF + wc * 32 + 8 * fq;
            float lb[8];
            if (sec == 1) {
#pragma unroll
                for (int k = 0; k < 8; ++k) lb[k] = 1.0f / (1.0f + __expf(lbl[1024 + col + k] - lbl[col + k]));
            }
#pragma unroll
            for (int ai = 0; ai < 2; ++ai)
#pragma unroll
                for (int m = 0; m < 4; ++m) {
                    const size_t row = (size_t)(row0 + ai * HALF + m * 16);
                    float o[8];
#pragma unroll
                    for (int k = 0; k < 8; ++k) o[k] = acc[ai][bj][m][k >> 2][k & 3];
                    if (sec == 0) { *(u32x4*)(QS + row * 2048 + col) = pack8_bf16(o); }
                    else if (sec == 2) { *(u32x4*)(VH + row * 1024 + col) = pack8_bf16(o); }
                    else if (sec == 6) { bf16_t* vt = SV + ((size_t)((row >> 11) * 16 + (col >> 6)) * 64 + (col & 63)) * 2048 + (row & 2047);
#pragma unroll
                        for (int k = 0; k < 8; ++k) vt[(size_t)k * 2048] = (bf16_t)(cvt_pk_bf16(o[k], o[k]) & 0xffffu); }
                    else if (sec == 1) { f16x8 g;
#pragma unroll
                        for (int k = 0; k < 8; ++k) g[k] = (_Float16)__logf(lb[k] + (1.0f - lb[k]) * sigm(o[k]));
                        *(f16x8*)(LOGF + row * 1024 + col) = g; }
                    else {
#pragma unroll
                        for (int k = 0; k < 8; ++k) o[k] = sigm(o[k]);
                        unsigned char* dst = (sec == 3) ? GH : (sec == 7 ? GA : GB);
                        *(u32x2*)(dst + row * 1024 + col) = pack8_u8(o); }
                }
        }
    }
};
struct EpiVT {
    static constexpr bool PERM = true, AFTER_DRAIN = false, KSPLIT = false;
    bf16_t* VT;
    __device__ __forceinline__ void operator()(const f32x4 (&acc)[2][2][4][2], const Unit& u, int wr, int wc, int fr, int fq) const {
        const int row0 = u.pm * BM + wr * 64 + fr;
#pragma unroll
        for (int ai = 0; ai < 2; ++ai)
#pragma unroll
            for (int m = 0; m < 4; ++m)
#pragma unroll
                for (int bj = 0; bj < 2; ++bj) {
                    const int r = row0 + ai * HALF + m * 16, c = u.pn * BM + bj * HALF + wc * 32 + 8 * fq;
                    float o[8];
#pragma unroll
                    for (int k = 0; k < 8; ++k) o[k] = acc[ai][bj][m][k >> 2][k & 3];
                    *(u32x4*)(VT + ((size_t)((c >> 11) * 16 + (r >> 6)) * 64 + (r & 63)) * 2048 + (c & 2047)) = pack8_bf16(o);
                }
    }
};
struct EpiMix {
    static constexpr bool PERM = true, AFTER_DRAIN = false, KSPLIT = true;
    const unsigned char* GA; const unsigned char* GB; bf16_t* MIXED;
    __device__ __forceinline__ void half0(f32x4 (&acc)[2][2][4][2], const Unit& u, int wr, int wc, int fr, int fq) const {
        const int row0 = u.pm * BM + wr * 64 + fr;
#pragma unroll
        for (int ai = 0; ai < 2; ++ai)
#pragma unroll
            for (int m = 0; m < 4; ++m)
#pragma unroll
                for (int bj = 0; bj < 2; ++bj) {
                    const size_t off = (size_t)(row0 + ai * HALF + m * 16) * 1024 + u.pn * BM + bj * HALF + wc * 32 + 8 * fq;
                    const u32x2 a = *(const u32x2*)(GA + off), b = *(const u32x2*)(GB + off);
#pragma unroll
                    for (int k = 0; k < 8; ++k) { const float qa = (float)((a[k >> 2] >> (8 * (k & 3))) & 255u), qb = (float)((b[k >> 2] >> (8 * (k & 3))) & 255u);
                        acc[ai][bj][m][k >> 2][k & 3] *= qa * __builtin_amdgcn_rcpf(qb); }
                    if (bj == 1 && (m & 1)) asm volatile("" ::: "memory");
                }
    }
    __device__ __forceinline__ void operator()(f32x4 (&acc)[2][2][4][2], const Unit& u, int wr, int wc, int fr, int fq) const {
        if (u.kh == 0) { half0(acc, u, wr, wc, fr, fq); return; }
        const int row0 = u.pm * BM + wr * 64 + fr;
        u32x2 gbv[2][4][2];
#pragma unroll
        for (int ai = 0; ai < 2; ++ai)
#pragma unroll
            for (int m = 0; m < 4; ++m)
#pragma unroll
                for (int bj = 0; bj < 2; ++bj) gbv[ai][m][bj] = *(const u32x2*)(GB + (size_t)(row0 + ai * HALF + m * 16) * 1024 + u.pn * BM + bj * HALF + wc * 32 + 8 * fq);
#pragma unroll
        for (int ai = 0; ai < 2; ++ai)
#pragma unroll
            for (int m = 0; m < 4; ++m)
#pragma unroll
                for (int bj = 0; bj < 2; ++bj) {
                    const size_t off = (size_t)(row0 + ai * HALF + m * 16) * 1024 + u.pn * BM + bj * HALF + wc * 32 + 8 * fq;
                    const u32x2 b = gbv[ai][m][bj]; float o[8];
#pragma unroll
                    for (int k = 0; k < 8; ++k) { const float qb = (float)((b[k >> 2] >> (8 * (k & 3))) & 255u); o[k] = acc[ai][bj][m][k >> 2][k & 3] * (qb * (1.0f / 255.0f)); }
                    *(u32x4*)(MIXED + off) = pack8_bf16(o);
                }
    }
};
struct EpiRes1 {
    static constexpr bool PERM = true, AFTER_DRAIN = false, KSPLIT = false;
    const float* x; bf16_t* DL; bf16_t* X1B; float* SSQ;
    __device__ __forceinline__ void operator()(const f32x4 (&acc)[2][2][4][2], const Unit& u, int wr, int wc, int fr, int fq) const {
        const int row0 = u.pm * BM + wr * 64 + fr;
#pragma unroll
        for (int ai = 0; ai < 2; ++ai)
#pragma unroll
            for (int mp = 0; mp < 2; ++mp) {
                f32x4 xv[2][2][2];
#pragma unroll
                for (int mm = 0; mm < 2; ++mm)
#pragma unroll
                    for (int bj = 0; bj < 2; ++bj) { const size_t off = (size_t)(row0 + ai * HALF + (2 * mp + mm) * 16) * 1024 + u.pn * BM + bj * HALF + wc * 32 + 8 * fq;
                        xv[mm][bj][0] = *(const f32x4*)(x + off); xv[mm][bj][1] = *(const f32x4*)(x + off + 4); }
#pragma unroll
                for (int mm = 0; mm < 2; ++mm) {
                    const int m = 2 * mp + mm; const int row = row0 + ai * HALF + m * 16; float ss = 0.f;
#pragma unroll
                    for (int bj = 0; bj < 2; ++bj) {
                        const size_t off = (size_t)row * 1024 + u.pn * BM + bj * HALF + wc * 32 + 8 * fq;
                        const f32x4 a0 = acc[ai][bj][m][0], a1 = acc[ai][bj][m][1];
                        const f32x4 v0 = xv[mm][bj][0] + a0, v1 = xv[mm][bj][1] + a1;
                        u32x4 dw; dw.x = cvt_pk_bf16(a0[0], a0[1]); dw.y = cvt_pk_bf16(a0[2], a0[3]); dw.z = cvt_pk_bf16(a1[0], a1[1]); dw.w = cvt_pk_bf16(a1[2], a1[3]); *(u32x4*)(DL + off) = dw;
                        u32x4 w; w.x = cvt_pk_bf16(v0[0], v0[1]); w.y = cvt_pk_bf16(v0[2], v0[3]); w.z = cvt_pk_bf16(v1[0], v1[1]); w.w = cvt_pk_bf16(v1[2], v1[3]);
                        *(u32x4*)(X1B + off) = w;
                        ss += (v0[0] * v0[0] + v0[1] * v0[1]) + (v0[2] * v0[2] + v0[3] * v0[3]) + (v1[0] * v1[0] + v1[1] * v1[1]) + (v1[2] * v1[2] + v1[3] * v1[3]);
                    }
                    ss += __shfl_xor(ss, 16); ss += __shfl_xor(ss, 32);
                    if (fq == 0) SSQ[(size_t)row * 16 + u.pn * 4 + wc] = ss;
                }
            }
    }
};
struct EpiSwiglu {
    static constexpr bool PERM = true, AFTER_DRAIN = false, KSPLIT = false;
    const float* SSQ; bf16_t* ACT;
    __device__ __forceinline__ void operator()(const f32x4 (&acc)[2][2][4][2], const Unit& u, int wr, int wc, int fr, int fq) const {
        const int row0 = u.pm * BM + wr * 64 + fr;
        f32x4 sq[2][4];
#pragma unroll
        for (int ai = 0; ai < 2; ++ai)
#pragma unroll
            for (int m = 0; m < 4; ++m) sq[ai][m] = *(const f32x4*)(SSQ + (size_t)(row0 + ai * HALF + m * 16) * 16 + 4 * fq);
#pragma unroll
        for (int ai = 0; ai < 2; ++ai)
#pragma unroll
            for (int m = 0; m < 4; ++m) {
                const int row = row0 + ai * HALF + m * 16;
                float ss = (sq[ai][m][0] + sq[ai][m][1]) + (sq[ai][m][2] + sq[ai][m][3]);
                ss += __shfl_xor(ss, 16); ss += __shfl_xor(ss, 32);
                const float rstd = __builtin_amdgcn_rsqf(ss * (1.0f / 1024.0f) + 1e-6f);
                float o[8];
#pragma unroll
                for (int k = 0; k < 8; ++k) { const float g = acc[ai][0][m][k >> 2][k & 3] * rstd, up = acc[ai][1][m][k >> 2][k & 3] * rstd; o[k] = g * sigm(g) * up; }
                *(u32x4*)(ACT + (size_t)row * 2816 + u.pn * 128 + wc * 32 + 8 * fq) = pack8_bf16(o);
            }
    }
};
struct EpiRes2 {
    static constexpr bool PERM = true, AFTER_DRAIN = false, KSPLIT = false;
    const float* x; const bf16_t* DL; float* out;
    __device__ __forceinline__ void operator()(const f32x4 (&acc)[2][2][4][2], const Unit& u, int wr, int wc, int fr, int fq) const {
        const int row0 = u.pm * BM + wr * 64 + fr;
#pragma unroll
        for (int ai = 0; ai < 2; ++ai)
#pragma unroll
            for (int mp = 0; mp < 2; ++mp) {
                f32x4 xv[2][2][2]; u32x4 dv[2][2];
#pragma unroll
                for (int mm = 0; mm < 2; ++mm)
#pragma unroll
                    for (int bj = 0; bj < 2; ++bj) { const size_t off = (size_t)(row0 + ai * HALF + (2 * mp + mm) * 16) * 1024 + u.pn * BM + bj * HALF + wc * 32 + 8 * fq;
                        xv[mm][bj][0] = *(const f32x4*)(x + off); xv[mm][bj][1] = *(const f32x4*)(x + off + 4); dv[mm][bj] = *(const u32x4*)(DL + off); }
#pragma unroll
                for (int mm = 0; mm < 2; ++mm)
#pragma unroll
                    for (int bj = 0; bj < 2; ++bj) { const int m = 2 * mp + mm;
                        const size_t off = (size_t)(row0 + ai * HALF + m * 16) * 1024 + u.pn * BM + bj * HALF + wc * 32 + 8 * fq;
                        const u32x4 dw = dv[mm][bj];
                        f32x4 d0, d1; d0[0] = __builtin_bit_cast(float, dw.x << 16); d0[1] = __builtin_bit_cast(float, dw.x & 0xffff0000u); d0[2] = __builtin_bit_cast(float, dw.y << 16); d0[3] = __builtin_bit_cast(float, dw.y & 0xffff0000u);
                        d1[0] = __builtin_bit_cast(float, dw.z << 16); d1[1] = __builtin_bit_cast(float, dw.z & 0xffff0000u); d1[2] = __builtin_bit_cast(float, dw.w << 16); d1[3] = __builtin_bit_cast(float, dw.w & 0xffff0000u);
                        const f32x4 v0 = (xv[mm][bj][0] + d0) + acc[ai][bj][m][0], v1 = (xv[mm][bj][1] + d1) + acc[ai][bj][m][1];
                        *(f32x4*)(out + off) = v0; *(f32x4*)(out + off + 4) = v1; }
            }
    }
};

template <class Epi, class Sched, bool ALIGN_EPI = false, bool SP2 = false>
__device__ __forceinline__ void gemm_phase(PG8_LAS unsigned char* lds, const Gemm g, const Sched& S, const Epi& E) {
    int tid_ = threadIdx.x; asm volatile("" : "+v"(tid_));
    const int tid = tid_, wid = __builtin_amdgcn_readfirstlane(tid >> 6), lane = tid & 63, wr = wid >> 2, wc = wid & 3, fr = lane & 15, fq = lane >> 4;
    const int K = g.K, nt = K / BK;
    unsigned voffA[2], voffB[2];
#pragma unroll
    for (int i = 0; i < 2; ++i) { int R, C; stage_rc(tid * 16 + i * 8192, R, C); const int Rb = Epi::PERM ? ((R & ~31) + perm32(R & 31)) : R;
        voffA[i] = (unsigned)(R * g.ld + C) * 2u; voffB[i] = (unsigned)(Rb * g.ld + C) * 2u; }
    const size_t kstep = (size_t)(BK * 2);
    const size_t hstep = (size_t)HALF * g.ld * 2; const size_t khb = (size_t)K * 2;
    const size_t tstep = 2 * hstep;
    const unsigned ldsw = (unsigned)wid * 1024u;
    const int aoff = lds_byte(wr * 64 + fr, fq * 8), boff = lds_byte(wc * 32 + fr, fq * 8);
#define PG8_SA(b, h) (((b) * 2 + (h)) * HTB)
#define PG8_SB(b, h) ((4 + (b) * 2 + (h)) * HTB)
#define PG8_STAGE(bufoff, gbase, voff) do { _Pragma("unroll") for (int _i = 0; _i < 2; ++_i) \
        __builtin_amdgcn_global_load_lds((const unsigned*)((const char*)(gbase) + (voff)[_i]), (PG8_LAS unsigned*)(lds + (bufoff) + ldsw + _i * 8192), 16, 0, 0); } while (0)
#define PG8_LDA(dst, b, h) do { _Pragma("unroll") for (int m = 0; m < 4; ++m) _Pragma("unroll") for (int k = 0; k < 2; ++k) dst[m][k] = *(const PG8_LAS bf16x8*)(lds + PG8_SA(b, h) + aoff + m * 2048 + k * 1024); } while (0)
#define PG8_LDB(dst, b, h) do { _Pragma("unroll") for (int n = 0; n < 2; ++n) _Pragma("unroll") for (int k = 0; k < 2; ++k) dst[n][k] = *(const PG8_LAS bf16x8*)(lds + PG8_SB(b, h) + boff + n * 2048 + k * 1024); } while (0)
#define PG8_MMA(ai, bj, At, Bt) do { __builtin_amdgcn_s_setprio(1); _Pragma("unroll") for (int m = 0; m < 4; ++m) _Pragma("unroll") for (int n = 0; n < 2; ++n) _Pragma("unroll") for (int k = 0; k < 2; ++k) \
        acc[ai][bj][m][n] = __builtin_amdgcn_mfma_f32_16x16x32_bf16(Bt[n][k], At[m][k], acc[ai][bj][m][n], 0, 0, 0); __builtin_amdgcn_s_setprio(0); } while (0)
#define PG8_WAIT_V(n) asm volatile("s_waitcnt vmcnt(" #n ")" ::: "memory")
#define PG8_WAIT_L(n) asm volatile("s_waitcnt lgkmcnt(" #n ")" ::: "memory")
#define PG8_BAR __builtin_amdgcn_s_barrier()
#define PG8_SCHED __builtin_amdgcn_sched_barrier(0)
    Unit cur, nxt; int ui = 0;
    if (!S.next(0, cur)) return;
    f32x4 acc[2][2][4][2];
#pragma unroll
    for (int a = 0; a < 2; ++a)
#pragma unroll
        for (int b = 0; b < 2; ++b)
#pragma unroll
            for (int m = 0; m < 4; ++m)
#pragma unroll
                for (int n = 0; n < 2; ++n) acc[a][b][m][n] = (f32x4){0.f, 0.f, 0.f, 0.f};
    bf16x8 At[4][2], B0[2][2], B1[2][2];
    const char* cA = (const char*)g.A + (size_t)cur.pm * tstep + cur.kh * khb; const char* cB = (const char*)g.Bt + (size_t)cur.pn * tstep + cur.kh * khb;
    S.a_ready(cur);
    if constexpr (SP2) {
        PG8_STAGE(PG8_SB(0, 0), cB, voffB); PG8_STAGE(PG8_SB(0, 1), cB + hstep, voffB); PG8_STAGE(PG8_SA(0, 0), cA, voffA); PG8_STAGE(PG8_SA(0, 1), cA + hstep, voffA);
        if (wr == 1) PG8_BAR;
        PG8_WAIT_V(2); PG8_BAR;
        PG8_STAGE(PG8_SB(1, 0), cB + kstep, voffB); PG8_STAGE(PG8_SA(1, 0), cA + kstep, voffA); PG8_STAGE(PG8_SB(1, 1), cB + hstep + kstep, voffB);
        PG8_WAIT_V(6); PG8_BAR;
    } else {
        PG8_STAGE(PG8_SB(0, 0), cB, voffB); PG8_STAGE(PG8_SA(0, 0), cA, voffA); PG8_STAGE(PG8_SB(0, 1), cB + hstep, voffB); PG8_STAGE(PG8_SA(0, 1), cA + hstep, voffA);
        if (wr == 1) PG8_BAR;
        PG8_WAIT_V(4); PG8_BAR;
        PG8_STAGE(PG8_SB(1, 0), cB + kstep, voffB); PG8_STAGE(PG8_SA(1, 0), cA + kstep, voffA); PG8_STAGE(PG8_SB(1, 1), cB + hstep + kstep, voffB);
        PG8_WAIT_V(6); PG8_BAR;
    }
    for (;;) {
        const bool has_next = S.next(ui + 1, nxt);
        const char* nA = has_next ? (const char*)g.A + (size_t)nxt.pm * tstep + nxt.kh * khb : cA; const char* nB = has_next ? (const char*)g.Bt + (size_t)nxt.pn * tstep + nxt.kh * khb : cB;
        for (int t = 0; t < nt; t += 2) {
            const bool last = (t == nt - 2);
            const char* a1 = cA + (size_t)(t + 1) * kstep;
            const char* a2 = last ? nA : cA + (size_t)(t + 2) * kstep; const char* b2 = last ? nB : cB + (size_t)(t + 2) * kstep;
            const char* a3 = a2 + kstep; const char* b3 = b2 + kstep;
            if (last && has_next) S.a_ready(nxt);
            if constexpr (SP2) {
            PG8_LDB(B0, 0, 0); PG8_LDB(B1, 0, 1); PG8_SCHED; PG8_LDA(At, 0, 0); PG8_STAGE(PG8_SA(1, 1), a1 + hstep, voffA);
            PG8_WAIT_V(8); PG8_WAIT_L(0); PG8_BAR; PG8_MMA(0, 0, At, B0); PG8_MMA(0, 1, At, B1); PG8_BAR; PG8_SCHED;
            PG8_LDA(At, 0, 1); PG8_STAGE(PG8_SB(0, 0), b2, voffB); PG8_STAGE(PG8_SB(0, 1), b2 + hstep, voffB); PG8_STAGE(PG8_SA(0, 0), a2, voffA);
            PG8_WAIT_V(8); PG8_WAIT_L(0); PG8_BAR; PG8_MMA(1, 0, At, B0); PG8_MMA(1, 1, At, B1); PG8_BAR; PG8_SCHED;
            PG8_LDB(B0, 1, 0); PG8_LDB(B1, 1, 1); PG8_SCHED; PG8_LDA(At, 1, 0); PG8_STAGE(PG8_SA(0, 1), a2 + hstep, voffA);
            PG8_WAIT_V(8); PG8_WAIT_L(0); PG8_BAR; PG8_MMA(0, 0, At, B0); PG8_MMA(0, 1, At, B1); PG8_BAR; PG8_SCHED;
            PG8_LDA(At, 1, 1); PG8_STAGE(PG8_SB(1, 0), b3, voffB); PG8_STAGE(PG8_SB(1, 1), b3 + hstep, voffB); PG8_STAGE(PG8_SA(1, 0), a3, voffA);
            PG8_WAIT_V(8); PG8_WAIT_L(0); PG8_BAR; PG8_MMA(1, 0, At, B0); PG8_MMA(1, 1, At, B1); PG8_BAR; PG8_SCHED;
            } else {
            PG8_LDB(B0, 0, 0); PG8_SCHED; PG8_LDA(At, 0, 0); PG8_STAGE(PG8_SA(1, 1), a1 + hstep, voffA);
            PG8_WAIT_L(8); PG8_BAR; PG8_WAIT_L(0); PG8_MMA(0, 0, At, B0); PG8_BAR; PG8_SCHED;
            PG8_LDB(B1, 0, 1); PG8_STAGE(PG8_SB(0, 0), b2, voffB);
            PG8_BAR; PG8_WAIT_L(0); PG8_MMA(0, 1, At, B1); PG8_BAR;
            PG8_LDA(At, 0, 1); PG8_STAGE(PG8_SA(0, 0), a2, voffA);
            PG8_BAR; PG8_WAIT_L(0); PG8_MMA(1, 0, At, B0); PG8_BAR; PG8_SCHED;
            PG8_STAGE(PG8_SB(0, 1), b2 + hstep, voffB);
            PG8_WAIT_V(6); PG8_BAR; PG8_MMA(1, 1, At, B1); PG8_BAR;
            PG8_LDB(B0, 1, 0); PG8_SCHED; PG8_LDA(At, 1, 0); PG8_STAGE(PG8_SA(0, 1), a2 + hstep, voffA);
            PG8_WAIT_L(8); PG8_BAR; PG8_WAIT_L(0); PG8_MMA(0, 0, At, B0); PG8_BAR; PG8_SCHED;
            PG8_LDB(B1, 1, 1); PG8_STAGE(PG8_SB(1, 0), b3, voffB);
            PG8_BAR; PG8_WAIT_L(0); PG8_MMA(0, 1, At, B1); PG8_BAR;
            PG8_LDA(At, 1, 1); PG8_STAGE(PG8_SA(1, 0), a3, voffA);
            PG8_BAR; PG8_WAIT_L(0); PG8_MMA(1, 0, At, B0); PG8_BAR; PG8_SCHED;
            PG8_STAGE(PG8_SB(1, 1), b3 + hstep, voffB);
            PG8_WAIT_V(6); PG8_BAR; PG8_MMA(1, 1, At, B1); PG8_BAR;
            }
        }
        if constexpr (ALIGN_EPI) { if (wr == 0) PG8_BAR; }
        if constexpr (!Epi::AFTER_DRAIN) { E(acc, cur, wr, wc, fr, fq); S.done(cur); }
        if (!has_next) break;
        if (!(Epi::KSPLIT && cur.kh == 0))
#pragma unroll
        for (int a = 0; a < 2; ++a)
#pragma unroll
            for (int b = 0; b < 2; ++b)
#pragma unroll
                for (int m = 0; m < 4; ++m)
#pragma unroll
                    for (int n = 0; n < 2; ++n) acc[a][b][m][n] = (f32x4){0.f, 0.f, 0.f, 0.f};
        cur = nxt; cA = nA; cB = nB; ++ui;
        if constexpr (ALIGN_EPI) { if (wr == 1) PG8_BAR; }
    }
    PG8_WAIT_V(0);
    if constexpr (!ALIGN_EPI) { if (wr == 0) PG8_BAR; }
    PG8_BAR;
    if constexpr (Epi::AFTER_DRAIN) { E.fused(acc, cur, wr, wc, fr, fq, lds, wid, lane); S.done(cur); }
#undef PG8_SA
#undef PG8_SB
#undef PG8_STAGE
#undef PG8_LDA
#undef PG8_LDB
#undef PG8_MMA
#undef PG8_WAIT_V
#undef PG8_WAIT_L
#undef PG8_BAR
#undef PG8_SCHED
}
}

constexpr int NWAVES = 8, NTHREADS = 512;
constexpr int BATCH = 8, SEQ = 2048, D = 1024, M = BATCH * SEQ, INW = 9216, FFH = 2816;
constexpr float EPS = 1e-6f;
constexpr size_t MiB = 1u << 20;
constexpr size_t WS_SSQ = 1 * MiB;
constexpr size_t WS_WIN = 2 * MiB;
constexpr size_t WS_WHS = 20 * MiB;
constexpr size_t WS_WO = 24 * MiB;
constexpr size_t WS_WF1 = 26 * MiB;
constexpr size_t WS_WF2 = 37 * MiB;
constexpr size_t WS_H = 43 * MiB;
constexpr size_t WS_MIXED = WS_H;
constexpr size_t WS_QS = 75 * MiB;
constexpr size_t WS_VH = 139 * MiB;
constexpr size_t WS_SK = 171 * MiB;
constexpr size_t WS_X1B = WS_SK;
constexpr size_t WS_GH = 203 * MiB, WS_GA = 219 * MiB, WS_GB = 235 * MiB;
constexpr size_t WS_ACT = 75 * MiB;
constexpr size_t WS_END = 251 * MiB;
static_assert(WS_ACT + (size_t)M * FFH * 2 <= WS_X1B, "ACT overlay");
constexpr int RING_BYTES = 131072, LDS_BYTES = 157696, MISC_OFF = LDS_BYTES - 256;

#define LAS __attribute__((address_space(3)))
typedef unsigned short bf16;
typedef unsigned v4u __attribute__((ext_vector_type(4)));
typedef float f32x4 __attribute__((ext_vector_type(4)));
__device__ __forceinline__ unsigned f2bf(float f) { unsigned u = __builtin_bit_cast(unsigned, f); return (u + 0x7fffu + ((u >> 16) & 1u)) >> 16; }
__device__ __forceinline__ unsigned pk2(float lo, float hi) { return f2bf(lo) | (f2bf(hi) << 16); }
__device__ __forceinline__ float bf2f(unsigned short b) { return __builtin_bit_cast(float, (unsigned)b << 16); }
__device__ __forceinline__ float wave_sum(float v) {
#pragma unroll
    for (int o = 1; o < 64; o <<= 1) v += __shfl_xor(v, o);
    return v;
}
struct Args { const float* in[13]; float* out; unsigned char* ws; int ph_lo, ph_hi; };

struct ConvItem { const float* W; bf16* WT; const float* ks; int N, ldT, koff, k0, n0d, n0s; };
__device__ __forceinline__ ConvItem conv_item(const Args& a, unsigned char* ws, int it) {
    constexpr int I_IN = 16 * (INW / 32), I_SQ = 16 * 32, I_F1 = 16 * (2 * FFH / 32);
    ConvItem p; int r = it; p.ks = nullptr; p.koff = 0;
    if (r < I_IN) { const int nblk = INW / 32, kb = r / nblk, nb = r % nblk, n0d = 32 * nb; const int sec = n0d >> 10; int n0s = n0d;
        if (sec == 4 || sec == 5) { const int q = n0d & 255; n0s = (n0d - q) + 64 * ((q >> 5) & 3) + 32 * (q >> 7); }
        p.W = a.in[2]; p.N = INW; p.WT = (bf16*)(ws + WS_WIN); p.ldT = 1024; p.k0 = 64 * kb; p.n0d = n0d; p.n0s = n0s; return p; } r -= I_IN;
    if (r < I_SQ) { p.W = a.in[7]; p.N = 1024; p.WT = (bf16*)(ws + WS_WHS); p.ldT = 2048; p.k0 = 64 * (r / 32); p.n0d = p.n0s = 32 * (r % 32); return p; } r -= I_SQ;
    if (r < I_SQ) { p.W = a.in[8]; p.N = 1024; p.WT = (bf16*)(ws + WS_WHS); p.ldT = 2048; p.koff = 1024; p.k0 = 64 * (r / 32); p.n0d = p.n0s = 32 * (r % 32); return p; } r -= I_SQ;
    if (r < I_SQ) { p.W = a.in[9]; p.N = 1024; p.WT = (bf16*)(ws + WS_WO); p.ldT = 1024; p.k0 = 64 * (r / 32); p.n0d = p.n0s = 32 * (r % 32); return p; } r -= I_SQ;
    if (r < I_F1) { const int nblk = 2 * FFH / 32, kb = r / nblk, nb = r % nblk, n0d = 32 * nb, pn = n0d >> 8, q = n0d & 255;
        p.W = a.in[11]; p.N = 2 * FFH; p.WT = (bf16*)(ws + WS_WF1); p.ldT = 1024; p.k0 = 64 * kb; p.n0d = n0d; p.n0s = (q >> 7) * FFH + 128 * pn + (q & 127); p.ks = a.in[10]; return p; } r -= I_F1;
    p.W = a.in[12]; p.N = 1024; p.WT = (bf16*)(ws + WS_WF2); p.ldT = FFH; p.k0 = 64 * (r / 32); p.n0d = p.n0s = 32 * (r % 32); return p;
}
__device__ __forceinline__ void conv_load(const ConvItem& p, float (&wv)[32], f32x4 (&kv)[2], int lane) {
    const float* wp = p.W + (size_t)(p.k0 + (lane >> 5)) * p.N + p.n0s + (lane & 31);
#pragma unroll
    for (int i = 0; i < 32; ++i) wv[i] = wp[(size_t)(2 * i) * p.N];
    if (p.ks) { kv[0] = *(const f32x4*)(p.ks + p.k0 + 8 * (lane & 7)); kv[1] = *(const f32x4*)(p.ks + p.k0 + 8 * (lane & 7) + 4); }
    else { kv[0] = (f32x4){1.f, 1.f, 1.f, 1.f}; kv[1] = kv[0]; }
}
__device__ __forceinline__ void conv_finish(const ConvItem& p, const float (&wv)[32], const f32x4 (&kv)[2], LAS float* scr, int lane) {
#pragma unroll
    for (int i = 0; i < 32; ++i) scr[(2 * i + (lane >> 5)) * 33 + (lane & 31)] = wv[i];
    asm volatile("s_waitcnt lgkmcnt(0)" ::: "memory");
    const int c = lane & 7;
#pragma unroll
    for (int j = 0; j < 4; ++j) { const int n = (lane >> 3) + 8 * j; const LAS float* s = scr + (8 * c) * 33 + n;
        v4u o; o.x = pk2(s[0 * 33] * kv[0][0], s[1 * 33] * kv[0][1]); o.y = pk2(s[2 * 33] * kv[0][2], s[3 * 33] * kv[0][3]); o.z = pk2(s[4 * 33] * kv[1][0], s[5 * 33] * kv[1][1]); o.w = pk2(s[6 * 33] * kv[1][2], s[7 * 33] * kv[1][3]);
        *(v4u*)(p.WT + (size_t)(p.n0d + n) * p.ldT + p.koff + p.k0 + 8 * c) = o; }
    asm volatile("s_waitcnt lgkmcnt(0)" ::: "memory");
}
template <int PART> __device__ __forceinline__ void p0_prologue(const Args& a, LAS unsigned char* lds, int wave, int lane, int gw, int NGW) {
    LAS float* scr = (LAS float*)(lds + wave * 16384);
    unsigned char* ws = a.ws;
    constexpr int I_IN = 16 * (INW / 32), I_SQ = 16 * 32, I_F1 = 16 * (2 * FFH / 32), I_F2 = (FFH / 64) * 32;
    constexpr int NITEMS = I_IN + 3 * I_SQ + I_F1 + I_F2;
    { int it = (PART == 0 ? gw : I_IN + gw); const int end = (PART == 0 ? I_IN : NITEMS);
      if (it < end) {
        ConvItem pa = conv_item(a, ws, it), pb = pa; float wa[32], wb[32]; f32x4 ka[2], kb[2];
        conv_load(pa, wa, ka, lane);
        for (;;) {
            const bool hb = it + NGW < end; if (hb) { pb = conv_item(a, ws, it + NGW); conv_load(pb, wb, kb, lane); }
            conv_finish(pa, wa, ka, scr, lane);
            if (!hb) break; it += NGW;
            const bool ha = it + NGW < end; if (ha) { pa = conv_item(a, ws, it + NGW); conv_load(pa, wa, ka, lane); }
            conv_finish(pb, wb, kb, scr, lane);
            if (!ha) break; it += NGW;
        }
      }
    }
    if (PART != 0) return;
    const float* g1 = a.in[1];
    f32x4 gv[4];
#pragma unroll
    for (int j = 0; j < 4; ++j) gv[j] = ((const f32x4*)g1)[lane + 64 * j];
    for (int m = gw; m < M; m += NGW) {
        const f32x4* xr = (const f32x4*)(a.in[0] + (size_t)m * D) + lane;
        f32x4 v[4]; float s = 0.f;
#pragma unroll
        for (int j = 0; j < 4; ++j) { v[j] = xr[64 * j]; s += (v[j].x * v[j].x + v[j].y * v[j].y) + (v[j].z * v[j].z + v[j].w * v[j].w); }
        const float rstd = __builtin_amdgcn_rsqf(wave_sum(s) * (1.f / D) + EPS);
        unsigned long long* o8 = (unsigned long long*)((bf16*)(ws + WS_H) + (size_t)m * D) + lane;
#pragma unroll
        for (int j = 0; j < 4; ++j) { const f32x4 y = v[j] * rstd * gv[j]; o8[64 * j] = (unsigned long long)pk2(y.x, y.y) | ((unsigned long long)pk2(y.z, y.w) << 32); }
    }
}

typedef short bf16x8_t __attribute__((ext_vector_type(8)));
typedef float f32x16 __attribute__((ext_vector_type(16)));
typedef unsigned u32x2_t __attribute__((ext_vector_type(2)));
typedef float f32x2_t __attribute__((ext_vector_type(2)));
typedef __bf16 bf16x2_cv __attribute__((ext_vector_type(2)));
__device__ __forceinline__ unsigned cvtpk(float lo, float hi) { const f32x2_t v = {lo, hi}; return __builtin_bit_cast(unsigned, __builtin_convertvector(v, bf16x2_cv)); }
__device__ __forceinline__ bf16x8_t pack_acc8(const f32x16& c, int p) {
    v4u w; if (p == 0) { w.x = cvtpk(c[0], c[1]); w.y = cvtpk(c[2], c[3]); w.z = cvtpk(c[4], c[5]); w.w = cvtpk(c[6], c[7]); }
    else { w.x = cvtpk(c[8], c[9]); w.y = cvtpk(c[10], c[11]); w.z = cvtpk(c[12], c[13]); w.w = cvtpk(c[14], c[15]); }
    return __builtin_bit_cast(bf16x8_t, w);
}
#define MFMA32(A, B, C) __builtin_amdgcn_mfma_f32_32x32x16_bf16((A), (B), (C), 0, 0, 0)
__device__ __forceinline__ void hgrn_mfma(const Args& a, LAS unsigned char* lds, int vblk, int nblk) {
    unsigned char* ws = a.ws;
    bf16* QS = (bf16*)(ws + WS_QS); const bf16* VH = (const bf16*)(ws + WS_VH); const unsigned char* GH = ws + WS_GH; const _Float16* LOGF = (const _Float16*)a.out;
    const float* ogain = a.in[4];
    constexpr int RS = 272, TS = 144;
    LAS unsigned char* L_QI = lds; LAS unsigned char* L_QA = lds + 64 * RS; LAS unsigned char* L_KA = lds + 2 * 64 * RS;
    LAS unsigned char* L_KST = lds + 3 * 64 * RS; LAS unsigned char* L_VT = L_KST + 128 * TS;
    LAS float* L_TQ = (LAS float*)(L_VT + 128 * TS); LAS float* L_DEC = L_TQ + 2048;     LAS float* L_SS = L_DEC + 128; LAS float* L_GN = L_SS + 256;
    const int tid = threadIdx.x, lane = tid & 63, wave = __builtin_amdgcn_readfirstlane(tid >> 6);
    const int dp = tid & 63, oct = wave, r32 = lane & 31, hi = lane >> 5, vt = wave & 3, tt = wave >> 2;
    const int kap = 16 * (r32 >> 4) + 8 * ((r32 >> 2) & 1) + 4 * ((r32 >> 3) & 1) + (r32 & 3);
    for (int item = vblk; item < BATCH * 8; item += nblk) {
        const int b = item >> 3, h = item & 7;
        f32x16 C[4];
#pragma unroll
        for (int i = 0; i < 4; ++i)
#pragma unroll
            for (int j = 0; j < 16; ++j) C[i][j] = 0.f;
        if (tid < 128) L_GN[tid] = ogain[h * 128 + tid];
        unsigned gN2[2][8], qN2[2][8], vN2[2][8];
#pragma unroll
        for (int c2 = 0; c2 < 2; ++c2) { const size_t row0 = (size_t)b * SEQ + 64 * c2 + 8 * oct;
#pragma unroll
          for (int i = 0; i < 8; ++i) { gN2[c2][i] = *(const unsigned*)(LOGF + (row0 + i) * 1024 + h * 128 + 2 * dp); qN2[c2][i] = *(const unsigned*)(QS + (row0 + i) * 2048 + h * 128 + 2 * dp); vN2[c2][i] = *(const unsigned*)(VH + (row0 + i) * 1024 + h * 128 + 2 * dp); } }
        { float run0 = 0.f, run1 = 0.f;
#pragma unroll
          for (int i = 0; i < 8; ++i) { run0 += (float)__builtin_bit_cast(_Float16, (unsigned short)(gN2[0][i] & 0xffffu)); run1 += (float)__builtin_bit_cast(_Float16, (unsigned short)(gN2[0][i] >> 16)); }
          *(LAS f32x2_t*)(L_TQ + oct * 128 + 2 * dp) = (f32x2_t){run0, run1}; }
        __syncthreads();
#pragma unroll 2
        for (int n = 0; n < SEQ / 64; ++n) {
            unsigned (&gN)[8] = gN2[n & 1]; unsigned (&qN)[8] = qN2[n & 1]; unsigned (&vN)[8] = vN2[n & 1];
            if (n + 1 < SEQ / 64) { float run0 = 0.f, run1 = 0.f;
#pragma unroll
                for (int i = 0; i < 8; ++i) { const unsigned gw_ = gN2[(n + 1) & 1][i]; run0 += (float)__builtin_bit_cast(_Float16, (unsigned short)(gw_ & 0xffffu)); run1 += (float)__builtin_bit_cast(_Float16, (unsigned short)(gw_ >> 16)); }
                *(LAS f32x2_t*)(L_TQ + ((n + 1) & 1) * 1024 + oct * 128 + 2 * dp) = (f32x2_t){run0, run1}; }
            float off0 = 0.f, off1 = 0.f, cref0 = 0.f, cref1 = 0.f, tot0 = 0.f, tot1 = 0.f;
#pragma unroll
            for (int o = 0; o < 8; ++o) { const f32x2_t tq = *(const LAS f32x2_t*)(L_TQ + (n & 1) * 1024 + o * 128 + 2 * dp);
                if (o < oct) { off0 += tq.x; off1 += tq.y; } if (o < 4) { cref0 += tq.x; cref1 += tq.y; } tot0 += tq.x; tot1 += tq.y; }
            const float xc0 = __expf(tot0), xc1 = __expf(tot1), xa0 = __expf(-cref0), xa1 = __expf(-cref1), xb0 = __expf(cref0), xb1 = __expf(cref1);
            if (oct == 0) *(LAS f32x2_t*)(L_DEC + 2 * dp) = (f32x2_t){xc0, xc1};
            float e0 = __expf(off0), e1 = __expf(off1);
            unsigned ksp0[4], ksp1[4], vsp0[4], vsp1[4];
#pragma unroll
            for (int i = 0; i < 8; ++i) {
                const float f0 = __expf((float)__builtin_bit_cast(_Float16, (unsigned short)(gN[i] & 0xffffu))), f1 = __expf((float)__builtin_bit_cast(_Float16, (unsigned short)(gN[i] >> 16)));
                e0 = fmaxf(e0 * f0, 1e-30f); e1 = fmaxf(e1 * f1, 1e-30f);
                const float r0 = __builtin_amdgcn_rcpf(e0), r1 = __builtin_amdgcn_rcpf(e1);
                const float k0 = 1.0f - f0, k1 = 1.0f - f1, q0 = __builtin_bit_cast(float, qN[i] << 16), q1 = __builtin_bit_cast(float, qN[i] & 0xffff0000u);
                const float qi0 = q0 * e0, qi1 = q1 * e1, kr0 = k0 * r0, kr1 = k1 * r1;
                const int t = 8 * oct + i;
                *(LAS unsigned*)(L_QI + t * RS + 4 * dp) = cvtpk(qi0, qi1);
                *(LAS unsigned*)(L_QA + t * RS + 4 * dp) = cvtpk(qi0 * xa0, qi1 * xa1);
                *(LAS unsigned*)(L_KA + t * RS + 4 * dp) = cvtpk(kr0 * xb0, kr1 * xb1);
                const unsigned ks = cvtpk(kr0 * xc0, kr1 * xc1);
                if (i & 1) { ksp0[i >> 1] |= ks << 16; ksp1[i >> 1] |= ks & 0xffff0000u; vsp0[i >> 1] |= vN[i] << 16; vsp1[i >> 1] |= vN[i] & 0xffff0000u; }
                else { ksp0[i >> 1] = ks & 0xffffu; ksp1[i >> 1] = ks >> 16; vsp0[i >> 1] = vN[i] & 0xffffu; vsp1[i >> 1] = vN[i] >> 16; }
            }
            *(LAS v4u*)(L_KST + (2 * dp) * TS + 16 * oct) = (v4u){ksp0[0], ksp0[1], ksp0[2], ksp0[3]}; *(LAS v4u*)(L_KST + (2 * dp + 1) * TS + 16 * oct) = (v4u){ksp1[0], ksp1[1], ksp1[2], ksp1[3]};
            *(LAS v4u*)(L_VT + (2 * dp) * TS + 16 * oct) = (v4u){vsp0[0], vsp0[1], vsp0[2], vsp0[3]}; *(LAS v4u*)(L_VT + (2 * dp + 1) * TS + 16 * oct) = (v4u){vsp1[0], vsp1[1], vsp1[2], vsp1[3]};
            __syncthreads();
            const size_t m = (size_t)b * SEQ + 64 * n + 32 * tt + r32;
            unsigned gt4[4];
#pragma unroll
            for (int a4 = 0; a4 < 4; ++a4) gt4[a4] = *(const unsigned*)(GH + m * 1024 + h * 128 + 32 * vt + 8 * a4 + 4 * hi);
            if (n + 2 < SEQ / 64) { const size_t row0 = (size_t)b * SEQ + 64 * (n + 2) + 8 * oct;
#pragma unroll
                for (int i = 0; i < 8; ++i) { gN[i] = *(const unsigned*)(LOGF + (row0 + i) * 1024 + h * 128 + 2 * dp); qN[i] = *(const unsigned*)(QS + (row0 + i) * 2048 + h * 128 + 2 * dp); vN[i] = *(const unsigned*)(VH + (row0 + i) * 1024 + h * 128 + 2 * dp); } }
#define SB() __builtin_amdgcn_sched_barrier(0)
            f32x16 O;
#pragma unroll
            for (int j = 0; j < 16; ++j) O[j] = 0.f;
            bf16x8_t Vt[4];
            {
                v4u qf[8];
#pragma unroll
                for (int i = 0; i < 8; ++i) { const LAS unsigned char* qp = L_QI + (32 * tt + r32) * RS + (32 * (i >> 1) + 16 * (i & 1) + 4 * hi) * 2;
                    const u32x2_t lo = *(const LAS u32x2_t*)qp, hi2 = *(const LAS u32x2_t*)(qp + 16); qf[i] = (v4u){lo.x, lo.y, hi2.x, hi2.y}; }
#pragma unroll
                for (int ks = 0; ks < 4; ++ks) Vt[ks] = *(const LAS bf16x8_t*)(L_VT + (32 * vt + r32) * TS + (16 * ks + 8 * hi) * 2);
                SB();
#pragma unroll
                for (int i = 0; i < 8; ++i) O = MFMA32(pack_acc8(C[i >> 1], i & 1), __builtin_bit_cast(bf16x8_t, qf[i]), O);
                SB();
            }
#pragma unroll
            for (int st = 0; st < 2; ++st) if (st <= tt) {
                f32x16 S;
#pragma unroll
                for (int j = 0; j < 16; ++j) S[j] = 0.f;
#pragma unroll
                for (int hb = 0; hb < 2; ++hb) {
                    bf16x8_t A[4], B[4];
#pragma unroll
                    for (int k4 = 0; k4 < 4; ++k4) { const int ks = 4 * hb + k4;
                        A[k4] = *(const LAS bf16x8_t*)(L_KA + (32 * st + kap) * RS + (16 * ks + 8 * hi) * 2);
                        B[k4] = *(const LAS bf16x8_t*)(L_QA + (32 * tt + r32) * RS + (16 * ks + 8 * hi) * 2); }
                    SB();
#pragma unroll
                    for (int k4 = 0; k4 < 4; ++k4) S = MFMA32(A[k4], B[k4], S);
                    SB();
                }
                if (st == tt) {
#pragma unroll
                    for (int j = 0; j < 16; ++j) { const int sl = 16 * (j >> 3) + 8 * hi + (j & 7); if (sl > r32) S[j] = 0.f; }
                }
                O = MFMA32(Vt[2 * st], pack_acc8(S, 0), O); O = MFMA32(Vt[2 * st + 1], pack_acc8(S, 1), O);
            }
#pragma unroll
            for (int dt = 0; dt < 4; ++dt) {
                f32x4 dc[4]; bf16x8_t A[4];
#pragma unroll
                for (int a4 = 0; a4 < 4; ++a4) dc[a4] = *(const LAS f32x4*)(L_DEC + 32 * dt + 8 * a4 + 4 * hi);
#pragma unroll
                for (int ks = 0; ks < 4; ++ks) A[ks] = *(const LAS bf16x8_t*)(L_KST + (32 * dt + r32) * TS + (16 * ks + 8 * hi) * 2);
                SB();
#pragma unroll
                for (int a4 = 0; a4 < 4; ++a4)
#pragma unroll
                    for (int cc = 0; cc < 4; ++cc) C[dt][4 * a4 + cc] *= dc[a4][cc];
#pragma unroll
                for (int ks = 0; ks < 4; ++ks) C[dt] = MFMA32(A[ks], Vt[ks], C[dt]);
                SB();
            }
#undef SB
            float ss = 0.f;
#pragma unroll
            for (int j = 0; j < 16; ++j) ss += O[j] * O[j];
            ss += __shfl_xor(ss, 32);
            if (hi == 0) L_SS[(tt * 4 + vt) * 32 + r32] = ss;
            __syncthreads();
            const float sst = (L_SS[(tt * 4 + 0) * 32 + r32] + L_SS[(tt * 4 + 1) * 32 + r32]) + (L_SS[(tt * 4 + 2) * 32 + r32] + L_SS[(tt * 4 + 3) * 32 + r32]);
            const float rstd = __builtin_amdgcn_rsqf(sst * (1.0f / 128.0f) + EPS);
#pragma unroll
            for (int a4 = 0; a4 < 4; ++a4) { const int v0 = h * 128 + 32 * vt + 8 * a4 + 4 * hi;
                const f32x4 gn = *(const LAS f32x4*)(L_GN + 32 * vt + 8 * a4 + 4 * hi); const unsigned gt = gt4[a4];
                float o[4];
#pragma unroll
                for (int cc = 0; cc < 4; ++cc) o[cc] = O[4 * a4 + cc] * rstd * gn[cc] * ((float)((gt >> (8 * cc)) & 255u) * (1.0f / 255.0f));
                u32x2_t w; w.x = cvtpk(o[0], o[1]); w.y = cvtpk(o[2], o[3]);
                *(u32x2_t*)(QS + m * 2048 + v0) = w; }
        }
        __syncthreads();
    }
}

__device__ __forceinline__ void hgrn_v2(const Args& a, LAS unsigned char* lds, int vblk, int nblk) {
    unsigned char* ws = a.ws;
    bf16* QS = (bf16*)(ws + WS_QS); const bf16* VH = (const bf16*)(ws + WS_VH); const unsigned char* GH = ws + WS_GH; const _Float16* LOGF = (const _Float16*)a.out;
    const float* ogain = a.in[4];
    constexpr int RS = 272, TS = 144, O_KA = 64 * RS, O_KAT = 2 * 64 * RS, O_VT = O_KAT + 128 * TS, BUFB = O_VT + 128 * TS;
    LAS float* L_TQ = (LAS float*)(lds + 2 * BUFB);
    LAS float* L_XS = L_TQ + 1024;
    LAS float* L_SS = L_XS + 512;
    LAS float* L_GN = L_SS + 512;
    const int tid = threadIdx.x, lane = tid & 63, wave = __builtin_amdgcn_readfirstlane(tid >> 6);
    const int r32 = lane & 31, hi = lane >> 5;
    const int kap = 16 * (r32 >> 4) + 8 * ((r32 >> 2) & 1) + 4 * ((r32 >> 3) & 1) + (r32 & 3);
    constexpr int NCH = SEQ / 64;
#define SB() __builtin_amdgcn_sched_barrier(0)
    for (int item = vblk; item < BATCH * 8; item += nblk) {
        const int b = item >> 3, h = item & 7;
        if (tid < 128) L_GN[tid] = ogain[h * 128 + tid];
        if (wave < 4) {
            const int vt = wave;
            f32x16 C[4];
#pragma unroll
            for (int i = 0; i < 4; ++i)
#pragma unroll
                for (int j = 0; j < 16; ++j) C[i][j] = 0.f;
            f32x16 O[2]; unsigned gt4[2][4];
#define HG_EPI(cn) do { _Pragma("unroll") for (int tt = 0; tt < 2; ++tt) { const LAS float* SSb = L_SS + ((cn) & 1) * 256; \
                const float sst = (SSb[(tt * 4 + 0) * 32 + r32] + SSb[(tt * 4 + 1) * 32 + r32]) + (SSb[(tt * 4 + 2) * 32 + r32] + SSb[(tt * 4 + 3) * 32 + r32]); \
                const float rstd = __builtin_amdgcn_rsqf(sst * (1.0f / 128.0f) + EPS); \
                const size_t m = (size_t)b * SEQ + 64 * (cn) + r32 + 32 * tt; \
                _Pragma("unroll") for (int a4 = 0; a4 < 4; ++a4) { const int v0 = h * 128 + 32 * vt + 8 * a4 + 4 * hi; \
                    const f32x4 gn = *(const LAS f32x4*)(L_GN + 32 * vt + 8 * a4 + 4 * hi); const unsigned gt = gt4[tt][a4]; float o[4]; \
                    _Pragma("unroll") for (int cc = 0; cc < 4; ++cc) o[cc] = O[tt][4 * a4 + cc] * rstd * gn[cc] * ((float)((gt >> (8 * cc)) & 255u) * (1.0f / 255.0f)); \
                    u32x2_t w; w.x = cvtpk(o[0], o[1]); w.y = cvtpk(o[2], o[3]); *(u32x2_t*)(QS + m * 2048 + v0) = w; } } } while (0)
            __syncthreads();
#pragma unroll 1
            for (int n = 0; n < NCH; ++n) {
                __syncthreads();
                if (n > 0) HG_EPI(n - 1);
                const LAS unsigned char* T = lds + (n & 1) * BUFB;
                const LAS float* XS = L_XS + (n & 1) * 256;
                const size_t m0 = (size_t)b * SEQ + 64 * n + r32;
#pragma unroll
                for (int tt = 0; tt < 2; ++tt)
#pragma unroll
                    for (int a4 = 0; a4 < 4; ++a4) gt4[tt][a4] = *(const unsigned*)(GH + (m0 + 32 * tt) * 1024 + h * 128 + 32 * vt + 8 * a4 + 4 * hi);
                bf16x8_t Cp[8]; bf16x8_t Vt[4];
#pragma unroll
                for (int ks = 0; ks < 4; ++ks) Vt[ks] = *(const LAS bf16x8_t*)(T + O_VT + (32 * vt + r32) * TS + (16 * ks + 8 * hi) * 2);
#pragma unroll
                for (int dt = 0; dt < 4; ++dt) {
#pragma unroll
                    for (int a4 = 0; a4 < 4; ++a4) { const f32x4 x1 = *(const LAS f32x4*)(XS + 32 * dt + 8 * a4 + 4 * hi);
#pragma unroll
                        for (int cc = 0; cc < 4; ++cc) C[dt][4 * a4 + cc] *= x1[cc]; }
                    Cp[2 * dt] = pack_acc8(C[dt], 0); Cp[2 * dt + 1] = pack_acc8(C[dt], 1);
                }
#pragma unroll
                for (int tt = 0; tt < 2; ++tt) {
#pragma unroll
                    for (int j = 0; j < 16; ++j) O[tt][j] = 0.f;
                    v4u qf[8];
#pragma unroll
                    for (int i = 0; i < 8; ++i) { const LAS unsigned char* qp = T + (32 * tt + r32) * RS + (32 * (i >> 1) + 16 * (i & 1) + 4 * hi) * 2;
                        const u32x2_t lo = *(const LAS u32x2_t*)qp, hi2 = *(const LAS u32x2_t*)(qp + 16); qf[i] = (v4u){lo.x, lo.y, hi2.x, hi2.y}; }
                    SB();
#pragma unroll
                    for (int i = 0; i < 8; ++i) O[tt] = MFMA32(Cp[i], __builtin_bit_cast(bf16x8_t, qf[i]), O[tt]);
                    SB();
#pragma unroll
                    for (int st = 0; st < 2; ++st) if (st <= tt) {
                        f32x16 S;
#pragma unroll
                        for (int j = 0; j < 16; ++j) S[j] = 0.f;
#pragma unroll
                        for (int hb = 0; hb < 2; ++hb) {
                            bf16x8_t A[4], B[4];
#pragma unroll
                            for (int k4 = 0; k4 < 4; ++k4) { const int ks = 4 * hb + k4;
                                A[k4] = *(const LAS bf16x8_t*)(T + O_KA + (32 * st + kap) * RS + (16 * ks + 8 * hi) * 2);
                                B[k4] = *(const LAS bf16x8_t*)(T + (32 * tt + r32) * RS + (16 * ks + 8 * hi) * 2); }
                            SB();
#pragma unroll
                            for (int k4 = 0; k4 < 4; ++k4) S = MFMA32(A[k4], B[k4], S);
                            SB();
                        }
                        if (st == tt) {
#pragma unroll
                            for (int j = 0; j < 16; ++j) { const int sl = 16 * (j >> 3) + 8 * hi + (j & 7); if (sl > r32) S[j] = 0.f; }
                        }
                        O[tt] = MFMA32(Vt[2 * st], pack_acc8(S, 0), O[tt]); O[tt] = MFMA32(Vt[2 * st + 1], pack_acc8(S, 1), O[tt]);
                    }
                    float ss = 0.f;
#pragma unroll
                    for (int j = 0; j < 16; ++j) ss += O[tt][j] * O[tt][j];
                    ss += __shfl_xor(ss, 32);
                    if (hi == 0) L_SS[(n & 1) * 256 + (tt * 4 + vt) * 32 + r32] = ss;
                }
#pragma unroll
                for (int dt = 0; dt < 4; ++dt) {
                    f32x4 x2[4]; bf16x8_t A[4];
#pragma unroll
                    for (int a4 = 0; a4 < 4; ++a4) x2[a4] = *(const LAS f32x4*)(XS + 128 + 32 * dt + 8 * a4 + 4 * hi);
#pragma unroll
                    for (int ks = 0; ks < 4; ++ks) A[ks] = *(const LAS bf16x8_t*)(T + O_KAT + (32 * dt + r32) * TS + (16 * ks + 8 * hi) * 2);
                    SB();
#pragma unroll
                    for (int ks = 0; ks < 4; ++ks) C[dt] = MFMA32(A[ks], Vt[ks], C[dt]);
#pragma unroll
                    for (int a4 = 0; a4 < 4; ++a4)
#pragma unroll
                        for (int cc = 0; cc < 4; ++cc) C[dt][4 * a4 + cc] *= x2[a4][cc];
                    SB();
                }
            }
            __syncthreads();
            HG_EPI(NCH - 1);
#undef HG_EPI
        } else {
            const int ptid = tid - 256, dp = ptid & 63, q4 = ptid >> 6;
            unsigned g2[2][16], q2[2][16], v2[2][16];
#define HG_LOAD(set, c) do { const size_t row0_ = (size_t)b * SEQ + 64 * (c) + 16 * q4; _Pragma("unroll") for (int i = 0; i < 16; ++i) { \
                g2[set][i] = *(const unsigned*)(LOGF + (row0_ + i) * 1024 + h * 128 + 2 * dp); q2[set][i] = *(const unsigned*)(QS + (row0_ + i) * 2048 + h * 128 + 2 * dp); \
                v2[set][i] = *(const unsigned*)(VH + (row0_ + i) * 1024 + h * 128 + 2 * dp); } } while (0)
#define HG_SUMS(set, c) do { float r0_ = 0.f, r1_ = 0.f; _Pragma("unroll") for (int i = 0; i < 16; ++i) { r0_ += (float)__builtin_bit_cast(_Float16, (unsigned short)(g2[set][i] & 0xffffu)); \
                r1_ += (float)__builtin_bit_cast(_Float16, (unsigned short)(g2[set][i] >> 16)); } *(LAS f32x2_t*)(L_TQ + ((c) & 1) * 512 + q4 * 128 + 2 * dp) = (f32x2_t){r0_, r1_}; } while (0)
            float e0, e1, xa0, xa1, xb0, xb1; unsigned kp0[8], kp1[8], vp0[8], vp1[8];
#define HG_BEGIN(c) do { float off0 = 0.f, off1 = 0.f, cref0 = 0.f, cref1 = 0.f, tot0 = 0.f, tot1 = 0.f; \
                _Pragma("unroll") for (int o = 0; o < 4; ++o) { const f32x2_t tq = *(const LAS f32x2_t*)(L_TQ + ((c) & 1) * 512 + o * 128 + 2 * dp); \
                    if (o < q4) { off0 += tq.x; off1 += tq.y; } if (o < 2) { cref0 += tq.x; cref1 += tq.y; } tot0 += tq.x; tot1 += tq.y; } \
                xa0 = __expf(-cref0); xa1 = __expf(-cref1); xb0 = __expf(cref0); xb1 = __expf(cref1); e0 = __expf(off0); e1 = __expf(off1); \
                if (q4 == 0) { *(LAS f32x2_t*)(L_XS + ((c) & 1) * 256 + 2 * dp) = (f32x2_t){xb0, xb1}; *(LAS f32x2_t*)(L_XS + ((c) & 1) * 256 + 128 + 2 * dp) = (f32x2_t){__expf(tot0 - cref0), __expf(tot1 - cref1)}; } } while (0)
#define HG_TOKENS(set, c, i0) do { LAS unsigned char* T_ = lds + ((c) & 1) * BUFB; _Pragma("unroll") for (int i = (i0); i < (i0) + 8; ++i) { \
                const unsigned gw_ = g2[set][i], qw_ = q2[set][i], vw_ = v2[set][i]; \
                const float f0 = __expf((float)__builtin_bit_cast(_Float16, (unsigned short)(gw_ & 0xffffu))), f1 = __expf((float)__builtin_bit_cast(_Float16, (unsigned short)(gw_ >> 16))); \
                e0 = fmaxf(e0 * f0, 1e-30f); e1 = fmaxf(e1 * f1, 1e-30f); \
                const float r0 = __builtin_amdgcn_rcpf(e0), r1 = __builtin_amdgcn_rcpf(e1); \
                const float qq0 = __builtin_bit_cast(float, qw_ << 16), qq1 = __builtin_bit_cast(float, qw_ & 0xffff0000u); \
                const int t = 16 * q4 + i; \
                *(LAS unsigned*)(T_ + t * RS + 4 * dp) = cvtpk(qq0 * e0 * xa0, qq1 * e1 * xa1); \
                const unsigned ka = cvtpk((1.0f - f0) * r0 * xb0, (1.0f - f1) * r1 * xb1); \
                *(LAS unsigned*)(T_ + O_KA + t * RS + 4 * dp) = ka; \
                if (i & 1) { kp0[i >> 1] |= ka << 16; kp1[i >> 1] |= ka & 0xffff0000u; vp0[i >> 1] |= vw_ << 16; vp1[i >> 1] |= vw_ & 0xffff0000u; } \
                else { kp0[i >> 1] = ka & 0xffffu; kp1[i >> 1] = ka >> 16; vp0[i >> 1] = vw_ & 0xffffu; vp1[i >> 1] = vw_ >> 16; } } } while (0)
#define HG_FINISH(c) do { LAS unsigned char* T_ = lds + ((c) & 1) * BUFB; \
                *(LAS v4u*)(T_ + O_KAT + (2 * dp) * TS + 32 * q4) = (v4u){kp0[0], kp0[1], kp0[2], kp0[3]}; *(LAS v4u*)(T_ + O_KAT + (2 * dp) * TS + 32 * q4 + 16) = (v4u){kp0[4], kp0[5], kp0[6], kp0[7]}; \
                *(LAS v4u*)(T_ + O_KAT + (2 * dp + 1) * TS + 32 * q4) = (v4u){kp1[0], kp1[1], kp1[2], kp1[3]}; *(LAS v4u*)(T_ + O_KAT + (2 * dp + 1) * TS + 32 * q4 + 16) = (v4u){kp1[4], kp1[5], kp1[6], kp1[7]}; \
                *(LAS v4u*)(T_ + O_VT + (2 * dp) * TS + 32 * q4) = (v4u){vp0[0], vp0[1], vp0[2], vp0[3]}; *(LAS v4u*)(T_ + O_VT + (2 * dp) * TS + 32 * q4 + 16) = (v4u){vp0[4], vp0[5], vp0[6], vp0[7]}; \
                *(LAS v4u*)(T_ + O_VT + (2 * dp + 1) * TS + 32 * q4) = (v4u){vp1[0], vp1[1], vp1[2], vp1[3]}; *(LAS v4u*)(T_ + O_VT + (2 * dp + 1) * TS + 32 * q4 + 16) = (v4u){vp1[4], vp1[5], vp1[6], vp1[7]}; } while (0)
            HG_LOAD(0, 0); HG_LOAD(1, 1);
            HG_SUMS(0, 0);
            __syncthreads();
            HG_SUMS(1, 1); HG_BEGIN(0); HG_TOKENS(0, 0, 0); HG_TOKENS(0, 0, 8); HG_FINISH(0); HG_LOAD(0, 2);
#pragma unroll 2
            for (int n = 0; n < NCH; ++n) {
                const int c = n + 1;
                __syncthreads();
                if (c < NCH) { if (c + 1 < NCH) HG_SUMS(n & 1, c + 1); HG_BEGIN(c); HG_TOKENS((n + 1) & 1, c, 0); HG_TOKENS((n + 1) & 1, c, 8); HG_FINISH(c); if (c + 2 < NCH) HG_LOAD((n + 1) & 1, c + 2); }
            }
            __syncthreads();
#undef HG_LOAD
#undef HG_SUMS
#undef HG_BEGIN
#undef HG_TOKENS
#undef HG_FINISH
        }
        __syncthreads();
    }
#undef SB
}

template <bool DIAG> __device__ __forceinline__ bool attn_tile(const bf16x8_t (&Kc)[4], const bf16x8_t (&Vc)[4], const bf16x8_t (&Qf)[4], f32x16& O0, f32x16& O1, float& carry, int r32, int hi) {
    f32x16 Sx;
#pragma unroll
    for (int j = 0; j < 16; ++j) Sx[j] = 0.f;
#pragma unroll
    for (int ks = 0; ks < 4; ++ks) Sx = MFMA32(Kc[ks], Qf[ks], Sx);
    float kp[16], sg[16];
#pragma unroll
    for (int j = 0; j < 16; ++j) {
        const float r = __builtin_amdgcn_rcpf(1.0f + __builtin_amdgcn_exp2f(Sx[j]));
        if (DIAG) { const int sl = 16 * (j >> 3) + 8 * hi + (j & 7); const bool valid = sl < r32; kp[j] = valid ? r : 1.f; sg[j] = valid ? 1.0f - r : 0.f; }
        else { kp[j] = r; sg[j] = 1.0f - r; }
    }
#pragma unroll
    for (int j = 6; j >= 0; --j) { sg[j] *= kp[j + 1]; kp[j] *= kp[j + 1]; sg[8 + j] *= kp[8 + j + 1]; kp[8 + j] *= kp[8 + j + 1]; }
    const float G0 = kp[0], G1 = kp[8];
    const float P0 = __shfl_xor(G0, 32), P1 = __shfl_xor(G1, 32);
    const float after0 = (hi == 0 ? P0 : 1.f) * P1 * G1 * carry, after1 = (hi == 0 ? P1 : 1.f) * carry;
#pragma unroll
    for (int j = 0; j < 16; ++j) sg[j] *= (j < 8 ? after0 : after1);
    carry *= (G0 * G1) * (P0 * P1);
    v4u w0, w1; w0.x = cvtpk(sg[0], sg[1]); w0.y = cvtpk(sg[2], sg[3]); w0.z = cvtpk(sg[4], sg[5]); w0.w = cvtpk(sg[6], sg[7]);
    w1.x = cvtpk(sg[8], sg[9]); w1.y = cvtpk(sg[10], sg[11]); w1.z = cvtpk(sg[12], sg[13]); w1.w = cvtpk(sg[14], sg[15]);
    const bf16x8_t Pb0 = __builtin_bit_cast(bf16x8_t, w0), Pb1 = __builtin_bit_cast(bf16x8_t, w1);
    O0 = MFMA32(Vc[0], Pb0, O0); O0 = MFMA32(Vc[1], Pb1, O0);
    O1 = MFMA32(Vc[2], Pb0, O1); O1 = MFMA32(Vc[3], Pb1, O1);
    return __all(carry == 0.f);
}
__device__ __forceinline__ void attn_mfma(const Args& a, int u0, int ucnt, int ustride) {
    unsigned char* ws = a.ws;
    bf16* QS = (bf16*)(ws + WS_QS); const bf16* SK = (const bf16*)(ws + WS_SK); const bf16* VT = (const bf16*)((unsigned char*)a.out + 32 * MiB);
    const int lane = threadIdx.x & 63, r32 = lane & 31, hi = lane >> 5;
    const int kap = 16 * (r32 >> 4) + 8 * ((r32 >> 2) & 1) + 4 * ((r32 >> 3) & 1) + (r32 & 3);
    for (int uk = 0; uk < ucnt; ++uk) { const int u = u0 + uk * ustride;
        const int qb = u & 63, bh = u >> 6, h = bh & 15, b = bh >> 4;
        const size_t rowq = (size_t)b * SEQ + 32 * qb + r32;
        bf16* qp = QS + rowq * 2048 + 1024 + 64 * h;
        const bf16* kbase = SK + ((size_t)b * SEQ + kap) * 1024 + 64 * h + 8 * hi;
        const bf16* vbase = VT + ((size_t)bh * 64 + r32) * 2048 + 8 * hi;
        bf16x8_t Qf[4];
#pragma unroll
        for (int ks = 0; ks < 4; ++ks) Qf[ks] = *(const bf16x8_t*)(qp + 16 * ks + 8 * hi);
        f32x16 O0, O1;
#pragma unroll
        for (int j = 0; j < 16; ++j) { O0[j] = 0.f; O1[j] = 0.f; }
        float carry = 1.f;
        bf16x8_t KA[4], VA[4], KB[4], VB[4];
#define ATT_LOAD(K_, V_, kb_) do { _Pragma("unroll") for (int ks = 0; ks < 4; ++ks) K_[ks] = *(const bf16x8_t*)(kbase + (size_t)(32 * (kb_)) * 1024 + 16 * ks); \
        _Pragma("unroll") for (int i = 0; i < 4; ++i) V_[i] = *(const bf16x8_t*)(vbase + (size_t)(32 * (i >> 1)) * 2048 + 32 * (kb_) + 16 * (i & 1)); } while (0)
        ATT_LOAD(KA, VA, qb);
        int kb = qb;
        ATT_LOAD(KB, VB, kb > 0 ? kb - 1 : 0);
        if (!(attn_tile<true>(KA, VA, Qf, O0, O1, carry, r32, hi) || kb == 0)) {
            --kb;
#pragma unroll 1
            for (;;) {
                ATT_LOAD(KA, VA, kb > 0 ? kb - 1 : 0);
                if (attn_tile<false>(KB, VB, Qf, O0, O1, carry, r32, hi) || kb == 0) break;
                --kb;
                ATT_LOAD(KB, VB, kb > 0 ? kb - 1 : 0);
                if (attn_tile<false>(KA, VA, Qf, O0, O1, carry, r32, hi) || kb == 0) break;
                --kb;
            }
        }
#undef ATT_LOAD
#pragma unroll
        for (int a4 = 0; a4 < 4; ++a4) {
            u32x2_t x0, x1; x0.x = cvtpk(O0[4 * a4], O0[4 * a4 + 1]); x0.y = cvtpk(O0[4 * a4 + 2], O0[4 * a4 + 3]); x1.x = cvtpk(O1[4 * a4], O1[4 * a4 + 1]); x1.y = cvtpk(O1[4 * a4 + 2], O1[4 * a4 + 3]);
            *(u32x2_t*)(qp + 8 * a4 + 4 * hi) = x0; *(u32x2_t*)(qp + 32 + 8 * a4 + 4 * hi) = x1; }
    }
}

#define XB_TMO      128
#define XB_XCNT(j)  (256  + 64 * (j))
#define XB_XSUB(j)  (1280 + 64 * (j))
#define XB_XGEN(j)  (2304 + 64 * (j))
#define XB_TOP      3328
#define XB_TOPGEN   3392
#define XCD_BAR_WORDS 3456
#define XB_SPIN_CAP (1u << 18)

__device__ __forceinline__ unsigned xb_ld(unsigned* p)              { return __hip_atomic_load(p, __ATOMIC_RELAXED, __HIP_MEMORY_SCOPE_AGENT); }
__device__ __forceinline__ unsigned xb_add(unsigned* p, unsigned v) { return __hip_atomic_fetch_add(p, v, __ATOMIC_RELAXED, __HIP_MEMORY_SCOPE_AGENT); }
__device__ __forceinline__ unsigned xb_xcc_id() { return (unsigned)__builtin_amdgcn_s_getreg((3 << 11) | 20) & 0xFu; }
#define XB_SPIN(cond, bar) do { unsigned _sp = 0; while (cond) { __builtin_amdgcn_s_sleep(1); \
    if ((++_sp & 255u) == 0u) { if (xb_ld(&(bar)[XB_TMO])) break; if (_sp > XB_SPIN_CAP) { atomicAdd(&(bar)[XB_TMO], 1u); break; } } } } while (0)

struct XcdBarrier {
    unsigned* bar; unsigned x;
    volatile LAS unsigned* st;
};

__device__ __forceinline__ XcdBarrier xcd_barrier_post(unsigned* bar, volatile LAS unsigned* st) {
    XcdBarrier b; b.bar = bar; b.x = xb_xcc_id(); b.st = st;
    if (threadIdx.x == 0) (void)xb_add(&bar[XB_XCNT(b.x)], 1u);
    return b;
}
__device__ __forceinline__ void xcd_barrier_complete(unsigned* bar, unsigned x, unsigned& nloc, unsigned& nx) {
    const unsigned G = gridDim.x * gridDim.y * gridDim.z;
    unsigned sum, cnt, mine, sp = 0u;
    for (;;) {
        sum = 0u; cnt = 0u; mine = 0u;
#pragma unroll
        for (unsigned j = 0; j < 16; ++j) { const unsigned c = xb_ld(&bar[XB_XCNT(j)]); sum += c; cnt += (c > 0u) ? 1u : 0u; mine = (j == x) ? c : mine; }
        if (sum == G) break;
        __builtin_amdgcn_s_sleep(1);
        if ((++sp & 255u) == 0u) { if (xb_ld(&bar[XB_TMO])) break; if (sp > XB_SPIN_CAP) { atomicAdd(&bar[XB_TMO], 1u); break; } }
    }
    nloc = mine > 0u ? mine : 1u; nx = cnt > 0u ? cnt : 1u;
}

__device__ __forceinline__ void xcd_barrier(const XcdBarrier& b) {
    asm volatile("s_waitcnt vmcnt(0)" ::: "memory");
    __syncthreads();
    if (threadIdx.x == 0) {
        unsigned* bar = b.bar;
        __builtin_amdgcn_s_waitcnt(0);
        unsigned nloc = b.st[0], nx = b.st[1];
        if (nloc == 0u) { xcd_barrier_complete(bar, b.x, nloc, nx); b.st[0] = nloc; b.st[1] = nx; }
        const unsigned old = xb_add(&bar[XB_XSUB(b.x)], 1u);
        const unsigned gen = old / nloc;
        if (old + 1u == (gen + 1u) * nloc) {
            __builtin_amdgcn_fence(__ATOMIC_RELEASE, "agent");
            asm volatile("s_waitcnt vmcnt(0)" ::: "memory");
            const unsigned og = xb_add(&bar[XB_TOP], 1u);
            const unsigned tg = og / nx;
            if (og + 1u == (tg + 1u) * nx) xb_add(&bar[XB_TOPGEN], 1u);
            else XB_SPIN(xb_ld(&bar[XB_TOPGEN]) == tg, bar);
            __builtin_amdgcn_fence(__ATOMIC_ACQUIRE, "agent");
            xb_add(&bar[XB_XGEN(b.x)], 1u);
            asm volatile("s_waitcnt vmcnt(0)" ::: "memory");
        } else {
            XB_SPIN(xb_ld(&bar[XB_XGEN(b.x)]) == gen, bar);
            __builtin_amdgcn_fence(__ATOMIC_ACQUIRE, "agent");
            asm volatile("s_waitcnt vmcnt(0)" ::: "memory");
        }
    }
    __syncthreads();
}

__global__ void __launch_bounds__(NTHREADS, 2) hybrid_fwd(Args args) {
    extern __shared__ __attribute__((aligned(16))) unsigned char lds_raw[];
    LAS unsigned char* lds = (LAS unsigned char*)lds_raw;
    cg::grid_group grid = cg::this_grid();
    const int tid = threadIdx.x, lane = tid & 63, wave = __builtin_amdgcn_readfirstlane(tid >> 6);
    const int G = gridDim.x;
    unsigned char* ws = args.ws;
    const int lo = args.ph_lo, hi = args.ph_hi;
    volatile LAS unsigned* MISC = (volatile LAS unsigned*)(lds + MISC_OFF);
    if (tid < 2) MISC[tid] = 0u;
    __syncthreads();
    const XcdBarrier bar = xcd_barrier_post((unsigned*)ws, MISC);
#define IN(k) (lo <= (k) && (k) < hi)
#define SEAM(k) do { if (IN(k) && IN((k) + 1)) { xcd_barrier(bar); } } while (0)
    if (lo < 0) grid.sync();
    if (IN(0)) { p0_prologue<0>(args, lds, wave, lane, (int)blockIdx.x * NWAVES + wave, G * NWAVES); asm volatile("s_waitcnt vmcnt(0) lgkmcnt(0)" ::: "memory"); __syncthreads(); }
    SEAM(0);
    if (IN(1)) {
        pg8::Gemm g{(const pg8::bf16_t*)(ws + WS_H), (const pg8::bf16_t*)(ws + WS_WIN), M, 6144, D, D}; pg8::StaticOrder S; S.init(M, 6144, G, (int)blockIdx.x);
        pg8::EpiProj E{(pg8::bf16_t*)(ws + WS_QS), (pg8::bf16_t*)(ws + WS_VH), (pg8::bf16_t*)(ws + WS_SK), (pg8::bf16_t*)((unsigned char*)args.out + 32 * MiB), ws + WS_GH, ws + WS_GA, ws + WS_GB, (_Float16*)args.out,
                       args.in[3], args.in[5], args.in[6], 0};
        pg8::gemm_phase<pg8::EpiProj, pg8::StaticOrder, true, true>(lds, g, S, E);
        pg8::Gemm g2{(const pg8::bf16_t*)(ws + WS_WIN) + (size_t)6144 * 1024, (const pg8::bf16_t*)(ws + WS_H), 1024, M, D, D}; pg8::StaticOrder S2; S2.init(1024, M, G, (int)blockIdx.x);
        pg8::EpiVT E2{(pg8::bf16_t*)((unsigned char*)args.out + 32 * MiB)};
        pg8::gemm_phase<pg8::EpiVT, pg8::StaticOrder, true, true>(lds, g2, S2, E2);
    }
    SEAM(1);
    if (IN(2)) {
        const pg8::Gemm gg{(const pg8::bf16_t*)(ws + WS_H), (const pg8::bf16_t*)(ws + WS_WIN) + (size_t)7168 * 1024, M, 2048, D, D};
        const pg8::EpiProj EG{(pg8::bf16_t*)(ws + WS_QS), (pg8::bf16_t*)(ws + WS_VH), (pg8::bf16_t*)(ws + WS_SK), (pg8::bf16_t*)((unsigned char*)args.out + 32 * MiB), ws + WS_GH, ws + WS_GA, ws + WS_GB, (_Float16*)args.out,
                              args.in[3], args.in[5], args.in[6], 28};
        constexpr int NUNITS = BATCH * 16 * (SEQ / 32);
        if (G == 256) {
            pg8::ListOrder S; S.s.init(M, 2048, 256, 0);
            if ((int)blockIdx.x < 64) { hgrn_v2(args, lds, (int)blockIdx.x, 64); if (wave < 6) p0_prologue<1>(args, lds, wave, lane, 1536 + (int)blockIdx.x * 6 + wave, 1920); S.l0 = -1; S.l1 = -1; S.l2 = -1; }
            else { const int idx = (int)blockIdx.x - 64;
                if (idx < 128) attn_mfma(args, idx * 40 + wave, 5, NWAVES); else attn_mfma(args, 5120 + (idx - 128) * 48 + wave, 6, NWAVES);
                p0_prologue<1>(args, lds, wave, lane, idx * NWAVES + wave, 1920);
                S.l0 = idx; S.l1 = 192 + idx; S.l2 = idx < 128 ? 384 + idx : -1; }
            asm volatile("s_waitcnt vmcnt(0) lgkmcnt(0)" ::: "memory"); __syncthreads();
            pg8::gemm_phase<pg8::EpiProj, pg8::ListOrder, true, true>(lds, gg, S, EG);
        } else {
            const int gw = (int)blockIdx.x * NWAVES + wave, ngw = G * NWAVES;
            hgrn_v2(args, lds, (int)blockIdx.x, G); attn_mfma(args, gw, (NUNITS - gw + ngw - 1) / ngw, ngw); p0_prologue<1>(args, lds, wave, lane, gw, ngw);
            asm volatile("s_waitcnt vmcnt(0) lgkmcnt(0)" ::: "memory"); __syncthreads();
            pg8::StaticOrder S; S.init(M, 2048, G, (int)blockIdx.x);
            pg8::gemm_phase<pg8::EpiProj, pg8::StaticOrder, true, true>(lds, gg, S, EG);
        }
        __syncthreads();
    }
    SEAM(2);
    if (IN(3)) {
        pg8::Gemm g{(const pg8::bf16_t*)(ws + WS_QS), (const pg8::bf16_t*)(ws + WS_WHS), M, D, 1024, 2048}; pg8::SplitOrder S; S.s.init(M, D, G, (int)blockIdx.x);
        pg8::EpiMix E{ws + WS_GA, ws + WS_GB, (pg8::bf16_t*)(ws + WS_MIXED)};
        pg8::gemm_phase<pg8::EpiMix, pg8::SplitOrder, true, true>(lds, g, S, E);
    }
    SEAM(3);
    if (IN(4)) {
        pg8::Gemm g{(const pg8::bf16_t*)(ws + WS_MIXED), (const pg8::bf16_t*)(ws + WS_WO), M, D, D, D}; pg8::StaticOrder S; S.init(M, D, G, (int)blockIdx.x);
        pg8::EpiRes1 E{args.in[0], (pg8::bf16_t*)(ws + WS_GA), (pg8::bf16_t*)(ws + WS_X1B), (float*)(ws + WS_SSQ)};
        pg8::gemm_phase<pg8::EpiRes1, pg8::StaticOrder, true, true>(lds, g, S, E);
    }
    SEAM(4);
    if (IN(5)) {
        pg8::Gemm g{(const pg8::bf16_t*)(ws + WS_X1B), (const pg8::bf16_t*)(ws + WS_WF1), M, 2 * FFH, D, D}; pg8::StaticOrder S; S.init(M, 2 * FFH, G, (int)blockIdx.x);
        pg8::EpiSwiglu E{(const float*)(ws + WS_SSQ), (pg8::bf16_t*)(ws + WS_ACT)};
        pg8::gemm_phase<pg8::EpiSwiglu, pg8::StaticOrder, true, true>(lds, g, S, E);
    }
    SEAM(5);
    if (IN(6)) {
        pg8::Gemm g{(const pg8::bf16_t*)(ws + WS_ACT), (const pg8::bf16_t*)(ws + WS_WF2), M, D, FFH, FFH}; pg8::StaticOrder S; S.init(M, D, G, (int)blockIdx.x);
        pg8::EpiRes2 E{args.in[0], (const pg8::bf16_t*)(ws + WS_GA), args.out};
        pg8::gemm_phase<pg8::EpiRes2, pg8::StaticOrder, true, true>(lds, g, S, E);
    }
#undef IN
#undef SEAM
}

#ifndef MK_N_LAUNCHES
#define MK_N_LAUNCHES 1
#endif
extern "C" void kernel_launch(void* const* d_in, const int* in_sizes, int n_in, void* d_out, int out_size, void* d_ws, size_t ws_size, hipStream_t stream) {
    static int grid = 0;
    if (grid == 0) {
        int dev = 0, cus = 0, per_cu = 0;
        if (n_in != 13 || ws_size < WS_END) { fprintf(stderr, "kernel_launch: unexpected inputs / workspace (%d, %zu)\n", n_in, ws_size); grid = -1; return; }
        hipGetDevice(&dev); hipDeviceGetAttribute(&cus, hipDeviceAttributeMultiprocessorCount, dev);
        if (hipFuncSetAttribute((const void*)hybrid_fwd, hipFuncAttributeMaxDynamicSharedMemorySize, LDS_BYTES) != hipSuccess) { fprintf(stderr, "kernel_launch: hipFuncSetAttribute failed\n"); grid = -1; return; }
        if (hipOccupancyMaxActiveBlocksPerMultiprocessor(&per_cu, (const void*)hybrid_fwd, NTHREADS, LDS_BYTES) != hipSuccess || per_cu < 1) { fprintf(stderr, "kernel_launch: occupancy query says %d\n", per_cu); per_cu = 1; }
        (void)hipGetLastError();
        grid = cus * per_cu;
    }
    if (grid < 0) return;
    if (hipMemsetAsync(d_ws, 0, 16384, stream) != hipSuccess) { fprintf(stderr, "kernel_launch: memset of the barrier words failed\n"); return; }
    Args a{};
    for (int i = 0; i < 13; ++i) a.in[i] = (const float*)d_in[i];
    a.out = (float*)d_out; a.ws = (unsigned char*)d_ws;
#if MK_N_LAUNCHES == 1
    a.ph_lo = 0; a.ph_hi = 7;
    void* kargs[] = {&a};
    hipError_t e = hipLaunchCooperativeKernel((const void*)hybrid_fwd, dim3(grid), dim3(NTHREADS), kargs, LDS_BYTES, stream);
    if (e != hipSuccess) fprintf(stderr, "cooperative launch failed: %s (grid %d)\n", hipGetErrorString(e), grid);
#else
    for (int p = 0; p < 7; ++p) { a.ph_lo = p; a.ph_hi = p + 1; hipLaunchKernelGGL(hybrid_fwd, dim3(grid), dim3(NTHREADS), LDS_BYTES, stream, a); }
#endif
}
```

```cpp
#include <hip/hip_runtime.h>
#include <hip/hip_cooperative_groups.h>
#include <cstdio>
#include <cstdint>
namespace cg = cooperative_groups;
namespace pg8 {
#define PG8_LAS __attribute__((address_space(3)))
typedef unsigned short bf16_t;
typedef short bf16x8 __attribute__((ext_vector_type(8)));
typedef float f32x4 __attribute__((ext_vector_type(4)));
typedef unsigned u32x4 __attribute__((ext_vector_type(4)));
constexpr int BM = 256, BK = 64, HALF = 128, HTB = HALF * BK * 2  , STAGE_BYTES = 8 * HTB, NXCD = 8, WGM = 8;

__host__ __device__ __forceinline__ int lds_byte(int r, int c) { const int st = (r >> 4) * 2 + (c >> 5), rr = r & 15, cc = c & 31, ob = rr * 64 + cc * 2; return st * 1024 + (ob ^ (((ob >> 9) & 1) << 5)); }
__host__ __device__ __forceinline__ void stage_rc(int b, int& R, int& C) { const int st = b / 1024, sb = b % 1024, swz = sb ^ (((sb >> 9) & 1) << 5); R = (st >> 1) * 16 + swz / 64; C = (st & 1) * 32 + (swz % 64) / 2; }
__host__ __device__ __forceinline__ int perm32(int rho) { const int n = rho >> 4, i = rho & 15; return 8 * (i >> 2) + 4 * n + (i & 3); }

struct Unit { int pm, pn, kh; };
struct Gemm { const bf16_t* A; const bf16_t* Bt; int M, N, K, ld; };

struct StaticOrder {
    int nM, nN, nwg, G, c;
    __host__ __device__ void init(int M, int N, int G_, int c_) { nM = M / BM; nN = N / BM; nwg = nM * nN; G = G_; c = c_; }
    __host__ __device__ bool next(int i, Unit& u) const { const long L = (long)i * G + c; if (L >= nwg) return false; return unit_of((int)L, u); }
    __host__ __device__ bool unit_of(int L, Unit& u) const {
        int wgid = L; { const int q = nwg / NXCD, r = nwg % NXCD, xcd = wgid % NXCD, off = wgid / NXCD; wgid = (xcd < r ? xcd * (q + 1) : r * (q + 1) + (xcd - r) * q) + off; }
        const int nig = WGM * nN, gid = wgid / nig, fm = gid * WGM, gsz = (nM - fm) < WGM ? (nM - fm) : WGM;
        u.pm = fm + ((wgid % nig) % gsz); u.pn = (wgid % nig) / gsz; u.kh = 0; return true;
    }
    __device__ __forceinline__ void a_ready(const Unit&) const {}
    __device__ __forceinline__ void done(const Unit&) const {}
};
struct ListOrder {
    StaticOrder s; int l0, l1, l2;
    __host__ __device__ bool next(int i, Unit& u) const { const int L = i == 0 ? l0 : (i == 1 ? l1 : (i == 2 ? l2 : -1)); if (L < 0 || L >= s.nwg) return false; return s.unit_of(L, u); }
    __device__ __forceinline__ void a_ready(const Unit&) const {}
    __device__ __forceinline__ void done(const Unit&) const {}
};
struct SplitOrder {
    StaticOrder s;
    __host__ __device__ bool next(int i, Unit& u) const { const bool ok = s.next(i >> 1, u); u.kh = i & 1; return ok; }
    __device__ __forceinline__ void a_ready(const Unit&) const {}
    __device__ __forceinline__ void done(const Unit&) const {}
};
typedef float f32x2_cv __attribute__((ext_vector_type(2))); typedef __bf16 bf16x2_cvv __attribute__((ext_vector_type(2)));
__device__ __forceinline__ unsigned cvt_pk_bf16(float lo, float hi) { const f32x2_cv v = {lo, hi}; return __builtin_bit_cast(unsigned, __builtin_convertvector(v, bf16x2_cvv)); }
typedef float f32x2 __attribute__((ext_vector_type(2)));
typedef _Float16 f16x8 __attribute__((ext_vector_type(8)));
typedef unsigned u32x2 __attribute__((ext_vector_type(2)));
__device__ __forceinline__ float sigm(float x) { return __builtin_amdgcn_rcpf(1.0f + __expf(-x)); }
__device__ __forceinline__ unsigned q8(float s) { float q = s * 255.0f + 0.5f; q = q < 1.0f ? 1.0f : (q > 255.0f ? 255.0f : q); return (unsigned)q; }
__device__ __forceinline__ u32x4 pack8_bf16(const float (&o)[8]) { u32x4 w; w.x = cvt_pk_bf16(o[0], o[1]); w.y = cvt_pk_bf16(o[2], o[3]); w.z = cvt_pk_bf16(o[4], o[5]); w.w = cvt_pk_bf16(o[6], o[7]); return w; }
__device__ __forceinline__ u32x2 pack8_u8(const float (&o)[8]) { u32x2 w; unsigned a = 0u, c = 0u;
#pragma unroll
    for (int k = 0; k < 4; ++k) { a = __builtin_amdgcn_cvt_pk_u8_f32(fmaxf(o[k] * 255.0f, 1.0f), k, a); c = __builtin_amdgcn_cvt_pk_u8_f32(fmaxf(o[4 + k] * 255.0f, 1.0f), k, c); }
    w.x = a; w.y = c; return w; }

struct EpiProj {
    static constexpr bool PERM = true, AFTER_DRAIN = false, KSPLIT = false;
    bf16_t* QS; bf16_t* VH; bf16_t* SK; bf16_t* SV; unsigned char* GH; unsigned char* GA; unsigned char* GB; _Float16* LOGF;
    const float* lbl; const float* qg; const float* kg; int pn0;
    __device__ __forceinline__ void operator()(const f32x4 (&acc)[2][2][4][2], const Unit& u, int wr, int wc, int fr, int fq) const {
        const int sec = (u.pn + pn0) >> 2, ct = (u.pn & 3) * 256;
        const int row0 = u.pm * BM + wr * 64 + fr;
        if (sec == 4 || sec == 5) {
            const int head = (u.pn & 3) * 4 + wc; const float* gp = (sec == 4 ? qg : kg) + head * 64 + 8 * fq;
            float gn[2][8];
#pragma unroll
            for (int bj = 0; bj < 2; ++bj) { const f32x4 a = *(const f32x4*)(gp + 32 * bj), b = *(const f32x4*)(gp + 32 * bj + 4);
                gn[bj][0] = a[0]; gn[bj][1] = a[1]; gn[bj][2] = a[2]; gn[bj][3] = a[3]; gn[bj][4] = b[0]; gn[bj][5] = b[1]; gn[bj][6] = b[2]; gn[bj][7] = b[3]; }
            const float sc = (sec == 4) ? 0.125f * 1.4426950408889634f : 1.0f;
#pragma unroll
            for (int ai = 0; ai < 2; ++ai)
#pragma unroll
                for (int m = 0; m < 4; ++m) {
                    float ss = 0.f;
#pragma unroll
                    for (int bj = 0; bj < 2; ++bj)
#pragma unroll
                        for (int n = 0; n < 2; ++n) { const f32x4 x = acc[ai][bj][m][n]; ss += (x[0] * x[0] + x[1] * x[1]) + (x[2] * x[2] + x[3] * x[3]); }
                    ss += __shfl_xor(ss, 16); ss += __shfl_xor(ss, 32);
                    const float rstd = __builtin_amdgcn_rsqf(ss * (1.0f / 64.0f) + 1e-6f) * sc;
                    const size_t row = (size_t)(row0 + ai * HALF + m * 16);
#pragma unroll
                    for (int bj = 0; bj < 2; ++bj) { float o[8];
#pragma unroll
                        for (int k = 0; k < 8; ++k) o[k] = acc[ai][bj][m][k >> 2][k & 3] * rstd * gn[bj][k];
                        bf16_t* dst = (sec == 4) ? (QS + row * 2048 + 1024 + head * 64 + 32 * bj + 8 * fq) : (SK + row * 1024 + head * 64 + 32 * bj + 8 * fq);
                        *(u32x4*)dst = pack8_bf16(o); }
                }
            return;
        }
#pragma unroll
        for (int bj = 0; bj < 2; ++bj) {
            const int col = ct + bj * HALF + wc * 32 + 8 * fq;
            float lb[8];
            if (sec == 1) {
#pragma unroll
                for (int k = 0; k < 8; ++k) lb[k] = 1.0f / (1.0f + __expf(lbl[1024 + col + k] - lbl[col + k]));
            }
#pragma unroll
            for (int ai = 0; ai < 2; ++ai)
#pragma unroll
                for (int m = 0; m < 4; ++m) {
                    const size_t row = (size_t)(row0 + ai * HALF + m * 16);
                    float o[8];
#pragma unroll
                    for (int k = 0; k < 8; ++k) o[k] = acc[ai][bj][m][k >> 2][k & 3];
                    if (sec == 0) { *(u32x4*)(QS + row * 2048 + col) = pack8_bf16(o); }
                    else if (sec == 2) { *(u32x4*)(VH + row * 1024 + col) = pack8_bf16(o); }
                    else if (sec == 6) { bf16_t* vt = SV + ((size_t)((row >> 11) * 16 + (col >> 6)) * 64 + (col & 63)) * 2048 + (row & 2047);
#pragma unroll
                        for (int k = 0; k < 8; ++k) vt[(size_t)k * 2048] = (bf16_t)(cvt_pk_bf16(o[k], o[k]) & 0xffffu); }
                    else if (sec == 1) { f16x8 g;
#pragma unroll
                        for (int k = 0; k < 8; ++k) g[k] = (_Float16)__logf(lb[k] + (1.0f - lb[k]) * sigm(o[k]));
                        *(f16x8*)(LOGF + row * 1024 + col) = g; }
                    else {
#pragma unroll
                        for (int k = 0; k < 8; ++k) o[k] = sigm(o[k]);
                        unsigned char* dst = (sec == 3) ? GH : (sec == 7 ? GA : GB);
                        *(u32x2*)(dst + row * 1024 + col) = pack8_u8(o); }
                }
        }
    }
};
struct EpiVT {
    static constexpr bool PERM = true, AFTER_DRAIN = false, KSPLIT = false;
    bf16_t* VT;
    __device__ __forceinline__ void operator()(const f32x4 (&acc)[2][2][4][2], const Unit& u, int wr, int wc, int fr, int fq) const {
        const int row0 = u.pm * BM + wr * 64 + fr;
#pragma unroll
        for (int ai = 0; ai < 2; ++ai)
#pragma unroll
            for (int m = 0; m < 4; ++m)
#pragma unroll
                for (int bj = 0; bj < 2; ++bj) {
                    const int r = row0 + ai * HALF + m * 16, c = u.pn * BM + bj * HALF + wc * 32 + 8 * fq;
                    float o[8];
#pragma unroll
                    for (int k = 0; k < 8; ++k) o[k] = acc[ai][bj][m][k >> 2][k & 3];
                    *(u32x4*)(VT + ((size_t)((c >> 11) * 16 + (r >> 6)) * 64 + (r & 63)) * 2048 + (c & 2047)) = pack8_bf16(o);
                }
    }
};
struct EpiMix {
    static constexpr bool PERM = true, AFTER_DRAIN = false, KSPLIT = true;
    const unsigned char* GA; const unsigned char* GB; bf16_t* MIXED;
    __device__ __forceinline__ void half0(f32x4 (&acc)[2][2][4][2], const Unit& u, int wr, int wc, int fr, int fq) const {
        const int row0 = u.pm * BM + wr * 64 + fr;
#pragma unroll
        for (int ai = 0; ai < 2; ++ai)
#pragma unroll
            for (int m = 0; m < 4; ++m)
#pragma unroll
                for (int bj = 0; bj < 2; ++bj) {
                    const size_t off = (size_t)(row0 + ai * HALF + m * 16) * 1024 + u.pn * BM + bj * HALF + wc * 32 + 8 * fq;
                    const u32x2 a = *(const u32x2*)(GA + off), b = *(const u32x2*)(GB + off);
#pragma unroll
                    for (int k = 0; k < 8; ++k) { const float qa = (float)((a[k >> 2] >> (8 * (k & 3))) & 255u), qb = (float)((b[k >> 2] >> (8 * (k & 3))) & 255u);
                        acc[ai][bj][m][k >> 2][k & 3] *= qa * __builtin_amdgcn_rcpf(qb); }
                    if (bj == 1 && (m & 1)) asm volatile("" ::: "memory");
                }
    }
    __device__ __forceinline__ void operator()(f32x4 (&acc)[2][2][4][2], const Unit& u, int wr, int wc, int fr, int fq) const {
        if (u.kh == 0) { half0(acc, u, wr, wc, fr, fq); return; }
        const int row0 = u.pm * BM + wr * 64 + fr;
        u32x2 gbv[2][4][2];
#pragma unroll
        for (int ai = 0; ai < 2; ++ai)
#pragma unroll
            for (int m = 0; m < 4; ++m)
#pragma unroll
                for (int bj = 0; bj < 2; ++bj) gbv[ai][m][bj] = *(const u32x2*)(GB + (size_t)(row0 + ai * HALF + m * 16) * 1024 + u.pn * BM + bj * HALF + wc * 32 + 8 * fq);
#pragma unroll
        for (int ai = 0; ai < 2; ++ai)
#pragma unroll
            for (int m = 0; m < 4; ++m)
#pragma unroll
                for (int bj = 0; bj < 2; ++bj) {
                    const size_t off = (size_t)(row0 + ai * HALF + m * 16) * 1024 + u.pn * BM + bj * HALF + wc * 32 + 8 * fq;
                    const u32x2 b = gbv[ai][m][bj]; float o[8];
#pragma unroll
                    for (int k = 0; k < 8; ++k) { const float qb = (float)((b[k >> 2] >> (8 * (k & 3))) & 255u); o[k] = acc[ai][bj][m][k >> 2][k & 3] * (qb * (1.0f / 255.0f)); }
                    *(u32x4*)(MIXED + off) = pack8_bf16(o);
                }
    }
};
struct EpiRes1 {
    static constexpr bool PERM = true, AFTER_DRAIN = false, KSPLIT = false;
    const float* x; bf16_t* DL; bf16_t* X1B; float* SSQ;
    __device__ __forceinline__ void operator()(const f32x4 (&acc)[2][2][4][2], const Unit& u, int wr, int wc, int fr, int fq) const {
        const int row0 = u.pm * BM + wr * 64 + fr;
#pragma unroll
        for (int ai = 0; ai < 2; ++ai)
#pragma unroll
            for (int mp = 0; mp < 2; ++mp) {
                f32x4 xv[2][2][2];
#pragma unroll
                for (int mm = 0; mm < 2; ++mm)
#pragma unroll
                    for (int bj = 0; bj < 2; ++bj) { const size_t off = (size_t)(row0 + ai * HALF + (2 * mp + mm) * 16) * 1024 + u.pn * BM + bj * HALF + wc * 32 + 8 * fq;
                        xv[mm][bj][0] = *(const f32x4*)(x + off); xv[mm][bj][1] = *(const f32x4*)(x + off + 4); }
#pragma unroll
                for (int mm = 0; mm < 2; ++mm) {
                    const int m = 2 * mp + mm; const int row = row0 + ai * HALF + m * 16; float ss = 0.f;
#pragma unroll
                    for (int bj = 0; bj < 2; ++bj) {
                        const size_t off = (size_t)row * 1024 + u.pn * BM + bj * HALF + wc * 32 + 8 * fq;
                        const f32x4 a0 = acc[ai][bj][m][0], a1 = acc[ai][bj][m][1];
                        const f32x4 v0 = xv[mm][bj][0] + a0, v1 = xv[mm][bj][1] + a1;
                        u32x4 dw; dw.x = cvt_pk_bf16(a0[0], a0[1]); dw.y = cvt_pk_bf16(a0[2], a0[3]); dw.z = cvt_pk_bf16(a1[0], a1[1]); dw.w = cvt_pk_bf16(a1[2], a1[3]); *(u32x4*)(DL + off) = dw;
                        u32x4 w; w.x = cvt_pk_bf16(v0[0], v0[1]); w.y = cvt_pk_bf16(v0[2], v0[3]); w.z = cvt_pk_bf16(v1[0], v1[1]); w.w = cvt_pk_bf16(v1[2], v1[3]);
                        *(u32x4*)(X1B + off) = w;
                        ss += (v0[0] * v0[0] + v0[1] * v0[1]) + (v0[2] * v0[2] + v0[3] * v0[3]) + (v1[0] * v1[0] + v1[1] * v1[1]) + (v1[2] * v1[2] + v1[3] * v1[3]);
                    }
                    ss += __shfl_xor(ss, 16); ss += __shfl_xor(ss, 32);
                    if (fq == 0) SSQ[(size_t)row * 16 + u.pn * 4 + wc] = ss;
                }
            }
    }
};
struct EpiSwiglu {
    static constexpr bool PERM = true, AFTER_DRAIN = false, KSPLIT = false;
    const float* SSQ; bf16_t* ACT;
    __device__ __forceinline__ void operator()(const f32x4 (&acc)[2][2][4][2], const Unit& u, int wr, int wc, int fr, int fq) const {
        const int row0 = u.pm * BM + wr * 64 + fr;
        f32x4 sq[2][4];
#pragma unroll
        for (int ai = 0; ai < 2; ++ai)
#pragma unroll
            for (int m = 0; m < 4; ++m) sq[ai][m] = *(const f32x4*)(SSQ + (size_t)(row0 + ai * HALF + m * 16) * 16 + 4 * fq);
#pragma unroll
        for (int ai = 0; ai < 2; ++ai)
#pragma unroll
            for (int m = 0; m < 4; ++m) {
                const int row = row0 + ai * HALF + m * 16;
                float ss = (sq[ai][m][0] + sq[ai][m][1]) + (sq[ai][m][2] + sq[ai][m][3]);
                ss += __shfl_xor(ss, 16); ss += __shfl_xor(ss, 32);
                const float rstd = __builtin_amdgcn_rsqf(ss * (1.0f / 1024.0f) + 1e-6f);
                float o[8];
#pragma unroll
                for (int k = 0; k < 8; ++k) { const float g = acc[ai][0][m][k >> 2][k & 3] * rstd, up = acc[ai][1][m][k >> 2][k & 3] * rstd; o[k] = g * sigm(g) * up; }
                *(u32x4*)(ACT + (size_t)row * 2816 + u.pn * 128 + wc * 32 + 8 * fq) = pack8_bf16(o);
            }
    }
};
struct EpiRes2 {
    static constexpr bool PERM = true, AFTER_DRAIN = false, KSPLIT = false;
    const float* x; const bf16_t* DL; float* out;
    __device__ __forceinline__ void operator()(const f32x4 (&acc)[2][2][4][2], const Unit& u, int wr, int wc, int fr, int fq) const {
        const int row0 = u.pm * BM + wr * 64 + fr;
#pragma unroll
        for (int ai = 0; ai < 2; ++ai)
#pragma unroll
            for (int mp = 0; mp < 2; ++mp) {
                f32x4 xv[2][2][2]; u32x4 dv[2][2];
#pragma unroll
                for (int mm = 0; mm < 2; ++mm)
#pragma unroll
                    for (int bj = 0; bj < 2; ++bj) { const size_t off = (size_t)(row0 + ai * HALF + (2 * mp + mm) * 16) * 1024 + u.pn * BM + bj * HALF + wc * 32 + 8 * fq;
                        xv[mm][bj][0] = *(const f32x4*)(x + off); xv[mm][bj][1] = *(const f32x4*)(x + off + 4); dv[mm][bj] = *(const u32x4*)(DL + off); }
#pragma unroll
                for (int mm = 0; mm < 2; ++mm)
#pragma unroll
                    for (int bj = 0; bj < 2; ++bj) { const int m = 2 * mp + mm;
                        const size_t off = (size_t)(row0 + ai * HALF + m * 16) * 1024 + u.pn * BM + bj * HALF + wc * 32 + 8 * fq;
                        const u32x4 dw = dv[mm][bj];
                        f32x4 d0, d1; d0[0] = __builtin_bit_cast(float, dw.x << 16); d0[1] = __builtin_bit_cast(float, dw.x & 0xffff0000u); d0[2] = __builtin_bit_cast(float, dw.y << 16); d0[3] = __builtin_bit_cast(float, dw.y & 0xffff0000u);
                        d1[0] = __builtin_bit_cast(float, dw.z << 16); d1[1] = __builtin_bit_cast(float, dw.z & 0xffff0000u); d1[2] = __builtin_bit_cast(float, dw.w << 16); d1[3] = __builtin_bit_cast(float, dw.w & 0xffff0000u);
                        const f32x4 v0 = (xv[mm][bj][0] + d0) + acc[ai][bj][m][0], v1 = (xv[mm][bj][1] + d1) + acc[ai][bj][m][1];
                        *(f32x4*)(out + off) = v0; *(f32x4*)(out + off + 4) = v1; }
            }
    }
};

template <class Epi, class Sched, bool ALIGN_EPI = false, bool SP2 = false>
__device__ __forceinline__ void gemm_phase(PG8_LAS unsigned char* lds, const Gemm g, const Sched& S, const Epi& E) {
    int tid_ = threadIdx.x; asm volatile("" : "+v"(tid_));
    const int tid = tid_, wid = __builtin_amdgcn_readfirstlane(tid >> 6), lane = tid & 63, wr = wid >> 2, wc = wid & 3, fr = lane & 15, fq = lane >> 4;
    const int K = g.K, nt = K / BK;
    unsigned voffA[2], voffB[2];
#pragma unroll
    for (int i = 0; i < 2; ++i) { int R, C; stage_rc(tid * 16 + i * 8192, R, C); const int Rb = Epi::PERM ? ((R & ~31) + perm32(R & 31)) : R;
        voffA[i] = (unsigned)(R * g.ld + C) * 2u; voffB[i] = (unsigned)(Rb * g.ld + C) * 2u; }
    const size_t kstep = (size_t)(BK * 2);
    const size_t hstep = (size_t)HALF * g.ld * 2; const size_t khb = (size_t)K * 2;
    const size_t tstep = 2 * hstep;
    const unsigned ldsw = (unsigned)wid * 1024u;
    const int aoff = lds_byte(wr * 64 + fr, fq * 8), boff = lds_byte(wc * 32 + fr, fq * 8);
#define PG8_SA(b, h) (((b) * 2 + (h)) * HTB)
#define PG8_SB(b, h) ((4 + (b) * 2 + (h)) * HTB)
#define PG8_STAGE(bufoff, gbase, voff) do { _Pragma("unroll") for (int _i = 0; _i < 2; ++_i) \
        __builtin_amdgcn_global_load_lds((const unsigned*)((const char*)(gbase) + (voff)[_i]), (PG8_LAS unsigned*)(lds + (bufoff) + ldsw + _i * 8192), 16, 0, 0); } while (0)
#define PG8_LDA(dst, b, h) do { _Pragma("unroll") for (int m = 0; m < 4; ++m) _Pragma("unroll") for (int k = 0; k < 2; ++k) dst[m][k] = *(const PG8_LAS bf16x8*)(lds + PG8_SA(b, h) + aoff + m * 2048 + k * 1024); } while (0)
#define PG8_LDB(dst, b, h) do { _Pragma("unroll") for (int n = 0; n < 2; ++n) _Pragma("unroll") for (int k = 0; k < 2; ++k) dst[n][k] = *(const PG8_LAS bf16x8*)(lds + PG8_SB(b, h) + boff + n * 2048 + k * 1024); } while (0)
#define PG8_MMA(ai, bj, At, Bt) do { __builtin_amdgcn_s_setprio(1); _Pragma("unroll") for (int m = 0; m < 4; ++m) _Pragma("unroll") for (int n = 0; n < 2; ++n) _Pragma("unroll") for (int k = 0; k < 2; ++k) \
        acc[ai][bj][m][n] = __builtin_amdgcn_mfma_f32_16x16x32_bf16(Bt[n][k], At[m][k], acc[ai][bj][m][n], 0, 0, 0); __builtin_amdgcn_s_setprio(0); } while (0)
#define PG8_WAIT_V(n) asm volatile("s_waitcnt vmcnt(" #n ")" ::: "memory")
#define PG8_WAIT_L(n) asm volatile("s_waitcnt lgkmcnt(" #n ")" ::: "memory")
#define PG8_BAR __builtin_amdgcn_s_barrier()
#define PG8_SCHED __builtin_amdgcn_sched_barrier(0)
    Unit cur, nxt; int ui = 0;
    if (!S.next(0, cur)) return;
    f32x4 acc[2][2][4][2];
#pragma unroll
    for (int a = 0; a < 2; ++a)
#pragma unroll
        for (int b = 0; b < 2; ++b)
#pragma unroll
            for (int m = 0; m < 4; ++m)
#pragma unroll
                for (int n = 0; n < 2; ++n) acc[a][b][m][n] = (f32x4){0.f, 0.f, 0.f, 0.f};
    bf16x8 At[4][2], B0[2][2], B1[2][2];
    const char* cA = (const char*)g.A + (size_t)cur.pm * tstep + cur.kh * khb; const char* cB = (const char*)g.Bt + (size_t)cur.pn * tstep + cur.kh * khb;
    S.a_ready(cur);
    if constexpr (SP2) {
        PG8_STAGE(PG8_SB(0, 0), cB, voffB); PG8_STAGE(PG8_SB(0, 1), cB + hstep, voffB); PG8_STAGE(PG8_SA(0, 0), cA, voffA); PG8_STAGE(PG8_SA(0, 1), cA + hstep, voffA);
        if (wr == 1) PG8_BAR;
        PG8_WAIT_V(2); PG8_BAR;
        PG8_STAGE(PG8_SB(1, 0), cB + kstep, voffB); PG8_STAGE(PG8_SA(1, 0), cA + kstep, voffA); PG8_STAGE(PG8_SB(1, 1), cB + hstep + kstep, voffB);
        PG8_WAIT_V(6); PG8_BAR;
    } else {
        PG8_STAGE(PG8_SB(0, 0), cB, voffB); PG8_STAGE(PG8_SA(0, 0), cA, voffA); PG8_STAGE(PG8_SB(0, 1), cB + hstep, voffB); PG8_STAGE(PG8_SA(0, 1), cA + hstep, voffA);
        if (wr == 1) PG8_BAR;
        PG8_WAIT_V(4); PG8_BAR;
        PG8_STAGE(PG8_SB(1, 0), cB + kstep, voffB); PG8_STAGE(PG8_SA(1, 0), cA + kstep, voffA); PG8_STAGE(PG8_SB(1, 1), cB + hstep + kstep, voffB);
        PG8_WAIT_V(6); PG8_BAR;
    }
    for (;;) {
        const bool has_next = S.next(ui + 1, nxt);
        const char* nA = has_next ? (const char*)g.A + (size_t)nxt.pm * tstep + nxt.kh * khb : cA; const char* nB = has_next ? (const char*)g.Bt + (size_t)nxt.pn * tstep + nxt.kh * khb : cB;
        for (int t = 0; t < nt; t += 2) {
            const bool last = (t == nt - 2);
            const char* a1 = cA + (size_t)(t + 1) * kstep;
            const char* a2 = last ? nA : cA + (size_t)(t + 2) * kstep; const char* b2 = last ? nB : cB + (size_t)(t + 2) * kstep;
            const char* a3 = a2 + kstep; const char* b3 = b2 + kstep;
            if (last && has_next) S.a_ready(nxt);
            if constexpr (SP2) {
            PG8_LDB(B0, 0, 0); PG8_LDB(B1, 0, 1); PG8_SCHED; PG8_LDA(At, 0, 0); PG8_STAGE(PG8_SA(1, 1), a1 + hstep, voffA);
            PG8_WAIT_V(8); PG8_WAIT_L(0); PG8_BAR; PG8_MMA(0, 0, At, B0); PG8_MMA(0, 1, At, B1); PG8_BAR; PG8_SCHED;
            PG8_LDA(At, 0, 1); PG8_STAGE(PG8_SB(0, 0), b2, voffB); PG8_STAGE(PG8_SB(0, 1), b2 + hstep, voffB); PG8_STAGE(PG8_SA(0, 0), a2, voffA);
            PG8_WAIT_V(8); PG8_WAIT_L(0); PG8_BAR; PG8_MMA(1, 0, At, B0); PG8_MMA(1, 1, At, B1); PG8_BAR; PG8_SCHED;
            PG8_LDB(B0, 1, 0); PG8_LDB(B1, 1, 1); PG8_SCHED; PG8_LDA(At, 1, 0); PG8_STAGE(PG8_SA(0, 1), a2 + hstep, voffA);
            PG8_WAIT_V(8); PG8_WAIT_L(0); PG8_BAR; PG8_MMA(0, 0, At, B0); PG8_MMA(0, 1, At, B1); PG8_BAR; PG8_SCHED;
            PG8_LDA(At, 1, 1); PG8_STAGE(PG8_SB(1, 0), b3, voffB); PG8_STAGE(PG8_SB(1, 1), b3 + hstep, voffB); PG8_STAGE(PG8_SA(1, 0), a3, voffA);
            PG8_WAIT_V(8); PG8_WAIT_L(0); PG8_BAR; PG8_MMA(1, 0, At, B0); PG8_MMA(1, 1, At, B1); PG8_BAR; PG8_SCHED;
            } else {
            PG8_LDB(B0, 0, 0); PG8_SCHED; PG8_LDA(At, 0, 0); PG8_STAGE(PG8_SA(1, 1), a1 + hstep, voffA);
            PG8_WAIT_L(8); PG8_BAR; PG8_WAIT_L(0); PG8_MMA(0, 0, At, B0); PG8_BAR; PG8_SCHED;
            PG8_LDB(B1, 0, 1); PG8_STAGE(PG8_SB(0, 0), b2, voffB);
            PG8_BAR; PG8_WAIT_L(0); PG8_MMA(0, 1, At, B1); PG8_BAR;
            PG8_LDA(At, 0, 1); PG8_STAGE(PG8_SA(0, 0), a2, voffA);
            PG8_BAR; PG8_WAIT_L(0); PG8_MMA(1, 0, At, B0); PG8_BAR; PG8_SCHED;
            PG8_STAGE(PG8_SB(0, 1), b2 + hstep, voffB);
            PG8_WAIT_V(6); PG8_BAR; PG8_MMA(1, 1, At, B1); PG8_BAR;
            PG8_LDB(B0, 1, 0); PG8_SCHED; PG8_LDA(At, 1, 0); PG8_STAGE(PG8_SA(0, 1), a2 + hstep, voffA);
            PG8_WAIT_L(8); PG8_BAR; PG8_WAIT_L(0); PG8_MMA(0, 0, At, B0); PG8_BAR; PG8_SCHED;
            PG8_LDB(B1, 1, 1); PG8_STAGE(PG8_SB(1, 0), b3, voffB);
            PG8_BAR; PG8_WAIT_L(0); PG8_MMA(0, 1, At, B1); PG8_BAR;
            PG8_LDA(At, 1, 1); PG8_STAGE(PG8_SA(1, 0), a3, voffA);
            PG8_BAR; PG8_WAIT_L(0); PG8_MMA(1, 0, At, B0); PG8_BAR; PG8_SCHED;
            PG8_STAGE(PG8_SB(1, 1), b3 + hstep, voffB);
            PG8_WAIT_V(6); PG8_BAR; PG8_MMA(1, 1, At, B1); PG8_BAR;
            }
        }
        if constexpr (ALIGN_EPI) { if (wr == 0) PG8_BAR; }
        if constexpr (!Epi::AFTER_DRAIN) { E(acc, cur, wr, wc, fr, fq); S.done(cur); }
        if (!has_next) break;
        if (!(Epi::KSPLIT && cur.kh == 0))
#pragma unroll
        for (int a = 0; a < 2; ++a)
#pragma unroll
            for (int b = 0; b < 2; ++b)
#pragma unroll
                for (int m = 0; m < 4; ++m)
#pragma unroll
                    for (int n = 0; n < 2; ++n) acc[a][b][m][n] = (f32x4){0.f, 0.f, 0.f, 0.f};
        cur = nxt; cA = nA; cB = nB; ++ui;
        if constexpr (ALIGN_EPI) { if (wr == 1) PG8_BAR; }
    }
    PG8_WAIT_V(0);
    if constexpr (!ALIGN_EPI) { if (wr == 0) PG8_BAR; }
    PG8_BAR;
    if constexpr (Epi::AFTER_DRAIN) { E.fused(acc, cur, wr, wc, fr, fq, lds, wid, lane); S.done(cur); }
#undef PG8_SA
#undef PG8_SB
#undef PG8_STAGE
#undef PG8_LDA
#undef PG8_LDB
#undef PG8_MMA
#undef PG8_WAIT_V
#undef PG8_WAIT_L
#undef PG8_BAR
#undef PG8_SCHED
}
}

constexpr int NWAVES = 8, NTHREADS = 512;
constexpr int BATCH = 8, SEQ = 2048, D = 1024, M = BATCH * SEQ, INW = 9216, FFH = 2816;
constexpr float EPS = 1e-6f;
constexpr size_t MiB = 1u << 20;
constexpr size_t WS_SSQ = 1 * MiB;
constexpr size_t WS_WIN = 2 * MiB;
constexpr size_t WS_WHS = 20 * MiB;
constexpr size_t WS_WO = 24 * MiB;
constexpr size_t WS_WF1 = 26 * MiB;
constexpr size_t WS_WF2 = 37 * MiB;
constexpr size_t WS_H = 43 * MiB;
constexpr size_t WS_MIXED = WS_H;
constexpr size_t WS_QS = 75 * MiB;
constexpr size_t WS_VH = 139 * MiB;
constexpr size_t WS_SK = 171 * MiB;
constexpr size_t WS_X1B = WS_SK;
constexpr size_t WS_GH = 203 * MiB, WS_GA = 219 * MiB, WS_GB = 235 * MiB;
constexpr size_t WS_ACT = 75 * MiB;
constexpr size_t WS_END = 251 * MiB;
static_assert(WS_ACT + (size_t)M * FFH * 2 <= WS_X1B, "ACT overlay");
constexpr int RING_BYTES = 131072, LDS_BYTES = 157696, MISC_OFF = LDS_BYTES - 256;

#define LAS __attribute__((address_space(3)))
typedef unsigned short bf16;
typedef unsigned v4u __attribute__((ext_vector_type(4)));
typedef float f32x4 __attribute__((ext_vector_type(4)));
__device__ __forceinline__ unsigned f2bf(float f) { unsigned u = __builtin_bit_cast(unsigned, f); return (u + 0x7fffu + ((u >> 16) & 1u)) >> 16; }
__device__ __forceinline__ unsigned pk2(float lo, float hi) { return f2bf(lo) | (f2bf(hi) << 16); }
__device__ __forceinline__ float bf2f(unsigned short b) { return __builtin_bit_cast(float, (unsigned)b << 16); }
__device__ __forceinline__ float wave_sum(float v) {
#pragma unroll
    for (int o = 1; o < 64; o <<= 1) v += __shfl_xor(v, o);
    return v;
}
struct Args { const float* in[13]; float* out; unsigned char* ws; int ph_lo, ph_hi; };

struct ConvItem { const float* W; bf16* WT; const float* ks; int N, ldT, koff, k0, n0d, n0s; };
__device__ __forceinline__ ConvItem conv_item(const Args& a, unsigned char* ws, int it) {
    constexpr int I_IN = 16 * (INW / 32), I_SQ = 16 * 32, I_F1 = 16 * (2 * FFH / 32);
    ConvItem p; int r = it; p.ks = nullptr; p.koff = 0;
    if (r < I_IN) { const int nblk = INW / 32, kb = r / nblk, nb = r % nblk, n0d = 32 * nb; const int sec = n0d >> 10; int n0s = n0d;
        if (sec == 4 || sec == 5) { const int q = n0d & 255; n0s = (n0d - q) + 64 * ((q >> 5) & 3) + 32 * (q >> 7); }
        p.W = a.in[2]; p.N = INW; p.WT = (bf16*)(ws + WS_WIN); p.ldT = 1024; p.k0 = 64 * kb; p.n0d = n0d; p.n0s = n0s; return p; } r -= I_IN;
    if (r < I_SQ) { p.W = a.in[7]; p.N = 1024; p.WT = (bf16*)(ws + WS_WHS); p.ldT = 2048; p.k0 = 64 * (r / 32); p.n0d = p.n0s = 32 * (r % 32); return p; } r -= I_SQ;
    if (r < I_SQ) { p.W = a.in[8]; p.N = 1024; p.WT = (bf16*)(ws + WS_WHS); p.ldT = 2048; p.koff = 1024; p.k0 = 64 * (r / 32); p.n0d = p.n0s = 32 * (r % 32); return p; } r -= I_SQ;
    if (r < I_SQ) { p.W = a.in[9]; p.N = 1024; p.WT = (bf16*)(ws + WS_WO); p.ldT = 1024; p.k0 = 64 * (r / 32); p.n0d = p.n0s = 32 * (r % 32); return p; } r -= I_SQ;
    if (r < I_F1) { const int nblk = 2 * FFH / 32, kb = r / nblk, nb = r % nblk, n0d = 32 * nb, pn = n0d >> 8, q = n0d & 255;
        p.W = a.in[11]; p.N = 2 * FFH; p.WT = (bf16*)(ws + WS_WF1); p.ldT = 1024; p.k0 = 64 * kb; p.n0d = n0d; p.n0s = (q >> 7) * FFH + 128 * pn + (q & 127); p.ks = a.in[10]; return p; } r -= I_F1;
    p.W = a.in[12]; p.N = 1024; p.WT = (bf16*)(ws + WS_WF2); p.ldT = FFH; p.k0 = 64 * (r / 32); p.n0d = p.n0s = 32 * (r % 32); return p;
}
__device__ __forceinline__ void conv_load(const ConvItem& p, float (&wv)[32], f32x4 (&kv)[2], int lane) {
    const float* wp = p.W + (size_t)(p.k0 + (lane >> 5)) * p.N + p.n0s + (lane & 31);
#pragma unroll
    for (int i = 0; i < 32; ++i) wv[i] = wp[(size_t)(2 * i) * p.N];
    if (p.ks) { kv[0] = *(const f32x4*)(p.ks + p.k0 + 8 * (lane & 7)); kv[1] = *(const f32x4*)(p.ks + p.k0 + 8 * (lane & 7) + 4); }
    else { kv[0] = (f32x4){1.f, 1.f, 1.f, 1.f}; kv[1] = kv[0]; }
}
__device__ __forceinline__ void conv_finish(const ConvItem& p, const float (&wv)[32], const f32x4 (&kv)[2], LAS float* scr, int lane) {
#pragma unroll
    for (int i = 0; i < 32; ++i) scr[(2 * i + (lane >> 5)) * 33 + (lane & 31)] = wv[i];
    asm volatile("s_waitcnt lgkmcnt(0)" ::: "memory");
    const int c = lane & 7;
#pragma unroll
    for (int j = 0; j < 4; ++j) { const int n = (lane >> 3) + 8 * j; const LAS float* s = scr + (8 * c) * 33 + n;
        v4u o; o.x = pk2(s[0 * 33] * kv[0][0], s[1 * 33] * kv[0][1]); o.y = pk2(s[2 * 33] * kv[0][2], s[3 * 33] * kv[0][3]); o.z = pk2(s[4 * 33] * kv[1][0], s[5 * 33] * kv[1][1]); o.w = pk2(s[6 * 33] * kv[1][2], s[7 * 33] * kv[1][3]);
        *(v4u*)(p.WT + (size_t)(p.n0d + n) * p.ldT + p.koff + p.k0 + 8 * c) = o; }
    asm volatile("s_waitcnt lgkmcnt(0)" ::: "memory");
}
template <int PART> __device__ __forceinline__ void p0_prologue(const Args& a, LAS unsigned char* lds, int wave, int lane, int gw, int NGW) {
    LAS float* scr = (LAS float*)(lds + wave * 16384);
    unsigned char* ws = a.ws;
    constexpr int I_IN = 16 * (INW / 32), I_SQ = 16 * 32, I_F1 = 16 * (2 * FFH / 32), I_F2 = (FFH / 64) * 32;
    constexpr int NITEMS = I_IN + 3 * I_SQ + I_F1 + I_F2;
    { int it = (PART == 0 ? gw : I_IN + gw); const int end = (PART == 0 ? I_IN : NITEMS);
      if (it < end) {
        ConvItem pa = conv_item(a, ws, it), pb = pa; float wa[32], wb[32]; f32x4 ka[2], kb[2];
        conv_load(pa, wa, ka, lane);
        for (;;) {
            const bool hb = it + NGW < end; if (hb) { pb = conv_item(a, ws, it + NGW); conv_load(pb, wb, kb, lane); }
            conv_finish(pa, wa, ka, scr, lane);
            if (!hb) break; it += NGW;
            const bool ha = it + NGW < end; if (ha) { pa = conv_item(a, ws, it + NGW); conv_load(pa, wa, ka, lane); }
            conv_finish(pb, wb, kb, scr, lane);
            if (!ha) break; it += NGW;
        }
      }
    }
    if (PART != 0) return;
    const float* g1 = a.in[1];
    f32x4 gv[4];
#pragma unroll
    for (int j = 0; j < 4; ++j) gv[j] = ((const f32x4*)g1)[lane + 64 * j];
    for (int m = gw; m < M; m += NGW) {
        const f32x4* xr = (const f32x4*)(a.in[0] + (size_t)m * D) + lane;
        f32x4 v[4]; float s = 0.f;
#pragma unroll
        for (int j = 0; j < 4; ++j) { v[j] = xr[64 * j]; s += (v[j].x * v[j].x + v[j].y * v[j].y) + (v[j].z * v[j].z + v[j].w * v[j].w); }
        const float rstd = __builtin_amdgcn_rsqf(wave_sum(s) * (1.f / D) + EPS);
        unsigned long long* o8 = (unsigned long long*)((bf16*)(ws + WS_H) + (size_t)m * D) + lane;
#pragma unroll
        for (int j = 0; j < 4; ++j) { const f32x4 y = v[j] * rstd * gv[j]; o8[64 * j] = (unsigned long long)pk2(y.x, y.y) | ((unsigned long long)pk2(y.z, y.w) << 32); }
    }
}

typedef short bf16x8_t __attribute__((ext_vector_type(8)));
typedef float f32x16 __attribute__((ext_vector_type(16)));
typedef unsigned u32x2_t __attribute__((ext_vector_type(2)));
typedef float f32x2_t __attribute__((ext_vector_type(2)));
typedef __bf16 bf16x2_cv __attribute__((ext_vector_type(2)));
__device__ __forceinline__ unsigned cvtpk(float lo, float hi) { const f32x2_t v = {lo, hi}; return __builtin_bit_cast(unsigned, __builtin_convertvector(v, bf16x2_cv)); }
__device__ __forceinline__ bf16x8_t pack_acc8(const f32x16& c, int p) {
    v4u w; if (p == 0) { w.x = cvtpk(c[0], c[1]); w.y = cvtpk(c[2], c[3]); w.z = cvtpk(c[4], c[5]); w.w = cvtpk(c[6], c[7]); }
    else { w.x = cvtpk(c[8], c[9]); w.y = cvtpk(c[10], c[11]); w.z = cvtpk(c[12], c[13]); w.w = cvtpk(c[14], c[15]); }
    return __builtin_bit_cast(bf16x8_t, w);
}
#define MFMA32(A, B, C) __builtin_amdgcn_mfma_f32_32x32x16_bf16((A), (B), (C), 0, 0, 0)
__device__ __forceinline__ void hgrn_mfma(const Args& a, LAS unsigned char* lds, int vblk, int nblk) {
    unsigned char* ws = a.ws;
    bf16* QS = (bf16*)(ws + WS_QS); const bf16* VH = (const bf16*)(ws + WS_VH); const unsigned char* GH = ws + WS_GH; const _Float16* LOGF = (const _Float16*)a.out;
    const float* ogain = a.in[4];
    constexpr int RS = 272, TS = 144;
    LAS unsigned char* L_QI = lds; LAS unsigned char* L_QA = lds + 64 * RS; LAS unsigned char* L_KA = lds + 2 * 64 * RS;
    LAS unsigned char* L_KST = lds + 3 * 64 * RS; LAS unsigned char* L_VT = L_KST + 128 * TS;
    LAS float* L_TQ = (LAS float*)(L_VT + 128 * TS); LAS float* L_DEC = L_TQ + 2048;     LAS float* L_SS = L_DEC + 128; LAS float* L_GN = L_SS + 256;
    const int tid = threadIdx.x, lane = tid & 63, wave = __builtin_amdgcn_readfirstlane(tid >> 6);
    const int dp = tid & 63, oct = wave, r32 = lane & 31, hi = lane >> 5, vt = wave & 3, tt = wave >> 2;
    const int kap = 16 * (r32 >> 4) + 8 * ((r32 >> 2) & 1) + 4 * ((r32 >> 3) & 1) + (r32 & 3);
    for (int item = vblk; item < BATCH * 8; item += nblk) {
        const int b = item >> 3, h = item & 7;
        f32x16 C[4];
#pragma unroll
        for (int i = 0; i < 4; ++i)
#pragma unroll
            for (int j = 0; j < 16; ++j) C[i][j] = 0.f;
        if (tid < 128) L_GN[tid] = ogain[h * 128 + tid];
        unsigned gN2[2][8], qN2[2][8], vN2[2][8];
#pragma unroll
        for (int c2 = 0; c2 < 2; ++c2) { const size_t row0 = (size_t)b * SEQ + 64 * c2 + 8 * oct;
#pragma unroll
          for (int i = 0; i < 8; ++i) { gN2[c2][i] = *(const unsigned*)(LOGF + (row0 + i) * 1024 + h * 128 + 2 * dp); qN2[c2][i] = *(const unsigned*)(QS + (row0 + i) * 2048 + h * 128 + 2 * dp); vN2[c2][i] = *(const unsigned*)(VH + (row0 + i) * 1024 + h * 128 + 2 * dp); } }
        { float run0 = 0.f, run1 = 0.f;
#pragma unroll
          for (int i = 0; i < 8; ++i) { run0 += (float)__builtin_bit_cast(_Float16, (unsigned short)(gN2[0][i] & 0xffffu)); run1 += (float)__builtin_bit_cast(_Float16, (unsigned short)(gN2[0][i] >> 16)); }
          *(LAS f32x2_t*)(L_TQ + oct * 128 + 2 * dp) = (f32x2_t){run0, run1}; }
        __syncthreads();
#pragma unroll 2
        for (int n = 0; n < SEQ / 64; ++n) {
            unsigned (&gN)[8] = gN2[n & 1]; unsigned (&qN)[8] = qN2[n & 1]; unsigned (&vN)[8] = vN2[n & 1];
            if (n + 1 < SEQ / 64) { float run0 = 0.f, run1 = 0.f;
#pragma unroll
                for (int i = 0; i < 8; ++i) { const unsigned gw_ = gN2[(n + 1) & 1][i]; run0 += (float)__builtin_bit_cast(_Float16, (unsigned short)(gw_ & 0xffffu)); run1 += (float)__builtin_bit_cast(_Float16, (unsigned short)(gw_ >> 16)); }
                *(LAS f32x2_t*)(L_TQ + ((n + 1) & 1) * 1024 + oct * 128 + 2 * dp) = (f32x2_t){run0, run1}; }
            float off0 = 0.f, off1 = 0.f, cref0 = 0.f, cref1 = 0.f, tot0 = 0.f, tot1 = 0.f;
#pragma unroll
            for (int o = 0; o < 8; ++o) { const f32x2_t tq = *(const LAS f32x2_t*)(L_TQ + (n & 1) * 1024 + o * 128 + 2 * dp);
                if (o < oct) { off0 += tq.x; off1 += tq.y; } if (o < 4) { cref0 += tq.x; cref1 += tq.y; } tot0 += tq.x; tot1 += tq.y; }
            const float xc0 = __expf(tot0), xc1 = __expf(tot1), xa0 = __expf(-cref0), xa1 = __expf(-cref1), xb0 = __expf(cref0), xb1 = __expf(cref1);
            if (oct == 0) *(LAS f32x2_t*)(L_DEC + 2 * dp) = (f32x2_t){xc0, xc1};
            float e0 = __expf(off0), e1 = __expf(off1);
            unsigned ksp0[4], ksp1[4], vsp0[4], vsp1[4];
#pragma unroll
            for (int i = 0; i < 8; ++i) {
                const float f0 = __expf((float)__builtin_bit_cast(_Float16, (unsigned short)(gN[i] & 0xffffu))), f1 = __expf((float)__builtin_bit_cast(_Float16, (unsigned short)(gN[i] >> 16)));
                e0 = fmaxf(e0 * f0, 1e-30f); e1 = fmaxf(e1 * f1, 1e-30f);
                const float r0 = __builtin_amdgcn_rcpf(e0), r1 = __builtin_amdgcn_rcpf(e1);
                const float k0 = 1.0f - f0, k1 = 1.0f - f1, q0 = __builtin_bit_cast(float, qN[i] << 16), q1 = __builtin_bit_cast(float, qN[i] & 0xffff0000u);
                const float qi0 = q0 * e0, qi1 = q1 * e1, kr0 = k0 * r0, kr1 = k1 * r1;
                const int t = 8 * oct + i;
                *(LAS unsigned*)(L_QI + t * RS + 4 * dp) = cvtpk(qi0, qi1);
                *(LAS unsigned*)(L_QA + t * RS + 4 * dp) = cvtpk(qi0 * xa0, qi1 * xa1);
                *(LAS unsigned*)(L_KA + t * RS + 4 * dp) = cvtpk(kr0 * xb0, kr1 * xb1);
                const unsigned ks = cvtpk(kr0 * xc0, kr1 * xc1);
                if (i & 1) { ksp0[i >> 1] |= ks << 16; ksp1[i >> 1] |= ks & 0xffff0000u; vsp0[i >> 1] |= vN[i] << 16; vsp1[i >> 1] |= vN[i] & 0xffff0000u; }
                else { ksp0[i >> 1] = ks & 0xffffu; ksp1[i >> 1] = ks >> 16; vsp0[i >> 1] = vN[i] & 0xffffu; vsp1[i >> 1] = vN[i] >> 16; }
            }
            *(LAS v4u*)(L_KST + (2 * dp) * TS + 16 * oct) = (v4u){ksp0[0], ksp0[1], ksp0[2], ksp0[3]}; *(LAS v4u*)(L_KST + (2 * dp + 1) * TS + 16 * oct) = (v4u){ksp1[0], ksp1[1], ksp1[2], ksp1[3]};
            *(LAS v4u*)(L_VT + (2 * dp) * TS + 16 * oct) = (v4u){vsp0[0], vsp0[1], vsp0[2], vsp0[3]}; *(LAS v4u*)(L_VT + (2 * dp + 1) * TS + 16 * oct) = (v4u){vsp1[0], vsp1[1], vsp1[2], vsp1[3]};
            __syncthreads();
            const size_t m = (size_t)b * SEQ + 64 * n + 32 * tt + r32;
            unsigned gt4[4];
#pragma unroll
            for (int a4 = 0; a4 < 4; ++a4) gt4[a4] = *(const unsigned*)(GH + m * 1024 + h * 128 + 32 * vt + 8 * a4 + 4 * hi);
            if (n + 2 < SEQ / 64) { const size_t row0 = (size_t)b * SEQ + 64 * (n + 2) + 8 * oct;
#pragma unroll
                for (int i = 0; i < 8; ++i) { gN[i] = *(const unsigned*)(LOGF + (row0 + i) * 1024 + h * 128 + 2 * dp); qN[i] = *(const unsigned*)(QS + (row0 + i) * 2048 + h * 128 + 2 * dp); vN[i] = *(const unsigned*)(VH + (row0 + i) * 1024 + h * 128 + 2 * dp); } }
#define SB() __builtin_amdgcn_sched_barrier(0)
            f32x16 O;
#pragma unroll
            for (int j = 0; j < 16; ++j) O[j] = 0.f;
            bf16x8_t Vt[4];
            {
                v4u qf[8];
#pragma unroll
                for (int i = 0; i < 8; ++i) { const LAS unsigned char* qp = L_QI + (32 * tt + r32) * RS + (32 * (i >> 1) + 16 * (i & 1) + 4 * hi) * 2;
                    const u32x2_t lo = *(const LAS u32x2_t*)qp, hi2 = *(const LAS u32x2_t*)(qp + 16); qf[i] = (v4u){lo.x, lo.y, hi2.x, hi2.y}; }
#pragma unroll
                for (int ks = 0; ks < 4; ++ks) Vt[ks] = *(const LAS bf16x8_t*)(L_VT + (32 * vt + r32) * TS + (16 * ks + 8 * hi) * 2);
                SB();
#pragma unroll
                for (int i = 0; i < 8; ++i) O = MFMA32(pack_acc8(C[i >> 1], i & 1), __builtin_bit_cast(bf16x8_t, qf[i]), O);
                SB();
            }
#pragma unroll
            for (int st = 0; st < 2; ++st) if (st <= tt) {
                f32x16 S;
#pragma unroll
                for (int j = 0; j < 16; ++j) S[j] = 0.f;
#pragma unroll
                for (int hb = 0; hb < 2; ++hb) {
                    bf16x8_t A[4], B[4];
#pragma unroll
                    for (int k4 = 0; k4 < 4; ++k4) { const int ks = 4 * hb + k4;
                        A[k4] = *(const LAS bf16x8_t*)(L_KA + (32 * st + kap) * RS + (16 * ks + 8 * hi) * 2);
                        B[k4] = *(const LAS bf16x8_t*)(L_QA + (32 * tt + r32) * RS + (16 * ks + 8 * hi) * 2); }
                    SB();
#pragma unroll
                    for (int k4 = 0; k4 < 4; ++k4) S = MFMA32(A[k4], B[k4], S);
                    SB();
                }
                if (st == tt) {
#pragma unroll
                    for (int j = 0; j < 16; ++j) { const int sl = 16 * (j >> 3) + 8 * hi + (j & 7); if (sl > r32) S[j] = 0.f; }
                }
                O = MFMA32(Vt[2 * st], pack_acc8(S, 0), O); O = MFMA32(Vt[2 * st + 1], pack_acc8(S, 1), O);
            }
#pragma unroll
            for (int dt = 0; dt < 4; ++dt) {
                f32x4 dc[4]; bf16x8_t A[4];
#pragma unroll
                for (int a4 = 0; a4 < 4; ++a4) dc[a4] = *(const LAS f32x4*)(L_DEC + 32 * dt + 8 * a4 + 4 * hi);
#pragma unroll
                for (int ks = 0; ks < 4; ++ks) A[ks] = *(const LAS bf16x8_t*)(L_KST + (32 * dt + r32) * TS + (16 * ks + 8 * hi) * 2);
                SB();
#pragma unroll
                for (int a4 = 0; a4 < 4; ++a4)
#pragma unroll
                    for (int cc = 0; cc < 4; ++cc) C[dt][4 * a4 + cc] *= dc[a4][cc];
#pragma unroll
                for (int ks = 0; ks < 4; ++ks) C[dt] = MFMA32(A[ks], Vt[ks], C[dt]);
                SB();
            }
#undef SB
            float ss = 0.f;
#pragma unroll
            for (int j = 0; j < 16; ++j) ss += O[j] * O[j];
            ss += __shfl_xor(ss, 32);
            if (hi == 0) L_SS[(tt * 4 + vt) * 32 + r32] = ss;
            __syncthreads();
            const float sst = (L_SS[(tt * 4 + 0) * 32 + r32] + L_SS[(tt * 4 + 1) * 32 + r32]) + (L_SS[(tt * 4 + 2) * 32 + r32] + L_SS[(tt * 4 + 3) * 32 + r32]);
            const float rstd = __builtin_amdgcn_rsqf(sst * (1.0f / 128.0f) + EPS);
#pragma unroll
            for (int a4 = 0; a4 < 4; ++a4) { const int v0 = h * 128 + 32 * vt + 8 * a4 + 4 * hi;
                const f32x4 gn = *(const LAS f32x4*)(L_GN + 32 * vt + 8 * a4 + 4 * hi); const unsigned gt = gt4[a4];
                float o[4];
#pragma unroll
                for (int cc = 0; cc < 4; ++cc) o[cc] = O[4 * a4 + cc] * rstd * gn[cc] * ((float)((gt >> (8 * cc)) & 255u) * (1.0f / 255.0f));
                u32x2_t w; w.x = cvtpk(o[0], o[1]); w.y = cvtpk(o[2], o[3]);
                *(u32x2_t*)(QS + m * 2048 + v0) = w; }
        }
        __syncthreads();
    }
}

__device__ __forceinline__ void hgrn_v2(const Args& a, LAS unsigned char* lds, int vblk, int nblk) {
    unsigned char* ws = a.ws;
    bf16* QS = (bf16*)(ws + WS_QS); const bf16* VH = (const bf16*)(ws + WS_VH); const unsigned char* GH = ws + WS_GH; const _Float16* LOGF = (const _Float16*)a.out;
    const float* ogain = a.in[4];
    constexpr int RS = 272, TS = 144, O_KA = 64 * RS, O_KAT = 2 * 64 * RS, O_VT = O_KAT + 128 * TS, BUFB = O_VT + 128 * TS;
    LAS float* L_TQ = (LAS float*)(lds + 2 * BUFB);
    LAS float* L_XS = L_TQ + 1024;
    LAS float* L_SS = L_XS + 512;
    LAS float* L_GN = L_SS + 512;
    const int tid = threadIdx.x, lane = tid & 63, wave = __builtin_amdgcn_readfirstlane(tid >> 6);
    const int r32 = lane & 31, hi = lane >> 5;
    const int kap = 16 * (r32 >> 4) + 8 * ((r32 >> 2) & 1) + 4 * ((r32 >> 3) & 1) + (r32 & 3);
    constexpr int NCH = SEQ / 64;
#define SB() __builtin_amdgcn_sched_barrier(0)
    for (int item = vblk; item < BATCH * 8; item += nblk) {
        const int b = item >> 3, h = item & 7;
        if (tid < 128) L_GN[tid] = ogain[h * 128 + tid];
        if (wave < 4) {
            const int vt = wave;
            f32x16 C[4];
#pragma unroll
            for (int i = 0; i < 4; ++i)
#pragma unroll
                for (int j = 0; j < 16; ++j) C[i][j] = 0.f;
            f32x16 O[2]; unsigned gt4[2][4];
#define HG_EPI(cn) do { _Pragma("unroll") for (int tt = 0; tt < 2; ++tt) { const LAS float* SSb = L_SS + ((cn) & 1) * 256; \
                const float sst = (SSb[(tt * 4 + 0) * 32 + r32] + SSb[(tt * 4 + 1) * 32 + r32]) + (SSb[(tt * 4 + 2) * 32 + r32] + SSb[(tt * 4 + 3) * 32 + r32]); \
                const float rstd = __builtin_amdgcn_rsqf(sst * (1.0f / 128.0f) + EPS); \
                const size_t m = (size_t)b * SEQ + 64 * (cn) + r32 + 32 * tt; \
                _Pragma("unroll") for (int a4 = 0; a4 < 4; ++a4) { const int v0 = h * 128 + 32 * vt + 8 * a4 + 4 * hi; \
                    const f32x4 gn = *(const LAS f32x4*)(L_GN + 32 * vt + 8 * a4 + 4 * hi); const unsigned gt = gt4[tt][a4]; float o[4]; \
                    _Pragma("unroll") for (int cc = 0; cc < 4; ++cc) o[cc] = O[tt][4 * a4 + cc] * rstd * gn[cc] * ((float)((gt >> (8 * cc)) & 255u) * (1.0f / 255.0f)); \
                    u32x2_t w; w.x = cvtpk(o[0], o[1]); w.y = cvtpk(o[2], o[3]); *(u32x2_t*)(QS + m * 2048 + v0) = w; } } } while (0)
            __syncthreads();
#pragma unroll 1
            for (int n = 0; n < NCH; ++n) {
                __syncthreads();
                if (n > 0) HG_EPI(n - 1);
                const LAS unsigned char* T = lds + (n & 1) * BUFB;
                const LAS float* XS = L_XS + (n & 1) * 256;
                const size_t m0 = (size_t)b * SEQ + 64 * n + r32;
#pragma unroll
                for (int tt = 0; tt < 2; ++tt)
#pragma unroll
                    for (int a4 = 0; a4 < 4; ++a4) gt4[tt][a4] = *(const unsigned*)(GH + (m0 + 32 * tt) * 1024 + h * 128 + 32 * vt + 8 * a4 + 4 * hi);
                bf16x8_t Cp[8]; bf16x8_t Vt[4];
#pragma unroll
                for (int ks = 0; ks < 4; ++ks) Vt[ks] = *(const LAS bf16x8_t*)(T + O_VT + (32 * vt + r32) * TS + (16 * ks + 8 * hi) * 2);
#pragma unroll
                for (int dt = 0; dt < 4; ++dt) {
#pragma unroll
                    for (int a4 = 0; a4 < 4; ++a4) { const f32x4 x1 = *(const LAS f32x4*)(XS + 32 * dt + 8 * a4 + 4 * hi);
#pragma unroll
                        for (int cc = 0; cc < 4; ++cc) C[dt][4 * a4 + cc] *= x1[cc]; }
                    Cp[2 * dt] = pack_acc8(C[dt], 0); Cp[2 * dt + 1] = pack_acc8(C[dt], 1);
                }
#pragma unroll
                for (int tt = 0; tt < 2; ++tt) {
#pragma unroll
                    for (int j = 0; j < 16; ++j) O[tt][j] = 0.f;
                    v4u qf[8];
#pragma unroll
                    for (int i = 0; i < 8; ++i) { const LAS unsigned char* qp = T + (32 * tt + r32) * RS + (32 * (i >> 1) + 16 * (i & 1) + 4 * hi) * 2;
                        const u32x2_t lo = *(const LAS u32x2_t*)qp, hi2 = *(const LAS u32x2_t*)(qp + 16); qf[i] = (v4u){lo.x, lo.y, hi2.x, hi2.y}; }
                    SB();
#pragma unroll
                    for (int i = 0; i < 8; ++i) O[tt] = MFMA32(Cp[i], __builtin_bit_cast(bf16x8_t, qf[i]), O[tt]);
                    SB();
#pragma unroll
                    for (int st = 0; st < 2; ++st) if (st <= tt) {
                        f32x16 S;
#pragma unroll
                        for (int j = 0; j < 16; ++j) S[j] = 0.f;
#pragma unroll
                        for (int hb = 0; hb < 2; ++hb) {
                            bf16x8_t A[4], B[4];
#pragma unroll
                            for (int k4 = 0; k4 < 4; ++k4) { const int ks = 4 * hb + k4;
                                A[k4] = *(const LAS bf16x8_t*)(T + O_KA + (32 * st + kap) * RS + (16 * ks + 8 * hi) * 2);
                                B[k4] = *(const LAS bf16x8_t*)(T + (32 * tt + r32) * RS + (16 * ks + 8 * hi) * 2); }
                            SB();
#pragma unroll
                            for (int k4 = 0; k4 < 4; ++k4) S = MFMA32(A[k4], B[k4], S);
                            SB();
                        }
                        if (st == tt) {
#pragma unroll
                            for (int j = 0; j < 16; ++j) { const int sl = 16 * (j >> 3) + 8 * hi + (j & 7); if (sl > r32) S[j] = 0.f; }
                        }
                        O[tt] = MFMA32(Vt[2 * st], pack_acc8(S, 0), O[tt]); O[tt] = MFMA32(Vt[2 * st + 1], pack_acc8(S, 1), O[tt]);
                    }
                    float ss = 0.f;
#pragma unroll
                    for (int j = 0; j < 16; ++j) ss += O[tt][j] * O[tt][j];
                    ss += __shfl_xor(ss, 32);
                    if (hi == 0) L_SS[(n & 1) * 256 + (tt * 4 + vt) * 32 + r32] = ss;
                }
#pragma unroll
                for (int dt = 0; dt < 4; ++dt) {
                    f32x4 x2[4]; bf16x8_t A[4];
#pragma unroll
                    for (int a4 = 0; a4 < 4; ++a4) x2[a4] = *(const LAS f32x4*)(XS + 128 + 32 * dt + 8 * a4 + 4 * hi);
#pragma unroll
                    for (int ks = 0; ks < 4; ++ks) A[ks] = *(const LAS bf16x8_t*)(T + O_KAT + (32 * dt + r32) * TS + (16 * ks + 8 * hi) * 2);
                    SB();
#pragma unroll
                    for (int ks = 0; ks < 4; ++ks) C[dt] = MFMA32(A[ks], Vt[ks], C[dt]);
#pragma unroll
                    for (int a4 = 0; a4 < 4; ++a4)
#pragma unroll
                        for (int cc = 0; cc < 4; ++cc) C[dt][4 * a4 + cc] *= x2[a4][cc];
                    SB();
                }
            }
            __syncthreads();
            HG_EPI(NCH - 1);
#undef HG_EPI
        } else {
            const int ptid = tid - 256, dp = ptid & 63, q4 = ptid >> 6;
            unsigned g2[2][16], q2[2][16], v2[2][16];
#define HG_LOAD(set, c) do { const size_t row0_ = (size_t)b * SEQ + 64 * (c) + 16 * q4; _Pragma("unroll") for (int i = 0; i < 16; ++i) { \
                g2[set][i] = *(const unsigned*)(LOGF + (row0_ + i) * 1024 + h * 128 + 2 * dp); q2[set][i] = *(const unsigned*)(QS + (row0_ + i) * 2048 + h * 128 + 2 * dp); \
                v2[set][i] = *(const unsigned*)(VH + (row0_ + i) * 1024 + h * 128 + 2 * dp); } } while (0)
#define HG_SUMS(set, c) do { float r0_ = 0.f, r1_ = 0.f; _Pragma("unroll") for (int i = 0; i < 16; ++i) { r0_ += (float)__builtin_bit_cast(_Float16, (unsigned short)(g2[set][i] & 0xffffu)); \
                r1_ += (float)__builtin_bit_cast(_Float16, (unsigned short)(g2[set][i] >> 16)); } *(LAS f32x2_t*)(L_TQ + ((c) & 1) * 512 + q4 * 128 + 2 * dp) = (f32x2_t){r0_, r1_}; } while (0)
            float e0, e1, xa0, xa1, xb0, xb1; unsigned kp0[8], kp1[8], vp0[8], vp1[8];
#define HG_BEGIN(c) do { float off0 = 0.f, off1 = 0.f, cref0 = 0.f, cref1 = 0.f, tot0 = 0.f, tot1 = 0.f; \
                _Pragma("unroll") for (int o = 0; o < 4; ++o) { const f32x2_t tq = *(const LAS f32x2_t*)(L_TQ + ((c) & 1) * 512 + o * 128 + 2 * dp); \
                    if (o < q4) { off0 += tq.x; off1 += tq.y; } if (o < 2) { cref0 += tq.x; cref1 += tq.y; } tot0 += tq.x; tot1 += tq.y; } \
                xa0 = __expf(-cref0); xa1 = __expf(-cref1); xb0 = __expf(cref0); xb1 = __expf(cref1); e0 = __expf(off0); e1 = __expf(off1); \
                if (q4 == 0) { *(LAS f32x2_t*)(L_XS + ((c) & 1) * 256 + 2 * dp) = (f32x2_t){xb0, xb1}; *(LAS f32x2_t*)(L_XS + ((c) & 1) * 256 + 128 + 2 * dp) = (f32x2_t){__expf(tot0 - cref0), __expf(tot1 - cref1)}; } } while (0)
#define HG_TOKENS(set, c, i0) do { LAS unsigned char* T_ = lds + ((c) & 1) * BUFB; _Pragma("unroll") for (int i = (i0); i < (i0) + 8; ++i) { \
                const unsigned gw_ = g2[set][i], qw_ = q2[set][i], vw_ = v2[set][i]; \
                const float f0 = __expf((float)__builtin_bit_cast(_Float16, (unsigned short)(gw_ & 0xffffu))), f1 = __expf((float)__builtin_bit_cast(_Float16, (unsigned short)(gw_ >> 16))); \
                e0 = fmaxf(e0 * f0, 1e-30f); e1 = fmaxf(e1 * f1, 1e-30f); \
                const float r0 = __builtin_amdgcn_rcpf(e0), r1 = __builtin_amdgcn_rcpf(e1); \
                const float qq0 = __builtin_bit_cast(float, qw_ << 16), qq1 = __builtin_bit_cast(float, qw_ & 0xffff0000u); \
                const int t = 16 * q4 + i; \
                *(LAS unsigned*)(T_ + t * RS + 4 * dp) = cvtpk(qq0 * e0 * xa0, qq1 * e1 * xa1); \
                const unsigned ka = cvtpk((1.0f - f0) * r0 * xb0, (1.0f - f1) * r1 * xb1); \
                *(LAS unsigned*)(T_ + O_KA + t * RS + 4 * dp) = ka; \
                if (i & 1) { kp0[i >> 1] |= ka << 16; kp1[i >> 1] |= ka & 0xffff0000u; vp0[i >> 1] |= vw_ << 16; vp1[i >> 1] |= vw_ & 0xffff0000u; } \
                else { kp0[i >> 1] = ka & 0xffffu; kp1[i >> 1] = ka >> 16; vp0[i >> 1] = vw_ & 0xffffu; vp1[i >> 1] = vw_ >> 16; } } } while (0)
#define HG_FINISH(c) do { LAS unsigned char* T_ = lds + ((c) & 1) * BUFB; \
                *(LAS v4u*)(T_ + O_KAT + (2 * dp) * TS + 32 * q4) = (v4u){kp0[0], kp0[1], kp0[2], kp0[3]}; *(LAS v4u*)(T_ + O_KAT + (2 * dp) * TS + 32 * q4 + 16) = (v4u){kp0[4], kp0[5], kp0[6], kp0[7]}; \
                *(LAS v4u*)(T_ + O_KAT + (2 * dp + 1) * TS + 32 * q4) = (v4u){kp1[0], kp1[1], kp1[2], kp1[3]}; *(LAS v4u*)(T_ + O_KAT + (2 * dp + 1) * TS + 32 * q4 + 16) = (v4u){kp1[4], kp1[5], kp1[6], kp1[7]}; \
                *(LAS v4u*)(T_ + O_VT + (2 * dp) * TS + 32 * q4) = (v4u){vp0[0], vp0[1], vp0[2], vp0[3]}; *(LAS v4u*)(T_ + O_VT + (2 * dp) * TS + 32 * q4 + 16) = (v4u){vp0[4], vp0[5], vp0[6], vp0[7]}; \
                *(LAS v4u*)(T_ + O_VT + (2 * dp + 1) * TS + 32 * q4) = (v4u){vp1[0], vp1[1], vp1[2], vp1[3]}; *(LAS v4u*)(T_ + O_VT + (2 * dp + 1) * TS + 32 * q4 + 16) = (v4u){vp1[4], vp1[5], vp1[6], vp1[7]}; } while (0)
            HG_LOAD(0, 0); HG_LOAD(1, 1);
            HG_SUMS(0, 0);
            __syncthreads();
            HG_SUMS(1, 1); HG_BEGIN(0); HG_TOKENS(0, 0, 0); HG_TOKENS(0, 0, 8); HG_FINISH(0); HG_LOAD(0, 2);
#pragma unroll 2
            for (int n = 0; n < NCH; ++n) {
                const int c = n + 1;
                __syncthreads();
                if (c < NCH) { if (c + 1 < NCH) HG_SUMS(n & 1, c + 1); HG_BEGIN(c); HG_TOKENS((n + 1) & 1, c, 0); HG_TOKENS((n + 1) & 1, c, 8); HG_FINISH(c); if (c + 2 < NCH) HG_LOAD((n + 1) & 1, c + 2); }
            }
            __syncthreads();
#undef HG_LOAD
#undef HG_SUMS
#undef HG_BEGIN
#undef HG_TOKENS
#undef HG_FINISH
        }
        __syncthreads();
    }
#undef SB
}

template <bool DIAG> __device__ __forceinline__ bool attn_tile(const bf16x8_t (&Kc)[4], const bf16x8_t (&Vc)[4], const bf16x8_t (&Qf)[4], f32x16& O0, f32x16& O1, float& carry, int r32, int hi) {
    f32x16 Sx;
#pragma unroll
    for (int j = 0; j < 16; ++j) Sx[j] = 0.f;
#pragma unroll
    for (int ks = 0; ks < 4; ++ks) Sx = MFMA32(Kc[ks], Qf[ks], Sx);
    float kp[16], sg[16];
#pragma unroll
    for (int j = 0; j < 16; ++j) {
        const float r = __builtin_amdgcn_rcpf(1.0f + __builtin_amdgcn_exp2f(Sx[j]));
        if (DIAG) { const int sl = 16 * (j >> 3) + 8 * hi + (j & 7); const bool valid = sl < r32; kp[j] = valid ? r : 1.f; sg[j] = valid ? 1.0f - r : 0.f; }
        else { kp[j] = r; sg[j] = 1.0f - r; }
    }
#pragma unroll
    for (int j = 6; j >= 0; --j) { sg[j] *= kp[j + 1]; kp[j] *= kp[j + 1]; sg[8 + j] *= kp[8 + j + 1]; kp[8 + j] *= kp[8 + j + 1]; }
    const float G0 = kp[0], G1 = kp[8];
    const float P0 = __shfl_xor(G0, 32), P1 = __shfl_xor(G1, 32);
    const float after0 = (hi == 0 ? P0 : 1.f) * P1 * G1 * carry, after1 = (hi == 0 ? P1 : 1.f) * carry;
#pragma unroll
    for (int j = 0; j < 16; ++j) sg[j] *= (j < 8 ? after0 : after1);
    carry *= (G0 * G1) * (P0 * P1);
    v4u w0, w1; w0.x = cvtpk(sg[0], sg[1]); w0.y = cvtpk(sg[2], sg[3]); w0.z = cvtpk(sg[4], sg[5]); w0.w = cvtpk(sg[6], sg[7]);
    w1.x = cvtpk(sg[8], sg[9]); w1.y = cvtpk(sg[10], sg[11]); w1.z = cvtpk(sg[12], sg[13]); w1.w = cvtpk(sg[14], sg[15]);
    const bf16x8_t Pb0 = __builtin_bit_cast(bf16x8_t, w0), Pb1 = __builtin_bit_cast(bf16x8_t, w1);
    O0 = MFMA32(Vc[0], Pb0, O0); O0 = MFMA32(Vc[1], Pb1, O0);
    O1 = MFMA32(Vc[2], Pb0, O1); O1 = MFMA32(Vc[3], Pb1, O1);
    return __all(carry < 0x1p-134f);
}
__device__ __forceinline__ void attn_mfma(const Args& a, int u0, int ucnt, int ustride) {
    unsigned char* ws = a.ws;
    bf16* QS = (bf16*)(ws + WS_QS); const bf16* SK = (const bf16*)(ws + WS_SK); const bf16* VT = (const bf16*)((unsigned char*)a.out + 32 * MiB);
    const int lane = threadIdx.x & 63, r32 = lane & 31, hi = lane >> 5;
    const int kap = 16 * (r32 >> 4) + 8 * ((r32 >> 2) & 1) + 4 * ((r32 >> 3) & 1) + (r32 & 3);
    for (int uk = 0; uk < ucnt; ++uk) { const int u = u0 + uk * ustride;
        const int qb = u & 63, bh = u >> 6, h = bh & 15, b = bh >> 4;
        const size_t rowq = (size_t)b * SEQ + 32 * qb + r32;
        bf16* qp = QS + rowq * 2048 + 1024 + 64 * h;
        const bf16* kbase = SK + ((size_t)b * SEQ + kap) * 1024 + 64 * h + 8 * hi;
        const bf16* vbase = VT + ((size_t)bh * 64 + r32) * 2048 + 8 * hi;
        bf16x8_t Qf[4];
#pragma unroll
        for (int ks = 0; ks < 4; ++ks) Qf[ks] = *(const bf16x8_t*)(qp + 16 * ks + 8 * hi);
        f32x16 O0, O1;
#pragma unroll
        for (int j = 0; j < 16; ++j) { O0[j] = 0.f; O1[j] = 0.f; }
        float carry = 1.f;
        bf16x8_t KA[4], VA[4], KB[4], VB[4];
#define ATT_LOAD(K_, V_, kb_) do { _Pragma("unroll") for (int ks = 0; ks < 4; ++ks) K_[ks] = *(const bf16x8_t*)(kbase + (size_t)(32 * (kb_)) * 1024 + 16 * ks); \
        _Pragma("unroll") for (int i = 0; i < 4; ++i) V_[i] = *(const bf16x8_t*)(vbase + (size_t)(32 * (i >> 1)) * 2048 + 32 * (kb_) + 16 * (i & 1)); } while (0)
        ATT_LOAD(KA, VA, qb);
        int kb = qb;
        ATT_LOAD(KB, VB, kb > 0 ? kb - 1 : 0);
        if (!(attn_tile<true>(KA, VA, Qf, O0, O1, carry, r32, hi) || kb == 0)) {
            --kb;
#pragma unroll 1
            for (;;) {
                ATT_LOAD(KA, VA, kb > 0 ? kb - 1 : 0);
                if (attn_tile<false>(KB, VB, Qf, O0, O1, carry, r32, hi) || kb == 0) break;
                --kb;
                ATT_LOAD(KB, VB, kb > 0 ? kb - 1 : 0);
                if (attn_tile<false>(KA, VA, Qf, O0, O1, carry, r32, hi) || kb == 0) break;
                --kb;
            }
        }
#undef ATT_LOAD
#pragma unroll
        for (int a4 = 0; a4 < 4; ++a4) {
            u32x2_t x0, x1; x0.x = cvtpk(O0[4 * a4], O0[4 * a4 + 1]); x0.y = cvtpk(O0[4 * a4 + 2], O0[4 * a4 + 3]); x1.x = cvtpk(O1[4 * a4], O1[4 * a4 + 1]); x1.y = cvtpk(O1[4 * a4 + 2], O1[4 * a4 + 3]);
            *(u32x2_t*)(qp + 8 * a4 + 4 * hi) = x0; *(u32x2_t*)(qp + 32 + 8 * a4 + 4 * hi) = x1; }
    }
}

#define XB_TMO      128
#define XB_XCNT(j)  (256  + 64 * (j))
#define XB_XSUB(j)  (1280 + 64 * (j))
#define XB_XGEN(j)  (2304 + 64 * (j))
#define XB_TOP      3328
#define XB_TOPGEN   3392
#define XCD_BAR_WORDS 3456
#define XB_SPIN_CAP (1u << 18)

__device__ __forceinline__ unsigned xb_ld(unsigned* p)              { return __hip_atomic_load(p, __ATOMIC_RELAXED, __HIP_MEMORY_SCOPE_AGENT); }
__device__ __forceinline__ unsigned xb_add(unsigned* p, unsigned v) { return __hip_atomic_fetch_add(p, v, __ATOMIC_RELAXED, __HIP_MEMORY_SCOPE_AGENT); }
__device__ __forceinline__ unsigned xb_xcc_id() { return (unsigned)__builtin_amdgcn_s_getreg((3 << 11) | 20) & 0xFu; }
#define XB_SPIN(cond, bar) do { unsigned _sp = 0; while (cond) { __builtin_amdgcn_s_sleep(1); \
    if ((++_sp & 255u) == 0u) { if (xb_ld(&(bar)[XB_TMO])) break; if (_sp > XB_SPIN_CAP) { atomicAdd(&(bar)[XB_TMO], 1u); break; } } } } while (0)

struct XcdBarrier {
    unsigned* bar; unsigned x;
    volatile LAS unsigned* st;
};

__device__ __forceinline__ XcdBarrier xcd_barrier_post(unsigned* bar, volatile LAS unsigned* st) {
    XcdBarrier b; b.bar = bar; b.x = xb_xcc_id(); b.st = st;
    if (threadIdx.x == 0) (void)xb_add(&bar[XB_XCNT(b.x)], 1u);
    return b;
}
__device__ __forceinline__ void xcd_barrier_complete(unsigned* bar, unsigned x, unsigned& nloc, unsigned& nx) {
    const unsigned G = gridDim.x * gridDim.y * gridDim.z;
    unsigned sum, cnt, mine, sp = 0u;
    for (;;) {
        sum = 0u; cnt = 0u; mine = 0u;
#pragma unroll
        for (unsigned j = 0; j < 16; ++j) { const unsigned c = xb_ld(&bar[XB_XCNT(j)]); sum += c; cnt += (c > 0u) ? 1u : 0u; mine = (j == x) ? c : mine; }
        if (sum == G) break;
        __builtin_amdgcn_s_sleep(1);
        if ((++sp & 255u) == 0u) { if (xb_ld(&bar[XB_TMO])) break; if (sp > XB_SPIN_CAP) { atomicAdd(&bar[XB_TMO], 1u); break; } }
    }
    nloc = mine > 0u ? mine : 1u; nx = cnt > 0u ? cnt : 1u;
}

__device__ __forceinline__ void xcd_barrier(const XcdBarrier& b) {
    asm volatile("s_waitcnt vmcnt(0)" ::: "memory");
    __syncthreads();
    if (threadIdx.x == 0) {
        unsigned* bar = b.bar;
        __builtin_amdgcn_s_waitcnt(0);
        unsigned nloc = b.st[0], nx = b.st[1];
        if (nloc == 0u) { xcd_barrier_complete(bar, b.x, nloc, nx); b.st[0] = nloc; b.st[1] = nx; }
        const unsigned old = xb_add(&bar[XB_XSUB(b.x)], 1u);
        const unsigned gen = old / nloc;
        if (old + 1u == (gen + 1u) * nloc) {
            __builtin_amdgcn_fence(__ATOMIC_RELEASE, "agent");
            asm volatile("s_waitcnt vmcnt(0)" ::: "memory");
            const unsigned og = xb_add(&bar[XB_TOP], 1u);
            const unsigned tg = og / nx;
            if (og + 1u == (tg + 1u) * nx) xb_add(&bar[XB_TOPGEN], 1u);
            else XB_SPIN(xb_ld(&bar[XB_TOPGEN]) == tg, bar);
            __builtin_amdgcn_fence(__ATOMIC_ACQUIRE, "agent");
            xb_add(&bar[XB_XGEN(b.x)], 1u);
            asm volatile("s_waitcnt vmcnt(0)" ::: "memory");
        } else {
            XB_SPIN(xb_ld(&bar[XB_XGEN(b.x)]) == gen, bar);
            __builtin_amdgcn_fence(__ATOMIC_ACQUIRE, "agent");
            asm volatile("s_waitcnt vmcnt(0)" ::: "memory");
        }
    }
    __syncthreads();
}

__global__ void __launch_bounds__(NTHREADS, 2) hybrid_fwd(Args args) {
    extern __shared__ __attribute__((aligned(16))) unsigned char lds_raw[];
    LAS unsigned char* lds = (LAS unsigned char*)lds_raw;
    cg::grid_group grid = cg::this_grid();
    const int tid = threadIdx.x, lane = tid & 63, wave = __builtin_amdgcn_readfirstlane(tid >> 6);
    const int G = gridDim.x;
    unsigned char* ws = args.ws;
    const int lo = args.ph_lo, hi = args.ph_hi;
    volatile LAS unsigned* MISC = (volatile LAS unsigned*)(lds + MISC_OFF);
    if (tid < 2) MISC[tid] = 0u;
    __syncthreads();
    const XcdBarrier bar = xcd_barrier_post((unsigned*)ws, MISC);
#define IN(k) (lo <= (k) && (k) < hi)
#define SEAM(k) do { if (IN(k) && IN((k) + 1)) { xcd_barrier(bar); } } while (0)
    if (lo < 0) grid.sync();
    if (IN(0)) { p0_prologue<0>(args, lds, wave, lane, (int)blockIdx.x * NWAVES + wave, G * NWAVES); asm volatile("s_waitcnt vmcnt(0) lgkmcnt(0)" ::: "memory"); __syncthreads(); }
    SEAM(0);
    if (IN(1)) {
        pg8::Gemm g{(const pg8::bf16_t*)(ws + WS_H), (const pg8::bf16_t*)(ws + WS_WIN), M, 6144, D, D}; pg8::StaticOrder S; S.init(M, 6144, G, (int)blockIdx.x);
        pg8::EpiProj E{(pg8::bf16_t*)(ws + WS_QS), (pg8::bf16_t*)(ws + WS_VH), (pg8::bf16_t*)(ws + WS_SK), (pg8::bf16_t*)((unsigned char*)args.out + 32 * MiB), ws + WS_GH, ws + WS_GA, ws + WS_GB, (_Float16*)args.out,
                       args.in[3], args.in[5], args.in[6], 0};
        pg8::gemm_phase<pg8::EpiProj, pg8::StaticOrder, true, true>(lds, g, S, E);
        pg8::Gemm g2{(const pg8::bf16_t*)(ws + WS_WIN) + (size_t)6144 * 1024, (const pg8::bf16_t*)(ws + WS_H), 1024, M, D, D}; pg8::StaticOrder S2; S2.init(1024, M, G, (int)blockIdx.x);
        pg8::EpiVT E2{(pg8::bf16_t*)((unsigned char*)args.out + 32 * MiB)};
        pg8::gemm_phase<pg8::EpiVT, pg8::StaticOrder, true, true>(lds, g2, S2, E2);
    }
    SEAM(1);
    if (IN(2)) {
        const pg8::Gemm gg{(const pg8::bf16_t*)(ws + WS_H), (const pg8::bf16_t*)(ws + WS_WIN) + (size_t)7168 * 1024, M, 2048, D, D};
        const pg8::EpiProj EG{(pg8::bf16_t*)(ws + WS_QS), (pg8::bf16_t*)(ws + WS_VH), (pg8::bf16_t*)(ws + WS_SK), (pg8::bf16_t*)((unsigned char*)args.out + 32 * MiB), ws + WS_GH, ws + WS_GA, ws + WS_GB, (_Float16*)args.out,
                              args.in[3], args.in[5], args.in[6], 28};
        constexpr int NUNITS = BATCH * 16 * (SEQ / 32);
        if (G == 256) {
            pg8::ListOrder S; S.s.init(M, 2048, 256, 0);
            if ((int)blockIdx.x < 64) { hgrn_v2(args, lds, (int)blockIdx.x, 64); if (wave < 6) p0_prologue<1>(args, lds, wave, lane, 1536 + (int)blockIdx.x * 6 + wave, 1920); S.l0 = -1; S.l1 = -1; S.l2 = -1; }
            else { const int idx = (int)blockIdx.x - 64;
                if (idx < 128) attn_mfma(args, idx * 40 + wave, 5, NWAVES); else attn_mfma(args, 5120 + (idx - 128) * 48 + wave, 6, NWAVES);
                p0_prologue<1>(args, lds, wave, lane, idx * NWAVES + wave, 1920);
                S.l0 = idx; S.l1 = 192 + idx; S.l2 = idx < 128 ? 384 + idx : -1; }
            asm volatile("s_waitcnt vmcnt(0) lgkmcnt(0)" ::: "memory"); __syncthreads();
            pg8::gemm_phase<pg8::EpiProj, pg8::ListOrder, true, true>(lds, gg, S, EG);
        } else {
            const int gw = (int)blockIdx.x * NWAVES + wave, ngw = G * NWAVES;
            hgrn_v2(args, lds, (int)blockIdx.x, G); attn_mfma(args, gw, (NUNITS - gw + ngw - 1) / ngw, ngw); p0_prologue<1>(args, lds, wave, lane, gw, ngw);
            asm volatile("s_waitcnt vmcnt(0) lgkmcnt(0)" ::: "memory"); __syncthreads();
            pg8::StaticOrder S; S.init(M, 2048, G, (int)blockIdx.x);
            pg8::gemm_phase<pg8::EpiProj, pg8::StaticOrder, true, true>(lds, gg, S, EG);
        }
        __syncthreads();
    }
    SEAM(2);
    if (IN(3)) {
        pg8::Gemm g{(const pg8::bf16_t*)(ws + WS_QS), (const pg8::bf16_t*)(ws + WS_WHS), M, D, 1024, 2048}; pg8::SplitOrder S; S.s.init(M, D, G, (int)blockIdx.x);
        pg8::EpiMix E{ws + WS_GA, ws + WS_GB, (pg8::bf16_t*)(ws + WS_MIXED)};
        pg8::gemm_phase<pg8::EpiMix, pg8::SplitOrder, true, true>(lds, g, S, E);
    }
    SEAM(3);
    if (IN(4)) {
        pg8::Gemm g{(const pg8::bf16_t*)(ws + WS_MIXED), (const pg8::bf16_t*)(ws + WS_WO), M, D, D, D}; pg8::StaticOrder S; S.init(M, D, G, (int)blockIdx.x);
        pg8::EpiRes1 E{args.in[0], (pg8::bf16_t*)(ws + WS_GA), (pg8::bf16_t*)(ws + WS_X1B), (float*)(ws + WS_SSQ)};
        pg8::gemm_phase<pg8::EpiRes1, pg8::StaticOrder, true, true>(lds, g, S, E);
    }
    SEAM(4);
    if (IN(5)) {
        pg8::Gemm g{(const pg8::bf16_t*)(ws + WS_X1B), (const pg8::bf16_t*)(ws + WS_WF1), M, 2 * FFH, D, D}; pg8::StaticOrder S; S.init(M, 2 * FFH, G, (int)blockIdx.x);
        pg8::EpiSwiglu E{(const float*)(ws + WS_SSQ), (pg8::bf16_t*)(ws + WS_ACT)};
        pg8::gemm_phase<pg8::EpiSwiglu, pg8::StaticOrder, true, true>(lds, g, S, E);
    }
    SEAM(5);
    if (IN(6)) {
        pg8::Gemm g{(const pg8::bf16_t*)(ws + WS_ACT), (const pg8::bf16_t*)(ws + WS_WF2), M, D, FFH, FFH}; pg8::StaticOrder S; S.init(M, D, G, (int)blockIdx.x);
        pg8::EpiRes2 E{args.in[0], (const pg8::bf16_t*)(ws + WS_GA), args.out};
        pg8::gemm_phase<pg8::EpiRes2, pg8::StaticOrder, true, true>(lds, g, S, E);
    }
#undef IN
#undef SEAM
}

#ifndef MK_N_LAUNCHES
#define MK_N_LAUNCHES 1
#endif
extern "C" void kernel_launch(void* const* d_in, const int* in_sizes, int n_in, void* d_out, int out_size, void* d_ws, size_t ws_size, hipStream_t stream) {
    static int grid = 0;
    if (grid == 0) {
        int dev = 0, cus = 0, per_cu = 0;
        if (n_in != 13 || ws_size < WS_END) { fprintf(stderr, "kernel_launch: unexpected inputs / workspace (%d, %zu)\n", n_in, ws_size); grid = -1; return; }
        hipGetDevice(&dev); hipDeviceGetAttribute(&cus, hipDeviceAttributeMultiprocessorCount, dev);
        if (hipFuncSetAttribute((const void*)hybrid_fwd, hipFuncAttributeMaxDynamicSharedMemorySize, LDS_BYTES) != hipSuccess) { fprintf(stderr, "kernel_launch: hipFuncSetAttribute failed\n"); grid = -1; return; }
        if (hipOccupancyMaxActiveBlocksPerMultiprocessor(&per_cu, (const void*)hybrid_fwd, NTHREADS, LDS_BYTES) != hipSuccess || per_cu < 1) { fprintf(stderr, "kernel_launch: occupancy query says %d\n", per_cu); per_cu = 1; }
        (void)hipGetLastError();
        grid = cus * per_cu;
    }
    if (grid < 0) return;
    if (hipMemsetAsync(d_ws, 0, 16384, stream) != hipSuccess) { fprintf(stderr, "kernel_launch: memset of the barrier words failed\n"); return; }
    Args a{};
    for (int i = 0; i < 13; ++i) a.in[i] = (const float*)d_in[i];
    a.out = (float*)d_out; a.ws = (unsigned char*)d_ws;
#if MK_N_LAUNCHES == 1
    a.ph_lo = 0; a.ph_hi = 7;
    void* kargs[] = {&a};
    hipError_t e = hipLaunchCooperativeKernel((const void*)hybrid_fwd, dim3(grid), dim3(NTHREADS), kargs, LDS_BYTES, stream);
    if (e != hipSuccess) fprintf(stderr, "cooperative launch failed: %s (grid %d)\n", hipGetErrorString(e), grid);
#else
    for (int p = 0; p < 7; ++p) { a.ph_lo = p; a.ph_hi = p + 1; hipLaunchKernelGGL(hybrid_fwd, dim3(grid), dim3(NTHREADS), LDS_BYTES, stream, a); }
#endif
}
```

```cpp
#include <hip/hip_runtime.h>
#include <hip/hip_cooperative_groups.h>
#include <cstdio>
#include <cstdint>
namespace cg = cooperative_groups;
namespace pg8 {
#define PG8_LAS __attribute__((address_space(3)))
typedef unsigned short bf16_t;
typedef short bf16x8 __attribute__((ext_vector_type(8)));
typedef float f32x4 __attribute__((ext_vector_type(4)));
typedef unsigned u32x4 __attribute__((ext_vector_type(4)));
constexpr int BM = 256, BK = 64, HALF = 128, HTB = HALF * BK * 2  , STAGE_BYTES = 8 * HTB, NXCD = 8, WGM = 8;

__host__ __device__ __forceinline__ int lds_byte(int r, int c) { const int st = (r >> 4) * 2 + (c >> 5), rr = r & 15, cc = c & 31, ob = rr * 64 + cc * 2; return st * 1024 + (ob ^ (((ob >> 9) & 1) << 5)); }
__host__ __device__ __forceinline__ void stage_rc(int b, int& R, int& C) { const int st = b / 1024, sb = b % 1024, swz = sb ^ (((sb >> 9) & 1) << 5); R = (st >> 1) * 16 + swz / 64; C = (st & 1) * 32 + (swz % 64) / 2; }
__host__ __device__ __forceinline__ int perm32(int rho) { const int n = rho >> 4, i = rho & 15; return 8 * (i >> 2) + 4 * n + (i & 3); }

struct Unit { int pm, pn, kh; };
struct Gemm { const bf16_t* A; const bf16_t* Bt; int M, N, K, ld; };

struct StaticOrder {
    int nM, nN, nwg, G, c;
    __host__ __device__ void init(int M, int N, int G_, int c_) { nM = M / BM; nN = N / BM; nwg = nM * nN; G = G_; c = c_; }
    __host__ __device__ bool next(int i, Unit& u) const { const long L = (long)i * G + c; if (L >= nwg) return false; return unit_of((int)L, u); }
    __host__ __device__ bool unit_of(int L, Unit& u) const {
        int wgid = L; { const int q = nwg / NXCD, r = nwg % NXCD, xcd = wgid % NXCD, off = wgid / NXCD; wgid = (xcd < r ? xcd * (q + 1) : r * (q + 1) + (xcd - r) * q) + off; }
        const int nig = WGM * nN, gid = wgid / nig, fm = gid * WGM, gsz = (nM - fm) < WGM ? (nM - fm) : WGM;
        u.pm = fm + ((wgid % nig) % gsz); u.pn = (wgid % nig) / gsz; u.kh = 0; return true;
    }
    __device__ __forceinline__ void a_ready(const Unit&) const {}
    __device__ __forceinline__ void done(const Unit&) const {}
};
struct ListOrder {
    StaticOrder s; int l0, l1, l2;
    __host__ __device__ bool next(int i, Unit& u) const { const int L = i == 0 ? l0 : (i == 1 ? l1 : (i == 2 ? l2 : -1)); if (L < 0 || L >= s.nwg) return false; return s.unit_of(L, u); }
    __device__ __forceinline__ void a_ready(const Unit&) const {}
    __device__ __forceinline__ void done(const Unit&) const {}
};
struct SplitOrder {
    StaticOrder s;
    __host__ __device__ bool next(int i, Unit& u) const { const bool ok = s.next(i >> 1, u); u.kh = i & 1; return ok; }
    __device__ __forceinline__ void a_ready(const Unit&) const {}
    __device__ __forceinline__ void done(const Unit&) const {}
};
typedef float f32x2_cv __attribute__((ext_vector_type(2))); typedef __bf16 bf16x2_cvv __attribute__((ext_vector_type(2)));
__device__ __forceinline__ unsigned cvt_pk_bf16(float lo, float hi) { const f32x2_cv v = {lo, hi}; return __builtin_bit_cast(unsigned, __builtin_convertvector(v, bf16x2_cvv)); }
typedef float f32x2 __attribute__((ext_vector_type(2)));
typedef _Float16 f16x8 __attribute__((ext_vector_type(8)));
typedef unsigned u32x2 __attribute__((ext_vector_type(2)));
__device__ __forceinline__ float sigm(float x) { return __builtin_amdgcn_rcpf(1.0f + __expf(-x)); }
__device__ __forceinline__ unsigned q8(float s) { float q = s * 255.0f + 0.5f; q = q < 1.0f ? 1.0f : (q > 255.0f ? 255.0f : q); return (unsigned)q; }
__device__ __forceinline__ u32x4 pack8_bf16(const float (&o)[8]) { u32x4 w; w.x = cvt_pk_bf16(o[0], o[1]); w.y = cvt_pk_bf16(o[2], o[3]); w.z = cvt_pk_bf16(o[4], o[5]); w.w = cvt_pk_bf16(o[6], o[7]); return w; }
__device__ __forceinline__ u32x2 pack8_u8(const float (&o)[8]) { u32x2 w; unsigned a = 0u, c = 0u;
#pragma unroll
    for (int k = 0; k < 4; ++k) { a = __builtin_amdgcn_cvt_pk_u8_f32(fmaxf(o[k] * 255.0f, 1.0f), k, a); c = __builtin_amdgcn_cvt_pk_u8_f32(fmaxf(o[4 + k] * 255.0f, 1.0f), k, c); }
    w.x = a; w.y = c; return w; }

struct EpiProj {
    static constexpr bool PERM = true, AFTER_DRAIN = false, KSPLIT = false;
    bf16_t* QS; bf16_t* VH; bf16_t* SK; bf16_t* SV; unsigned char* GH; unsigned char* GA; unsigned char* GB; _Float16* LOGF;
    const float* lbl; const float* qg; const float* kg; int pn0;
    __device__ __forceinline__ void operator()(const f32x4 (&acc)[2][2][4][2], const Unit& u, int wr, int wc, int fr, int fq) const {
        const int sec = (u.pn + pn0) >> 2, ct = (u.pn & 3) * 256;
        const int row0 = u.pm * BM + wr * 64 + fr;
        if (sec == 4 || sec == 5) {
            const int head = (u.pn & 3) * 4 + wc; const float* gp = (sec == 4 ? qg : kg) + head * 64 + 8 * fq;
            float gn[2][8];
#pragma unroll
            for (int bj = 0; bj < 2; ++bj) { const f32x4 a = *(const f32x4*)(gp + 32 * bj), b = *(const f32x4*)(gp + 32 * bj + 4);
                gn[bj][0] = a[0]; gn[bj][1] = a[1]; gn[bj][2] = a[2]; gn[bj][3] = a[3]; gn[bj][4] = b[0]; gn[bj][5] = b[1]; gn[bj][6] = b[2]; gn[bj][7] = b[3]; }
            const float sc = (sec == 4) ? 0.125f * 1.4426950408889634f : 1.0f;
#pragma unroll
            for (int ai = 0; ai < 2; ++ai)
#pragma unroll
                for (int m = 0; m < 4; ++m) {
                    float ss = 0.f;
#pragma unroll
                    for (int bj = 0; bj < 2; ++bj)
#pragma unroll
                        for (int n = 0; n < 2; ++n) { const f32x4 x = acc[ai][bj][m][n]; ss += (x[0] * x[0] + x[1] * x[1]) + (x[2] * x[2] + x[3] * x[3]); }
                    ss += __shfl_xor(ss, 16); ss += __shfl_xor(ss, 32);
                    const float rstd = __builtin_amdgcn_rsqf(ss * (1.0f / 64.0f) + 1e-6f) * sc;
                    const size_t row = (size_t)(row0 + ai * HALF + m * 16);
#pragma unroll
                    for (int bj = 0; bj < 2; ++bj) { float o[8];
#pragma unroll
                        for (int k = 0; k < 8; ++k) o[k] = acc[ai][bj][m][k >> 2][k & 3] * rstd * gn[bj][k];
                        bf16_t* dst = (sec == 4) ? (QS + row * 2048 + 1024 + head * 64 + 32 * bj + 8 * fq) : (SK + row * 1024 + head * 64 + 32 * bj + 8 * fq);
                        *(u32x4*)dst = pack8_bf16(o); }
                }
            return;
        }
        switch (sec) {
            case 0: store_kind<0>(acc, row0, ct, wc, fq, nullptr); break;
            case 1: store_kind<1>(acc, row0, ct, wc, fq, nullptr); break;
            case 2: store_kind<2>(acc, row0, ct, wc, fq, nullptr); break;
            case 3: store_kind<3>(acc, row0, ct, wc, fq, GH); break;
            case 6: store_kind<6>(acc, row0, ct, wc, fq, nullptr); break;
            case 7: store_kind<3>(acc, row0, ct, wc, fq, GA); break;
            default: store_kind<3>(acc, row0, ct, wc, fq, GB); break;
        }
    }
    template <int KIND> __device__ __forceinline__ void store_kind(const f32x4 (&acc)[2][2][4][2], int row0, int ct, int wc, int fq, unsigned char* g8) const {
#pragma unroll
        for (int bj = 0; bj < 2; ++bj) {
            const int col = ct + bj * HALF + wc * 32 + 8 * fq;
            float lb[8];
            if (KIND == 1) {
#pragma unroll
                for (int k = 0; k < 8; ++k) lb[k] = __builtin_amdgcn_rcpf(1.0f + __expf(lbl[1024 + col + k] - lbl[col + k]));
            }
#pragma unroll
            for (int ai = 0; ai < 2; ++ai)
#pragma unroll
                for (int m = 0; m < 4; ++m) {
                    const size_t row = (size_t)(row0 + ai * HALF + m * 16);
                    float o[8];
#pragma unroll
                    for (int k = 0; k < 8; ++k) o[k] = acc[ai][bj][m][k >> 2][k & 3];
                    if (KIND == 0) { *(u32x4*)(QS + row * 2048 + col) = pack8_bf16(o); }
                    else if (KIND == 2) { *(u32x4*)(VH + row * 1024 + col) = pack8_bf16(o); }
                    else if (KIND == 6) { bf16_t* vt = SV + ((size_t)((row >> 11) * 16 + (col >> 6)) * 64 + (col & 63)) * 2048 + (row & 2047);
#pragma unroll
                        for (int k = 0; k < 8; ++k) vt[(size_t)k * 2048] = (bf16_t)(cvt_pk_bf16(o[k], o[k]) & 0xffffu); }
                    else if (KIND == 1) { f16x8 g;
#pragma unroll
                        for (int k = 0; k < 8; ++k) g[k] = (_Float16)__logf(lb[k] + (1.0f - lb[k]) * sigm(o[k]));
                        *(f16x8*)(LOGF + row * 1024 + col) = g; }
                    else {
#pragma unroll
                        for (int k = 0; k < 8; ++k) o[k] = sigm(o[k]);
                        *(u32x2*)(g8 + row * 1024 + col) = pack8_u8(o); }
                }
        }
    }
};

struct EpiVT {
    static constexpr bool PERM = true, AFTER_DRAIN = false, KSPLIT = false;
    bf16_t* VT;
    __device__ __forceinline__ void operator()(const f32x4 (&acc)[2][2][4][2], const Unit& u, int wr, int wc, int fr, int fq) const {
        const int row0 = u.pm * BM + wr * 64 + fr;
#pragma unroll
        for (int ai = 0; ai < 2; ++ai)
#pragma unroll
            for (int m = 0; m < 4; ++m)
#pragma unroll
                for (int bj = 0; bj < 2; ++bj) {
                    const int r = row0 + ai * HALF + m * 16, c = u.pn * BM + bj * HALF + wc * 32 + 8 * fq;
                    float o[8];
#pragma unroll
                    for (int k = 0; k < 8; ++k) o[k] = acc[ai][bj][m][k >> 2][k & 3];
                    *(u32x4*)(VT + ((size_t)((c >> 11) * 16 + (r >> 6)) * 64 + (r & 63)) * 2048 + (c & 2047)) = pack8_bf16(o);
                }
    }
};
struct EpiMix {
    static constexpr bool PERM = true, AFTER_DRAIN = false, KSPLIT = true;
    const unsigned char* GA; const unsigned char* GB; bf16_t* MIXED;
    __device__ __forceinline__ void half0(f32x4 (&acc)[2][2][4][2], const Unit& u, int wr, int wc, int fr, int fq) const {
        const int row0 = u.pm * BM + wr * 64 + fr;
#pragma unroll
        for (int ai = 0; ai < 2; ++ai)
#pragma unroll
            for (int m = 0; m < 4; ++m)
#pragma unroll
                for (int bj = 0; bj < 2; ++bj) {
                    const size_t off = (size_t)(row0 + ai * HALF + m * 16) * 1024 + u.pn * BM + bj * HALF + wc * 32 + 8 * fq;
                    const u32x2 a = *(const u32x2*)(GA + off), b = *(const u32x2*)(GB + off);
#pragma unroll
                    for (int k = 0; k < 8; ++k) { const float qa = (float)((a[k >> 2] >> (8 * (k & 3))) & 255u), qb = (float)((b[k >> 2] >> (8 * (k & 3))) & 255u);
                        acc[ai][bj][m][k >> 2][k & 3] *= qa * __builtin_amdgcn_rcpf(qb); }
                    if (bj == 1 && (m & 1)) asm volatile("" ::: "memory");
                }
    }
    __device__ __forceinline__ void operator()(f32x4 (&acc)[2][2][4][2], const Unit& u, int wr, int wc, int fr, int fq) const {
        if (u.kh == 0) { half0(acc, u, wr, wc, fr, fq); return; }
        const int row0 = u.pm * BM + wr * 64 + fr;
        u32x2 gbv[2][4][2];
#pragma unroll
        for (int ai = 0; ai < 2; ++ai)
#pragma unroll
            for (int m = 0; m < 4; ++m)
#pragma unroll
                for (int bj = 0; bj < 2; ++bj) gbv[ai][m][bj] = *(const u32x2*)(GB + (size_t)(row0 + ai * HALF + m * 16) * 1024 + u.pn * BM + bj * HALF + wc * 32 + 8 * fq);
#pragma unroll
        for (int ai = 0; ai < 2; ++ai)
#pragma unroll
            for (int m = 0; m < 4; ++m)
#pragma unroll
                for (int bj = 0; bj < 2; ++bj) {
                    const size_t off = (size_t)(row0 + ai * HALF + m * 16) * 1024 + u.pn * BM + bj * HALF + wc * 32 + 8 * fq;
                    const u32x2 b = gbv[ai][m][bj]; float o[8];
#pragma unroll
                    for (int k = 0; k < 8; ++k) { const float qb = (float)((b[k >> 2] >> (8 * (k & 3))) & 255u); o[k] = acc[ai][bj][m][k >> 2][k & 3] * (qb * (1.0f / 255.0f)); }
                    *(u32x4*)(MIXED + off) = pack8_bf16(o);
                }
    }
};
struct EpiRes1 {
    static constexpr bool PERM = true, AFTER_DRAIN = false, KSPLIT = false;
    const float* x; bf16_t* DL; bf16_t* X1B; float* SSQ;
    __device__ __forceinline__ void operator()(const f32x4 (&acc)[2][2][4][2], const Unit& u, int wr, int wc, int fr, int fq) const {
        const int row0 = u.pm * BM + wr * 64 + fr;
#pragma unroll
        for (int ai = 0; ai < 2; ++ai)
#pragma unroll
            for (int mp = 0; mp < 2; ++mp) {
                f32x4 xv[2][2][2];
#pragma unroll
                for (int mm = 0; mm < 2; ++mm)
#pragma unroll
                    for (int bj = 0; bj < 2; ++bj) { const size_t off = (size_t)(row0 + ai * HALF + (2 * mp + mm) * 16) * 1024 + u.pn * BM + bj * HALF + wc * 32 + 8 * fq;
                        xv[mm][bj][0] = *(const f32x4*)(x + off); xv[mm][bj][1] = *(const f32x4*)(x + off + 4); }
#pragma unroll
                for (int mm = 0; mm < 2; ++mm) {
                    const int m = 2 * mp + mm; const int row = row0 + ai * HALF + m * 16; float ss = 0.f;
#pragma unroll
                    for (int bj = 0; bj < 2; ++bj) {
                        const size_t off = (size_t)row * 1024 + u.pn * BM + bj * HALF + wc * 32 + 8 * fq;
                        const f32x4 a0 = acc[ai][bj][m][0], a1 = acc[ai][bj][m][1];
                        const f32x4 v0 = xv[mm][bj][0] + a0, v1 = xv[mm][bj][1] + a1;
                        u32x4 dw; dw.x = cvt_pk_bf16(a0[0], a0[1]); dw.y = cvt_pk_bf16(a0[2], a0[3]); dw.z = cvt_pk_bf16(a1[0], a1[1]); dw.w = cvt_pk_bf16(a1[2], a1[3]); *(u32x4*)(DL + off) = dw;
                        u32x4 w; w.x = cvt_pk_bf16(v0[0], v0[1]); w.y = cvt_pk_bf16(v0[2], v0[3]); w.z = cvt_pk_bf16(v1[0], v1[1]); w.w = cvt_pk_bf16(v1[2], v1[3]);
                        *(u32x4*)(X1B + off) = w;
                        ss += (v0[0] * v0[0] + v0[1] * v0[1]) + (v0[2] * v0[2] + v0[3] * v0[3]) + (v1[0] * v1[0] + v1[1] * v1[1]) + (v1[2] * v1[2] + v1[3] * v1[3]);
                    }
                    ss += __shfl_xor(ss, 16); ss += __shfl_xor(ss, 32);
                    if (fq == 0) SSQ[(size_t)row * 16 + u.pn * 4 + wc] = ss;
                }
            }
    }
};
struct EpiSwiglu {
    static constexpr bool PERM = true, AFTER_DRAIN = false, KSPLIT = false;
    const float* SSQ; bf16_t* ACT;
    __device__ __forceinline__ void operator()(const f32x4 (&acc)[2][2][4][2], const Unit& u, int wr, int wc, int fr, int fq) const {
        const int row0 = u.pm * BM + wr * 64 + fr;
        f32x4 sq[2][4];
#pragma unroll
        for (int ai = 0; ai < 2; ++ai)
#pragma unroll
            for (int m = 0; m < 4; ++m) sq[ai][m] = *(const f32x4*)(SSQ + (size_t)(row0 + ai * HALF + m * 16) * 16 + 4 * fq);
#pragma unroll
        for (int ai = 0; ai < 2; ++ai)
#pragma unroll
            for (int m = 0; m < 4; ++m) {
                const int row = row0 + ai * HALF + m * 16;
                float ss = (sq[ai][m][0] + sq[ai][m][1]) + (sq[ai][m][2] + sq[ai][m][3]);
                ss += __shfl_xor(ss, 16); ss += __shfl_xor(ss, 32);
                const float rstd = __builtin_amdgcn_rsqf(ss * (1.0f / 1024.0f) + 1e-6f);
                float o[8];
#pragma unroll
                for (int k = 0; k < 8; ++k) { const float g = acc[ai][0][m][k >> 2][k & 3] * rstd, up = acc[ai][1][m][k >> 2][k & 3] * rstd; o[k] = g * sigm(g) * up; }
                *(u32x4*)(ACT + (size_t)row * 2816 + u.pn * 128 + wc * 32 + 8 * fq) = pack8_bf16(o);
            }
    }
};
struct EpiRes2 {
    static constexpr bool PERM = true, AFTER_DRAIN = false, KSPLIT = false;
    const float* x; const bf16_t* DL; float* out;
    __device__ __forceinline__ void operator()(const f32x4 (&acc)[2][2][4][2], const Unit& u, int wr, int wc, int fr, int fq) const {
        const int row0 = u.pm * BM + wr * 64 + fr;
#pragma unroll
        for (int ai = 0; ai < 2; ++ai)
#pragma unroll
            for (int mp = 0; mp < 2; ++mp) {
                f32x4 xv[2][2][2]; u32x4 dv[2][2];
#pragma unroll
                for (int mm = 0; mm < 2; ++mm)
#pragma unroll
                    for (int bj = 0; bj < 2; ++bj) { const size_t off = (size_t)(row0 + ai * HALF + (2 * mp + mm) * 16) * 1024 + u.pn * BM + bj * HALF + wc * 32 + 8 * fq;
                        xv[mm][bj][0] = *(const f32x4*)(x + off); xv[mm][bj][1] = *(const f32x4*)(x + off + 4); dv[mm][bj] = *(const u32x4*)(DL + off); }
#pragma unroll
                for (int mm = 0; mm < 2; ++mm)
#pragma unroll
                    for (int bj = 0; bj < 2; ++bj) { const int m = 2 * mp + mm;
                        const size_t off = (size_t)(row0 + ai * HALF + m * 16) * 1024 + u.pn * BM + bj * HALF + wc * 32 + 8 * fq;
                        const u32x4 dw = dv[mm][bj];
                        f32x4 d0, d1; d0[0] = __builtin_bit_cast(float, dw.x << 16); d0[1] = __builtin_bit_cast(float, dw.x & 0xffff0000u); d0[2] = __builtin_bit_cast(float, dw.y << 16); d0[3] = __builtin_bit_cast(float, dw.y & 0xffff0000u);
                        d1[0] = __builtin_bit_cast(float, dw.z << 16); d1[1] = __builtin_bit_cast(float, dw.z & 0xffff0000u); d1[2] = __builtin_bit_cast(float, dw.w << 16); d1[3] = __builtin_bit_cast(float, dw.w & 0xffff0000u);
                        const f32x4 v0 = (xv[mm][bj][0] + d0) + acc[ai][bj][m][0], v1 = (xv[mm][bj][1] + d1) + acc[ai][bj][m][1];
                        *(f32x4*)(out + off) = v0; *(f32x4*)(out + off + 4) = v1; }
            }
    }
};

template <class Epi, class Sched, bool ALIGN_EPI = false, bool SP2 = false>
__device__ __forceinline__ void gemm_phase(PG8_LAS unsigned char* lds, const Gemm g, const Sched& S, const Epi& E) {
    int tid_ = threadIdx.x; asm volatile("" : "+v"(tid_));
    const int tid = tid_, wid = __builtin_amdgcn_readfirstlane(tid >> 6), lane = tid & 63, wr = wid >> 2, wc = wid & 3, fr = lane & 15, fq = lane >> 4;
    const int K = g.K, nt = K / BK;
    unsigned voffA[2], voffB[2];
#pragma unroll
    for (int i = 0; i < 2; ++i) { int R, C; stage_rc(tid * 16 + i * 8192, R, C); const int Rb = Epi::PERM ? ((R & ~31) + perm32(R & 31)) : R;
        voffA[i] = (unsigned)(R * g.ld + C) * 2u; voffB[i] = (unsigned)(Rb * g.ld + C) * 2u; }
    const size_t kstep = (size_t)(BK * 2);
    const size_t hstep = (size_t)HALF * g.ld * 2; const size_t khb = (size_t)K * 2;
    const size_t tstep = 2 * hstep;
    const unsigned ldsw = (unsigned)wid * 1024u;
    const int aoff = lds_byte(wr * 64 + fr, fq * 8), boff = lds_byte(wc * 32 + fr, fq * 8);
#define PG8_SA(b, h) (((b) * 2 + (h)) * HTB)
#define PG8_SB(b, h) ((4 + (b) * 2 + (h)) * HTB)
#define PG8_STAGE(bufoff, gbase, voff) do { _Pragma("unroll") for (int _i = 0; _i < 2; ++_i) \
        __builtin_amdgcn_global_load_lds((const unsigned*)((const char*)(gbase) + (voff)[_i]), (PG8_LAS unsigned*)(lds + (bufoff) + ldsw + _i * 8192), 16, 0, 0); } while (0)
#define PG8_LDA(dst, b, h) do { _Pragma("unroll") for (int m = 0; m < 4; ++m) _Pragma("unroll") for (int k = 0; k < 2; ++k) dst[m][k] = *(const PG8_LAS bf16x8*)(lds + PG8_SA(b, h) + aoff + m * 2048 + k * 1024); } while (0)
#define PG8_LDB(dst, b, h) do { _Pragma("unroll") for (int n = 0; n < 2; ++n) _Pragma("unroll") for (int k = 0; k < 2; ++k) dst[n][k] = *(const PG8_LAS bf16x8*)(lds + PG8_SB(b, h) + boff + n * 2048 + k * 1024); } while (0)
#define PG8_MMA(ai, bj, At, Bt) do { __builtin_amdgcn_s_setprio(1); _Pragma("unroll") for (int m = 0; m < 4; ++m) _Pragma("unroll") for (int n = 0; n < 2; ++n) _Pragma("unroll") for (int k = 0; k < 2; ++k) \
        acc[ai][bj][m][n] = __builtin_amdgcn_mfma_f32_16x16x32_bf16(Bt[n][k], At[m][k], acc[ai][bj][m][n], 0, 0, 0); __builtin_amdgcn_s_setprio(0); } while (0)
#define PG8_WAIT_V(n) asm volatile("s_waitcnt vmcnt(" #n ")" ::: "memory")
#define PG8_WAIT_L(n) asm volatile("s_waitcnt lgkmcnt(" #n ")" ::: "memory")
#define PG8_BAR __builtin_amdgcn_s_barrier()
#define PG8_SCHED __builtin_amdgcn_sched_barrier(0)
    Unit cur, nxt; int ui = 0;
    if (!S.next(0, cur)) return;
    f32x4 acc[2][2][4][2];
#pragma unroll
    for (int a = 0; a < 2; ++a)
#pragma unroll
        for (int b = 0; b < 2; ++b)
#pragma unroll
            for (int m = 0; m < 4; ++m)
#pragma unroll
                for (int n = 0; n < 2; ++n) acc[a][b][m][n] = (f32x4){0.f, 0.f, 0.f, 0.f};
    bf16x8 At[4][2], B0[2][2], B1[2][2];
    const char* cA = (const char*)g.A + (size_t)cur.pm * tstep + cur.kh * khb; const char* cB = (const char*)g.Bt + (size_t)cur.pn * tstep + cur.kh * khb;
    S.a_ready(cur);
    if constexpr (SP2) {
        PG8_STAGE(PG8_SB(0, 0), cB, voffB); PG8_STAGE(PG8_SB(0, 1), cB + hstep, voffB); PG8_STAGE(PG8_SA(0, 0), cA, voffA); PG8_STAGE(PG8_SA(0, 1), cA + hstep, voffA);
        if (wr == 1) PG8_BAR;
        PG8_WAIT_V(2); PG8_BAR;
        PG8_STAGE(PG8_SB(1, 0), cB + kstep, voffB); PG8_STAGE(PG8_SA(1, 0), cA + kstep, voffA); PG8_STAGE(PG8_SB(1, 1), cB + hstep + kstep, voffB);
        PG8_WAIT_V(6); PG8_BAR;
    } else {
        PG8_STAGE(PG8_SB(0, 0), cB, voffB); PG8_STAGE(PG8_SA(0, 0), cA, voffA); PG8_STAGE(PG8_SB(0, 1), cB + hstep, voffB); PG8_STAGE(PG8_SA(0, 1), cA + hstep, voffA);
        if (wr == 1) PG8_BAR;
        PG8_WAIT_V(4); PG8_BAR;
        PG8_STAGE(PG8_SB(1, 0), cB + kstep, voffB); PG8_STAGE(PG8_SA(1, 0), cA + kstep, voffA); PG8_STAGE(PG8_SB(1, 1), cB + hstep + kstep, voffB);
        PG8_WAIT_V(6); PG8_BAR;
    }
    for (;;) {
        const bool has_next = S.next(ui + 1, nxt);
        const char* nA = has_next ? (const char*)g.A + (size_t)nxt.pm * tstep + nxt.kh * khb : cA; const char* nB = has_next ? (const char*)g.Bt + (size_t)nxt.pn * tstep + nxt.kh * khb : cB;
        for (int t = 0; t < nt; t += 2) {
            const bool last = (t == nt - 2);
            const char* a1 = cA + (size_t)(t + 1) * kstep;
            const char* a2 = last ? nA : cA + (size_t)(t + 2) * kstep; const char* b2 = last ? nB : cB + (size_t)(t + 2) * kstep;
            const char* a3 = a2 + kstep; const char* b3 = b2 + kstep;
            if (last && has_next) S.a_ready(nxt);
            if constexpr (SP2) {
            PG8_LDB(B0, 0, 0); PG8_LDB(B1, 0, 1); PG8_SCHED; PG8_LDA(At, 0, 0); PG8_STAGE(PG8_SA(1, 1), a1 + hstep, voffA);
            PG8_WAIT_V(8); PG8_WAIT_L(0); PG8_BAR; PG8_MMA(0, 0, At, B0); PG8_MMA(0, 1, At, B1); PG8_BAR; PG8_SCHED;
            PG8_LDA(At, 0, 1); PG8_STAGE(PG8_SB(0, 0), b2, voffB); PG8_STAGE(PG8_SB(0, 1), b2 + hstep, voffB); PG8_STAGE(PG8_SA(0, 0), a2, voffA);
            PG8_WAIT_V(8); PG8_WAIT_L(0); PG8_BAR; PG8_MMA(1, 0, At, B0); PG8_MMA(1, 1, At, B1); PG8_BAR; PG8_SCHED;
            PG8_LDB(B0, 1, 0); PG8_LDB(B1, 1, 1); PG8_SCHED; PG8_LDA(At, 1, 0); PG8_STAGE(PG8_SA(0, 1), a2 + hstep, voffA);
            PG8_WAIT_V(8); PG8_WAIT_L(0); PG8_BAR; PG8_MMA(0, 0, At, B0); PG8_MMA(0, 1, At, B1); PG8_BAR; PG8_SCHED;
            PG8_LDA(At, 1, 1); PG8_STAGE(PG8_SB(1, 0), b3, voffB); PG8_STAGE(PG8_SB(1, 1), b3 + hstep, voffB); PG8_STAGE(PG8_SA(1, 0), a3, voffA);
            PG8_WAIT_V(8); PG8_WAIT_L(0); PG8_BAR; PG8_MMA(1, 0, At, B0); PG8_MMA(1, 1, At, B1); PG8_BAR; PG8_SCHED;
            } else {
            PG8_LDB(B0, 0, 0); PG8_SCHED; PG8_LDA(At, 0, 0); PG8_STAGE(PG8_SA(1, 1), a1 + hstep, voffA);
            PG8_WAIT_L(8); PG8_BAR; PG8_WAIT_L(0); PG8_MMA(0, 0, At, B0); PG8_BAR; PG8_SCHED;
            PG8_LDB(B1, 0, 1); PG8_STAGE(PG8_SB(0, 0), b2, voffB);
            PG8_BAR; PG8_WAIT_L(0); PG8_MMA(0, 1, At, B1); PG8_BAR;
            PG8_LDA(At, 0, 1); PG8_STAGE(PG8_SA(0, 0), a2, voffA);
            PG8_BAR; PG8_WAIT_L(0); PG8_MMA(1, 0, At, B0); PG8_BAR; PG8_SCHED;
            PG8_STAGE(PG8_SB(0, 1), b2 + hstep, voffB);
            PG8_WAIT_V(6); PG8_BAR; PG8_MMA(1, 1, At, B1); PG8_BAR;
            PG8_LDB(B0, 1, 0); PG8_SCHED; PG8_LDA(At, 1, 0); PG8_STAGE(PG8_SA(0, 1), a2 + hstep, voffA);
            PG8_WAIT_L(8); PG8_BAR; PG8_WAIT_L(0); PG8_MMA(0, 0, At, B0); PG8_BAR; PG8_SCHED;
            PG8_LDB(B1, 1, 1); PG8_STAGE(PG8_SB(1, 0), b3, voffB);
            PG8_BAR; PG8_WAIT_L(0); PG8_MMA(0, 1, At, B1); PG8_BAR;
            PG8_LDA(At, 1, 1); PG8_STAGE(PG8_SA(1, 0), a3, voffA);
            PG8_BAR; PG8_WAIT_L(0); PG8_MMA(1, 0, At, B0); PG8_BAR; PG8_SCHED;
            PG8_STAGE(PG8_SB(1, 1), b3 + hstep, voffB);
            PG8_WAIT_V(6); PG8_BAR; PG8_MMA(1, 1, At, B1); PG8_BAR;
            }
        }
        if constexpr (ALIGN_EPI) { if (wr == 0) PG8_BAR; }
        if constexpr (!Epi::AFTER_DRAIN) { E(acc, cur, wr, wc, fr, fq); S.done(cur); }
        if (!has_next) break;
        if (!(Epi::KSPLIT && cur.kh == 0))
#pragma unroll
        for (int a = 0; a < 2; ++a)
#pragma unroll
            for (int b = 0; b < 2; ++b)
#pragma unroll
                for (int m = 0; m < 4; ++m)
#pragma unroll
                    for (int n = 0; n < 2; ++n) acc[a][b][m][n] = (f32x4){0.f, 0.f, 0.f, 0.f};
        cur = nxt; cA = nA; cB = nB; ++ui;
        if constexpr (ALIGN_EPI) { if (wr == 1) PG8_BAR; }
    }
    PG8_WAIT_V(0);
    if constexpr (!ALIGN_EPI) { if (wr == 0) PG8_BAR; }
    PG8_BAR;
    if constexpr (Epi::AFTER_DRAIN) { E.fused(acc, cur, wr, wc, fr, fq, lds, wid, lane); S.done(cur); }
#undef PG8_SA
#undef PG8_SB
#undef PG8_STAGE
#undef PG8_LDA
#undef PG8_LDB
#undef PG8_MMA
#undef PG8_WAIT_V
#undef PG8_WAIT_L
#undef PG8_BAR
#undef PG8_SCHED
}
}

constexpr int NWAVES = 8, NTHREADS = 512;
constexpr int BATCH = 8, SEQ = 2048, D = 1024, M = BATCH * SEQ, INW = 9216, FFH = 2816;
constexpr float EPS = 1e-6f;
constexpr size_t MiB = 1u << 20;
constexpr size_t WS_SSQ = 1 * MiB;
constexpr size_t WS_WIN = 2 * MiB;
constexpr size_t WS_WHS = 20 * MiB;
constexpr size_t WS_WO = 24 * MiB;
constexpr size_t WS_WF1 = 26 * MiB;
constexpr size_t WS_WF2 = 37 * MiB;
constexpr size_t WS_H = 43 * MiB;
constexpr size_t WS_MIXED = WS_H;
constexpr size_t WS_QS = 75 * MiB;
constexpr size_t WS_VH = 139 * MiB;
constexpr size_t WS_SK = 171 * MiB;
constexpr size_t WS_X1B = WS_SK;
constexpr size_t WS_GH = 203 * MiB, WS_GA = 219 * MiB, WS_GB = 235 * MiB;
constexpr size_t WS_ACT = 75 * MiB;
constexpr size_t WS_END = 251 * MiB;
static_assert(WS_ACT + (size_t)M * FFH * 2 <= WS_X1B, "ACT overlay");
constexpr int RING_BYTES = 131072, LDS_BYTES = 157696, MISC_OFF = LDS_BYTES - 256;

#define LAS __attribute__((address_space(3)))
typedef unsigned short bf16;
typedef unsigned v4u __attribute__((ext_vector_type(4)));
typedef float f32x4 __attribute__((ext_vector_type(4)));
__device__ __forceinline__ unsigned f2bf(float f) { unsigned u = __builtin_bit_cast(unsigned, f); return (u + 0x7fffu + ((u >> 16) & 1u)) >> 16; }
__device__ __forceinline__ unsigned pk2(float lo, float hi) { return f2bf(lo) | (f2bf(hi) << 16); }
__device__ __forceinline__ float bf2f(unsigned short b) { return __builtin_bit_cast(float, (unsigned)b << 16); }
__device__ __forceinline__ float wave_sum(float v) {
#pragma unroll
    for (int o = 1; o < 64; o <<= 1) v += __shfl_xor(v, o);
    return v;
}
struct Args { const float* in[13]; float* out; unsigned char* ws; int ph_lo, ph_hi; };

struct ConvItem { const float* W; bf16* WT; const float* ks; int N, ldT, koff, k0, n0d, n0s; };
__device__ __forceinline__ ConvItem conv_item(const Args& a, unsigned char* ws, int it) {
    constexpr int I_IN = 16 * (INW / 32), I_SQ = 16 * 32, I_F1 = 16 * (2 * FFH / 32);
    ConvItem p; int r = it; p.ks = nullptr; p.koff = 0;
    if (r < I_IN) { const int nblk = INW / 32, kb = r / nblk, nb = r % nblk, n0d = 32 * nb; const int sec = n0d >> 10; int n0s = n0d;
        if (sec == 4 || sec == 5) { const int q = n0d & 255; n0s = (n0d - q) + 64 * ((q >> 5) & 3) + 32 * (q >> 7); }
        p.W = a.in[2]; p.N = INW; p.WT = (bf16*)(ws + WS_WIN); p.ldT = 1024; p.k0 = 64 * kb; p.n0d = n0d; p.n0s = n0s; return p; } r -= I_IN;
    if (r < I_SQ) { p.W = a.in[7]; p.N = 1024; p.WT = (bf16*)(ws + WS_WHS); p.ldT = 2048; p.k0 = 64 * (r / 32); p.n0d = p.n0s = 32 * (r % 32); return p; } r -= I_SQ;
    if (r < I_SQ) { p.W = a.in[8]; p.N = 1024; p.WT = (bf16*)(ws + WS_WHS); p.ldT = 2048; p.koff = 1024; p.k0 = 64 * (r / 32); p.n0d = p.n0s = 32 * (r % 32); return p; } r -= I_SQ;
    if (r < I_SQ) { p.W = a.in[9]; p.N = 1024; p.WT = (bf16*)(ws + WS_WO); p.ldT = 1024; p.k0 = 64 * (r / 32); p.n0d = p.n0s = 32 * (r % 32); return p; } r -= I_SQ;
    if (r < I_F1) { const int nblk = 2 * FFH / 32, kb = r / nblk, nb = r % nblk, n0d = 32 * nb, pn = n0d >> 8, q = n0d & 255;
        p.W = a.in[11]; p.N = 2 * FFH; p.WT = (bf16*)(ws + WS_WF1); p.ldT = 1024; p.k0 = 64 * kb; p.n0d = n0d; p.n0s = (q >> 7) * FFH + 128 * pn + (q & 127); p.ks = a.in[10]; return p; } r -= I_F1;
    p.W = a.in[12]; p.N = 1024; p.WT = (bf16*)(ws + WS_WF2); p.ldT = FFH; p.k0 = 64 * (r / 32); p.n0d = p.n0s = 32 * (r % 32); return p;
}
__device__ __forceinline__ void conv_load(const ConvItem& p, float (&wv)[32], f32x4 (&kv)[2], int lane) {
    const float* wp = p.W + (size_t)(p.k0 + (lane >> 5)) * p.N + p.n0s + (lane & 31);
#pragma unroll
    for (int i = 0; i < 32; ++i) wv[i] = wp[(size_t)(2 * i) * p.N];
    if (p.ks) { kv[0] = *(const f32x4*)(p.ks + p.k0 + 8 * (lane & 7)); kv[1] = *(const f32x4*)(p.ks + p.k0 + 8 * (lane & 7) + 4); }
    else { kv[0] = (f32x4){1.f, 1.f, 1.f, 1.f}; kv[1] = kv[0]; }
}
__device__ __forceinline__ void conv_finish(const ConvItem& p, const float (&wv)[32], const f32x4 (&kv)[2], LAS float* scr, int lane) {
#pragma unroll
    for (int i = 0; i < 32; ++i) scr[(2 * i + (lane >> 5)) * 33 + (lane & 31)] = wv[i];
    asm volatile("s_waitcnt lgkmcnt(0)" ::: "memory");
    const int c = lane & 7;
#pragma unroll
    for (int j = 0; j < 4; ++j) { const int n = (lane >> 3) + 8 * j; const LAS float* s = scr + (8 * c) * 33 + n;
        v4u o; o.x = pk2(s[0 * 33] * kv[0][0], s[1 * 33] * kv[0][1]); o.y = pk2(s[2 * 33] * kv[0][2], s[3 * 33] * kv[0][3]); o.z = pk2(s[4 * 33] * kv[1][0], s[5 * 33] * kv[1][1]); o.w = pk2(s[6 * 33] * kv[1][2], s[7 * 33] * kv[1][3]);
        *(v4u*)(p.WT + (size_t)(p.n0d + n) * p.ldT + p.koff + p.k0 + 8 * c) = o; }
    asm volatile("s_waitcnt lgkmcnt(0)" ::: "memory");
}
template <int PART> __device__ __forceinline__ void p0_prologue(const Args& a, LAS unsigned char* lds, int wave, int lane, int gw, int NGW) {
    LAS float* scr = (LAS float*)(lds + wave * 16384);
    unsigned char* ws = a.ws;
    constexpr int I_IN = 16 * (INW / 32), I_SQ = 16 * 32, I_F1 = 16 * (2 * FFH / 32), I_F2 = (FFH / 64) * 32;
    constexpr int NITEMS = I_IN + 3 * I_SQ + I_F1 + I_F2;
    { int it = (PART == 0 ? gw : I_IN + gw); const int end = (PART == 0 ? I_IN : NITEMS);
      if (it < end) {
        ConvItem pa = conv_item(a, ws, it), pb = pa; float wa[32], wb[32]; f32x4 ka[2], kb[2];
        conv_load(pa, wa, ka, lane);
        for (;;) {
            const bool hb = it + NGW < end; if (hb) { pb = conv_item(a, ws, it + NGW); conv_load(pb, wb, kb, lane); }
            conv_finish(pa, wa, ka, scr, lane);
            if (!hb) break; it += NGW;
            const bool ha = it + NGW < end; if (ha) { pa = conv_item(a, ws, it + NGW); conv_load(pa, wa, ka, lane); }
            conv_finish(pb, wb, kb, scr, lane);
            if (!ha) break; it += NGW;
        }
      }
    }
    if (PART != 0) return;
    const float* g1 = a.in[1];
    f32x4 gv[4];
#pragma unroll
    for (int j = 0; j < 4; ++j) gv[j] = ((const f32x4*)g1)[lane + 64 * j];
    for (int m = gw; m < M; m += NGW) {
        const f32x4* xr = (const f32x4*)(a.in[0] + (size_t)m * D) + lane;
        f32x4 v[4]; float s = 0.f;
#pragma unroll
        for (int j = 0; j < 4; ++j) { v[j] = xr[64 * j]; s += (v[j].x * v[j].x + v[j].y * v[j].y) + (v[j].z * v[j].z + v[j].w * v[j].w); }
        const float rstd = __builtin_amdgcn_rsqf(wave_sum(s) * (1.f / D) + EPS);
        unsigned long long* o8 = (unsigned long long*)((bf16*)(ws + WS_H) + (size_t)m * D) + lane;
#pragma unroll
        for (int j = 0; j < 4; ++j) { const f32x4 y = v[j] * rstd * gv[j]; o8[64 * j] = (unsigned long long)pk2(y.x, y.y) | ((unsigned long long)pk2(y.z, y.w) << 32); }
    }
}

typedef short bf16x8_t __attribute__((ext_vector_type(8)));
typedef float f32x16 __attribute__((ext_vector_type(16)));
typedef unsigned u32x2_t __attribute__((ext_vector_type(2)));
typedef float f32x2_t __attribute__((ext_vector_type(2)));
typedef __bf16 bf16x2_cv __attribute__((ext_vector_type(2)));
__device__ __forceinline__ unsigned cvtpk(float lo, float hi) { const f32x2_t v = {lo, hi}; return __builtin_bit_cast(unsigned, __builtin_convertvector(v, bf16x2_cv)); }
__device__ __forceinline__ bf16x8_t pack_acc8(const f32x16& c, int p) {
    v4u w; if (p == 0) { w.x = cvtpk(c[0], c[1]); w.y = cvtpk(c[2], c[3]); w.z = cvtpk(c[4], c[5]); w.w = cvtpk(c[6], c[7]); }
    else { w.x = cvtpk(c[8], c[9]); w.y = cvtpk(c[10], c[11]); w.z = cvtpk(c[12], c[13]); w.w = cvtpk(c[14], c[15]); }
    return __builtin_bit_cast(bf16x8_t, w);
}
#define MFMA32(A, B, C) __builtin_amdgcn_mfma_f32_32x32x16_bf16((A), (B), (C), 0, 0, 0)
__device__ __forceinline__ void hgrn_mfma(const Args& a, LAS unsigned char* lds, int vblk, int nblk) {
    unsigned char* ws = a.ws;
    bf16* QS = (bf16*)(ws + WS_QS); const bf16* VH = (const bf16*)(ws + WS_VH); const unsigned char* GH = ws + WS_GH; const _Float16* LOGF = (const _Float16*)a.out;
    const float* ogain = a.in[4];
    constexpr int RS = 272, TS = 144;
    LAS unsigned char* L_QI = lds; LAS unsigned char* L_QA = lds + 64 * RS; LAS unsigned char* L_KA = lds + 2 * 64 * RS;
    LAS unsigned char* L_KST = lds + 3 * 64 * RS; LAS unsigned char* L_VT = L_KST + 128 * TS;
    LAS float* L_TQ = (LAS float*)(L_VT + 128 * TS); LAS float* L_DEC = L_TQ + 2048;     LAS float* L_SS = L_DEC + 128; LAS float* L_GN = L_SS + 256;
    const int tid = threadIdx.x, lane = tid & 63, wave = __builtin_amdgcn_readfirstlane(tid >> 6);
    const int dp = tid & 63, oct = wave, r32 = lane & 31, hi = lane >> 5, vt = wave & 3, tt = wave >> 2;
    const int kap = 16 * (r32 >> 4) + 8 * ((r32 >> 2) & 1) + 4 * ((r32 >> 3) & 1) + (r32 & 3);
    for (int item = vblk; item < BATCH * 8; item += nblk) {
        const int b = item >> 3, h = item & 7;
        f32x16 C[4];
#pragma unroll
        for (int i = 0; i < 4; ++i)
#pragma unroll
            for (int j = 0; j < 16; ++j) C[i][j] = 0.f;
        if (tid < 128) L_GN[tid] = ogain[h * 128 + tid];
        unsigned gN2[2][8], qN2[2][8], vN2[2][8];
#pragma unroll
        for (int c2 = 0; c2 < 2; ++c2) { const size_t row0 = (size_t)b * SEQ + 64 * c2 + 8 * oct;
#pragma unroll
          for (int i = 0; i < 8; ++i) { gN2[c2][i] = *(const unsigned*)(LOGF + (row0 + i) * 1024 + h * 128 + 2 * dp); qN2[c2][i] = *(const unsigned*)(QS + (row0 + i) * 2048 + h * 128 + 2 * dp); vN2[c2][i] = *(const unsigned*)(VH + (row0 + i) * 1024 + h * 128 + 2 * dp); } }
        { float run0 = 0.f, run1 = 0.f;
#pragma unroll
          for (int i = 0; i < 8; ++i) { run0 += (float)__builtin_bit_cast(_Float16, (unsigned short)(gN2[0][i] & 0xffffu)); run1 += (float)__builtin_bit_cast(_Float16, (unsigned short)(gN2[0][i] >> 16)); }
          *(LAS f32x2_t*)(L_TQ + oct * 128 + 2 * dp) = (f32x2_t){run0, run1}; }
        __syncthreads();
#pragma unroll 2
        for (int n = 0; n < SEQ / 64; ++n) {
            unsigned (&gN)[8] = gN2[n & 1]; unsigned (&qN)[8] = qN2[n & 1]; unsigned (&vN)[8] = vN2[n & 1];
            if (n + 1 < SEQ / 64) { float run0 = 0.f, run1 = 0.f;
#pragma unroll
                for (int i = 0; i < 8; ++i) { const unsigned gw_ = gN2[(n + 1) & 1][i]; run0 += (float)__builtin_bit_cast(_Float16, (unsigned short)(gw_ & 0xffffu)); run1 += (float)__builtin_bit_cast(_Float16, (unsigned short)(gw_ >> 16)); }
                *(LAS f32x2_t*)(L_TQ + ((n + 1) & 1) * 1024 + oct * 128 + 2 * dp) = (f32x2_t){run0, run1}; }
            float off0 = 0.f, off1 = 0.f, cref0 = 0.f, cref1 = 0.f, tot0 = 0.f, tot1 = 0.f;
#pragma unroll
            for (int o = 0; o < 8; ++o) { const f32x2_t tq = *(const LAS f32x2_t*)(L_TQ + (n & 1) * 1024 + o * 128 + 2 * dp);
                if (o < oct) { off0 += tq.x; off1 += tq.y; } if (o < 4) { cref0 += tq.x; cref1 += tq.y; } tot0 += tq.x; tot1 += tq.y; }
            const float xc0 = __expf(tot0), xc1 = __expf(tot1), xa0 = __expf(-cref0), xa1 = __expf(-cref1), xb0 = __expf(cref0), xb1 = __expf(cref1);
            if (oct == 0) *(LAS f32x2_t*)(L_DEC + 2 * dp) = (f32x2_t){xc0, xc1};
            float e0 = __expf(off0), e1 = __expf(off1);
            unsigned ksp0[4], ksp1[4], vsp0[4], vsp1[4];
#pragma unroll
            for (int i = 0; i < 8; ++i) {
                const float f0 = __expf((float)__builtin_bit_cast(_Float16, (unsigned short)(gN[i] & 0xffffu))), f1 = __expf((float)__builtin_bit_cast(_Float16, (unsigned short)(gN[i] >> 16)));
                e0 = fmaxf(e0 * f0, 1e-30f); e1 = fmaxf(e1 * f1, 1e-30f);
                const float r0 = __builtin_amdgcn_rcpf(e0), r1 = __builtin_amdgcn_rcpf(e1);
                const float k0 = 1.0f - f0, k1 = 1.0f - f1, q0 = __builtin_bit_cast(float, qN[i] << 16), q1 = __builtin_bit_cast(float, qN[i] & 0xffff0000u);
                const float qi0 = q0 * e0, qi1 = q1 * e1, kr0 = k0 * r0, kr1 = k1 * r1;
                const int t = 8 * oct + i;
                *(LAS unsigned*)(L_QI + t * RS + 4 * dp) = cvtpk(qi0, qi1);
                *(LAS unsigned*)(L_QA + t * RS + 4 * dp) = cvtpk(qi0 * xa0, qi1 * xa1);
                *(LAS unsigned*)(L_KA + t * RS + 4 * dp) = cvtpk(kr0 * xb0, kr1 * xb1);
                const unsigned ks = cvtpk(kr0 * xc0, kr1 * xc1);
                if (i & 1) { ksp0[i >> 1] |= ks << 16; ksp1[i >> 1] |= ks & 0xffff0000u; vsp0[i >> 1] |= vN[i] << 16; vsp1[i >> 1] |= vN[i] & 0xffff0000u; }
                else { ksp0[i >> 1] = ks & 0xffffu; ksp1[i >> 1] = ks >> 16; vsp0[i >> 1] = vN[i] & 0xffffu; vsp1[i >> 1] = vN[i] >> 16; }
            }
            *(LAS v4u*)(L_KST + (2 * dp) * TS + 16 * oct) = (v4u){ksp0[0], ksp0[1], ksp0[2], ksp0[3]}; *(LAS v4u*)(L_KST + (2 * dp + 1) * TS + 16 * oct) = (v4u){ksp1[0], ksp1[1], ksp1[2], ksp1[3]};
            *(LAS v4u*)(L_VT + (2 * dp) * TS + 16 * oct) = (v4u){vsp0[0], vsp0[1], vsp0[2], vsp0[3]}; *(LAS v4u*)(L_VT + (2 * dp + 1) * TS + 16 * oct) = (v4u){vsp1[0], vsp1[1], vsp1[2], vsp1[3]};
            __syncthreads();
            const size_t m = (size_t)b * SEQ + 64 * n + 32 * tt + r32;
            unsigned gt4[4];
#pragma unroll
            for (int a4 = 0; a4 < 4; ++a4) gt4[a4] = *(const unsigned*)(GH + m * 1024 + h * 128 + 32 * vt + 8 * a4 + 4 * hi);
            if (n + 2 < SEQ / 64) { const size_t row0 = (size_t)b * SEQ + 64 * (n + 2) + 8 * oct;
#pragma unroll
                for (int i = 0; i < 8; ++i) { gN[i] = *(const unsigned*)(LOGF + (row0 + i) * 1024 + h * 128 + 2 * dp); qN[i] = *(const unsigned*)(QS + (row0 + i) * 2048 + h * 128 + 2 * dp); vN[i] = *(const unsigned*)(VH + (row0 + i) * 1024 + h * 128 + 2 * dp); } }
#define SB() __builtin_amdgcn_sched_barrier(0)
            f32x16 O;
#pragma unroll
            for (int j = 0; j < 16; ++j) O[j] = 0.f;
            bf16x8_t Vt[4];
            {
                v4u qf[8];
#pragma unroll
                for (int i = 0; i < 8; ++i) { const LAS unsigned char* qp = L_QI + (32 * tt + r32) * RS + (32 * (i >> 1) + 16 * (i & 1) + 4 * hi) * 2;
                    const u32x2_t lo = *(const LAS u32x2_t*)qp, hi2 = *(const LAS u32x2_t*)(qp + 16); qf[i] = (v4u){lo.x, lo.y, hi2.x, hi2.y}; }
#pragma unroll
                for (int ks = 0; ks < 4; ++ks) Vt[ks] = *(const LAS bf16x8_t*)(L_VT + (32 * vt + r32) * TS + (16 * ks + 8 * hi) * 2);
                SB();
#pragma unroll
                for (int i = 0; i < 8; ++i) O = MFMA32(pack_acc8(C[i >> 1], i & 1), __builtin_bit_cast(bf16x8_t, qf[i]), O);
                SB();
            }
#pragma unroll
            for (int st = 0; st < 2; ++st) if (st <= tt) {
                f32x16 S;
#pragma unroll
                for (int j = 0; j < 16; ++j) S[j] = 0.f;
#pragma unroll
                for (int hb = 0; hb < 2; ++hb) {
                    bf16x8_t A[4], B[4];
#pragma unroll
                    for (int k4 = 0; k4 < 4; ++k4) { const int ks = 4 * hb + k4;
                        A[k4] = *(const LAS bf16x8_t*)(L_KA + (32 * st + kap) * RS + (16 * ks + 8 * hi) * 2);
                        B[k4] = *(const LAS bf16x8_t*)(L_QA + (32 * tt + r32) * RS + (16 * ks + 8 * hi) * 2); }
                    SB();
#pragma unroll
                    for (int k4 = 0; k4 < 4; ++k4) S = MFMA32(A[k4], B[k4], S);
                    SB();
                }
                if (st == tt) {
#pragma unroll
                    for (int j = 0; j < 16; ++j) { const int sl = 16 * (j >> 3) + 8 * hi + (j & 7); if (sl > r32) S[j] = 0.f; }
                }
                O = MFMA32(Vt[2 * st], pack_acc8(S, 0), O); O = MFMA32(Vt[2 * st + 1], pack_acc8(S, 1), O);
            }
#pragma unroll
            for (int dt = 0; dt < 4; ++dt) {
                f32x4 dc[4]; bf16x8_t A[4];
#pragma unroll
                for (int a4 = 0; a4 < 4; ++a4) dc[a4] = *(const LAS f32x4*)(L_DEC + 32 * dt + 8 * a4 + 4 * hi);
#pragma unroll
                for (int ks = 0; ks < 4; ++ks) A[ks] = *(const LAS bf16x8_t*)(L_KST + (32 * dt + r32) * TS + (16 * ks + 8 * hi) * 2);
                SB();
#pragma unroll
                for (int a4 = 0; a4 < 4; ++a4)
#pragma unroll
                    for (int cc = 0; cc < 4; ++cc) C[dt][4 * a4 + cc] *= dc[a4][cc];
#pragma unroll
                for (int ks = 0; ks < 4; ++ks) C[dt] = MFMA32(A[ks], Vt[ks], C[dt]);
                SB();
            }
#undef SB
            float ss = 0.f;
#pragma unroll
            for (int j = 0; j < 16; ++j) ss += O[j] * O[j];
            ss += __shfl_xor(ss, 32);
            if (hi == 0) L_SS[(tt * 4 + vt) * 32 + r32] = ss;
            __syncthreads();
            const float sst = (L_SS[(tt * 4 + 0) * 32 + r32] + L_SS[(tt * 4 + 1) * 32 + r32]) + (L_SS[(tt * 4 + 2) * 32 + r32] + L_SS[(tt * 4 + 3) * 32 + r32]);
            const float rstd = __builtin_amdgcn_rsqf(sst * (1.0f / 128.0f) + EPS);
#pragma unroll
            for (int a4 = 0; a4 < 4; ++a4) { const int v0 = h * 128 + 32 * vt + 8 * a4 + 4 * hi;
                const f32x4 gn = *(const LAS f32x4*)(L_GN + 32 * vt + 8 * a4 + 4 * hi); const unsigned gt = gt4[a4];
                float o[4];
#pragma unroll
                for (int cc = 0; cc < 4; ++cc) o[cc] = O[4 * a4 + cc] * rstd * gn[cc] * ((float)((gt >> (8 * cc)) & 255u) * (1.0f / 255.0f));
                u32x2_t w; w.x = cvtpk(o[0], o[1]); w.y = cvtpk(o[2], o[3]);
                *(u32x2_t*)(QS + m * 2048 + v0) = w; }
        }
        __syncthreads();
    }
}

__device__ __forceinline__ void hgrn_v2(const Args& a, LAS unsigned char* lds, int vblk, int nblk) {
    unsigned char* ws = a.ws;
    bf16* QS = (bf16*)(ws + WS_QS); const bf16* VH = (const bf16*)(ws + WS_VH); const unsigned char* GH = ws + WS_GH; const _Float16* LOGF = (const _Float16*)a.out;
    const float* ogain = a.in[4];
    constexpr int RS = 272, TS = 144, O_KA = 64 * RS, O_KAT = 2 * 64 * RS, O_VT = O_KAT + 128 * TS, BUFB = O_VT + 128 * TS;
    LAS float* L_TQ = (LAS float*)(lds + 2 * BUFB);
    LAS float* L_XS = L_TQ + 1024;
    LAS float* L_SS = L_XS + 512;
    LAS float* L_GN = L_SS + 512;
    const int tid = threadIdx.x, lane = tid & 63, wave = __builtin_amdgcn_readfirstlane(tid >> 6);
    const int r32 = lane & 31, hi = lane >> 5;
    const int kap = 16 * (r32 >> 4) + 8 * ((r32 >> 2) & 1) + 4 * ((r32 >> 3) & 1) + (r32 & 3);
    constexpr int NCH = SEQ / 64;
#define SB() __builtin_amdgcn_sched_barrier(0)
    for (int item = vblk; item < BATCH * 8; item += nblk) {
        const int b = item >> 3, h = item & 7;
        if (tid < 128) L_GN[tid] = ogain[h * 128 + tid];
        if (wave < 4) {
            const int vt = wave;
            f32x16 C[4];
#pragma unroll
            for (int i = 0; i < 4; ++i)
#pragma unroll
                for (int j = 0; j < 16; ++j) C[i][j] = 0.f;
            f32x16 O[2]; unsigned gt4[2][4];
#define HG_EPI(cn) do { _Pragma("unroll") for (int tt = 0; tt < 2; ++tt) { const LAS float* SSb = L_SS + ((cn) & 1) * 256; \
                const float sst = (SSb[(tt * 4 + 0) * 32 + r32] + SSb[(tt * 4 + 1) * 32 + r32]) + (SSb[(tt * 4 + 2) * 32 + r32] + SSb[(tt * 4 + 3) * 32 + r32]); \
                const float rstd = __builtin_amdgcn_rsqf(sst * (1.0f / 128.0f) + EPS); \
                const size_t m = (size_t)b * SEQ + 64 * (cn) + r32 + 32 * tt; \
                _Pragma("unroll") for (int a4 = 0; a4 < 4; ++a4) { const int v0 = h * 128 + 32 * vt + 8 * a4 + 4 * hi; \
                    const f32x4 gn = *(const LAS f32x4*)(L_GN + 32 * vt + 8 * a4 + 4 * hi); const unsigned gt = gt4[tt][a4]; float o[4]; \
                    _Pragma("unroll") for (int cc = 0; cc < 4; ++cc) o[cc] = O[tt][4 * a4 + cc] * rstd * gn[cc] * ((float)((gt >> (8 * cc)) & 255u) * (1.0f / 255.0f)); \
                    u32x2_t w; w.x = cvtpk(o[0], o[1]); w.y = cvtpk(o[2], o[3]); *(u32x2_t*)(QS + m * 2048 + v0) = w; } } } while (0)
            __syncthreads();
#pragma unroll 1
            for (int n = 0; n < NCH; ++n) {
                __syncthreads();
                if (n > 0) HG_EPI(n - 1);
                const LAS unsigned char* T = lds + (n & 1) * BUFB;
                const LAS float* XS = L_XS + (n & 1) * 256;
                const size_t m0 = (size_t)b * SEQ + 64 * n + r32;
#pragma unroll
                for (int tt = 0; tt < 2; ++tt)
#pragma unroll
                    for (int a4 = 0; a4 < 4; ++a4) gt4[tt][a4] = *(const unsigned*)(GH + (m0 + 32 * tt) * 1024 + h * 128 + 32 * vt + 8 * a4 + 4 * hi);
                bf16x8_t Cp[8]; bf16x8_t Vt[4];
#pragma unroll
                for (int ks = 0; ks < 4; ++ks) Vt[ks] = *(const LAS bf16x8_t*)(T + O_VT + (32 * vt + r32) * TS + (16 * ks + 8 * hi) * 2);
#pragma unroll
                for (int dt = 0; dt < 4; ++dt) {
#pragma unroll
                    for (int a4 = 0; a4 < 4; ++a4) { const f32x4 x1 = *(const LAS f32x4*)(XS + 32 * dt + 8 * a4 + 4 * hi);
#pragma unroll
                        for (int cc = 0; cc < 4; ++cc) C[dt][4 * a4 + cc] *= x1[cc]; }
                    Cp[2 * dt] = pack_acc8(C[dt], 0); Cp[2 * dt + 1] = pack_acc8(C[dt], 1);
                }
#pragma unroll
                for (int tt = 0; tt < 2; ++tt) {
#pragma unroll
                    for (int j = 0; j < 16; ++j) O[tt][j] = 0.f;
                    v4u qf[8];
#pragma unroll
                    for (int i = 0; i < 8; ++i) { const LAS unsigned char* qp = T + (32 * tt + r32) * RS + (32 * (i >> 1) + 16 * (i & 1) + 4 * hi) * 2;
                        const u32x2_t lo = *(const LAS u32x2_t*)qp, hi2 = *(const LAS u32x2_t*)(qp + 16); qf[i] = (v4u){lo.x, lo.y, hi2.x, hi2.y}; }
                    SB();
#pragma unroll
                    for (int i = 0; i < 8; ++i) O[tt] = MFMA32(Cp[i], __builtin_bit_cast(bf16x8_t, qf[i]), O[tt]);
                    SB();
#pragma unroll
                    for (int st = 0; st < 2; ++st) if (st <= tt) {
                        f32x16 S;
#pragma unroll
                        for (int j = 0; j < 16; ++j) S[j] = 0.f;
#pragma unroll
                        for (int hb = 0; hb < 2; ++hb) {
                            bf16x8_t A[4], B[4];
#pragma unroll
                            for (int k4 = 0; k4 < 4; ++k4) { const int ks = 4 * hb + k4;
                                A[k4] = *(const LAS bf16x8_t*)(T + O_KA + (32 * st + kap) * RS + (16 * ks + 8 * hi) * 2);
                                B[k4] = *(const LAS bf16x8_t*)(T + (32 * tt + r32) * RS + (16 * ks + 8 * hi) * 2); }
                            SB();
#pragma unroll
                            for (int k4 = 0; k4 < 4; ++k4) S = MFMA32(A[k4], B[k4], S);
                            SB();
                        }
                        if (st == tt) {
#pragma unroll
                            for (int j = 0; j < 16; ++j) { const int sl = 16 * (j >> 3) + 8 * hi + (j & 7); if (sl > r32) S[j] = 0.f; }
                        }
                        O[tt] = MFMA32(Vt[2 * st], pack_acc8(S, 0), O[tt]); O[tt] = MFMA32(Vt[2 * st + 1], pack_acc8(S, 1), O[tt]);
                    }
                    float ss = 0.f;
#pragma unroll
                    for (int j = 0; j < 16; ++j) ss += O[tt][j] * O[tt][j];
                    ss += __shfl_xor(ss, 32);
                    if (hi == 0) L_SS[(n & 1) * 256 + (tt * 4 + vt) * 32 + r32] = ss;
                }
#pragma unroll
                for (int dt = 0; dt < 4; ++dt) {
                    f32x4 x2[4]; bf16x8_t A[4];
#pragma unroll
                    for (int a4 = 0; a4 < 4; ++a4) x2[a4] = *(const LAS f32x4*)(XS + 128 + 32 * dt + 8 * a4 + 4 * hi);
#pragma unroll
                    for (int ks = 0; ks < 4; ++ks) A[ks] = *(const LAS bf16x8_t*)(T + O_KAT + (32 * dt + r32) * TS + (16 * ks + 8 * hi) * 2);
                    SB();
#pragma unroll
                    for (int ks = 0; ks < 4; ++ks) C[dt] = MFMA32(A[ks], Vt[ks], C[dt]);
#pragma unroll
                    for (int a4 = 0; a4 < 4; ++a4)
#pragma unroll
                        for (int cc = 0; cc < 4; ++cc) C[dt][4 * a4 + cc] *= x2[a4][cc];
                    SB();
                }
            }
            __syncthreads();
            HG_EPI(NCH - 1);
#undef HG_EPI
        } else {
            const int ptid = tid - 256, dp = ptid & 63, q4 = ptid >> 6;
            unsigned g2[2][16], q2[2][16], v2[2][16];
#define HG_LOAD(set, c) do { const size_t row0_ = (size_t)b * SEQ + 64 * (c) + 16 * q4; _Pragma("unroll") for (int i = 0; i < 16; ++i) { \
                g2[set][i] = *(const unsigned*)(LOGF + (row0_ + i) * 1024 + h * 128 + 2 * dp); q2[set][i] = *(const unsigned*)(QS + (row0_ + i) * 2048 + h * 128 + 2 * dp); \
                v2[set][i] = *(const unsigned*)(VH + (row0_ + i) * 1024 + h * 128 + 2 * dp); } } while (0)
#define HG_SUMS(set, c) do { float r0_ = 0.f, r1_ = 0.f; _Pragma("unroll") for (int i = 0; i < 16; ++i) { r0_ += (float)__builtin_bit_cast(_Float16, (unsigned short)(g2[set][i] & 0xffffu)); \
                r1_ += (float)__builtin_bit_cast(_Float16, (unsigned short)(g2[set][i] >> 16)); } *(LAS f32x2_t*)(L_TQ + ((c) & 1) * 512 + q4 * 128 + 2 * dp) = (f32x2_t){r0_, r1_}; } while (0)
            float e0, e1, xa0, xa1, xb0, xb1; unsigned kp0[8], kp1[8], vp0[8], vp1[8];
#define HG_BEGIN(c) do { float off0 = 0.f, off1 = 0.f, cref0 = 0.f, cref1 = 0.f, tot0 = 0.f, tot1 = 0.f; \
                _Pragma("unroll") for (int o = 0; o < 4; ++o) { const f32x2_t tq = *(const LAS f32x2_t*)(L_TQ + ((c) & 1) * 512 + o * 128 + 2 * dp); \
                    if (o < q4) { off0 += tq.x; off1 += tq.y; } if (o < 2) { cref0 += tq.x; cref1 += tq.y; } tot0 += tq.x; tot1 += tq.y; } \
                xa0 = __expf(-cref0); xa1 = __expf(-cref1); xb0 = __expf(cref0); xb1 = __expf(cref1); e0 = __expf(off0); e1 = __expf(off1); \
                if (q4 == 0) { *(LAS f32x2_t*)(L_XS + ((c) & 1) * 256 + 2 * dp) = (f32x2_t){xb0, xb1}; *(LAS f32x2_t*)(L_XS + ((c) & 1) * 256 + 128 + 2 * dp) = (f32x2_t){__expf(tot0 - cref0), __expf(tot1 - cref1)}; } } while (0)
#define HG_TOKENS(set, c, i0) do { LAS unsigned char* T_ = lds + ((c) & 1) * BUFB; _Pragma("unroll") for (int i = (i0); i < (i0) + 8; ++i) { \
                const unsigned gw_ = g2[set][i], qw_ = q2[set][i], vw_ = v2[set][i]; \
                const float f0 = __expf((float)__builtin_bit_cast(_Float16, (unsigned short)(gw_ & 0xffffu))), f1 = __expf((float)__builtin_bit_cast(_Float16, (unsigned short)(gw_ >> 16))); \
                e0 = fmaxf(e0 * f0, 1e-30f); e1 = fmaxf(e1 * f1, 1e-30f); \
                const float r0 = __builtin_amdgcn_rcpf(e0), r1 = __builtin_amdgcn_rcpf(e1); \
                const float qq0 = __builtin_bit_cast(float, qw_ << 16), qq1 = __builtin_bit_cast(float, qw_ & 0xffff0000u); \
                const int t = 16 * q4 + i; \
                *(LAS unsigned*)(T_ + t * RS + 4 * dp) = cvtpk(qq0 * e0 * xa0, qq1 * e1 * xa1); \
                const unsigned ka = cvtpk((1.0f - f0) * r0 * xb0, (1.0f - f1) * r1 * xb1); \
                *(LAS unsigned*)(T_ + O_KA + t * RS + 4 * dp) = ka; \
                if (i & 1) { kp0[i >> 1] |= ka << 16; kp1[i >> 1] |= ka & 0xffff0000u; vp0[i >> 1] |= vw_ << 16; vp1[i >> 1] |= vw_ & 0xffff0000u; } \
                else { kp0[i >> 1] = ka & 0xffffu; kp1[i >> 1] = ka >> 16; vp0[i >> 1] = vw_ & 0xffffu; vp1[i >> 1] = vw_ >> 16; } } } while (0)
#define HG_FINISH(c) do { LAS unsigned char* T_ = lds + ((c) & 1) * BUFB; \
                *(LAS v4u*)(T_ + O_KAT + (2 * dp) * TS + 32 * q4) = (v4u){kp0[0], kp0[1], kp0[2], kp0[3]}; *(LAS v4u*)(T_ + O_KAT + (2 * dp) * TS + 32 * q4 + 16) = (v4u){kp0[4], kp0[5], kp0[6], kp0[7]}; \
                *(LAS v4u*)(T_ + O_KAT + (2 * dp + 1) * TS + 32 * q4) = (v4u){kp1[0], kp1[1], kp1[2], kp1[3]}; *(LAS v4u*)(T_ + O_KAT + (2 * dp + 1) * TS + 32 * q4 + 16) = (v4u){kp1[4], kp1[5], kp1[6], kp1[7]}; \
                *(LAS v4u*)(T_ + O_VT + (2 * dp) * TS + 32 * q4) = (v4u){vp0[0], vp0[1], vp0[2], vp0[3]}; *(LAS v4u*)(T_ + O_VT + (2 * dp) * TS + 32 * q4 + 16) = (v4u){vp0[4], vp0[5], vp0[6], vp0[7]}; \
                *(LAS v4u*)(T_ + O_VT + (2 * dp + 1) * TS + 32 * q4) = (v4u){vp1[0], vp1[1], vp1[2], vp1[3]}; *(LAS v4u*)(T_ + O_VT + (2 * dp + 1) * TS + 32 * q4 + 16) = (v4u){vp1[4], vp1[5], vp1[6], vp1[7]}; } while (0)
            HG_LOAD(0, 0); HG_LOAD(1, 1);
            HG_SUMS(0, 0);
            __syncthreads();
            HG_SUMS(1, 1); HG_BEGIN(0); HG_TOKENS(0, 0, 0); HG_TOKENS(0, 0, 8); HG_FINISH(0); HG_LOAD(0, 2);
#pragma unroll 2
            for (int n = 0; n < NCH; ++n) {
                const int c = n + 1;
                __syncthreads();
                if (c < NCH) { if (c + 1 < NCH) HG_SUMS(n & 1, c + 1); HG_BEGIN(c); HG_TOKENS((n + 1) & 1, c, 0); HG_TOKENS((n + 1) & 1, c, 8); HG_FINISH(c); if (c + 2 < NCH) HG_LOAD((n + 1) & 1, c + 2); }
            }
            __syncthreads();
#undef HG_LOAD
#undef HG_SUMS
#undef HG_BEGIN
#undef HG_TOKENS
#undef HG_FINISH
        }
        __syncthreads();
    }
#undef SB
}

template <bool DIAG> __device__ __forceinline__ bool attn_tile(const bf16x8_t (&Kc)[4], const bf16x8_t (&Vc)[4], const bf16x8_t (&Qf)[4], f32x16& O0, f32x16& O1, float& carry, int r32, int hi) {
    f32x16 Sx;
#pragma unroll
    for (int j = 0; j < 16; ++j) Sx[j] = 0.f;
#pragma unroll
    for (int ks = 0; ks < 4; ++ks) Sx = MFMA32(Kc[ks], Qf[ks], Sx);
    float kp[16], sg[16];
#pragma unroll
    for (int j = 0; j < 16; ++j) {
        const float r = __builtin_amdgcn_rcpf(1.0f + __builtin_amdgcn_exp2f(Sx[j]));
        if (DIAG) { const int sl = 16 * (j >> 3) + 8 * hi + (j & 7); const bool valid = sl < r32; kp[j] = valid ? r : 1.f; sg[j] = valid ? 1.0f - r : 0.f; }
        else { kp[j] = r; sg[j] = 1.0f - r; }
    }
#pragma unroll
    for (int j = 6; j >= 0; --j) { sg[j] *= kp[j + 1]; kp[j] *= kp[j + 1]; sg[8 + j] *= kp[8 + j + 1]; kp[8 + j] *= kp[8 + j + 1]; }
    const float G0 = kp[0], G1 = kp[8];
    const float P0 = __shfl_xor(G0, 32), P1 = __shfl_xor(G1, 32);
    const float after0 = (hi == 0 ? P0 : 1.f) * P1 * G1 * carry, after1 = (hi == 0 ? P1 : 1.f) * carry;
#pragma unroll
    for (int j = 0; j < 16; ++j) sg[j] *= (j < 8 ? after0 : after1);
    carry *= (G0 * G1) * (P0 * P1);
    v4u w0, w1; w0.x = cvtpk(sg[0], sg[1]); w0.y = cvtpk(sg[2], sg[3]); w0.z = cvtpk(sg[4], sg[5]); w0.w = cvtpk(sg[6], sg[7]);
    w1.x = cvtpk(sg[8], sg[9]); w1.y = cvtpk(sg[10], sg[11]); w1.z = cvtpk(sg[12], sg[13]); w1.w = cvtpk(sg[14], sg[15]);
    const bf16x8_t Pb0 = __builtin_bit_cast(bf16x8_t, w0), Pb1 = __builtin_bit_cast(bf16x8_t, w1);
    O0 = MFMA32(Vc[0], Pb0, O0); O0 = MFMA32(Vc[1], Pb1, O0);
    O1 = MFMA32(Vc[2], Pb0, O1); O1 = MFMA32(Vc[3], Pb1, O1);
    return __all(carry < 0x1p-134f);
}
__device__ __forceinline__ void attn_mfma(const Args& a, int u0, int ucnt, int ustride) {
    unsigned char* ws = a.ws;
    bf16* QS = (bf16*)(ws + WS_QS); const bf16* SK = (const bf16*)(ws + WS_SK); const bf16* VT = (const bf16*)((unsigned char*)a.out + 32 * MiB);
    const int lane = threadIdx.x & 63, r32 = lane & 31, hi = lane >> 5;
    const int kap = 16 * (r32 >> 4) + 8 * ((r32 >> 2) & 1) + 4 * ((r32 >> 3) & 1) + (r32 & 3);
    for (int uk = 0; uk < ucnt; ++uk) { const int u = u0 + uk * ustride;
        const int qb = u & 63, bh = u >> 6, h = bh & 15, b = bh >> 4;
        const size_t rowq = (size_t)b * SEQ + 32 * qb + r32;
        bf16* qp = QS + rowq * 2048 + 1024 + 64 * h;
        const bf16* kbase = SK + ((size_t)b * SEQ + kap) * 1024 + 64 * h + 8 * hi;
        const bf16* vbase = VT + ((size_t)bh * 64 + r32) * 2048 + 8 * hi;
        bf16x8_t Qf[4];
#pragma unroll
        for (int ks = 0; ks < 4; ++ks) Qf[ks] = *(const bf16x8_t*)(qp + 16 * ks + 8 * hi);
        f32x16 O0, O1;
#pragma unroll
        for (int j = 0; j < 16; ++j) { O0[j] = 0.f; O1[j] = 0.f; }
        float carry = 1.f;
        bf16x8_t KA[4], VA[4], KB[4], VB[4];
#define ATT_LOAD(K_, V_, kb_) do { _Pragma("unroll") for (int ks = 0; ks < 4; ++ks) K_[ks] = *(const bf16x8_t*)(kbase + (size_t)(32 * (kb_)) * 1024 + 16 * ks); \
        _Pragma("unroll") for (int i = 0; i < 4; ++i) V_[i] = *(const bf16x8_t*)(vbase + (size_t)(32 * (i >> 1)) * 2048 + 32 * (kb_) + 16 * (i & 1)); } while (0)
        ATT_LOAD(KA, VA, qb);
        int kb = qb;
        ATT_LOAD(KB, VB, kb > 0 ? kb - 1 : 0);
        if (!(attn_tile<true>(KA, VA, Qf, O0, O1, carry, r32, hi) || kb == 0)) {
            --kb;
#pragma unroll 1
            for (;;) {
                ATT_LOAD(KA, VA, kb > 0 ? kb - 1 : 0);
                if (attn_tile<false>(KB, VB, Qf, O0, O1, carry, r32, hi) || kb == 0) break;
                --kb;
                ATT_LOAD(KB, VB, kb > 0 ? kb - 1 : 0);
                if (attn_tile<false>(KA, VA, Qf, O0, O1, carry, r32, hi) || kb == 0) break;
                --kb;
            }
        }
#undef ATT_LOAD
#pragma unroll
        for (int a4 = 0; a4 < 4; ++a4) {
            u32x2_t x0, x1; x0.x = cvtpk(O0[4 * a4], O0[4 * a4 + 1]); x0.y = cvtpk(O0[4 * a4 + 2], O0[4 * a4 + 3]); x1.x = cvtpk(O1[4 * a4], O1[4 * a4 + 1]); x1.y = cvtpk(O1[4 * a4 + 2], O1[4 * a4 + 3]);
            *(u32x2_t*)(qp + 8 * a4 + 4 * hi) = x0; *(u32x2_t*)(qp + 32 + 8 * a4 + 4 * hi) = x1; }
    }
}

#define XB_TMO      128
#define XB_XCNT(j)  (256  + 64 * (j))
#define XB_XSUB(j)  (1280 + 64 * (j))
#define XB_XGEN(j)  (2304 + 64 * (j))
#define XB_TOP      3328
#define XB_TOPGEN   3392
#define XCD_BAR_WORDS 3456
#define XB_SPIN_CAP (1u << 18)

__device__ __forceinline__ unsigned xb_ld(unsigned* p)              { return __hip_atomic_load(p, __ATOMIC_RELAXED, __HIP_MEMORY_SCOPE_AGENT); }
__device__ __forceinline__ unsigned xb_add(unsigned* p, unsigned v) { return __hip_atomic_fetch_add(p, v, __ATOMIC_RELAXED, __HIP_MEMORY_SCOPE_AGENT); }
__device__ __forceinline__ unsigned xb_xcc_id() { return (unsigned)__builtin_amdgcn_s_getreg((3 << 11) | 20) & 0xFu; }
#define XB_SPIN(cond, bar) do { unsigned _sp = 0; while (cond) { __builtin_amdgcn_s_sleep(1); \
    if ((++_sp & 255u) == 0u) { if (xb_ld(&(bar)[XB_TMO])) break; if (_sp > XB_SPIN_CAP) { atomicAdd(&(bar)[XB_TMO], 1u); break; } } } } while (0)

struct XcdBarrier {
    unsigned* bar; unsigned x;
    volatile LAS unsigned* st;
};

__device__ __forceinline__ XcdBarrier xcd_barrier_post(unsigned* bar, volatile LAS unsigned* st) {
    XcdBarrier b; b.bar = bar; b.x = xb_xcc_id(); b.st = st;
    if (threadIdx.x == 0) (void)xb_add(&bar[XB_XCNT(b.x)], 1u);
    return b;
}
__device__ __forceinline__ void xcd_barrier_complete(unsigned* bar, unsigned x, unsigned& nloc, unsigned& nx) {
    const unsigned G = gridDim.x * gridDim.y * gridDim.z;
    unsigned sum, cnt, mine, sp = 0u;
    for (;;) {
        sum = 0u; cnt = 0u; mine = 0u;
#pragma unroll
        for (unsigned j = 0; j < 16; ++j) { const unsigned c = xb_ld(&bar[XB_XCNT(j)]); sum += c; cnt += (c > 0u) ? 1u : 0u; mine = (j == x) ? c : mine; }
        if (sum == G) break;
        __builtin_amdgcn_s_sleep(1);
        if ((++sp & 255u) == 0u) { if (xb_ld(&bar[XB_TMO])) break; if (sp > XB_SPIN_CAP) { atomicAdd(&bar[XB_TMO], 1u); break; } }
    }
    nloc = mine > 0u ? mine : 1u; nx = cnt > 0u ? cnt : 1u;
}

__device__ __forceinline__ void xcd_barrier(const XcdBarrier& b) {
    asm volatile("s_waitcnt vmcnt(0)" ::: "memory");
    __syncthreads();
    if (threadIdx.x == 0) {
        unsigned* bar = b.bar;
        __builtin_amdgcn_s_waitcnt(0);
        unsigned nloc = b.st[0], nx = b.st[1];
        if (nloc == 0u) { xcd_barrier_complete(bar, b.x, nloc, nx); b.st[0] = nloc; b.st[1] = nx; }
        const unsigned old = xb_add(&bar[XB_XSUB(b.x)], 1u);
        const unsigned gen = old / nloc;
        if (old + 1u == (gen + 1u) * nloc) {
            __builtin_amdgcn_fence(__ATOMIC_RELEASE, "agent");
            asm volatile("s_waitcnt vmcnt(0)" ::: "memory");
            const unsigned og = xb_add(&bar[XB_TOP], 1u);
            const unsigned tg = og / nx;
            if (og + 1u == (tg + 1u) * nx) xb_add(&bar[XB_TOPGEN], 1u);
            else XB_SPIN(xb_ld(&bar[XB_TOPGEN]) == tg, bar);
            __builtin_amdgcn_fence(__ATOMIC_ACQUIRE, "agent");
            xb_add(&bar[XB_XGEN(b.x)], 1u);
            asm volatile("s_waitcnt vmcnt(0)" ::: "memory");
        } else {
            XB_SPIN(xb_ld(&bar[XB_XGEN(b.x)]) == gen, bar);
            __builtin_amdgcn_fence(__ATOMIC_ACQUIRE, "agent");
            asm volatile("s_waitcnt vmcnt(0)" ::: "memory");
        }
    }
    __syncthreads();
}

__global__ void __launch_bounds__(NTHREADS, 2) hybrid_fwd(Args args) {
    extern __shared__ __attribute__((aligned(16))) unsigned char lds_raw[];
    LAS unsigned char* lds = (LAS unsigned char*)lds_raw;
    cg::grid_group grid = cg::this_grid();
    const int tid = threadIdx.x, lane = tid & 63, wave = __builtin_amdgcn_readfirstlane(tid >> 6);
    const int G = gridDim.x;
    unsigned char* ws = args.ws;
    const int lo = args.ph_lo, hi = args.ph_hi;
    volatile LAS unsigned* MISC = (volatile LAS unsigned*)(lds + MISC_OFF);
    if (tid < 2) MISC[tid] = 0u;
    __syncthreads();
    const XcdBarrier bar = xcd_barrier_post((unsigned*)ws, MISC);
#define IN(k) (lo <= (k) && (k) < hi)
#define SEAM(k) do { if (IN(k) && IN((k) + 1)) { xcd_barrier(bar); } } while (0)
    if (lo < 0) grid.sync();
    if (IN(0)) { p0_prologue<0>(args, lds, wave, lane, (int)blockIdx.x * NWAVES + wave, G * NWAVES); asm volatile("s_waitcnt vmcnt(0) lgkmcnt(0)" ::: "memory"); __syncthreads(); }
    SEAM(0);
    if (IN(1)) {
        pg8::Gemm g{(const pg8::bf16_t*)(ws + WS_H), (const pg8::bf16_t*)(ws + WS_WIN), M, 6144, D, D}; pg8::StaticOrder S; S.init(M, 6144, G, (int)blockIdx.x);
        pg8::EpiProj E{(pg8::bf16_t*)(ws + WS_QS), (pg8::bf16_t*)(ws + WS_VH), (pg8::bf16_t*)(ws + WS_SK), (pg8::bf16_t*)((unsigned char*)args.out + 32 * MiB), ws + WS_GH, ws + WS_GA, ws + WS_GB, (_Float16*)args.out,
                       args.in[3], args.in[5], args.in[6], 0};
        pg8::gemm_phase<pg8::EpiProj, pg8::StaticOrder, true, true>(lds, g, S, E);
        pg8::Gemm g2{(const pg8::bf16_t*)(ws + WS_WIN) + (size_t)6144 * 1024, (const pg8::bf16_t*)(ws + WS_H), 1024, M, D, D}; pg8::StaticOrder S2; S2.init(1024, M, G, (int)blockIdx.x);
        pg8::EpiVT E2{(pg8::bf16_t*)((unsigned char*)args.out + 32 * MiB)};
        pg8::gemm_phase<pg8::EpiVT, pg8::StaticOrder, true, true>(lds, g2, S2, E2);
    }
    SEAM(1);
    if (IN(2)) {
        const pg8::Gemm gg{(const pg8::bf16_t*)(ws + WS_H), (const pg8::bf16_t*)(ws + WS_WIN) + (size_t)7168 * 1024, M, 2048, D, D};
        const pg8::EpiProj EG{(pg8::bf16_t*)(ws + WS_QS), (pg8::bf16_t*)(ws + WS_VH), (pg8::bf16_t*)(ws + WS_SK), (pg8::bf16_t*)((unsigned char*)args.out + 32 * MiB), ws + WS_GH, ws + WS_GA, ws + WS_GB, (_Float16*)args.out,
                              args.in[3], args.in[5], args.in[6], 28};
        constexpr int NUNITS = BATCH * 16 * (SEQ / 32);
        if (G == 256) {
            pg8::ListOrder S; S.s.init(M, 2048, 256, 0);
            if ((int)blockIdx.x < 64) { hgrn_v2(args, lds, (int)blockIdx.x, 64); if (wave < 6) p0_prologue<1>(args, lds, wave, lane, 1536 + (int)blockIdx.x * 6 + wave, 1920); S.l0 = -1; S.l1 = -1; S.l2 = -1; }
            else { const int idx = (int)blockIdx.x - 64;
                if (idx < 128) attn_mfma(args, idx * 40 + wave, 5, NWAVES); else attn_mfma(args, 5120 + (idx - 128) * 48 + wave, 6, NWAVES);
                p0_prologue<1>(args, lds, wave, lane, idx * NWAVES + wave, 1920);
                S.l0 = idx; S.l1 = 192 + idx; S.l2 = idx < 128 ? 384 + idx : -1; }
            asm volatile("s_waitcnt vmcnt(0) lgkmcnt(0)" ::: "memory"); __syncthreads();
            pg8::gemm_phase<pg8::EpiProj, pg8::ListOrder, true, true>(lds, gg, S, EG);
        } else {
            const int gw = (int)blockIdx.x * NWAVES + wave, ngw = G * NWAVES;
            hgrn_v2(args, lds, (int)blockIdx.x, G); attn_mfma(args, gw, (NUNITS - gw + ngw - 1) / ngw, ngw); p0_prologue<1>(args, lds, wave, lane, gw, ngw);
            asm volatile("s_waitcnt vmcnt(0) lgkmcnt(0)" ::: "memory"); __syncthreads();
            pg8::StaticOrder S; S.init(M, 2048, G, (int)blockIdx.x);
            pg8::gemm_phase<pg8::EpiProj, pg8::StaticOrder, true, true>(lds, gg, S, EG);
        }
        __syncthreads();
    }
    SEAM(2);
    if (IN(3)) {
        pg8::Gemm g{(const pg8::bf16_t*)(ws + WS_QS), (const pg8::bf16_t*)(ws + WS_WHS), M, D, 1024, 2048}; pg8::SplitOrder S; S.s.init(M, D, G, (int)blockIdx.x);
        pg8::EpiMix E{ws + WS_GA, ws + WS_GB, (pg8::bf16_t*)(ws + WS_MIXED)};
        pg8::gemm_phase<pg8::EpiMix, pg8::SplitOrder, true, true>(lds, g, S, E);
    }
    SEAM(3);
    if (IN(4)) {
        pg8::Gemm g{(const pg8::bf16_t*)(ws + WS_MIXED), (const pg8::bf16_t*)(ws + WS_WO), M, D, D, D}; pg8::StaticOrder S; S.init(M, D, G, (int)blockIdx.x);
        pg8::EpiRes1 E{args.in[0], (pg8::bf16_t*)(ws + WS_GA), (pg8::bf16_t*)(ws + WS_X1B), (float*)(ws + WS_SSQ)};
        pg8::gemm_phase<pg8::EpiRes1, pg8::StaticOrder, true, true>(lds, g, S, E);
    }
    SEAM(4);
    if (IN(5)) {
        pg8::Gemm g{(const pg8::bf16_t*)(ws + WS_X1B), (const pg8::bf16_t*)(ws + WS_WF1), M, 2 * FFH, D, D}; pg8::StaticOrder S; S.init(M, 2 * FFH, G, (int)blockIdx.x);
        pg8::EpiSwiglu E{(const float*)(ws + WS_SSQ), (pg8::bf16_t*)(ws + WS_ACT)};
        pg8::gemm_phase<pg8::EpiSwiglu, pg8::StaticOrder, true, true>(lds, g, S, E);
    }
    SEAM(5);
    if (IN(6)) {
        pg8::Gemm g{(const pg8::bf16_t*)(ws + WS_ACT), (const pg8::bf16_t*)(ws + WS_WF2), M, D, FFH, FFH}; pg8::StaticOrder S; S.init(M, D, G, (int)blockIdx.x);
        pg8::EpiRes2 E{args.in[0], (const pg8::bf16_t*)(ws + WS_GA), args.out};
        pg8::gemm_phase<pg8::EpiRes2, pg8::StaticOrder, true, true>(lds, g, S, E);
    }
#undef IN
#undef SEAM
}

#ifndef MK_N_LAUNCHES
#define MK_N_LAUNCHES 1
#endif
extern "C" void kernel_launch(void* const* d_in, const int* in_sizes, int n_in, void* d_out, int out_size, void* d_ws, size_t ws_size, hipStream_t stream) {
    static int grid = 0;
    if (grid == 0) {
        int dev = 0, cus = 0, per_cu = 0;
        if (n_in != 13 || ws_size < WS_END) { fprintf(stderr, "kernel_launch: unexpected inputs / workspace (%d, %zu)\n", n_in, ws_size); grid = -1; return; }
        hipGetDevice(&dev); hipDeviceGetAttribute(&cus, hipDeviceAttributeMultiprocessorCount, dev);
        if (hipFuncSetAttribute((const void*)hybrid_fwd, hipFuncAttributeMaxDynamicSharedMemorySize, LDS_BYTES) != hipSuccess) { fprintf(stderr, "kernel_launch: hipFuncSetAttribute failed\n"); grid = -1; return; }
        if (hipOccupancyMaxActiveBlocksPerMultiprocessor(&per_cu, (const void*)hybrid_fwd, NTHREADS, LDS_BYTES) != hipSuccess || per_cu < 1) { fprintf(stderr, "kernel_launch: occupancy query says %d\n", per_cu); per_cu = 1; }
        (void)hipGetLastError();
        grid = cus * per_cu;
    }
    if (grid < 0) return;
    if (hipMemsetAsync(d_ws, 0, 16384, stream) != hipSuccess) { fprintf(stderr, "kernel_launch: memset of the barrier words failed\n"); return; }
    Args a{};
    for (int i = 0; i < 13; ++i) a.in[i] = (const float*)d_in[i];
    a.out = (float*)d_out; a.ws = (unsigned char*)d_ws;
#if MK_N_LAUNCHES == 1
    a.ph_lo = 0; a.ph_hi = 7;
    void* kargs[] = {&a};
    hipError_t e = hipLaunchCooperativeKernel((const void*)hybrid_fwd, dim3(grid), dim3(NTHREADS), kargs, LDS_BYTES, stream);
    if (e != hipSuccess) fprintf(stderr, "cooperative launch failed: %s (grid %d)\n", hipGetErrorString(e), grid);
#else
    for (int p = 0; p < 7; ++p) { a.ph_lo = p; a.ph_hi = p + 1; hipLaunchKernelGGL(hybrid_fwd, dim3(grid), dim3(NTHREADS), LDS_BYTES, stream, a); }
#endif
}
```

```cpp
#include <hip/hip_runtime.h>
#include <hip/hip_cooperative_groups.h>
#include <cstdio>
#include <cstdint>
namespace cg = cooperative_groups;
namespace pg8 {
#define PG8_LAS __attribute__((address_space(3)))
typedef unsigned short bf16_t;
typedef short bf16x8 __attribute__((ext_vector_type(8)));
typedef float f32x4 __attribute__((ext_vector_type(4)));
typedef unsigned u32x4 __attribute__((ext_vector_type(4)));
constexpr int BM = 256, BK = 64, HALF = 128, HTB = HALF * BK * 2  , STAGE_BYTES = 8 * HTB, NXCD = 8, WGM = 8;

__host__ __device__ __forceinline__ int lds_byte(int r, int c) { const int st = (r >> 4) * 2 + (c >> 5), rr = r & 15, cc = c & 31, ob = rr * 64 + cc * 2; return st * 1024 + (ob ^ (((ob >> 9) & 1) << 5)); }
__host__ __device__ __forceinline__ void stage_rc(int b, int& R, int& C) { const int st = b / 1024, sb = b % 1024, swz = sb ^ (((sb >> 9) & 1) << 5); R = (st >> 1) * 16 + swz / 64; C = (st & 1) * 32 + (swz % 64) / 2; }
__host__ __device__ __forceinline__ int perm32(int rho) { const int n = rho >> 4, i = rho & 15; return 8 * (i >> 2) + 4 * n + (i & 3); }

struct Unit { int pm, pn, kh; };
struct Gemm { const bf16_t* A; const bf16_t* Bt; int M, N, K, ld; };

struct StaticOrder {
    int nM, nN, nwg, G, c;
    __host__ __device__ void init(int M, int N, int G_, int c_) { nM = M / BM; nN = N / BM; nwg = nM * nN; G = G_; c = c_; }
    __host__ __device__ bool next(int i, Unit& u) const { const long L = (long)i * G + c; if (L >= nwg) return false; return unit_of((int)L, u); }
    __host__ __device__ bool unit_of(int L, Unit& u) const {
        int wgid = L; { const int q = nwg / NXCD, r = nwg % NXCD, xcd = wgid % NXCD, off = wgid / NXCD; wgid = (xcd < r ? xcd * (q + 1) : r * (q + 1) + (xcd - r) * q) + off; }
        const int nig = WGM * nN, gid = wgid / nig, fm = gid * WGM, gsz = (nM - fm) < WGM ? (nM - fm) : WGM;
        u.pm = fm + ((wgid % nig) % gsz); u.pn = (wgid % nig) / gsz; u.kh = 0; return true;
    }
    __device__ __forceinline__ void a_ready(const Unit&) const {}
    __device__ __forceinline__ void done(const Unit&) const {}
};
struct ListOrder {
    StaticOrder s; int l0, l1, l2;
    __host__ __device__ bool next(int i, Unit& u) const { const int L = i == 0 ? l0 : (i == 1 ? l1 : (i == 2 ? l2 : -1)); if (L < 0 || L >= s.nwg) return false; return s.unit_of(L, u); }
    __device__ __forceinline__ void a_ready(const Unit&) const {}
    __device__ __forceinline__ void done(const Unit&) const {}
};
struct SplitOrder {
    StaticOrder s;
    __host__ __device__ bool next(int i, Unit& u) const { const bool ok = s.next(i >> 1, u); u.kh = i & 1; return ok; }
    __device__ __forceinline__ void a_ready(const Unit&) const {}
    __device__ __forceinline__ void done(const Unit&) const {}
};
typedef float f32x2_cv __attribute__((ext_vector_type(2))); typedef __bf16 bf16x2_cvv __attribute__((ext_vector_type(2)));
__device__ __forceinline__ unsigned cvt_pk_bf16(float lo, float hi) { const f32x2_cv v = {lo, hi}; return __builtin_bit_cast(unsigned, __builtin_convertvector(v, bf16x2_cvv)); }
typedef float f32x2 __attribute__((ext_vector_type(2)));
typedef _Float16 f16x8 __attribute__((ext_vector_type(8)));
typedef unsigned u32x2 __attribute__((ext_vector_type(2)));
__device__ __forceinline__ float sigm(float x) { return __builtin_amdgcn_rcpf(1.0f + __expf(-x)); }
__device__ __forceinline__ unsigned q8(float s) { float q = s * 255.0f + 0.5f; q = q < 1.0f ? 1.0f : (q > 255.0f ? 255.0f : q); return (unsigned)q; }
__device__ __forceinline__ u32x4 pack8_bf16(const float (&o)[8]) { u32x4 w; w.x = cvt_pk_bf16(o[0], o[1]); w.y = cvt_pk_bf16(o[2], o[3]); w.z = cvt_pk_bf16(o[4], o[5]); w.w = cvt_pk_bf16(o[6], o[7]); return w; }
__device__ __forceinline__ u32x2 pack8_u8(const float (&o)[8]) { u32x2 w; unsigned a = 0u, c = 0u;
#pragma unroll
    for (int k = 0; k < 4; ++k) { a = __builtin_amdgcn_cvt_pk_u8_f32(fmaxf(o[k] * 255.0f, 1.0f), k, a); c = __builtin_amdgcn_cvt_pk_u8_f32(fmaxf(o[4 + k] * 255.0f, 1.0f), k, c); }
    w.x = a; w.y = c; return w; }

struct EpiProj {
    static constexpr bool PERM = true, AFTER_DRAIN = false, KSPLIT = false;
    bf16_t* QS; bf16_t* VH; bf16_t* SK; bf16_t* SV; unsigned char* GH; unsigned char* GA; unsigned char* GB; _Float16* LOGF;
    const float* lbl; const float* qg; const float* kg; int pn0;
    __device__ __forceinline__ void operator()(const f32x4 (&acc)[2][2][4][2], const Unit& u, int wr, int wc, int fr, int fq) const {
        const int sec = (u.pn + pn0) >> 2, ct = (u.pn & 3) * 256;
        const int row0 = u.pm * BM + wr * 64 + fr;
        if (sec == 4 || sec == 5) {
            const int head = (u.pn & 3) * 4 + wc; const float* gp = (sec == 4 ? qg : kg) + head * 64 + 8 * fq;
            float gn[2][8];
#pragma unroll
            for (int bj = 0; bj < 2; ++bj) { const f32x4 a = *(const f32x4*)(gp + 32 * bj), b = *(const f32x4*)(gp + 32 * bj + 4);
                gn[bj][0] = a[0]; gn[bj][1] = a[1]; gn[bj][2] = a[2]; gn[bj][3] = a[3]; gn[bj][4] = b[0]; gn[bj][5] = b[1]; gn[bj][6] = b[2]; gn[bj][7] = b[3]; }
            const float sc = (sec == 4) ? 0.125f * 1.4426950408889634f : 1.0f;
#pragma unroll
            for (int ai = 0; ai < 2; ++ai)
#pragma unroll
                for (int m = 0; m < 4; ++m) {
                    float ss = 0.f;
#pragma unroll
                    for (int bj = 0; bj < 2; ++bj)
#pragma unroll
                        for (int n = 0; n < 2; ++n) { const f32x4 x = acc[ai][bj][m][n]; ss += (x[0] * x[0] + x[1] * x[1]) + (x[2] * x[2] + x[3] * x[3]); }
                    ss += __shfl_xor(ss, 16); ss += __shfl_xor(ss, 32);
                    const float rstd = __builtin_amdgcn_rsqf(ss * (1.0f / 64.0f) + 1e-6f) * sc;
                    const size_t row = (size_t)(row0 + ai * HALF + m * 16);
#pragma unroll
                    for (int bj = 0; bj < 2; ++bj) { float o[8];
#pragma unroll
                        for (int k = 0; k < 8; ++k) o[k] = acc[ai][bj][m][k >> 2][k & 3] * rstd * gn[bj][k];
                        bf16_t* dst = (sec == 4) ? (QS + row * 2048 + 1024 + head * 64 + 32 * bj + 8 * fq) : (SK + row * 1024 + head * 64 + 32 * bj + 8 * fq);
                        *(u32x4*)dst = pack8_bf16(o); }
                }
            return;
        }
        switch (sec) {
            case 0: store_kind<0>(acc, row0, ct, wc, fq, nullptr); break;
            case 1: store_kind<1>(acc, row0, ct, wc, fq, nullptr); break;
            case 2: store_kind<2>(acc, row0, ct, wc, fq, nullptr); break;
            case 3: store_kind<3>(acc, row0, ct, wc, fq, GH); break;
            case 6: store_kind<6>(acc, row0, ct, wc, fq, nullptr); break;
            case 7: store_kind<3>(acc, row0, ct, wc, fq, GA); break;
            default: store_kind<3>(acc, row0, ct, wc, fq, GB); break;
        }
    }
    template <int KIND> __device__ __forceinline__ void store_kind(const f32x4 (&acc)[2][2][4][2], int row0, int ct, int wc, int fq, unsigned char* g8) const {
#pragma unroll
        for (int bj = 0; bj < 2; ++bj) {
            const int col = ct + bj * HALF + wc * 32 + 8 * fq;
            float lb[8];
            if (KIND == 1) {
#pragma unroll
                for (int k = 0; k < 8; ++k) lb[k] = __builtin_amdgcn_rcpf(1.0f + __expf(lbl[1024 + col + k] - lbl[col + k]));
            }
#pragma unroll
            for (int ai = 0; ai < 2; ++ai)
#pragma unroll
                for (int m = 0; m < 4; ++m) {
                    const size_t row = (size_t)(row0 + ai * HALF + m * 16);
                    float o[8];
#pragma unroll
                    for (int k = 0; k < 8; ++k) o[k] = acc[ai][bj][m][k >> 2][k & 3];
                    if (KIND == 0) { *(u32x4*)(QS + row * 2048 + col) = pack8_bf16(o); }
                    else if (KIND == 2) { *(u32x4*)(VH + row * 1024 + col) = pack8_bf16(o); }
                    else if (KIND == 6) { bf16_t* vt = SV + ((size_t)((row >> 11) * 16 + (col >> 6)) * 64 + (col & 63)) * 2048 + (row & 2047);
#pragma unroll
                        for (int k = 0; k < 8; ++k) vt[(size_t)k * 2048] = (bf16_t)(cvt_pk_bf16(o[k], o[k]) & 0xffffu); }
                    else if (KIND == 1) { f16x8 g;
#pragma unroll
                        for (int k = 0; k < 8; ++k) g[k] = (_Float16)__logf(lb[k] + (1.0f - lb[k]) * sigm(o[k]));
                        *(f16x8*)(LOGF + row * 1024 + col) = g; }
                    else {
#pragma unroll
                        for (int k = 0; k < 8; ++k) o[k] = sigm(o[k]);
                        *(u32x2*)(g8 + row * 1024 + col) = pack8_u8(o); }
                }
        }
    }
};

struct EpiVT {
    static constexpr bool PERM = true, AFTER_DRAIN = false, KSPLIT = false;
    bf16_t* VT;
    __device__ __forceinline__ void operator()(const f32x4 (&acc)[2][2][4][2], const Unit& u, int wr, int wc, int fr, int fq) const {
        const int row0 = u.pm * BM + wr * 64 + fr;
#pragma unroll
        for (int ai = 0; ai < 2; ++ai)
#pragma unroll
            for (int m = 0; m < 4; ++m)
#pragma unroll
                for (int bj = 0; bj < 2; ++bj) {
                    const int r = row0 + ai * HALF + m * 16, c = u.pn * BM + bj * HALF + wc * 32 + 8 * fq;
                    float o[8];
#pragma unroll
                    for (int k = 0; k < 8; ++k) o[k] = acc[ai][bj][m][k >> 2][k & 3];
                    *(u32x4*)(VT + ((size_t)((c >> 11) * 16 + (r >> 6)) * 64 + (r & 63)) * 2048 + (c & 2047)) = pack8_bf16(o);
                }
    }
};
struct EpiMix {
    static constexpr bool PERM = true, AFTER_DRAIN = false, KSPLIT = true;
    const unsigned char* GA; const unsigned char* GB; bf16_t* MIXED;
    __device__ __forceinline__ void half0(f32x4 (&acc)[2][2][4][2], const Unit& u, int wr, int wc, int fr, int fq) const {
        const int row0 = u.pm * BM + wr * 64 + fr;
#pragma unroll
        for (int ai = 0; ai < 2; ++ai)
#pragma unroll
            for (int m = 0; m < 4; ++m)
#pragma unroll
                for (int bj = 0; bj < 2; ++bj) {
                    const size_t off = (size_t)(row0 + ai * HALF + m * 16) * 1024 + u.pn * BM + bj * HALF + wc * 32 + 8 * fq;
                    const u32x2 a = *(const u32x2*)(GA + off), b = *(const u32x2*)(GB + off);
#pragma unroll
                    for (int k = 0; k < 8; ++k) { const float qa = (float)((a[k >> 2] >> (8 * (k & 3))) & 255u), qb = (float)((b[k >> 2] >> (8 * (k & 3))) & 255u);
                        acc[ai][bj][m][k >> 2][k & 3] *= qa * __builtin_amdgcn_rcpf(qb); }
                    if (bj == 1 && (m & 1)) asm volatile("" ::: "memory");
                }
    }
    __device__ __forceinline__ void operator()(f32x4 (&acc)[2][2][4][2], const Unit& u, int wr, int wc, int fr, int fq) const {
        if (u.kh == 0) { half0(acc, u, wr, wc, fr, fq); return; }
        const int row0 = u.pm * BM + wr * 64 + fr;
        u32x2 gbv[2][4][2];
#pragma unroll
        for (int ai = 0; ai < 2; ++ai)
#pragma unroll
            for (int m = 0; m < 4; ++m)
#pragma unroll
                for (int bj = 0; bj < 2; ++bj) gbv[ai][m][bj] = *(const u32x2*)(GB + (size_t)(row0 + ai * HALF + m * 16) * 1024 + u.pn * BM + bj * HALF + wc * 32 + 8 * fq);
#pragma unroll
        for (int ai = 0; ai < 2; ++ai)
#pragma unroll
            for (int m = 0; m < 4; ++m)
#pragma unroll
                for (int bj = 0; bj < 2; ++bj) {
                    const size_t off = (size_t)(row0 + ai * HALF + m * 16) * 1024 + u.pn * BM + bj * HALF + wc * 32 + 8 * fq;
                    const u32x2 b = gbv[ai][m][bj]; float o[8];
#pragma unroll
                    for (int k = 0; k < 8; ++k) { const float qb = (float)((b[k >> 2] >> (8 * (k & 3))) & 255u); o[k] = acc[ai][bj][m][k >> 2][k & 3] * (qb * (1.0f / 255.0f)); }
                    *(u32x4*)(MIXED + off) = pack8_bf16(o);
                }
    }
};
struct EpiRes1 {
    static constexpr bool PERM = true, AFTER_DRAIN = false, KSPLIT = false;
    const float* x; bf16_t* DL; bf16_t* X1B; float* SSQ;
    __device__ __forceinline__ void operator()(const f32x4 (&acc)[2][2][4][2], const Unit& u, int wr, int wc, int fr, int fq) const {
        const int row0 = u.pm * BM + wr * 64 + fr;
#pragma unroll
        for (int ai = 0; ai < 2; ++ai)
#pragma unroll
            for (int mp = 0; mp < 2; ++mp) {
                f32x4 xv[2][2][2];
#pragma unroll
                for (int mm = 0; mm < 2; ++mm)
#pragma unroll
                    for (int bj = 0; bj < 2; ++bj) { const size_t off = (size_t)(row0 + ai * HALF + (2 * mp + mm) * 16) * 1024 + u.pn * BM + bj * HALF + wc * 32 + 8 * fq;
                        xv[mm][bj][0] = *(const f32x4*)(x + off); xv[mm][bj][1] = *(const f32x4*)(x + off + 4); }
#pragma unroll
                for (int mm = 0; mm < 2; ++mm) {
                    const int m = 2 * mp + mm; const int row = row0 + ai * HALF + m * 16; float ss = 0.f;
#pragma unroll
                    for (int bj = 0; bj < 2; ++bj) {
                        const size_t off = (size_t)row * 1024 + u.pn * BM + bj * HALF + wc * 32 + 8 * fq;
                        const f32x4 a0 = acc[ai][bj][m][0], a1 = acc[ai][bj][m][1];
                        const f32x4 v0 = xv[mm][bj][0] + a0, v1 = xv[mm][bj][1] + a1;
                        u32x4 dw; dw.x = cvt_pk_bf16(a0[0], a0[1]); dw.y = cvt_pk_bf16(a0[2], a0[3]); dw.z = cvt_pk_bf16(a1[0], a1[1]); dw.w = cvt_pk_bf16(a1[2], a1[3]); *(u32x4*)(DL + off) = dw;
                        u32x4 w; w.x = cvt_pk_bf16(v0[0], v0[1]); w.y = cvt_pk_bf16(v0[2], v0[3]); w.z = cvt_pk_bf16(v1[0], v1[1]); w.w = cvt_pk_bf16(v1[2], v1[3]);
                        *(u32x4*)(X1B + off) = w;
                        ss += (v0[0] * v0[0] + v0[1] * v0[1]) + (v0[2] * v0[2] + v0[3] * v0[3]) + (v1[0] * v1[0] + v1[1] * v1[1]) + (v1[2] * v1[2] + v1[3] * v1[3]);
                    }
                    ss += __shfl_xor(ss, 16); ss += __shfl_xor(ss, 32);
                    if (fq == 0) SSQ[(size_t)row * 16 + u.pn * 4 + wc] = ss;
                }
            }
    }
};
struct EpiSwiglu {
    static constexpr bool PERM = true, AFTER_DRAIN = false, KSPLIT = false;
    const float* SSQ; bf16_t* ACT;
    __device__ __forceinline__ void operator()(const f32x4 (&acc)[2][2][4][2], const Unit& u, int wr, int wc, int fr, int fq) const {
        const int row0 = u.pm * BM + wr * 64 + fr;
        f32x4 sq[2][4];
#pragma unroll
        for (int ai = 0; ai < 2; ++ai)
#pragma unroll
            for (int m = 0; m < 4; ++m) sq[ai][m] = *(const f32x4*)(SSQ + (size_t)(row0 + ai * HALF + m * 16) * 16 + 4 * fq);
#pragma unroll
        for (int ai = 0; ai < 2; ++ai)
#pragma unroll
            for (int m = 0; m < 4; ++m) {
                const int row = row0 + ai * HALF + m * 16;
                float ss = (sq[ai][m][0] + sq[ai][m][1]) + (sq[ai][m][2] + sq[ai][m][3]);
                ss += __shfl_xor(ss, 16); ss += __shfl_xor(ss, 32);
                const float rstd = __builtin_amdgcn_rsqf(ss * (1.0f / 1024.0f) + 1e-6f);
                float o[8];
#pragma unroll
                for (int k = 0; k < 8; ++k) { const float g = acc[ai][0][m][k >> 2][k & 3] * rstd, up = acc[ai][1][m][k >> 2][k & 3] * rstd; o[k] = g * sigm(g) * up; }
                *(u32x4*)(ACT + (size_t)row * 2816 + u.pn * 128 + wc * 32 + 8 * fq) = pack8_bf16(o);
            }
    }
};
struct EpiRes2 {
    static constexpr bool PERM = true, AFTER_DRAIN = false, KSPLIT = false;
    const float* x; const bf16_t* DL; float* out;
    __device__ __forceinline__ void operator()(const f32x4 (&acc)[2][2][4][2], const Unit& u, int wr, int wc, int fr, int fq) const {
        const int row0 = u.pm * BM + wr * 64 + fr;
#pragma unroll
        for (int ai = 0; ai < 2; ++ai)
#pragma unroll
            for (int mp = 0; mp < 2; ++mp) {
                f32x4 xv[2][2][2]; u32x4 dv[2][2];
#pragma unroll
                for (int mm = 0; mm < 2; ++mm)
#pragma unroll
                    for (int bj = 0; bj < 2; ++bj) { const size_t off = (size_t)(row0 + ai * HALF + (2 * mp + mm) * 16) * 1024 + u.pn * BM + bj * HALF + wc * 32 + 8 * fq;
                        xv[mm][bj][0] = *(const f32x4*)(x + off); xv[mm][bj][1] = *(const f32x4*)(x + off + 4); dv[mm][bj] = *(const u32x4*)(DL + off); }
#pragma unroll
                for (int mm = 0; mm < 2; ++mm)
#pragma unroll
                    for (int bj = 0; bj < 2; ++bj) { const int m = 2 * mp + mm;
                        const size_t off = (size_t)(row0 + ai * HALF + m * 16) * 1024 + u.pn * BM + bj * HALF + wc * 32 + 8 * fq;
                        const u32x4 dw = dv[mm][bj];
                        f32x4 d0, d1; d0[0] = __builtin_bit_cast(float, dw.x << 16); d0[1] = __builtin_bit_cast(float, dw.x & 0xffff0000u); d0[2] = __builtin_bit_cast(float, dw.y << 16); d0[3] = __builtin_bit_cast(float, dw.y & 0xffff0000u);
                        d1[0] = __builtin_bit_cast(float, dw.z << 16); d1[1] = __builtin_bit_cast(float, dw.z & 0xffff0000u); d1[2] = __builtin_bit_cast(float, dw.w << 16); d1[3] = __builtin_bit_cast(float, dw.w & 0xffff0000u);
                        const f32x4 v0 = (xv[mm][bj][0] + d0) + acc[ai][bj][m][0], v1 = (xv[mm][bj][1] + d1) + acc[ai][bj][m][1];
                        *(f32x4*)(out + off) = v0; *(f32x4*)(out + off + 4) = v1; }
            }
    }
};

template <class Epi, class Sched, bool ALIGN_EPI = false, bool SP2 = false>
__device__ __forceinline__ void gemm_phase(PG8_LAS unsigned char* lds, const Gemm g, const Sched& S, const Epi& E) {
    int tid_ = threadIdx.x; asm volatile("" : "+v"(tid_));
    const int tid = tid_, wid = __builtin_amdgcn_readfirstlane(tid >> 6), lane = tid & 63, wr = wid >> 2, wc = wid & 3, fr = lane & 15, fq = lane >> 4;
    const int K = g.K, nt = K / BK;
    unsigned voffA[2], voffB[2];
#pragma unroll
    for (int i = 0; i < 2; ++i) { int R, C; stage_rc(tid * 16 + i * 8192, R, C); const int Rb = Epi::PERM ? ((R & ~31) + perm32(R & 31)) : R;
        voffA[i] = (unsigned)(R * g.ld + C) * 2u; voffB[i] = (unsigned)(Rb * g.ld + C) * 2u; }
    const size_t kstep = (size_t)(BK * 2);
    const size_t hstep = (size_t)HALF * g.ld * 2; const size_t khb = (size_t)K * 2;
    const size_t tstep = 2 * hstep;
    const unsigned ldsw = (unsigned)wid * 1024u;
    const int aoff = lds_byte(wr * 64 + fr, fq * 8), boff = lds_byte(wc * 32 + fr, fq * 8);
#define PG8_SA(b, h) (((b) * 2 + (h)) * HTB)
#define PG8_SB(b, h) ((4 + (b) * 2 + (h)) * HTB)
#define PG8_STAGE(bufoff, gbase, voff) do { _Pragma("unroll") for (int _i = 0; _i < 2; ++_i) \
        __builtin_amdgcn_global_load_lds((const unsigned*)((const char*)(gbase) + (voff)[_i]), (PG8_LAS unsigned*)(lds + (bufoff) + ldsw + _i * 8192), 16, 0, 0); } while (0)
#define PG8_LDA(dst, b, h) do { _Pragma("unroll") for (int m = 0; m < 4; ++m) _Pragma("unroll") for (int k = 0; k < 2; ++k) dst[m][k] = *(const PG8_LAS bf16x8*)(lds + PG8_SA(b, h) + aoff + m * 2048 + k * 1024); } while (0)
#define PG8_LDB(dst, b, h) do { _Pragma("unroll") for (int n = 0; n < 2; ++n) _Pragma("unroll") for (int k = 0; k < 2; ++k) dst[n][k] = *(const PG8_LAS bf16x8*)(lds + PG8_SB(b, h) + boff + n * 2048 + k * 1024); } while (0)
#define PG8_MMA(ai, bj, At, Bt) do { __builtin_amdgcn_s_setprio(1); _Pragma("unroll") for (int m = 0; m < 4; ++m) _Pragma("unroll") for (int n = 0; n < 2; ++n) _Pragma("unroll") for (int k = 0; k < 2; ++k) \
        acc[ai][bj][m][n] = __builtin_amdgcn_mfma_f32_16x16x32_bf16(Bt[n][k], At[m][k], acc[ai][bj][m][n], 0, 0, 0); __builtin_amdgcn_s_setprio(0); } while (0)
#define PG8_WAIT_V(n) asm volatile("s_waitcnt vmcnt(" #n ")" ::: "memory")
#define PG8_WAIT_L(n) asm volatile("s_waitcnt lgkmcnt(" #n ")" ::: "memory")
#define PG8_BAR __builtin_amdgcn_s_barrier()
#define PG8_SCHED __builtin_amdgcn_sched_barrier(0)
    Unit cur, nxt; int ui = 0;
    if (!S.next(0, cur)) return;
    f32x4 acc[2][2][4][2];
#pragma unroll
    for (int a = 0; a < 2; ++a)
#pragma unroll
        for (int b = 0; b < 2; ++b)
#pragma unroll
            for (int m = 0; m < 4; ++m)
#pragma unroll
                for (int n = 0; n < 2; ++n) acc[a][b][m][n] = (f32x4){0.f, 0.f, 0.f, 0.f};
    bf16x8 At[4][2], B0[2][2], B1[2][2];
    const char* cA = (const char*)g.A + (size_t)cur.pm * tstep + cur.kh * khb; const char* cB = (const char*)g.Bt + (size_t)cur.pn * tstep + cur.kh * khb;
    S.a_ready(cur);
    if constexpr (SP2) {
        PG8_STAGE(PG8_SB(0, 0), cB, voffB); PG8_STAGE(PG8_SB(0, 1), cB + hstep, voffB); PG8_STAGE(PG8_SA(0, 0), cA, voffA); PG8_STAGE(PG8_SA(0, 1), cA + hstep, voffA);
        if (wr == 1) PG8_BAR;
        PG8_WAIT_V(2); PG8_BAR;
        PG8_STAGE(PG8_SB(1, 0), cB + kstep, voffB); PG8_STAGE(PG8_SA(1, 0), cA + kstep, voffA); PG8_STAGE(PG8_SB(1, 1), cB + hstep + kstep, voffB);
        PG8_WAIT_V(6); PG8_BAR;
    } else {
        PG8_STAGE(PG8_SB(0, 0), cB, voffB); PG8_STAGE(PG8_SA(0, 0), cA, voffA); PG8_STAGE(PG8_SB(0, 1), cB + hstep, voffB); PG8_STAGE(PG8_SA(0, 1), cA + hstep, voffA);
        if (wr == 1) PG8_BAR;
        PG8_WAIT_V(4); PG8_BAR;
        PG8_STAGE(PG8_SB(1, 0), cB + kstep, voffB); PG8_STAGE(PG8_SA(1, 0), cA + kstep, voffA); PG8_STAGE(PG8_SB(1, 1), cB + hstep + kstep, voffB);
        PG8_WAIT_V(6); PG8_BAR;
    }
    for (;;) {
        const bool has_next = S.next(ui + 1, nxt);
        const char* nA = has_next ? (const char*)g.A + (size_t)nxt.pm * tstep + nxt.kh * khb : cA; const char* nB = has_next ? (const char*)g.Bt + (size_t)nxt.pn * tstep + nxt.kh * khb : cB;
        for (int t = 0; t < nt; t += 2) {
            const bool last = (t == nt - 2);
            const char* a1 = cA + (size_t)(t + 1) * kstep;
            const char* a2 = last ? nA : cA + (size_t)(t + 2) * kstep; const char* b2 = last ? nB : cB + (size_t)(t + 2) * kstep;
            const char* a3 = a2 + kstep; const char* b3 = b2 + kstep;
            if (last && has_next) S.a_ready(nxt);
            if constexpr (SP2) {
            PG8_LDB(B0, 0, 0); PG8_LDB(B1, 0, 1); PG8_SCHED; PG8_LDA(At, 0, 0); PG8_STAGE(PG8_SA(1, 1), a1 + hstep, voffA);
            PG8_WAIT_V(8); PG8_WAIT_L(0); PG8_BAR; PG8_MMA(0, 0, At, B0); PG8_MMA(0, 1, At, B1); PG8_BAR; PG8_SCHED;
            PG8_LDA(At, 0, 1); PG8_STAGE(PG8_SB(0, 0), b2, voffB); PG8_STAGE(PG8_SB(0, 1), b2 + hstep, voffB); PG8_STAGE(PG8_SA(0, 0), a2, voffA);
            PG8_WAIT_V(8); PG8_WAIT_L(0); PG8_BAR; PG8_MMA(1, 0, At, B0); PG8_MMA(1, 1, At, B1); PG8_BAR; PG8_SCHED;
            PG8_LDB(B0, 1, 0); PG8_LDB(B1, 1, 1); PG8_SCHED; PG8_LDA(At, 1, 0); PG8_STAGE(PG8_SA(0, 1), a2 + hstep, voffA);
            PG8_WAIT_V(8); PG8_WAIT_L(0); PG8_BAR; PG8_MMA(0, 0, At, B0); PG8_MMA(0, 1, At, B1); PG8_BAR; PG8_SCHED;
            PG8_LDA(At, 1, 1); PG8_STAGE(PG8_SB(1, 0), b3, voffB); PG8_STAGE(PG8_SB(1, 1), b3 + hstep, voffB); PG8_STAGE(PG8_SA(1, 0), a3, voffA);
            PG8_WAIT_V(8); PG8_WAIT_L(0); PG8_BAR; PG8_MMA(1, 0, At, B0); PG8_MMA(1, 1, At, B1); PG8_BAR; PG8_SCHED;
            } else {
            PG8_LDB(B0, 0, 0); PG8_SCHED; PG8_LDA(At, 0, 0); PG8_STAGE(PG8_SA(1, 1), a1 + hstep, voffA);
            PG8_WAIT_L(8); PG8_BAR; PG8_WAIT_L(0); PG8_MMA(0, 0, At, B0); PG8_BAR; PG8_SCHED;
            PG8_LDB(B1, 0, 1); PG8_STAGE(PG8_SB(0, 0), b2, voffB);
            PG8_BAR; PG8_WAIT_L(0); PG8_MMA(0, 1, At, B1); PG8_BAR;
            PG8_LDA(At, 0, 1); PG8_STAGE(PG8_SA(0, 0), a2, voffA);
            PG8_BAR; PG8_WAIT_L(0); PG8_MMA(1, 0, At, B0); PG8_BAR; PG8_SCHED;
            PG8_STAGE(PG8_SB(0, 1), b2 + hstep, voffB);
            PG8_WAIT_V(6); PG8_BAR; PG8_MMA(1, 1, At, B1); PG8_BAR;
            PG8_LDB(B0, 1, 0); PG8_SCHED; PG8_LDA(At, 1, 0); PG8_STAGE(PG8_SA(0, 1), a2 + hstep, voffA);
            PG8_WAIT_L(8); PG8_BAR; PG8_WAIT_L(0); PG8_MMA(0, 0, At, B0); PG8_BAR; PG8_SCHED;
            PG8_LDB(B1, 1, 1); PG8_STAGE(PG8_SB(1, 0), b3, voffB);
            PG8_BAR; PG8_WAIT_L(0); PG8_MMA(0, 1, At, B1); PG8_BAR;
            PG8_LDA(At, 1, 1); PG8_STAGE(PG8_SA(1, 0), a3, voffA);
            PG8_BAR; PG8_WAIT_L(0); PG8_MMA(1, 0, At, B0); PG8_BAR; PG8_SCHED;
            PG8_STAGE(PG8_SB(1, 1), b3 + hstep, voffB);
            PG8_WAIT_V(6); PG8_BAR; PG8_MMA(1, 1, At, B1); PG8_BAR;
            }
        }
        if constexpr (ALIGN_EPI) { if (wr == 0) PG8_BAR; }
        if constexpr (!Epi::AFTER_DRAIN) { E(acc, cur, wr, wc, fr, fq); S.done(cur); }
        if (!has_next) break;
        if (!(Epi::KSPLIT && cur.kh == 0))
#pragma unroll
        for (int a = 0; a < 2; ++a)
#pragma unroll
            for (int b = 0; b < 2; ++b)
#pragma unroll
                for (int m = 0; m < 4; ++m)
#pragma unroll
                    for (int n = 0; n < 2; ++n) acc[a][b][m][n] = (f32x4){0.f, 0.f, 0.f, 0.f};
        cur = nxt; cA = nA; cB = nB; ++ui;
        if constexpr (ALIGN_EPI) { if (wr == 1) PG8_BAR; }
    }
    PG8_WAIT_V(0);
    if constexpr (!ALIGN_EPI) { if (wr == 0) PG8_BAR; }
    PG8_BAR;
    if constexpr (Epi::AFTER_DRAIN) { E.fused(acc, cur, wr, wc, fr, fq, lds, wid, lane); S.done(cur); }
#undef PG8_SA
#undef PG8_SB
#undef PG8_STAGE
#undef PG8_LDA
#undef PG8_LDB
#undef PG8_MMA
#undef PG8_WAIT_V
#undef PG8_WAIT_L
#undef PG8_BAR
#undef PG8_SCHED
}
}

constexpr int NWAVES = 8, NTHREADS = 512;
constexpr int BATCH = 8, SEQ = 2048, D = 1024, M = BATCH * SEQ, INW = 9216, FFH = 2816;
constexpr float EPS = 1e-6f;
constexpr size_t MiB = 1u << 20;
constexpr size_t WS_SSQ = 1 * MiB;
constexpr size_t WS_WIN = 2 * MiB;
constexpr size_t WS_WHS = 20 * MiB;
constexpr size_t WS_WO = 24 * MiB;
constexpr size_t WS_WF1 = 26 * MiB;
constexpr size_t WS_WF2 = 37 * MiB;
constexpr size_t WS_H = 43 * MiB;
constexpr size_t WS_MIXED = WS_H;
constexpr size_t WS_QS = 75 * MiB;
constexpr size_t WS_VH = 139 * MiB;
constexpr size_t WS_SK = 171 * MiB;
constexpr size_t WS_X1B = WS_SK;
constexpr size_t WS_GH = 203 * MiB, WS_GA = 219 * MiB, WS_GB = 235 * MiB;
constexpr size_t WS_ACT = 75 * MiB;
constexpr size_t WS_END = 251 * MiB;
static_assert(WS_ACT + (size_t)M * FFH * 2 <= WS_X1B, "ACT overlay");
constexpr int RING_BYTES = 131072, LDS_BYTES = 157696, MISC_OFF = LDS_BYTES - 256;

#define LAS __attribute__((address_space(3)))
typedef unsigned short bf16;
typedef unsigned v4u __attribute__((ext_vector_type(4)));
typedef float f32x4 __attribute__((ext_vector_type(4)));
__device__ __forceinline__ unsigned f2bf(float f) { unsigned u = __builtin_bit_cast(unsigned, f); return (u + 0x7fffu + ((u >> 16) & 1u)) >> 16; }
__device__ __forceinline__ unsigned pk2(float lo, float hi) { return f2bf(lo) | (f2bf(hi) << 16); }
__device__ __forceinline__ float bf2f(unsigned short b) { return __builtin_bit_cast(float, (unsigned)b << 16); }
__device__ __forceinline__ float wave_sum(float v) {
#pragma unroll
    for (int o = 1; o < 64; o <<= 1) v += __shfl_xor(v, o);
    return v;
}
struct Args { const float* in[13]; float* out; unsigned char* ws; int ph_lo, ph_hi; };

struct ConvItem { const float* W; bf16* WT; const float* ks; int N, ldT, koff, k0, n0d, n0s; };
__device__ __forceinline__ ConvItem conv_item(const Args& a, unsigned char* ws, int it) {
    constexpr int I_IN = 16 * (INW / 32), I_SQ = 16 * 32, I_F1 = 16 * (2 * FFH / 32);
    ConvItem p; int r = it; p.ks = nullptr; p.koff = 0;
    if (r < I_IN) { const int nblk = INW / 32, kb = r / nblk, nb = r % nblk, n0d = 32 * nb; const int sec = n0d >> 10; int n0s = n0d;
        if (sec == 4 || sec == 5) { const int q = n0d & 255; n0s = (n0d - q) + 64 * ((q >> 5) & 3) + 32 * (q >> 7); }
        p.W = a.in[2]; p.N = INW; p.WT = (bf16*)(ws + WS_WIN); p.ldT = 1024; p.k0 = 64 * kb; p.n0d = n0d; p.n0s = n0s; return p; } r -= I_IN;
    if (r < I_SQ) { p.W = a.in[7]; p.N = 1024; p.WT = (bf16*)(ws + WS_WHS); p.ldT = 2048; p.k0 = 64 * (r / 32); p.n0d = p.n0s = 32 * (r % 32); return p; } r -= I_SQ;
    if (r < I_SQ) { p.W = a.in[8]; p.N = 1024; p.WT = (bf16*)(ws + WS_WHS); p.ldT = 2048; p.koff = 1024; p.k0 = 64 * (r / 32); p.n0d = p.n0s = 32 * (r % 32); return p; } r -= I_SQ;
    if (r < I_SQ) { p.W = a.in[9]; p.N = 1024; p.WT = (bf16*)(ws + WS_WO); p.ldT = 1024; p.k0 = 64 * (r / 32); p.n0d = p.n0s = 32 * (r % 32); return p; } r -= I_SQ;
    if (r < I_F1) { const int nblk = 2 * FFH / 32, kb = r / nblk, nb = r % nblk, n0d = 32 * nb, pn = n0d >> 8, q = n0d & 255;
        p.W = a.in[11]; p.N = 2 * FFH; p.WT = (bf16*)(ws + WS_WF1); p.ldT = 1024; p.k0 = 64 * kb; p.n0d = n0d; p.n0s = (q >> 7) * FFH + 128 * pn + (q & 127); p.ks = a.in[10]; return p; } r -= I_F1;
    p.W = a.in[12]; p.N = 1024; p.WT = (bf16*)(ws + WS_WF2); p.ldT = FFH; p.k0 = 64 * (r / 32); p.n0d = p.n0s = 32 * (r % 32); return p;
}
__device__ __forceinline__ void conv_load(const ConvItem& p, float (&wv)[32], f32x4 (&kv)[2], int lane) {
    const float* wp = p.W + (size_t)(p.k0 + (lane >> 5)) * p.N + p.n0s + (lane & 31);
#pragma unroll
    for (int i = 0; i < 32; ++i) wv[i] = wp[(size_t)(2 * i) * p.N];
    if (p.ks) { kv[0] = *(const f32x4*)(p.ks + p.k0 + 8 * (lane & 7)); kv[1] = *(const f32x4*)(p.ks + p.k0 + 8 * (lane & 7) + 4); }
    else { kv[0] = (f32x4){1.f, 1.f, 1.f, 1.f}; kv[1] = kv[0]; }
}
__device__ __forceinline__ void conv_finish(const ConvItem& p, const float (&wv)[32], const f32x4 (&kv)[2], LAS float* scr, int lane) {
#pragma unroll
    for (int i = 0; i < 32; ++i) scr[(2 * i + (lane >> 5)) * 33 + (lane & 31)] = wv[i];
    asm volatile("s_waitcnt lgkmcnt(0)" ::: "memory");
    const int c = lane & 7;
#pragma unroll
    for (int j = 0; j < 4; ++j) { const int n = (lane >> 3) + 8 * j; const LAS float* s = scr + (8 * c) * 33 + n;
        v4u o; o.x = pk2(s[0 * 33] * kv[0][0], s[1 * 33] * kv[0][1]); o.y = pk2(s[2 * 33] * kv[0][2], s[3 * 33] * kv[0][3]); o.z = pk2(s[4 * 33] * kv[1][0], s[5 * 33] * kv[1][1]); o.w = pk2(s[6 * 33] * kv[1][2], s[7 * 33] * kv[1][3]);
        *(v4u*)(p.WT + (size_t)(p.n0d + n) * p.ldT + p.koff + p.k0 + 8 * c) = o; }
    asm volatile("s_waitcnt lgkmcnt(0)" ::: "memory");
}
template <int PART> __device__ __forceinline__ void p0_prologue(const Args& a, LAS unsigned char* lds, int wave, int lane, int gw, int NGW, int it_last = 1 << 30) {
    LAS float* scr = (LAS float*)(lds + wave * 16384);
    unsigned char* ws = a.ws;
    constexpr int I_IN = 16 * (INW / 32), I_SQ = 16 * 32, I_F1 = 16 * (2 * FFH / 32), I_F2 = (FFH / 64) * 32;
    constexpr int NITEMS = I_IN + 3 * I_SQ + I_F1 + I_F2;
    { int it = (PART == 0 ? gw : I_IN + gw); const int end = (PART == 0 ? I_IN : (I_IN + it_last < NITEMS ? I_IN + it_last : NITEMS));
      if (it < end) {
        ConvItem pa = conv_item(a, ws, it), pb = pa; float wa[32], wb[32]; f32x4 ka[2], kb[2];
        conv_load(pa, wa, ka, lane);
        for (;;) {
            const bool hb = it + NGW < end; if (hb) { pb = conv_item(a, ws, it + NGW); conv_load(pb, wb, kb, lane); }
            conv_finish(pa, wa, ka, scr, lane);
            if (!hb) break; it += NGW;
            const bool ha = it + NGW < end; if (ha) { pa = conv_item(a, ws, it + NGW); conv_load(pa, wa, ka, lane); }
            conv_finish(pb, wb, kb, scr, lane);
            if (!ha) break; it += NGW;
        }
      }
    }
    if (PART != 0) return;
    const float* g1 = a.in[1];
    f32x4 gv[4];
#pragma unroll
    for (int j = 0; j < 4; ++j) gv[j] = ((const f32x4*)g1)[lane + 64 * j];
    for (int m = gw; m < M; m += NGW) {
        const f32x4* xr = (const f32x4*)(a.in[0] + (size_t)m * D) + lane;
        f32x4 v[4]; float s = 0.f;
#pragma unroll
        for (int j = 0; j < 4; ++j) { v[j] = xr[64 * j]; s += (v[j].x * v[j].x + v[j].y * v[j].y) + (v[j].z * v[j].z + v[j].w * v[j].w); }
        const float rstd = __builtin_amdgcn_rsqf(wave_sum(s) * (1.f / D) + EPS);
        unsigned long long* o8 = (unsigned long long*)((bf16*)(ws + WS_H) + (size_t)m * D) + lane;
#pragma unroll
        for (int j = 0; j < 4; ++j) { const f32x4 y = v[j] * rstd * gv[j]; o8[64 * j] = (unsigned long long)pk2(y.x, y.y) | ((unsigned long long)pk2(y.z, y.w) << 32); }
    }
}

typedef short bf16x8_t __attribute__((ext_vector_type(8)));
typedef float f32x16 __attribute__((ext_vector_type(16)));
typedef unsigned u32x2_t __attribute__((ext_vector_type(2)));
typedef float f32x2_t __attribute__((ext_vector_type(2)));
typedef __bf16 bf16x2_cv __attribute__((ext_vector_type(2)));
__device__ __forceinline__ unsigned cvtpk(float lo, float hi) { const f32x2_t v = {lo, hi}; return __builtin_bit_cast(unsigned, __builtin_convertvector(v, bf16x2_cv)); }
__device__ __forceinline__ bf16x8_t pack_acc8(const f32x16& c, int p) {
    v4u w; if (p == 0) { w.x = cvtpk(c[0], c[1]); w.y = cvtpk(c[2], c[3]); w.z = cvtpk(c[4], c[5]); w.w = cvtpk(c[6], c[7]); }
    else { w.x = cvtpk(c[8], c[9]); w.y = cvtpk(c[10], c[11]); w.z = cvtpk(c[12], c[13]); w.w = cvtpk(c[14], c[15]); }
    return __builtin_bit_cast(bf16x8_t, w);
}
#define MFMA32(A, B, C) __builtin_amdgcn_mfma_f32_32x32x16_bf16((A), (B), (C), 0, 0, 0)
__device__ __forceinline__ void hgrn_mfma(const Args& a, LAS unsigned char* lds, int vblk, int nblk) {
    unsigned char* ws = a.ws;
    bf16* QS = (bf16*)(ws + WS_QS); const bf16* VH = (const bf16*)(ws + WS_VH); const unsigned char* GH = ws + WS_GH; const _Float16* LOGF = (const _Float16*)a.out;
    const float* ogain = a.in[4];
    constexpr int RS = 272, TS = 144;
    LAS unsigned char* L_QI = lds; LAS unsigned char* L_QA = lds + 64 * RS; LAS unsigned char* L_KA = lds + 2 * 64 * RS;
    LAS unsigned char* L_KST = lds + 3 * 64 * RS; LAS unsigned char* L_VT = L_KST + 128 * TS;
    LAS float* L_TQ = (LAS float*)(L_VT + 128 * TS); LAS float* L_DEC = L_TQ + 2048;     LAS float* L_SS = L_DEC + 128; LAS float* L_GN = L_SS + 256;
    const int tid = threadIdx.x, lane = tid & 63, wave = __builtin_amdgcn_readfirstlane(tid >> 6);
    const int dp = tid & 63, oct = wave, r32 = lane & 31, hi = lane >> 5, vt = wave & 3, tt = wave >> 2;
    const int kap = 16 * (r32 >> 4) + 8 * ((r32 >> 2) & 1) + 4 * ((r32 >> 3) & 1) + (r32 & 3);
    for (int item = vblk; item < BATCH * 8; item += nblk) {
        const int b = item >> 3, h = item & 7;
        f32x16 C[4];
#pragma unroll
        for (int i = 0; i < 4; ++i)
#pragma unroll
            for (int j = 0; j < 16; ++j) C[i][j] = 0.f;
        if (tid < 128) L_GN[tid] = ogain[h * 128 + tid];
        unsigned gN2[2][8], qN2[2][8], vN2[2][8];
#pragma unroll
        for (int c2 = 0; c2 < 2; ++c2) { const size_t row0 = (size_t)b * SEQ + 64 * c2 + 8 * oct;
#pragma unroll
          for (int i = 0; i < 8; ++i) { gN2[c2][i] = *(const unsigned*)(LOGF + (row0 + i) * 1024 + h * 128 + 2 * dp); qN2[c2][i] = *(const unsigned*)(QS + (row0 + i) * 2048 + h * 128 + 2 * dp); vN2[c2][i] = *(const unsigned*)(VH + (row0 + i) * 1024 + h * 128 + 2 * dp); } }
        { float run0 = 0.f, run1 = 0.f;
#pragma unroll
          for (int i = 0; i < 8; ++i) { run0 += (float)__builtin_bit_cast(_Float16, (unsigned short)(gN2[0][i] & 0xffffu)); run1 += (float)__builtin_bit_cast(_Float16, (unsigned short)(gN2[0][i] >> 16)); }
          *(LAS f32x2_t*)(L_TQ + oct * 128 + 2 * dp) = (f32x2_t){run0, run1}; }
        __syncthreads();
#pragma unroll 2
        for (int n = 0; n < SEQ / 64; ++n) {
            unsigned (&gN)[8] = gN2[n & 1]; unsigned (&qN)[8] = qN2[n & 1]; unsigned (&vN)[8] = vN2[n & 1];
            if (n + 1 < SEQ / 64) { float run0 = 0.f, run1 = 0.f;
#pragma unroll
                for (int i = 0; i < 8; ++i) { const unsigned gw_ = gN2[(n + 1) & 1][i]; run0 += (float)__builtin_bit_cast(_Float16, (unsigned short)(gw_ & 0xffffu)); run1 += (float)__builtin_bit_cast(_Float16, (unsigned short)(gw_ >> 16)); }
                *(LAS f32x2_t*)(L_TQ + ((n + 1) & 1) * 1024 + oct * 128 + 2 * dp) = (f32x2_t){run0, run1}; }
            float off0 = 0.f, off1 = 0.f, cref0 = 0.f, cref1 = 0.f, tot0 = 0.f, tot1 = 0.f;
#pragma unroll
            for (int o = 0; o < 8; ++o) { const f32x2_t tq = *(const LAS f32x2_t*)(L_TQ + (n & 1) * 1024 + o * 128 + 2 * dp);
                if (o < oct) { off0 += tq.x; off1 += tq.y; } if (o < 4) { cref0 += tq.x; cref1 += tq.y; } tot0 += tq.x; tot1 += tq.y; }
            const float xc0 = __expf(tot0), xc1 = __expf(tot1), xa0 = __expf(-cref0), xa1 = __expf(-cref1), xb0 = __expf(cref0), xb1 = __expf(cref1);
            if (oct == 0) *(LAS f32x2_t*)(L_DEC + 2 * dp) = (f32x2_t){xc0, xc1};
            float e0 = __expf(off0), e1 = __expf(off1);
            unsigned ksp0[4], ksp1[4], vsp0[4], vsp1[4];
#pragma unroll
            for (int i = 0; i < 8; ++i) {
                const float f0 = __expf((float)__builtin_bit_cast(_Float16, (unsigned short)(gN[i] & 0xffffu))), f1 = __expf((float)__builtin_bit_cast(_Float16, (unsigned short)(gN[i] >> 16)));
                e0 = fmaxf(e0 * f0, 1e-30f); e1 = fmaxf(e1 * f1, 1e-30f);
                const float r0 = __builtin_amdgcn_rcpf(e0), r1 = __builtin_amdgcn_rcpf(e1);
                const float k0 = 1.0f - f0, k1 = 1.0f - f1, q0 = __builtin_bit_cast(float, qN[i] << 16), q1 = __builtin_bit_cast(float, qN[i] & 0xffff0000u);
                const float qi0 = q0 * e0, qi1 = q1 * e1, kr0 = k0 * r0, kr1 = k1 * r1;
                const int t = 8 * oct + i;
                *(LAS unsigned*)(L_QI + t * RS + 4 * dp) = cvtpk(qi0, qi1);
                *(LAS unsigned*)(L_QA + t * RS + 4 * dp) = cvtpk(qi0 * xa0, qi1 * xa1);
                *(LAS unsigned*)(L_KA + t * RS + 4 * dp) = cvtpk(kr0 * xb0, kr1 * xb1);
                const unsigned ks = cvtpk(kr0 * xc0, kr1 * xc1);
                if (i & 1) { ksp0[i >> 1] |= ks << 16; ksp1[i >> 1] |= ks & 0xffff0000u; vsp0[i >> 1] |= vN[i] << 16; vsp1[i >> 1] |= vN[i] & 0xffff0000u; }
                else { ksp0[i >> 1] = ks & 0xffffu; ksp1[i >> 1] = ks >> 16; vsp0[i >> 1] = vN[i] & 0xffffu; vsp1[i >> 1] = vN[i] >> 16; }
            }
            *(LAS v4u*)(L_KST + (2 * dp) * TS + 16 * oct) = (v4u){ksp0[0], ksp0[1], ksp0[2], ksp0[3]}; *(LAS v4u*)(L_KST + (2 * dp + 1) * TS + 16 * oct) = (v4u){ksp1[0], ksp1[1], ksp1[2], ksp1[3]};
            *(LAS v4u*)(L_VT + (2 * dp) * TS + 16 * oct) = (v4u){vsp0[0], vsp0[1], vsp0[2], vsp0[3]}; *(LAS v4u*)(L_VT + (2 * dp + 1) * TS + 16 * oct) = (v4u){vsp1[0], vsp1[1], vsp1[2], vsp1[3]};
            __syncthreads();
            const size_t m = (size_t)b * SEQ + 64 * n + 32 * tt + r32;
            unsigned gt4[4];
#pragma unroll
            for (int a4 = 0; a4 < 4; ++a4) gt4[a4] = *(const unsigned*)(GH + m * 1024 + h * 128 + 32 * vt + 8 * a4 + 4 * hi);
            if (n + 2 < SEQ / 64) { const size_t row0 = (size_t)b * SEQ + 64 * (n + 2) + 8 * oct;
#pragma unroll
                for (int i = 0; i < 8; ++i) { gN[i] = *(const unsigned*)(LOGF + (row0 + i) * 1024 + h * 128 + 2 * dp); qN[i] = *(const unsigned*)(QS + (row0 + i) * 2048 + h * 128 + 2 * dp); vN[i] = *(const unsigned*)(VH + (row0 + i) * 1024 + h * 128 + 2 * dp); } }
#define SB() __builtin_amdgcn_sched_barrier(0)
            f32x16 O;
#pragma unroll
            for (int j = 0; j < 16; ++j) O[j] = 0.f;
            bf16x8_t Vt[4];
            {
                v4u qf[8];
#pragma unroll
                for (int i = 0; i < 8; ++i) { const LAS unsigned char* qp = L_QI + (32 * tt + r32) * RS + (32 * (i >> 1) + 16 * (i & 1) + 4 * hi) * 2;
                    const u32x2_t lo = *(const LAS u32x2_t*)qp, hi2 = *(const LAS u32x2_t*)(qp + 16); qf[i] = (v4u){lo.x, lo.y, hi2.x, hi2.y}; }
#pragma unroll
                for (int ks = 0; ks < 4; ++ks) Vt[ks] = *(const LAS bf16x8_t*)(L_VT + (32 * vt + r32) * TS + (16 * ks + 8 * hi) * 2);
                SB();
#pragma unroll
                for (int i = 0; i < 8; ++i) O = MFMA32(pack_acc8(C[i >> 1], i & 1), __builtin_bit_cast(bf16x8_t, qf[i]), O);
                SB();
            }
#pragma unroll
            for (int st = 0; st < 2; ++st) if (st <= tt) {
                f32x16 S;
#pragma unroll
                for (int j = 0; j < 16; ++j) S[j] = 0.f;
#pragma unroll
                for (int hb = 0; hb < 2; ++hb) {
                    bf16x8_t A[4], B[4];
#pragma unroll
                    for (int k4 = 0; k4 < 4; ++k4) { const int ks = 4 * hb + k4;
                        A[k4] = *(const LAS bf16x8_t*)(L_KA + (32 * st + kap) * RS + (16 * ks + 8 * hi) * 2);
                        B[k4] = *(const LAS bf16x8_t*)(L_QA + (32 * tt + r32) * RS + (16 * ks + 8 * hi) * 2); }
                    SB();
#pragma unroll
                    for (int k4 = 0; k4 < 4; ++k4) S = MFMA32(A[k4], B[k4], S);
                    SB();
                }
                if (st == tt) {
#pragma unroll
                    for (int j = 0; j < 16; ++j) { const int sl = 16 * (j >> 3) + 8 * hi + (j & 7); if (sl > r32) S[j] = 0.f; }
                }
                O = MFMA32(Vt[2 * st], pack_acc8(S, 0), O); O = MFMA32(Vt[2 * st + 1], pack_acc8(S, 1), O);
            }
#pragma unroll
            for (int dt = 0; dt < 4; ++dt) {
                f32x4 dc[4]; bf16x8_t A[4];
#pragma unroll
                for (int a4 = 0; a4 < 4; ++a4) dc[a4] = *(const LAS f32x4*)(L_DEC + 32 * dt + 8 * a4 + 4 * hi);
#pragma unroll
                for (int ks = 0; ks < 4; ++ks) A[ks] = *(const LAS bf16x8_t*)(L_KST + (32 * dt + r32) * TS + (16 * ks + 8 * hi) * 2);
                SB();
#pragma unroll
                for (int a4 = 0; a4 < 4; ++a4)
#pragma unroll
                    for (int cc = 0; cc < 4; ++cc) C[dt][4 * a4 + cc] *= dc[a4][cc];
#pragma unroll
                for (int ks = 0; ks < 4; ++ks) C[dt] = MFMA32(A[ks], Vt[ks], C[dt]);
                SB();
            }
#undef SB
            float ss = 0.f;
#pragma unroll
            for (int j = 0; j < 16; ++j) ss += O[j] * O[j];
            ss += __shfl_xor(ss, 32);
            if (hi == 0) L_SS[(tt * 4 + vt) * 32 + r32] = ss;
            __syncthreads();
            const float sst = (L_SS[(tt * 4 + 0) * 32 + r32] + L_SS[(tt * 4 + 1) * 32 + r32]) + (L_SS[(tt * 4 + 2) * 32 + r32] + L_SS[(tt * 4 + 3) * 32 + r32]);
            const float rstd = __builtin_amdgcn_rsqf(sst * (1.0f / 128.0f) + EPS);
#pragma unroll
            for (int a4 = 0; a4 < 4; ++a4) { const int v0 = h * 128 + 32 * vt + 8 * a4 + 4 * hi;
                const f32x4 gn = *(const LAS f32x4*)(L_GN + 32 * vt + 8 * a4 + 4 * hi); const unsigned gt = gt4[a4];
                float o[4];
#pragma unroll
                for (int cc = 0; cc < 4; ++cc) o[cc] = O[4 * a4 + cc] * rstd * gn[cc] * ((float)((gt >> (8 * cc)) & 255u) * (1.0f / 255.0f));
                u32x2_t w; w.x = cvtpk(o[0], o[1]); w.y = cvtpk(o[2], o[3]);
                *(u32x2_t*)(QS + m * 2048 + v0) = w; }
        }
        __syncthreads();
    }
}

__device__ __forceinline__ void hgrn_v2(const Args& a, LAS unsigned char* lds, int vblk, int nblk) {
    unsigned char* ws = a.ws;
    bf16* QS = (bf16*)(ws + WS_QS); const bf16* VH = (const bf16*)(ws + WS_VH); const unsigned char* GH = ws + WS_GH; const _Float16* LOGF = (const _Float16*)a.out;
    const float* ogain = a.in[4];
    constexpr int RS = 272, TS = 144, O_KA = 64 * RS, O_KAT = 2 * 64 * RS, O_VT = O_KAT + 128 * TS, BUFB = O_VT + 128 * TS;
    LAS float* L_TQ = (LAS float*)(lds + 2 * BUFB);
    LAS float* L_XS = L_TQ + 1024;
    LAS float* L_SS = L_XS + 512;
    LAS float* L_GN = L_SS + 512;
    const int tid = threadIdx.x, lane = tid & 63, wave = __builtin_amdgcn_readfirstlane(tid >> 6);
    const int r32 = lane & 31, hi = lane >> 5;
    const int kap = 16 * (r32 >> 4) + 8 * ((r32 >> 2) & 1) + 4 * ((r32 >> 3) & 1) + (r32 & 3);
    constexpr int NCH = SEQ / 64;
#define SB() __builtin_amdgcn_sched_barrier(0)
    for (int item = vblk; item < BATCH * 8; item += nblk) {
        const int b = item >> 3, h = item & 7;
        if (tid < 128) L_GN[tid] = ogain[h * 128 + tid];
        if (wave < 4) {
            const int vt = wave;
            f32x16 C[4];
#pragma unroll
            for (int i = 0; i < 4; ++i)
#pragma unroll
                for (int j = 0; j < 16; ++j) C[i][j] = 0.f;
            f32x16 O[2]; unsigned gt4[2][4];
#define HG_EPI(cn) do { _Pragma("unroll") for (int tt = 0; tt < 2; ++tt) { const LAS float* SSb = L_SS + ((cn) & 1) * 256; \
                const float sst = (SSb[(tt * 4 + 0) * 32 + r32] + SSb[(tt * 4 + 1) * 32 + r32]) + (SSb[(tt * 4 + 2) * 32 + r32] + SSb[(tt * 4 + 3) * 32 + r32]); \
                const float rstd = __builtin_amdgcn_rsqf(sst * (1.0f / 128.0f) + EPS); \
                const size_t m = (size_t)b * SEQ + 64 * (cn) + r32 + 32 * tt; \
                _Pragma("unroll") for (int a4 = 0; a4 < 4; ++a4) { const int v0 = h * 128 + 32 * vt + 8 * a4 + 4 * hi; \
                    const f32x4 gn = *(const LAS f32x4*)(L_GN + 32 * vt + 8 * a4 + 4 * hi); const unsigned gt = gt4[tt][a4]; float o[4]; \
                    _Pragma("unroll") for (int cc = 0; cc < 4; ++cc) o[cc] = O[tt][4 * a4 + cc] * rstd * gn[cc] * ((float)((gt >> (8 * cc)) & 255u) * (1.0f / 255.0f)); \
                    u32x2_t w; w.x = cvtpk(o[0], o[1]); w.y = cvtpk(o[2], o[3]); *(u32x2_t*)(QS + m * 2048 + v0) = w; } } } while (0)
            __syncthreads();
#pragma unroll 1
            for (int n = 0; n < NCH; ++n) {
                __syncthreads();
                if (n > 0) HG_EPI(n - 1);
                const LAS unsigned char* T = lds + (n & 1) * BUFB;
                const LAS float* XS = L_XS + (n & 1) * 256;
                const size_t m0 = (size_t)b * SEQ + 64 * n + r32;
#pragma unroll
                for (int tt = 0; tt < 2; ++tt)
#pragma unroll
                    for (int a4 = 0; a4 < 4; ++a4) gt4[tt][a4] = *(const unsigned*)(GH + (m0 + 32 * tt) * 1024 + h * 128 + 32 * vt + 8 * a4 + 4 * hi);
                bf16x8_t Cp[8]; bf16x8_t Vt[4];
#pragma unroll
                for (int ks = 0; ks < 4; ++ks) Vt[ks] = *(const LAS bf16x8_t*)(T + O_VT + (32 * vt + r32) * TS + (16 * ks + 8 * hi) * 2);
#pragma unroll
                for (int dt = 0; dt < 4; ++dt) {
#pragma unroll
                    for (int a4 = 0; a4 < 4; ++a4) { const f32x4 x1 = *(const LAS f32x4*)(XS + 32 * dt + 8 * a4 + 4 * hi);
#pragma unroll
                        for (int cc = 0; cc < 4; ++cc) C[dt][4 * a4 + cc] *= x1[cc]; }
                    Cp[2 * dt] = pack_acc8(C[dt], 0); Cp[2 * dt + 1] = pack_acc8(C[dt], 1);
                }
#pragma unroll
                for (int tt = 0; tt < 2; ++tt) {
#pragma unroll
                    for (int j = 0; j < 16; ++j) O[tt][j] = 0.f;
                    v4u qf[8];
#pragma unroll
                    for (int i = 0; i < 8; ++i) { const LAS unsigned char* qp = T + (32 * tt + r32) * RS + (32 * (i >> 1) + 16 * (i & 1) + 4 * hi) * 2;
                        const u32x2_t lo = *(const LAS u32x2_t*)qp, hi2 = *(const LAS u32x2_t*)(qp + 16); qf[i] = (v4u){lo.x, lo.y, hi2.x, hi2.y}; }
                    SB();
#pragma unroll
                    for (int i = 0; i < 8; ++i) O[tt] = MFMA32(Cp[i], __builtin_bit_cast(bf16x8_t, qf[i]), O[tt]);
                    SB();
#pragma unroll
                    for (int st = 0; st < 2; ++st) if (st <= tt) {
                        f32x16 S;
#pragma unroll
                        for (int j = 0; j < 16; ++j) S[j] = 0.f;
#pragma unroll
                        for (int hb = 0; hb < 2; ++hb) {
                            bf16x8_t A[4], B[4];
#pragma unroll
                            for (int k4 = 0; k4 < 4; ++k4) { const int ks = 4 * hb + k4;
                                A[k4] = *(const LAS bf16x8_t*)(T + O_KA + (32 * st + kap) * RS + (16 * ks + 8 * hi) * 2);
                                B[k4] = *(const LAS bf16x8_t*)(T + (32 * tt + r32) * RS + (16 * ks + 8 * hi) * 2); }
                            SB();
#pragma unroll
                            for (int k4 = 0; k4 < 4; ++k4) S = MFMA32(A[k4], B[k4], S);
                            SB();
                        }
                        if (st == tt) {
#pragma unroll
                            for (int j = 0; j < 16; ++j) { const int sl = 16 * (j >> 3) + 8 * hi + (j & 7); if (sl > r32) S[j] = 0.f; }
                        }
                        O[tt] = MFMA32(Vt[2 * st], pack_acc8(S, 0), O[tt]); O[tt] = MFMA32(Vt[2 * st + 1], pack_acc8(S, 1), O[tt]);
                    }
                    float ss = 0.f;
#pragma unroll
                    for (int j = 0; j < 16; ++j) ss += O[tt][j] * O[tt][j];
                    ss += __shfl_xor(ss, 32);
                    if (hi == 0) L_SS[(n & 1) * 256 + (tt * 4 + vt) * 32 + r32] = ss;
                }
#pragma unroll
                for (int dt = 0; dt < 4; ++dt) {
                    f32x4 x2[4]; bf16x8_t A[4];
#pragma unroll
                    for (int a4 = 0; a4 < 4; ++a4) x2[a4] = *(const LAS f32x4*)(XS + 128 + 32 * dt + 8 * a4 + 4 * hi);
#pragma unroll
                    for (int ks = 0; ks < 4; ++ks) A[ks] = *(const LAS bf16x8_t*)(T + O_KAT + (32 * dt + r32) * TS + (16 * ks + 8 * hi) * 2);
                    SB();
#pragma unroll
                    for (int ks = 0; ks < 4; ++ks) C[dt] = MFMA32(A[ks], Vt[ks], C[dt]);
#pragma unroll
                    for (int a4 = 0; a4 < 4; ++a4)
#pragma unroll
                        for (int cc = 0; cc < 4; ++cc) C[dt][4 * a4 + cc] *= x2[a4][cc];
                    SB();
                }
            }
            __syncthreads();
            HG_EPI(NCH - 1);
#undef HG_EPI
        } else {
            const int ptid = tid - 256, dp = ptid & 63, q4 = ptid >> 6;
            unsigned g2[2][16], q2[2][16], v2[2][16];
#define HG_LOAD(set, c) do { const size_t row0_ = (size_t)b * SEQ + 64 * (c) + 16 * q4; _Pragma("unroll") for (int i = 0; i < 16; ++i) { \
                g2[set][i] = *(const unsigned*)(LOGF + (row0_ + i) * 1024 + h * 128 + 2 * dp); q2[set][i] = *(const unsigned*)(QS + (row0_ + i) * 2048 + h * 128 + 2 * dp); \
                v2[set][i] = *(const unsigned*)(VH + (row0_ + i) * 1024 + h * 128 + 2 * dp); } } while (0)
#define HG_SUMS(set, c) do { float r0_ = 0.f, r1_ = 0.f; _Pragma("unroll") for (int i = 0; i < 16; ++i) { r0_ += (float)__builtin_bit_cast(_Float16, (unsigned short)(g2[set][i] & 0xffffu)); \
                r1_ += (float)__builtin_bit_cast(_Float16, (unsigned short)(g2[set][i] >> 16)); } *(LAS f32x2_t*)(L_TQ + ((c) & 1) * 512 + q4 * 128 + 2 * dp) = (f32x2_t){r0_, r1_}; } while (0)
            float e0, e1, xa0, xa1, xb0, xb1; unsigned kp0[8], kp1[8], vp0[8], vp1[8];
#define HG_BEGIN(c) do { float off0 = 0.f, off1 = 0.f, cref0 = 0.f, cref1 = 0.f, tot0 = 0.f, tot1 = 0.f; \
                _Pragma("unroll") for (int o = 0; o < 4; ++o) { const f32x2_t tq = *(const LAS f32x2_t*)(L_TQ + ((c) & 1) * 512 + o * 128 + 2 * dp); \
                    if (o < q4) { off0 += tq.x; off1 += tq.y; } if (o < 2) { cref0 += tq.x; cref1 += tq.y; } tot0 += tq.x; tot1 += tq.y; } \
                xa0 = __expf(-cref0); xa1 = __expf(-cref1); xb0 = __expf(cref0); xb1 = __expf(cref1); e0 = __expf(off0); e1 = __expf(off1); \
                if (q4 == 0) { *(LAS f32x2_t*)(L_XS + ((c) & 1) * 256 + 2 * dp) = (f32x2_t){xb0, xb1}; *(LAS f32x2_t*)(L_XS + ((c) & 1) * 256 + 128 + 2 * dp) = (f32x2_t){__expf(tot0 - cref0), __expf(tot1 - cref1)}; } } while (0)
#define HG_TOKENS(set, c, i0) do { LAS unsigned char* T_ = lds + ((c) & 1) * BUFB; _Pragma("unroll") for (int i = (i0); i < (i0) + 8; ++i) { \
                const unsigned gw_ = g2[set][i], qw_ = q2[set][i], vw_ = v2[set][i]; \
                const float f0 = __expf((float)__builtin_bit_cast(_Float16, (unsigned short)(gw_ & 0xffffu))), f1 = __expf((float)__builtin_bit_cast(_Float16, (unsigned short)(gw_ >> 16))); \
                e0 = fmaxf(e0 * f0, 1e-30f); e1 = fmaxf(e1 * f1, 1e-30f); \
                const float r0 = __builtin_amdgcn_rcpf(e0), r1 = __builtin_amdgcn_rcpf(e1); \
                const float qq0 = __builtin_bit_cast(float, qw_ << 16), qq1 = __builtin_bit_cast(float, qw_ & 0xffff0000u); \
                const int t = 16 * q4 + i; \
                *(LAS unsigned*)(T_ + t * RS + 4 * dp) = cvtpk(qq0 * e0 * xa0, qq1 * e1 * xa1); \
                const unsigned ka = cvtpk((1.0f - f0) * r0 * xb0, (1.0f - f1) * r1 * xb1); \
                *(LAS unsigned*)(T_ + O_KA + t * RS + 4 * dp) = ka; \
                if (i & 1) { kp0[i >> 1] |= ka << 16; kp1[i >> 1] |= ka & 0xffff0000u; vp0[i >> 1] |= vw_ << 16; vp1[i >> 1] |= vw_ & 0xffff0000u; } \
                else { kp0[i >> 1] = ka & 0xffffu; kp1[i >> 1] = ka >> 16; vp0[i >> 1] = vw_ & 0xffffu; vp1[i >> 1] = vw_ >> 16; } } } while (0)
#define HG_FINISH(c) do { LAS unsigned char* T_ = lds + ((c) & 1) * BUFB; \
                *(LAS v4u*)(T_ + O_KAT + (2 * dp) * TS + 32 * q4) = (v4u){kp0[0], kp0[1], kp0[2], kp0[3]}; *(LAS v4u*)(T_ + O_KAT + (2 * dp) * TS + 32 * q4 + 16) = (v4u){kp0[4], kp0[5], kp0[6], kp0[7]}; \
                *(LAS v4u*)(T_ + O_KAT + (2 * dp + 1) * TS + 32 * q4) = (v4u){kp1[0], kp1[1], kp1[2], kp1[3]}; *(LAS v4u*)(T_ + O_KAT + (2 * dp + 1) * TS + 32 * q4 + 16) = (v4u){kp1[4], kp1[5], kp1[6], kp1[7]}; \
                *(LAS v4u*)(T_ + O_VT + (2 * dp) * TS + 32 * q4) = (v4u){vp0[0], vp0[1], vp0[2], vp0[3]}; *(LAS v4u*)(T_ + O_VT + (2 * dp) * TS + 32 * q4 + 16) = (v4u){vp0[4], vp0[5], vp0[6], vp0[7]}; \
                *(LAS v4u*)(T_ + O_VT + (2 * dp + 1) * TS + 32 * q4) = (v4u){vp1[0], vp1[1], vp1[2], vp1[3]}; *(LAS v4u*)(T_ + O_VT + (2 * dp + 1) * TS + 32 * q4 + 16) = (v4u){vp1[4], vp1[5], vp1[6], vp1[7]}; } while (0)
            HG_LOAD(0, 0); HG_LOAD(1, 1);
            HG_SUMS(0, 0);
            __syncthreads();
            HG_SUMS(1, 1); HG_BEGIN(0); HG_TOKENS(0, 0, 0); HG_TOKENS(0, 0, 8); HG_FINISH(0); HG_LOAD(0, 2);
#pragma unroll 2
            for (int n = 0; n < NCH; ++n) {
                const int c = n + 1;
                __syncthreads();
                if (c < NCH) { if (c + 1 < NCH) HG_SUMS(n & 1, c + 1); HG_BEGIN(c); HG_TOKENS((n + 1) & 1, c, 0); HG_TOKENS((n + 1) & 1, c, 8); HG_FINISH(c); if (c + 2 < NCH) HG_LOAD((n + 1) & 1, c + 2); }
            }
            __syncthreads();
#undef HG_LOAD
#undef HG_SUMS
#undef HG_BEGIN
#undef HG_TOKENS
#undef HG_FINISH
        }
        __syncthreads();
    }
#undef SB
}

template <bool DIAG> __device__ __forceinline__ bool attn_tile(const bf16x8_t (&Kc)[4], const bf16x8_t (&Vc)[4], const bf16x8_t (&Qf)[4], f32x16& O0, f32x16& O1, float& carry, int r32, int hi) {
    f32x16 Sx;
#pragma unroll
    for (int j = 0; j < 16; ++j) Sx[j] = 0.f;
#pragma unroll
    for (int ks = 0; ks < 4; ++ks) Sx = MFMA32(Kc[ks], Qf[ks], Sx);
    float kp[16], sg[16];
#pragma unroll
    for (int j = 0; j < 16; ++j) {
        const float r = __builtin_amdgcn_rcpf(1.0f + __builtin_amdgcn_exp2f(Sx[j]));
        if (DIAG) { const int sl = 16 * (j >> 3) + 8 * hi + (j & 7); const bool valid = sl < r32; kp[j] = valid ? r : 1.f; sg[j] = valid ? 1.0f - r : 0.f; }
        else { kp[j] = r; sg[j] = 1.0f - r; }
    }
#pragma unroll
    for (int j = 6; j >= 0; --j) { sg[j] *= kp[j + 1]; kp[j] *= kp[j + 1]; sg[8 + j] *= kp[8 + j + 1]; kp[8 + j] *= kp[8 + j + 1]; }
    const float G0 = kp[0], G1 = kp[8];
    const float P0 = __shfl_xor(G0, 32), P1 = __shfl_xor(G1, 32);
    const float after0 = (hi == 0 ? P0 : 1.f) * P1 * G1 * carry, after1 = (hi == 0 ? P1 : 1.f) * carry;
#pragma unroll
    for (int j = 0; j < 16; ++j) sg[j] *= (j < 8 ? after0 : after1);
    carry *= (G0 * G1) * (P0 * P1);
    v4u w0, w1; w0.x = cvtpk(sg[0], sg[1]); w0.y = cvtpk(sg[2], sg[3]); w0.z = cvtpk(sg[4], sg[5]); w0.w = cvtpk(sg[6], sg[7]);
    w1.x = cvtpk(sg[8], sg[9]); w1.y = cvtpk(sg[10], sg[11]); w1.z = cvtpk(sg[12], sg[13]); w1.w = cvtpk(sg[14], sg[15]);
    const bf16x8_t Pb0 = __builtin_bit_cast(bf16x8_t, w0), Pb1 = __builtin_bit_cast(bf16x8_t, w1);
    O0 = MFMA32(Vc[0], Pb0, O0); O0 = MFMA32(Vc[1], Pb1, O0);
    O1 = MFMA32(Vc[2], Pb0, O1); O1 = MFMA32(Vc[3], Pb1, O1);
    return __all(carry < 0x1p-134f);
}
__device__ __forceinline__ void attn_mfma(const Args& a, int u0, int ucnt, int ustride) {
    unsigned char* ws = a.ws;
    bf16* QS = (bf16*)(ws + WS_QS); const bf16* SK = (const bf16*)(ws + WS_SK); const bf16* VT = (const bf16*)((unsigned char*)a.out + 32 * MiB);
    const int lane = threadIdx.x & 63, r32 = lane & 31, hi = lane >> 5;
    const int kap = 16 * (r32 >> 4) + 8 * ((r32 >> 2) & 1) + 4 * ((r32 >> 3) & 1) + (r32 & 3);
    for (int uk = 0; uk < ucnt; ++uk) { const int u = u0 + uk * ustride;
        const int qb = u & 63, bh = u >> 6, h = bh & 15, b = bh >> 4;
        const size_t rowq = (size_t)b * SEQ + 32 * qb + r32;
        bf16* qp = QS + rowq * 2048 + 1024 + 64 * h;
        const bf16* kbase = SK + ((size_t)b * SEQ + kap) * 1024 + 64 * h + 8 * hi;
        const bf16* vbase = VT + ((size_t)bh * 64 + r32) * 2048 + 8 * hi;
        bf16x8_t Qf[4];
#pragma unroll
        for (int ks = 0; ks < 4; ++ks) Qf[ks] = *(const bf16x8_t*)(qp + 16 * ks + 8 * hi);
        f32x16 O0, O1;
#pragma unroll
        for (int j = 0; j < 16; ++j) { O0[j] = 0.f; O1[j] = 0.f; }
        float carry = 1.f;
        bf16x8_t KA[4], VA[4], KB[4], VB[4];
#define ATT_LOAD(K_, V_, kb_) do { _Pragma("unroll") for (int ks = 0; ks < 4; ++ks) K_[ks] = *(const bf16x8_t*)(kbase + (size_t)(32 * (kb_)) * 1024 + 16 * ks); \
        _Pragma("unroll") for (int i = 0; i < 4; ++i) V_[i] = *(const bf16x8_t*)(vbase + (size_t)(32 * (i >> 1)) * 2048 + 32 * (kb_) + 16 * (i & 1)); } while (0)
        ATT_LOAD(KA, VA, qb);
        int kb = qb;
        ATT_LOAD(KB, VB, kb > 0 ? kb - 1 : 0);
        if (!(attn_tile<true>(KA, VA, Qf, O0, O1, carry, r32, hi) || kb == 0)) {
            --kb;
#pragma unroll 1
            for (;;) {
                ATT_LOAD(KA, VA, kb > 0 ? kb - 1 : 0);
                if (attn_tile<false>(KB, VB, Qf, O0, O1, carry, r32, hi) || kb == 0) break;
                --kb;
                ATT_LOAD(KB, VB, kb > 0 ? kb - 1 : 0);
                if (attn_tile<false>(KA, VA, Qf, O0, O1, carry, r32, hi) || kb == 0) break;
                --kb;
            }
        }
#undef ATT_LOAD
#pragma unroll
        for (int a4 = 0; a4 < 4; ++a4) {
            u32x2_t x0, x1; x0.x = cvtpk(O0[4 * a4], O0[4 * a4 + 1]); x0.y = cvtpk(O0[4 * a4 + 2], O0[4 * a4 + 3]); x1.x = cvtpk(O1[4 * a4], O1[4 * a4 + 1]); x1.y = cvtpk(O1[4 * a4 + 2], O1[4 * a4 + 3]);
            *(u32x2_t*)(qp + 8 * a4 + 4 * hi) = x0; *(u32x2_t*)(qp + 32 + 8 * a4 + 4 * hi) = x1; }
    }
}

#define XB_TMO      128
#define XB_XCNT(j)  (256  + 64 * (j))
#define XB_XSUB(j)  (1280 + 64 * (j))
#define XB_XGEN(j)  (2304 + 64 * (j))
#define XB_TOP      3328
#define XB_TOPGEN   3392
#define XCD_BAR_WORDS 3456
#define XB_SPIN_CAP (1u << 18)

__device__ __forceinline__ unsigned xb_ld(unsigned* p)              { return __hip_atomic_load(p, __ATOMIC_RELAXED, __HIP_MEMORY_SCOPE_AGENT); }
__device__ __forceinline__ unsigned xb_add(unsigned* p, unsigned v) { return __hip_atomic_fetch_add(p, v, __ATOMIC_RELAXED, __HIP_MEMORY_SCOPE_AGENT); }
__device__ __forceinline__ unsigned xb_xcc_id() { return (unsigned)__builtin_amdgcn_s_getreg((3 << 11) | 20) & 0xFu; }
#define XB_SPIN(cond, bar) do { unsigned _sp = 0; while (cond) { __builtin_amdgcn_s_sleep(1); \
    if ((++_sp & 255u) == 0u) { if (xb_ld(&(bar)[XB_TMO])) break; if (_sp > XB_SPIN_CAP) { atomicAdd(&(bar)[XB_TMO], 1u); break; } } } } while (0)

struct XcdBarrier {
    unsigned* bar; unsigned x;
    volatile LAS unsigned* st;
};

__device__ __forceinline__ XcdBarrier xcd_barrier_post(unsigned* bar, volatile LAS unsigned* st) {
    XcdBarrier b; b.bar = bar; b.x = xb_xcc_id(); b.st = st;
    if (threadIdx.x == 0) (void)xb_add(&bar[XB_XCNT(b.x)], 1u);
    return b;
}
__device__ __forceinline__ void xcd_barrier_complete(unsigned* bar, unsigned x, unsigned& nloc, unsigned& nx) {
    const unsigned G = gridDim.x * gridDim.y * gridDim.z;
    unsigned sum, cnt, mine, sp = 0u;
    for (;;) {
        sum = 0u; cnt = 0u; mine = 0u;
#pragma unroll
        for (unsigned j = 0; j < 16; ++j) { const unsigned c = xb_ld(&bar[XB_XCNT(j)]); sum += c; cnt += (c > 0u) ? 1u : 0u; mine = (j == x) ? c : mine; }
        if (sum == G) break;
        __builtin_amdgcn_s_sleep(1);
        if ((++sp & 255u) == 0u) { if (xb_ld(&bar[XB_TMO])) break; if (sp > XB_SPIN_CAP) { atomicAdd(&bar[XB_TMO], 1u); break; } }
    }
    nloc = mine > 0u ? mine : 1u; nx = cnt > 0u ? cnt : 1u;
}

__device__ __forceinline__ void xcd_barrier(const XcdBarrier& b) {
    asm volatile("s_waitcnt vmcnt(0)" ::: "memory");
    __syncthreads();
    if (threadIdx.x == 0) {
        unsigned* bar = b.bar;
        __builtin_amdgcn_s_waitcnt(0);
        unsigned nloc = b.st[0], nx = b.st[1];
        if (nloc == 0u) { xcd_barrier_complete(bar, b.x, nloc, nx); b.st[0] = nloc; b.st[1] = nx; }
        const unsigned old = xb_add(&bar[XB_XSUB(b.x)], 1u);
        const unsigned gen = old / nloc;
        if (old + 1u == (gen + 1u) * nloc) {
            __builtin_amdgcn_fence(__ATOMIC_RELEASE, "agent");
            asm volatile("s_waitcnt vmcnt(0)" ::: "memory");
            const unsigned og = xb_add(&bar[XB_TOP], 1u);
            const unsigned tg = og / nx;
            if (og + 1u == (tg + 1u) * nx) xb_add(&bar[XB_TOPGEN], 1u);
            else XB_SPIN(xb_ld(&bar[XB_TOPGEN]) == tg, bar);
            __builtin_amdgcn_fence(__ATOMIC_ACQUIRE, "agent");
            xb_add(&bar[XB_XGEN(b.x)], 1u);
            asm volatile("s_waitcnt vmcnt(0)" ::: "memory");
        } else {
            XB_SPIN(xb_ld(&bar[XB_XGEN(b.x)]) == gen, bar);
            __builtin_amdgcn_fence(__ATOMIC_ACQUIRE, "agent");
            asm volatile("s_waitcnt vmcnt(0)" ::: "memory");
        }
    }
    __syncthreads();
}

__global__ void __launch_bounds__(NTHREADS, 2) hybrid_fwd(Args args) {
    extern __shared__ __attribute__((aligned(16))) unsigned char lds_raw[];
    LAS unsigned char* lds = (LAS unsigned char*)lds_raw;
    cg::grid_group grid = cg::this_grid();
    const int tid = threadIdx.x, lane = tid & 63, wave = __builtin_amdgcn_readfirstlane(tid >> 6);
    const int G = gridDim.x;
    unsigned char* ws = args.ws;
    const int lo = args.ph_lo, hi = args.ph_hi;
    volatile LAS unsigned* MISC = (volatile LAS unsigned*)(lds + MISC_OFF);
    if (tid < 2) MISC[tid] = 0u;
    __syncthreads();
    const XcdBarrier bar = xcd_barrier_post((unsigned*)ws, MISC);
#define IN(k) (lo <= (k) && (k) < hi)
#define SEAM(k) do { if (IN(k) && IN((k) + 1)) { xcd_barrier(bar); } } while (0)
    if (lo < 0) grid.sync();
    if (IN(0)) { p0_prologue<0>(args, lds, wave, lane, (int)blockIdx.x * NWAVES + wave, G * NWAVES); asm volatile("s_waitcnt vmcnt(0) lgkmcnt(0)" ::: "memory"); __syncthreads(); }
    SEAM(0);
    if (IN(1)) {
        pg8::Gemm g{(const pg8::bf16_t*)(ws + WS_H), (const pg8::bf16_t*)(ws + WS_WIN), M, 6144, D, D}; pg8::StaticOrder S; S.init(M, 6144, G, (int)blockIdx.x);
        pg8::EpiProj E{(pg8::bf16_t*)(ws + WS_QS), (pg8::bf16_t*)(ws + WS_VH), (pg8::bf16_t*)(ws + WS_SK), (pg8::bf16_t*)((unsigned char*)args.out + 32 * MiB), ws + WS_GH, ws + WS_GA, ws + WS_GB, (_Float16*)args.out,
                       args.in[3], args.in[5], args.in[6], 0};
        pg8::gemm_phase<pg8::EpiProj, pg8::StaticOrder, true, true>(lds, g, S, E);
        pg8::Gemm g2{(const pg8::bf16_t*)(ws + WS_WIN) + (size_t)6144 * 1024, (const pg8::bf16_t*)(ws + WS_H), 1024, M, D, D}; pg8::StaticOrder S2; S2.init(1024, M, G, (int)blockIdx.x);
        pg8::EpiVT E2{(pg8::bf16_t*)((unsigned char*)args.out + 32 * MiB)};
        pg8::gemm_phase<pg8::EpiVT, pg8::StaticOrder, true, true>(lds, g2, S2, E2);
    }
    SEAM(1);
    if (IN(2)) {
        const pg8::Gemm gg{(const pg8::bf16_t*)(ws + WS_H), (const pg8::bf16_t*)(ws + WS_WIN) + (size_t)7168 * 1024, M, 2048, D, D};
        const pg8::EpiProj EG{(pg8::bf16_t*)(ws + WS_QS), (pg8::bf16_t*)(ws + WS_VH), (pg8::bf16_t*)(ws + WS_SK), (pg8::bf16_t*)((unsigned char*)args.out + 32 * MiB), ws + WS_GH, ws + WS_GA, ws + WS_GB, (_Float16*)args.out,
                              args.in[3], args.in[5], args.in[6], 28};
        constexpr int NUNITS = BATCH * 16 * (SEQ / 32);
        if (G == 256) {
            pg8::ListOrder S; S.s.init(M, 2048, 256, 0);
            if ((int)blockIdx.x < 64) { hgrn_v2(args, lds, (int)blockIdx.x, 64); p0_prologue<1>(args, lds, wave, lane, 2048 + 512 + (int)blockIdx.x * NWAVES + wave, 1024); S.l0 = -1; S.l1 = -1; S.l2 = -1; }
            else { const int idx = (int)blockIdx.x - 64;
                if (idx < 128) attn_mfma(args, idx * 40 + wave, 5, NWAVES); else attn_mfma(args, 5120 + (idx - 128) * 48 + wave, 6, NWAVES);
                if (idx < 128) p0_prologue<1>(args, lds, wave, lane, idx * NWAVES + wave, 1024, 2048);
                else p0_prologue<1>(args, lds, wave, lane, 2048 + (idx - 128) * NWAVES + wave, 1024);
                S.l0 = idx; S.l1 = 192 + idx; S.l2 = idx < 128 ? 384 + idx : -1; }
            asm volatile("s_waitcnt vmcnt(0) lgkmcnt(0)" ::: "memory"); __syncthreads();
            pg8::gemm_phase<pg8::EpiProj, pg8::ListOrder, true, true>(lds, gg, S, EG);
        } else {
            const int gw = (int)blockIdx.x * NWAVES + wave, ngw = G * NWAVES;
            hgrn_v2(args, lds, (int)blockIdx.x, G); attn_mfma(args, gw, (NUNITS - gw + ngw - 1) / ngw, ngw); p0_prologue<1>(args, lds, wave, lane, gw, ngw);
            asm volatile("s_waitcnt vmcnt(0) lgkmcnt(0)" ::: "memory"); __syncthreads();
            pg8::StaticOrder S; S.init(M, 2048, G, (int)blockIdx.x);
            pg8::gemm_phase<pg8::EpiProj, pg8::StaticOrder, true, true>(lds, gg, S, EG);
        }
        __syncthreads();
    }
    SEAM(2);
    if (IN(3)) {
        pg8::Gemm g{(const pg8::bf16_t*)(ws + WS_QS), (const pg8::bf16_t*)(ws + WS_WHS), M, D, 1024, 2048}; pg8::SplitOrder S; S.s.init(M, D, G, (int)blockIdx.x);
        pg8::EpiMix E{ws + WS_GA, ws + WS_GB, (pg8::bf16_t*)(ws + WS_MIXED)};
        pg8::gemm_phase<pg8::EpiMix, pg8::SplitOrder, true, true>(lds, g, S, E);
    }
    SEAM(3);
    if (IN(4)) {
        pg8::Gemm g{(const pg8::bf16_t*)(ws + WS_MIXED), (const pg8::bf16_t*)(ws + WS_WO), M, D, D, D}; pg8::StaticOrder S; S.init(M, D, G, (int)blockIdx.x);
        pg8::EpiRes1 E{args.in[0], (pg8::bf16_t*)(ws + WS_GA), (pg8::bf16_t*)(ws + WS_X1B), (float*)(ws + WS_SSQ)};
        pg8::gemm_phase<pg8::EpiRes1, pg8::StaticOrder, true, true>(lds, g, S, E);
    }
    SEAM(4);
    if (IN(5)) {
        pg8::Gemm g{(const pg8::bf16_t*)(ws + WS_X1B), (const pg8::bf16_t*)(ws + WS_WF1), M, 2 * FFH, D, D}; pg8::StaticOrder S; S.init(M, 2 * FFH, G, (int)blockIdx.x);
        pg8::EpiSwiglu E{(const float*)(ws + WS_SSQ), (pg8::bf16_t*)(ws + WS_ACT)};
        pg8::gemm_phase<pg8::EpiSwiglu, pg8::StaticOrder, true, true>(lds, g, S, E);
    }
    SEAM(5);
    if (IN(6)) {
        pg8::Gemm g{(const pg8::bf16_t*)(ws + WS_ACT), (const pg8::bf16_t*)(ws + WS_WF2), M, D, FFH, FFH}; pg8::StaticOrder S; S.init(M, D, G, (int)blockIdx.x);
        pg8::EpiRes2 E{args.in[0], (const pg8::bf16_t*)(ws + WS_GA), args.out};
        pg8::gemm_phase<pg8::EpiRes2, pg8::StaticOrder, true, true>(lds, g, S, E);
    }
#undef IN
#undef SEAM
}

#ifndef MK_N_LAUNCHES
#define MK_N_LAUNCHES 1
#endif
extern "C" void kernel_launch(void* const* d_in, const int* in_sizes, int n_in, void* d_out, int out_size, void* d_ws, size_t ws_size, hipStream_t stream) {
    static int grid = 0;
    if (grid == 0) {
        int dev = 0, cus = 0, per_cu = 0;
        if (n_in != 13 || ws_size < WS_END) { fprintf(stderr, "kernel_launch: unexpected inputs / workspace (%d, %zu)\n", n_in, ws_size); grid = -1; return; }
        hipGetDevice(&dev); hipDeviceGetAttribute(&cus, hipDeviceAttributeMultiprocessorCount, dev);
        if (hipFuncSetAttribute((const void*)hybrid_fwd, hipFuncAttributeMaxDynamicSharedMemorySize, LDS_BYTES) != hipSuccess) { fprintf(stderr, "kernel_launch: hipFuncSetAttribute failed\n"); grid = -1; return; }
        if (hipOccupancyMaxActiveBlocksPerMultiprocessor(&per_cu, (const void*)hybrid_fwd, NTHREADS, LDS_BYTES) != hipSuccess || per_cu < 1) { fprintf(stderr, "kernel_launch: occupancy query says %d\n", per_cu); per_cu = 1; }
        (void)hipGetLastError();
        grid = cus * per_cu;
    }
    if (grid < 0) return;
    if (hipMemsetAsync(d_ws, 0, 16384, stream) != hipSuccess) { fprintf(stderr, "kernel_launch: memset of the barrier words failed\n"); return; }
    Args a{};
    for (int i = 0; i < 13; ++i) a.in[i] = (const float*)d_in[i];
    a.out = (float*)d_out; a.ws = (unsigned char*)d_ws;
#if MK_N_LAUNCHES == 1
    a.ph_lo = 0; a.ph_hi = 7;
    void* kargs[] = {&a};
    hipError_t e = hipLaunchCooperativeKernel((const void*)hybrid_fwd, dim3(grid), dim3(NTHREADS), kargs, LDS_BYTES, stream);
    if (e != hipSuccess) fprintf(stderr, "cooperative launch failed: %s (grid %d)\n", hipGetErrorString(e), grid);
#else
    for (int p = 0; p < 7; ++p) { a.ph_lo = p; a.ph_hi = p + 1; hipLaunchKernelGGL(hybrid_fwd, dim3(grid), dim3(NTHREADS), LDS_BYTES, stream, a); }
#endif
}
```

```cpp
#include <hip/hip_runtime.h>
#include <hip/hip_cooperative_groups.h>
#include <cstdio>
#include <cstdint>
namespace cg = cooperative_groups;
namespace pg8 {
#define PG8_LAS __attribute__((address_space(3)))
typedef unsigned short bf16_t;
typedef short bf16x8 __attribute__((ext_vector_type(8)));
typedef float f32x4 __attribute__((ext_vector_type(4)));
typedef unsigned u32x4 __attribute__((ext_vector_type(4)));
constexpr int BM = 256, BK = 64, HALF = 128, HTB = HALF * BK * 2  , STAGE_BYTES = 8 * HTB, NXCD = 8, WGM = 8;

__host__ __device__ __forceinline__ int lds_byte(int r, int c) { const int st = (r >> 4) * 2 + (c >> 5), rr = r & 15, cc = c & 31, ob = rr * 64 + cc * 2; return st * 1024 + (ob ^ (((ob >> 9) & 1) << 5)); }
__host__ __device__ __forceinline__ void stage_rc(int b, int& R, int& C) { const int st = b / 1024, sb = b % 1024, swz = sb ^ (((sb >> 9) & 1) << 5); R = (st >> 1) * 16 + swz / 64; C = (st & 1) * 32 + (swz % 64) / 2; }
__host__ __device__ __forceinline__ int perm32(int rho) { const int n = rho >> 4, i = rho & 15; return 8 * (i >> 2) + 4 * n + (i & 3); }

struct Unit { int pm, pn, kh; };
struct Gemm { const bf16_t* A; const bf16_t* Bt; int M, N, K, ld; };

struct StaticOrder {
    int nM, nN, nwg, G, c;
    __host__ __device__ void init(int M, int N, int G_, int c_) { nM = M / BM; nN = N / BM; nwg = nM * nN; G = G_; c = c_; }
    __host__ __device__ bool next(int i, Unit& u) const { const long L = (long)i * G + c; if (L >= nwg) return false; return unit_of((int)L, u); }
    __host__ __device__ bool unit_of(int L, Unit& u) const {
        int wgid = L; { const int q = nwg / NXCD, r = nwg % NXCD, xcd = wgid % NXCD, off = wgid / NXCD; wgid = (xcd < r ? xcd * (q + 1) : r * (q + 1) + (xcd - r) * q) + off; }
        const int nig = WGM * nN, gid = wgid / nig, fm = gid * WGM, gsz = (nM - fm) < WGM ? (nM - fm) : WGM;
        u.pm = fm + ((wgid % nig) % gsz); u.pn = (wgid % nig) / gsz; u.kh = 0; return true;
    }
    __device__ __forceinline__ void a_ready(const Unit&) const {}
    __device__ __forceinline__ void done(const Unit&) const {}
};
struct ListOrder {
    StaticOrder s; int l0, l1, l2;
    __host__ __device__ bool next(int i, Unit& u) const { const int L = i == 0 ? l0 : (i == 1 ? l1 : (i == 2 ? l2 : -1)); if (L < 0 || L >= s.nwg) return false; return s.unit_of(L, u); }
    __device__ __forceinline__ void a_ready(const Unit&) const {}
    __device__ __forceinline__ void done(const Unit&) const {}
};
struct SplitOrder {
    StaticOrder s;
    __host__ __device__ bool next(int i, Unit& u) const { const bool ok = s.next(i >> 1, u); u.kh = i & 1; return ok; }
    __device__ __forceinline__ void a_ready(const Unit&) const {}
    __device__ __forceinline__ void done(const Unit&) const {}
};
typedef float f32x2_cv __attribute__((ext_vector_type(2))); typedef __bf16 bf16x2_cvv __attribute__((ext_vector_type(2)));
__device__ __forceinline__ unsigned cvt_pk_bf16(float lo, float hi) { const f32x2_cv v = {lo, hi}; return __builtin_bit_cast(unsigned, __builtin_convertvector(v, bf16x2_cvv)); }
typedef float f32x2 __attribute__((ext_vector_type(2)));
typedef _Float16 f16x8 __attribute__((ext_vector_type(8)));
typedef unsigned u32x2 __attribute__((ext_vector_type(2)));
__device__ __forceinline__ float sigm(float x) { return __builtin_amdgcn_rcpf(1.0f + __expf(-x)); }
__device__ __forceinline__ unsigned q8(float s) { float q = s * 255.0f + 0.5f; q = q < 1.0f ? 1.0f : (q > 255.0f ? 255.0f : q); return (unsigned)q; }
__device__ __forceinline__ u32x4 pack8_bf16(const float (&o)[8]) { u32x4 w; w.x = cvt_pk_bf16(o[0], o[1]); w.y = cvt_pk_bf16(o[2], o[3]); w.z = cvt_pk_bf16(o[4], o[5]); w.w = cvt_pk_bf16(o[6], o[7]); return w; }
__device__ __forceinline__ u32x2 pack8_u8(const float (&o)[8]) { u32x2 w; unsigned a = 0u, c = 0u;
#pragma unroll
    for (int k = 0; k < 4; ++k) { a = __builtin_amdgcn_cvt_pk_u8_f32(fmaxf(o[k] * 255.0f, 1.0f), k, a); c = __builtin_amdgcn_cvt_pk_u8_f32(fmaxf(o[4 + k] * 255.0f, 1.0f), k, c); }
    w.x = a; w.y = c; return w; }

struct EpiProj {
    static constexpr bool PERM = true, AFTER_DRAIN = false, KSPLIT = false;
    bf16_t* QS; bf16_t* VH; bf16_t* SK; bf16_t* SV; unsigned char* GH; unsigned char* GA; unsigned char* GB; _Float16* LOGF;
    const float* lbl; const float* qg; const float* kg; int pn0;
    __device__ __forceinline__ void operator()(const f32x4 (&acc)[2][2][4][2], const Unit& u, int wr, int wc, int fr, int fq) const {
        const int sec = (u.pn + pn0) >> 2, ct = (u.pn & 3) * 256;
        const int row0 = u.pm * BM + wr * 64 + fr;
        if (sec == 4 || sec == 5) {
            const int head = (u.pn & 3) * 4 + wc; const float* gp = (sec == 4 ? qg : kg) + head * 64 + 8 * fq;
            float gn[2][8];
#pragma unroll
            for (int bj = 0; bj < 2; ++bj) { const f32x4 a = *(const f32x4*)(gp + 32 * bj), b = *(const f32x4*)(gp + 32 * bj + 4);
                gn[bj][0] = a[0]; gn[bj][1] = a[1]; gn[bj][2] = a[2]; gn[bj][3] = a[3]; gn[bj][4] = b[0]; gn[bj][5] = b[1]; gn[bj][6] = b[2]; gn[bj][7] = b[3]; }
            const float sc = (sec == 4) ? 0.125f * 1.4426950408889634f : 1.0f;
#pragma unroll
            for (int ai = 0; ai < 2; ++ai)
#pragma unroll
                for (int m = 0; m < 4; ++m) {
                    float ss = 0.f;
#pragma unroll
                    for (int bj = 0; bj < 2; ++bj)
#pragma unroll
                        for (int n = 0; n < 2; ++n) { const f32x4 x = acc[ai][bj][m][n]; ss += (x[0] * x[0] + x[1] * x[1]) + (x[2] * x[2] + x[3] * x[3]); }
                    ss += __shfl_xor(ss, 16); ss += __shfl_xor(ss, 32);
                    const float rstd = __builtin_amdgcn_rsqf(ss * (1.0f / 64.0f) + 1e-6f) * sc;
                    const size_t row = (size_t)(row0 + ai * HALF + m * 16);
#pragma unroll
                    for (int bj = 0; bj < 2; ++bj) { float o[8];
#pragma unroll
                        for (int k = 0; k < 8; ++k) o[k] = acc[ai][bj][m][k >> 2][k & 3] * rstd * gn[bj][k];
                        bf16_t* dst = (sec == 4) ? (QS + row * 2048 + 1024 + head * 64 + 32 * bj + 8 * fq) : (SK + row * 1024 + head * 64 + 32 * bj + 8 * fq);
                        *(u32x4*)dst = pack8_bf16(o); }
                }
            return;
        }
        switch (sec) {
            case 0: store_kind<0>(acc, row0, ct, wc, fq, nullptr); break;
            case 1: store_kind<1>(acc, row0, ct, wc, fq, nullptr); break;
            case 2: store_kind<2>(acc, row0, ct, wc, fq, nullptr); break;
            case 3: store_kind<3>(acc, row0, ct, wc, fq, GH); break;
            case 6: store_kind<6>(acc, row0, ct, wc, fq, nullptr); break;
            case 7: store_kind<3>(acc, row0, ct, wc, fq, GA); break;
            default: store_kind<3>(acc, row0, ct, wc, fq, GB); break;
        }
    }
    template <int KIND> __device__ __forceinline__ void store_kind(const f32x4 (&acc)[2][2][4][2], int row0, int ct, int wc, int fq, unsigned char* g8) const {
#pragma unroll
        for (int bj = 0; bj < 2; ++bj) {
            const int col = ct + bj * HALF + wc * 32 + 8 * fq;
            float lb[8];
            if (KIND == 1) {
#pragma unroll
                for (int k = 0; k < 8; ++k) lb[k] = __builtin_amdgcn_rcpf(1.0f + __expf(lbl[1024 + col + k] - lbl[col + k]));
            }
#pragma unroll
            for (int ai = 0; ai < 2; ++ai)
#pragma unroll
                for (int m = 0; m < 4; ++m) {
                    const size_t row = (size_t)(row0 + ai * HALF + m * 16);
                    float o[8];
#pragma unroll
                    for (int k = 0; k < 8; ++k) o[k] = acc[ai][bj][m][k >> 2][k & 3];
                    if (KIND == 0) { *(u32x4*)(QS + row * 2048 + col) = pack8_bf16(o); }
                    else if (KIND == 2) { *(u32x4*)(VH + row * 1024 + col) = pack8_bf16(o); }
                    else if (KIND == 6) { bf16_t* vt = SV + ((size_t)((row >> 11) * 16 + (col >> 6)) * 64 + (col & 63)) * 2048 + (row & 2047);
#pragma unroll
                        for (int k = 0; k < 8; ++k) vt[(size_t)k * 2048] = (bf16_t)(cvt_pk_bf16(o[k], o[k]) & 0xffffu); }
                    else if (KIND == 1) { f16x8 g;
#pragma unroll
                        for (int k = 0; k < 8; ++k) g[k] = (_Float16)__builtin_amdgcn_logf(lb[k] + (1.0f - lb[k]) * sigm(o[k]));
                        *(f16x8*)(LOGF + row * 1024 + col) = g; }
                    else {
#pragma unroll
                        for (int k = 0; k < 8; ++k) o[k] = sigm(o[k]);
                        *(u32x2*)(g8 + row * 1024 + col) = pack8_u8(o); }
                }
        }
    }
};

struct EpiVT {
    static constexpr bool PERM = true, AFTER_DRAIN = false, KSPLIT = false;
    bf16_t* VT;
    __device__ __forceinline__ void operator()(const f32x4 (&acc)[2][2][4][2], const Unit& u, int wr, int wc, int fr, int fq) const {
        const int row0 = u.pm * BM + wr * 64 + fr;
#pragma unroll
        for (int ai = 0; ai < 2; ++ai)
#pragma unroll
            for (int m = 0; m < 4; ++m)
#pragma unroll
                for (int bj = 0; bj < 2; ++bj) {
                    const int r = row0 + ai * HALF + m * 16, c = u.pn * BM + bj * HALF + wc * 32 + 8 * fq;
                    float o[8];
#pragma unroll
                    for (int k = 0; k < 8; ++k) o[k] = acc[ai][bj][m][k >> 2][k & 3];
                    *(u32x4*)(VT + ((size_t)((c >> 11) * 16 + (r >> 6)) * 64 + (r & 63)) * 2048 + (c & 2047)) = pack8_bf16(o);
                }
    }
};
struct EpiMix {
    static constexpr bool PERM = true, AFTER_DRAIN = false, KSPLIT = true;
    const unsigned char* GA; const unsigned char* GB; bf16_t* MIXED;
    __device__ __forceinline__ void half0(f32x4 (&acc)[2][2][4][2], const Unit& u, int wr, int wc, int fr, int fq) const {
        const int row0 = u.pm * BM + wr * 64 + fr;
#pragma unroll
        for (int ai = 0; ai < 2; ++ai)
#pragma unroll
            for (int m = 0; m < 4; ++m)
#pragma unroll
                for (int bj = 0; bj < 2; ++bj) {
                    const size_t off = (size_t)(row0 + ai * HALF + m * 16) * 1024 + u.pn * BM + bj * HALF + wc * 32 + 8 * fq;
                    const u32x2 a = *(const u32x2*)(GA + off), b = *(const u32x2*)(GB + off);
#pragma unroll
                    for (int k = 0; k < 8; ++k) { const float qa = (float)((a[k >> 2] >> (8 * (k & 3))) & 255u), qb = (float)((b[k >> 2] >> (8 * (k & 3))) & 255u);
                        acc[ai][bj][m][k >> 2][k & 3] *= qa * __builtin_amdgcn_rcpf(qb); }
                    if (bj == 1 && (m & 1)) asm volatile("" ::: "memory");
                }
    }
    __device__ __forceinline__ void operator()(f32x4 (&acc)[2][2][4][2], const Unit& u, int wr, int wc, int fr, int fq) const {
        if (u.kh == 0) { half0(acc, u, wr, wc, fr, fq); return; }
        const int row0 = u.pm * BM + wr * 64 + fr;
        u32x2 gbv[2][4][2];
#pragma unroll
        for (int ai = 0; ai < 2; ++ai)
#pragma unroll
            for (int m = 0; m < 4; ++m)
#pragma unroll
                for (int bj = 0; bj < 2; ++bj) gbv[ai][m][bj] = *(const u32x2*)(GB + (size_t)(row0 + ai * HALF + m * 16) * 1024 + u.pn * BM + bj * HALF + wc * 32 + 8 * fq);
#pragma unroll
        for (int ai = 0; ai < 2; ++ai)
#pragma unroll
            for (int m = 0; m < 4; ++m)
#pragma unroll
                for (int bj = 0; bj < 2; ++bj) {
                    const size_t off = (size_t)(row0 + ai * HALF + m * 16) * 1024 + u.pn * BM + bj * HALF + wc * 32 + 8 * fq;
                    const u32x2 b = gbv[ai][m][bj]; float o[8];
#pragma unroll
                    for (int k = 0; k < 8; ++k) { const float qb = (float)((b[k >> 2] >> (8 * (k & 3))) & 255u); o[k] = acc[ai][bj][m][k >> 2][k & 3] * (qb * (1.0f / 255.0f)); }
                    *(u32x4*)(MIXED + off) = pack8_bf16(o);
                }
    }
};
struct EpiRes1 {
    static constexpr bool PERM = true, AFTER_DRAIN = false, KSPLIT = false;
    const float* x; bf16_t* DL; bf16_t* X1B; float* SSQ;
    __device__ __forceinline__ void operator()(const f32x4 (&acc)[2][2][4][2], const Unit& u, int wr, int wc, int fr, int fq) const {
        const int row0 = u.pm * BM + wr * 64 + fr;
#pragma unroll
        for (int ai = 0; ai < 2; ++ai)
#pragma unroll
            for (int mp = 0; mp < 2; ++mp) {
                f32x4 xv[2][2][2];
#pragma unroll
                for (int mm = 0; mm < 2; ++mm)
#pragma unroll
                    for (int bj = 0; bj < 2; ++bj) { const size_t off = (size_t)(row0 + ai * HALF + (2 * mp + mm) * 16) * 1024 + u.pn * BM + bj * HALF + wc * 32 + 8 * fq;
                        xv[mm][bj][0] = *(const f32x4*)(x + off); xv[mm][bj][1] = *(const f32x4*)(x + off + 4); }
#pragma unroll
                for (int mm = 0; mm < 2; ++mm) {
                    const int m = 2 * mp + mm; const int row = row0 + ai * HALF + m * 16; float ss = 0.f;
#pragma unroll
                    for (int bj = 0; bj < 2; ++bj) {
                        const size_t off = (size_t)row * 1024 + u.pn * BM + bj * HALF + wc * 32 + 8 * fq;
                        const f32x4 a0 = acc[ai][bj][m][0], a1 = acc[ai][bj][m][1];
                        const f32x4 v0 = xv[mm][bj][0] + a0, v1 = xv[mm][bj][1] + a1;
                        u32x4 dw; dw.x = cvt_pk_bf16(a0[0], a0[1]); dw.y = cvt_pk_bf16(a0[2], a0[3]); dw.z = cvt_pk_bf16(a1[0], a1[1]); dw.w = cvt_pk_bf16(a1[2], a1[3]); *(u32x4*)(DL + off) = dw;
                        u32x4 w; w.x = cvt_pk_bf16(v0[0], v0[1]); w.y = cvt_pk_bf16(v0[2], v0[3]); w.z = cvt_pk_bf16(v1[0], v1[1]); w.w = cvt_pk_bf16(v1[2], v1[3]);
                        *(u32x4*)(X1B + off) = w;
                        ss += (v0[0] * v0[0] + v0[1] * v0[1]) + (v0[2] * v0[2] + v0[3] * v0[3]) + (v1[0] * v1[0] + v1[1] * v1[1]) + (v1[2] * v1[2] + v1[3] * v1[3]);
                    }
                    ss += __shfl_xor(ss, 16); ss += __shfl_xor(ss, 32);
                    if (fq == 0) SSQ[(size_t)row * 16 + u.pn * 4 + wc] = ss;
                }
            }
    }
};
struct EpiSwiglu {
    static constexpr bool PERM = true, AFTER_DRAIN = false, KSPLIT = false;
    const float* SSQ; bf16_t* ACT;
    __device__ __forceinline__ void operator()(const f32x4 (&acc)[2][2][4][2], const Unit& u, int wr, int wc, int fr, int fq) const {
        const int row0 = u.pm * BM + wr * 64 + fr;
        f32x4 sq[2][4];
#pragma unroll
        for (int ai = 0; ai < 2; ++ai)
#pragma unroll
            for (int m = 0; m < 4; ++m) sq[ai][m] = *(const f32x4*)(SSQ + (size_t)(row0 + ai * HALF + m * 16) * 16 + 4 * fq);
#pragma unroll
        for (int ai = 0; ai < 2; ++ai)
#pragma unroll
            for (int m = 0; m < 4; ++m) {
                const int row = row0 + ai * HALF + m * 16;
                float ss = (sq[ai][m][0] + sq[ai][m][1]) + (sq[ai][m][2] + sq[ai][m][3]);
                ss += __shfl_xor(ss, 16); ss += __shfl_xor(ss, 32);
                const float rstd = __builtin_amdgcn_rsqf(ss * (1.0f / 1024.0f) + 1e-6f);
                float o[8];
#pragma unroll
                for (int k = 0; k < 8; ++k) { const float g = acc[ai][0][m][k >> 2][k & 3] * rstd, up = acc[ai][1][m][k >> 2][k & 3] * rstd; o[k] = g * sigm(g) * up; }
                *(u32x4*)(ACT + (size_t)row * 2816 + u.pn * 128 + wc * 32 + 8 * fq) = pack8_bf16(o);
            }
    }
};
struct EpiRes2 {
    static constexpr bool PERM = true, AFTER_DRAIN = false, KSPLIT = false;
    const float* x; const bf16_t* DL; float* out;
    __device__ __forceinline__ void operator()(const f32x4 (&acc)[2][2][4][2], const Unit& u, int wr, int wc, int fr, int fq) const {
        const int row0 = u.pm * BM + wr * 64 + fr;
#pragma unroll
        for (int ai = 0; ai < 2; ++ai)
#pragma unroll
            for (int mp = 0; mp < 2; ++mp) {
                f32x4 xv[2][2][2]; u32x4 dv[2][2];
#pragma unroll
                for (int mm = 0; mm < 2; ++mm)
#pragma unroll
                    for (int bj = 0; bj < 2; ++bj) { const size_t off = (size_t)(row0 + ai * HALF + (2 * mp + mm) * 16) * 1024 + u.pn * BM + bj * HALF + wc * 32 + 8 * fq;
                        xv[mm][bj][0] = *(const f32x4*)(x + off); xv[mm][bj][1] = *(const f32x4*)(x + off + 4); dv[mm][bj] = *(const u32x4*)(DL + off); }
#pragma unroll
                for (int mm = 0; mm < 2; ++mm)
#pragma unroll
                    for (int bj = 0; bj < 2; ++bj) { const int m = 2 * mp + mm;
                        const size_t off = (size_t)(row0 + ai * HALF + m * 16) * 1024 + u.pn * BM + bj * HALF + wc * 32 + 8 * fq;
                        const u32x4 dw = dv[mm][bj];
                        f32x4 d0, d1; d0[0] = __builtin_bit_cast(float, dw.x << 16); d0[1] = __builtin_bit_cast(float, dw.x & 0xffff0000u); d0[2] = __builtin_bit_cast(float, dw.y << 16); d0[3] = __builtin_bit_cast(float, dw.y & 0xffff0000u);
                        d1[0] = __builtin_bit_cast(float, dw.z << 16); d1[1] = __builtin_bit_cast(float, dw.z & 0xffff0000u); d1[2] = __builtin_bit_cast(float, dw.w << 16); d1[3] = __builtin_bit_cast(float, dw.w & 0xffff0000u);
                        const f32x4 v0 = (xv[mm][bj][0] + d0) + acc[ai][bj][m][0], v1 = (xv[mm][bj][1] + d1) + acc[ai][bj][m][1];
                        *(f32x4*)(out + off) = v0; *(f32x4*)(out + off + 4) = v1; }
            }
    }
};

template <class Epi, class Sched, bool ALIGN_EPI = false, bool SP2 = false>
__device__ __forceinline__ void gemm_phase(PG8_LAS unsigned char* lds, const Gemm g, const Sched& S, const Epi& E) {
    int tid_ = threadIdx.x; asm volatile("" : "+v"(tid_));
    const int tid = tid_, wid = __builtin_amdgcn_readfirstlane(tid >> 6), lane = tid & 63, wr = wid >> 2, wc = wid & 3, fr = lane & 15, fq = lane >> 4;
    const int K = g.K, nt = K / BK;
    unsigned voffA[2], voffB[2];
#pragma unroll
    for (int i = 0; i < 2; ++i) { int R, C; stage_rc(tid * 16 + i * 8192, R, C); const int Rb = Epi::PERM ? ((R & ~31) + perm32(R & 31)) : R;
        voffA[i] = (unsigned)(R * g.ld + C) * 2u; voffB[i] = (unsigned)(Rb * g.ld + C) * 2u; }
    const size_t kstep = (size_t)(BK * 2);
    const size_t hstep = (size_t)HALF * g.ld * 2; const size_t khb = (size_t)K * 2;
    const size_t tstep = 2 * hstep;
    const unsigned ldsw = (unsigned)wid * 1024u;
    const int aoff = lds_byte(wr * 64 + fr, fq * 8), boff = lds_byte(wc * 32 + fr, fq * 8);
#define PG8_SA(b, h) (((b) * 2 + (h)) * HTB)
#define PG8_SB(b, h) ((4 + (b) * 2 + (h)) * HTB)
#define PG8_STAGE(bufoff, gbase, voff) do { _Pragma("unroll") for (int _i = 0; _i < 2; ++_i) \
        __builtin_amdgcn_global_load_lds((const unsigned*)((const char*)(gbase) + (voff)[_i]), (PG8_LAS unsigned*)(lds + (bufoff) + ldsw + _i * 8192), 16, 0, 0); } while (0)
#define PG8_LDA(dst, b, h) do { _Pragma("unroll") for (int m = 0; m < 4; ++m) _Pragma("unroll") for (int k = 0; k < 2; ++k) dst[m][k] = *(const PG8_LAS bf16x8*)(lds + PG8_SA(b, h) + aoff + m * 2048 + k * 1024); } while (0)
#define PG8_LDB(dst, b, h) do { _Pragma("unroll") for (int n = 0; n < 2; ++n) _Pragma("unroll") for (int k = 0; k < 2; ++k) dst[n][k] = *(const PG8_LAS bf16x8*)(lds + PG8_SB(b, h) + boff + n * 2048 + k * 1024); } while (0)
#define PG8_MMA(ai, bj, At, Bt) do { __builtin_amdgcn_s_setprio(1); _Pragma("unroll") for (int m = 0; m < 4; ++m) _Pragma("unroll") for (int n = 0; n < 2; ++n) _Pragma("unroll") for (int k = 0; k < 2; ++k) \
        acc[ai][bj][m][n] = __builtin_amdgcn_mfma_f32_16x16x32_bf16(Bt[n][k], At[m][k], acc[ai][bj][m][n], 0, 0, 0); __builtin_amdgcn_s_setprio(0); } while (0)
#define PG8_WAIT_V(n) asm volatile("s_waitcnt vmcnt(" #n ")" ::: "memory")
#define PG8_WAIT_L(n) asm volatile("s_waitcnt lgkmcnt(" #n ")" ::: "memory")
#define PG8_BAR __builtin_amdgcn_s_barrier()
#define PG8_SCHED __builtin_amdgcn_sched_barrier(0)
    Unit cur, nxt; int ui = 0;
    if (!S.next(0, cur)) return;
    f32x4 acc[2][2][4][2];
#pragma unroll
    for (int a = 0; a < 2; ++a)
#pragma unroll
        for (int b = 0; b < 2; ++b)
#pragma unroll
            for (int m = 0; m < 4; ++m)
#pragma unroll
                for (int n = 0; n < 2; ++n) acc[a][b][m][n] = (f32x4){0.f, 0.f, 0.f, 0.f};
    bf16x8 At[4][2], B0[2][2], B1[2][2];
    const char* cA = (const char*)g.A + (size_t)cur.pm * tstep + cur.kh * khb; const char* cB = (const char*)g.Bt + (size_t)cur.pn * tstep + cur.kh * khb;
    S.a_ready(cur);
    if constexpr (SP2) {
        PG8_STAGE(PG8_SB(0, 0), cB, voffB); PG8_STAGE(PG8_SB(0, 1), cB + hstep, voffB); PG8_STAGE(PG8_SA(0, 0), cA, voffA); PG8_STAGE(PG8_SA(0, 1), cA + hstep, voffA);
        if (wr == 1) PG8_BAR;
        PG8_WAIT_V(2); PG8_BAR;
        PG8_STAGE(PG8_SB(1, 0), cB + kstep, voffB); PG8_STAGE(PG8_SA(1, 0), cA + kstep, voffA); PG8_STAGE(PG8_SB(1, 1), cB + hstep + kstep, voffB);
        PG8_WAIT_V(6); PG8_BAR;
    } else {
        PG8_STAGE(PG8_SB(0, 0), cB, voffB); PG8_STAGE(PG8_SA(0, 0), cA, voffA); PG8_STAGE(PG8_SB(0, 1), cB + hstep, voffB); PG8_STAGE(PG8_SA(0, 1), cA + hstep, voffA);
        if (wr == 1) PG8_BAR;
        PG8_WAIT_V(4); PG8_BAR;
        PG8_STAGE(PG8_SB(1, 0), cB + kstep, voffB); PG8_STAGE(PG8_SA(1, 0), cA + kstep, voffA); PG8_STAGE(PG8_SB(1, 1), cB + hstep + kstep, voffB);
        PG8_WAIT_V(6); PG8_BAR;
    }
    for (;;) {
        const bool has_next = S.next(ui + 1, nxt);
        const char* nA = has_next ? (const char*)g.A + (size_t)nxt.pm * tstep + nxt.kh * khb : cA; const char* nB = has_next ? (const char*)g.Bt + (size_t)nxt.pn * tstep + nxt.kh * khb : cB;
        for (int t = 0; t < nt; t += 2) {
            const bool last = (t == nt - 2);
            const char* a1 = cA + (size_t)(t + 1) * kstep;
            const char* a2 = last ? nA : cA + (size_t)(t + 2) * kstep; const char* b2 = last ? nB : cB + (size_t)(t + 2) * kstep;
            const char* a3 = a2 + kstep; const char* b3 = b2 + kstep;
            if (last && has_next) S.a_ready(nxt);
            if constexpr (SP2) {
            PG8_LDB(B0, 0, 0); PG8_LDB(B1, 0, 1); PG8_SCHED; PG8_LDA(At, 0, 0); PG8_STAGE(PG8_SA(1, 1), a1 + hstep, voffA);
            PG8_WAIT_V(8); PG8_WAIT_L(0); PG8_BAR; PG8_MMA(0, 0, At, B0); PG8_MMA(0, 1, At, B1); PG8_BAR; PG8_SCHED;
            PG8_LDA(At, 0, 1); PG8_STAGE(PG8_SB(0, 0), b2, voffB); PG8_STAGE(PG8_SB(0, 1), b2 + hstep, voffB); PG8_STAGE(PG8_SA(0, 0), a2, voffA);
            PG8_WAIT_V(8); PG8_WAIT_L(0); PG8_BAR; PG8_MMA(1, 0, At, B0); PG8_MMA(1, 1, At, B1); PG8_BAR; PG8_SCHED;
            PG8_LDB(B0, 1, 0); PG8_LDB(B1, 1, 1); PG8_SCHED; PG8_LDA(At, 1, 0); PG8_STAGE(PG8_SA(0, 1), a2 + hstep, voffA);
            PG8_WAIT_V(8); PG8_WAIT_L(0); PG8_BAR; PG8_MMA(0, 0, At, B0); PG8_MMA(0, 1, At, B1); PG8_BAR; PG8_SCHED;
            PG8_LDA(At, 1, 1); PG8_STAGE(PG8_SB(1, 0), b3, voffB); PG8_STAGE(PG8_SB(1, 1), b3 + hstep, voffB); PG8_STAGE(PG8_SA(1, 0), a3, voffA);
            PG8_WAIT_V(8); PG8_WAIT_L(0); PG8_BAR; PG8_MMA(1, 0, At, B0); PG8_MMA(1, 1, At, B1); PG8_BAR; PG8_SCHED;
            } else {
            PG8_LDB(B0, 0, 0); PG8_SCHED; PG8_LDA(At, 0, 0); PG8_STAGE(PG8_SA(1, 1), a1 + hstep, voffA);
            PG8_WAIT_L(8); PG8_BAR; PG8_WAIT_L(0); PG8_MMA(0, 0, At, B0); PG8_BAR; PG8_SCHED;
            PG8_LDB(B1, 0, 1); PG8_STAGE(PG8_SB(0, 0), b2, voffB);
            PG8_BAR; PG8_WAIT_L(0); PG8_MMA(0, 1, At, B1); PG8_BAR;
            PG8_LDA(At, 0, 1); PG8_STAGE(PG8_SA(0, 0), a2, voffA);
            PG8_BAR; PG8_WAIT_L(0); PG8_MMA(1, 0, At, B0); PG8_BAR; PG8_SCHED;
            PG8_STAGE(PG8_SB(0, 1), b2 + hstep, voffB);
            PG8_WAIT_V(6); PG8_BAR; PG8_MMA(1, 1, At, B1); PG8_BAR;
            PG8_LDB(B0, 1, 0); PG8_SCHED; PG8_LDA(At, 1, 0); PG8_STAGE(PG8_SA(0, 1), a2 + hstep, voffA);
            PG8_WAIT_L(8); PG8_BAR; PG8_WAIT_L(0); PG8_MMA(0, 0, At, B0); PG8_BAR; PG8_SCHED;
            PG8_LDB(B1, 1, 1); PG8_STAGE(PG8_SB(1, 0), b3, voffB);
            PG8_BAR; PG8_WAIT_L(0); PG8_MMA(0, 1, At, B1); PG8_BAR;
            PG8_LDA(At, 1, 1); PG8_STAGE(PG8_SA(1, 0), a3, voffA);
            PG8_BAR; PG8_WAIT_L(0); PG8_MMA(1, 0, At, B0); PG8_BAR; PG8_SCHED;
            PG8_STAGE(PG8_SB(1, 1), b3 + hstep, voffB);
            PG8_WAIT_V(6); PG8_BAR; PG8_MMA(1, 1, At, B1); PG8_BAR;
            }
        }
        if constexpr (ALIGN_EPI) { if (wr == 0) PG8_BAR; }
        if constexpr (!Epi::AFTER_DRAIN) { E(acc, cur, wr, wc, fr, fq); S.done(cur); }
        if (!has_next) break;
        if (!(Epi::KSPLIT && cur.kh == 0))
#pragma unroll
        for (int a = 0; a < 2; ++a)
#pragma unroll
            for (int b = 0; b < 2; ++b)
#pragma unroll
                for (int m = 0; m < 4; ++m)
#pragma unroll
                    for (int n = 0; n < 2; ++n) acc[a][b][m][n] = (f32x4){0.f, 0.f, 0.f, 0.f};
        cur = nxt; cA = nA; cB = nB; ++ui;
        if constexpr (ALIGN_EPI) { if (wr == 1) PG8_BAR; }
    }
    PG8_WAIT_V(0);
    if constexpr (!ALIGN_EPI) { if (wr == 0) PG8_BAR; }
    PG8_BAR;
    if constexpr (Epi::AFTER_DRAIN) { E.fused(acc, cur, wr, wc, fr, fq, lds, wid, lane); S.done(cur); }
#undef PG8_SA
#undef PG8_SB
#undef PG8_STAGE
#undef PG8_LDA
#undef PG8_LDB
#undef PG8_MMA
#undef PG8_WAIT_V
#undef PG8_WAIT_L
#undef PG8_BAR
#undef PG8_SCHED
}
}

constexpr int NWAVES = 8, NTHREADS = 512;
constexpr int BATCH = 8, SEQ = 2048, D = 1024, M = BATCH * SEQ, INW = 9216, FFH = 2816;
constexpr float EPS = 1e-6f;
constexpr size_t MiB = 1u << 20;
constexpr size_t WS_SSQ = 1 * MiB;
constexpr size_t WS_WIN = 2 * MiB;
constexpr size_t WS_WHS = 20 * MiB;
constexpr size_t WS_WO = 24 * MiB;
constexpr size_t WS_WF1 = 26 * MiB;
constexpr size_t WS_WF2 = 37 * MiB;
constexpr size_t WS_H = 43 * MiB;
constexpr size_t WS_MIXED = WS_H;
constexpr size_t WS_QS = 75 * MiB;
constexpr size_t WS_VH = 139 * MiB;
constexpr size_t WS_SK = 171 * MiB;
constexpr size_t WS_X1B = WS_SK;
constexpr size_t WS_GH = 203 * MiB, WS_GA = 219 * MiB, WS_GB = 235 * MiB;
constexpr size_t WS_ACT = 75 * MiB;
constexpr size_t WS_END = 251 * MiB;
static_assert(WS_ACT + (size_t)M * FFH * 2 <= WS_X1B, "ACT overlay");
constexpr int RING_BYTES = 131072, LDS_BYTES = 157696, MISC_OFF = LDS_BYTES - 256;

#define LAS __attribute__((address_space(3)))
typedef unsigned short bf16;
typedef unsigned v4u __attribute__((ext_vector_type(4)));
typedef float f32x4 __attribute__((ext_vector_type(4)));
__device__ __forceinline__ unsigned f2bf(float f) { unsigned u = __builtin_bit_cast(unsigned, f); return (u + 0x7fffu + ((u >> 16) & 1u)) >> 16; }
__device__ __forceinline__ unsigned pk2(float lo, float hi) { return f2bf(lo) | (f2bf(hi) << 16); }
__device__ __forceinline__ float bf2f(unsigned short b) { return __builtin_bit_cast(float, (unsigned)b << 16); }
__device__ __forceinline__ float wave_sum(float v) {
#pragma unroll
    for (int o = 1; o < 64; o <<= 1) v += __shfl_xor(v, o);
    return v;
}
struct Args { const float* in[13]; float* out; unsigned char* ws; int ph_lo, ph_hi; };

struct ConvItem { const float* W; bf16* WT; const float* ks; int N, ldT, koff, k0, n0d, n0s; };
__device__ __forceinline__ ConvItem conv_item(const Args& a, unsigned char* ws, int it) {
    constexpr int I_IN = 16 * (INW / 32), I_SQ = 16 * 32, I_F1 = 16 * (2 * FFH / 32);
    ConvItem p; int r = it; p.ks = nullptr; p.koff = 0;
    if (r < I_IN) { const int nblk = INW / 32, kb = r / nblk, nb = r % nblk, n0d = 32 * nb; const int sec = n0d >> 10; int n0s = n0d;
        if (sec == 4 || sec == 5) { const int q = n0d & 255; n0s = (n0d - q) + 64 * ((q >> 5) & 3) + 32 * (q >> 7); }
        p.W = a.in[2]; p.N = INW; p.WT = (bf16*)(ws + WS_WIN); p.ldT = 1024; p.k0 = 64 * kb; p.n0d = n0d; p.n0s = n0s; return p; } r -= I_IN;
    if (r < I_SQ) { p.W = a.in[7]; p.N = 1024; p.WT = (bf16*)(ws + WS_WHS); p.ldT = 2048; p.k0 = 64 * (r / 32); p.n0d = p.n0s = 32 * (r % 32); return p; } r -= I_SQ;
    if (r < I_SQ) { p.W = a.in[8]; p.N = 1024; p.WT = (bf16*)(ws + WS_WHS); p.ldT = 2048; p.koff = 1024; p.k0 = 64 * (r / 32); p.n0d = p.n0s = 32 * (r % 32); return p; } r -= I_SQ;
    if (r < I_SQ) { p.W = a.in[9]; p.N = 1024; p.WT = (bf16*)(ws + WS_WO); p.ldT = 1024; p.k0 = 64 * (r / 32); p.n0d = p.n0s = 32 * (r % 32); return p; } r -= I_SQ;
    if (r < I_F1) { const int nblk = 2 * FFH / 32, kb = r / nblk, nb = r % nblk, n0d = 32 * nb, pn = n0d >> 8, q = n0d & 255;
        p.W = a.in[11]; p.N = 2 * FFH; p.WT = (bf16*)(ws + WS_WF1); p.ldT = 1024; p.k0 = 64 * kb; p.n0d = n0d; p.n0s = (q >> 7) * FFH + 128 * pn + (q & 127); p.ks = a.in[10]; return p; } r -= I_F1;
    p.W = a.in[12]; p.N = 1024; p.WT = (bf16*)(ws + WS_WF2); p.ldT = FFH; p.k0 = 64 * (r / 32); p.n0d = p.n0s = 32 * (r % 32); return p;
}
__device__ __forceinline__ void conv_load(const ConvItem& p, float (&wv)[32], f32x4 (&kv)[2], int lane) {
    const float* wp = p.W + (size_t)(p.k0 + (lane >> 5)) * p.N + p.n0s + (lane & 31);
#pragma unroll
    for (int i = 0; i < 32; ++i) wv[i] = wp[(size_t)(2 * i) * p.N];
    if (p.ks) { kv[0] = *(const f32x4*)(p.ks + p.k0 + 8 * (lane & 7)); kv[1] = *(const f32x4*)(p.ks + p.k0 + 8 * (lane & 7) + 4); }
    else { kv[0] = (f32x4){1.f, 1.f, 1.f, 1.f}; kv[1] = kv[0]; }
}
__device__ __forceinline__ void conv_finish(const ConvItem& p, const float (&wv)[32], const f32x4 (&kv)[2], LAS float* scr, int lane) {
#pragma unroll
    for (int i = 0; i < 32; ++i) scr[(2 * i + (lane >> 5)) * 33 + (lane & 31)] = wv[i];
    asm volatile("s_waitcnt lgkmcnt(0)" ::: "memory");
    const int c = lane & 7;
#pragma unroll
    for (int j = 0; j < 4; ++j) { const int n = (lane >> 3) + 8 * j; const LAS float* s = scr + (8 * c) * 33 + n;
        v4u o; o.x = pk2(s[0 * 33] * kv[0][0], s[1 * 33] * kv[0][1]); o.y = pk2(s[2 * 33] * kv[0][2], s[3 * 33] * kv[0][3]); o.z = pk2(s[4 * 33] * kv[1][0], s[5 * 33] * kv[1][1]); o.w = pk2(s[6 * 33] * kv[1][2], s[7 * 33] * kv[1][3]);
        *(v4u*)(p.WT + (size_t)(p.n0d + n) * p.ldT + p.koff + p.k0 + 8 * c) = o; }
    asm volatile("s_waitcnt lgkmcnt(0)" ::: "memory");
}
template <int PART> __device__ __forceinline__ void p0_prologue(const Args& a, LAS unsigned char* lds, int wave, int lane, int gw, int NGW, int it_last = 1 << 30) {
    LAS float* scr = (LAS float*)(lds + wave * 16384);
    unsigned char* ws = a.ws;
    constexpr int I_IN = 16 * (INW / 32), I_SQ = 16 * 32, I_F1 = 16 * (2 * FFH / 32), I_F2 = (FFH / 64) * 32;
    constexpr int NITEMS = I_IN + 3 * I_SQ + I_F1 + I_F2;
    { int it = (PART == 0 ? gw : I_IN + gw); const int end = (PART == 0 ? I_IN : (I_IN + it_last < NITEMS ? I_IN + it_last : NITEMS));
      if (it < end) {
        ConvItem pa = conv_item(a, ws, it), pb = pa; float wa[32], wb[32]; f32x4 ka[2], kb[2];
        conv_load(pa, wa, ka, lane);
        for (;;) {
            const bool hb = it + NGW < end; if (hb) { pb = conv_item(a, ws, it + NGW); conv_load(pb, wb, kb, lane); }
            conv_finish(pa, wa, ka, scr, lane);
            if (!hb) break; it += NGW;
            const bool ha = it + NGW < end; if (ha) { pa = conv_item(a, ws, it + NGW); conv_load(pa, wa, ka, lane); }
            conv_finish(pb, wb, kb, scr, lane);
            if (!ha) break; it += NGW;
        }
      }
    }
    if (PART != 0) return;
    const float* g1 = a.in[1];
    f32x4 gv[4];
#pragma unroll
    for (int j = 0; j < 4; ++j) gv[j] = ((const f32x4*)g1)[lane + 64 * j];
    for (int m = gw; m < M; m += NGW) {
        const f32x4* xr = (const f32x4*)(a.in[0] + (size_t)m * D) + lane;
        f32x4 v[4]; float s = 0.f;
#pragma unroll
        for (int j = 0; j < 4; ++j) { v[j] = xr[64 * j]; s += (v[j].x * v[j].x + v[j].y * v[j].y) + (v[j].z * v[j].z + v[j].w * v[j].w); }
        const float rstd = __builtin_amdgcn_rsqf(wave_sum(s) * (1.f / D) + EPS);
        unsigned long long* o8 = (unsigned long long*)((bf16*)(ws + WS_H) + (size_t)m * D) + lane;
#pragma unroll
        for (int j = 0; j < 4; ++j) { const f32x4 y = v[j] * rstd * gv[j]; o8[64 * j] = (unsigned long long)pk2(y.x, y.y) | ((unsigned long long)pk2(y.z, y.w) << 32); }
    }
}

typedef short bf16x8_t __attribute__((ext_vector_type(8)));
typedef float f32x16 __attribute__((ext_vector_type(16)));
typedef unsigned u32x2_t __attribute__((ext_vector_type(2)));
typedef float f32x2_t __attribute__((ext_vector_type(2)));
typedef __bf16 bf16x2_cv __attribute__((ext_vector_type(2)));
__device__ __forceinline__ unsigned cvtpk(float lo, float hi) { const f32x2_t v = {lo, hi}; return __builtin_bit_cast(unsigned, __builtin_convertvector(v, bf16x2_cv)); }
__device__ __forceinline__ bf16x8_t pack_acc8(const f32x16& c, int p) {
    v4u w; if (p == 0) { w.x = cvtpk(c[0], c[1]); w.y = cvtpk(c[2], c[3]); w.z = cvtpk(c[4], c[5]); w.w = cvtpk(c[6], c[7]); }
    else { w.x = cvtpk(c[8], c[9]); w.y = cvtpk(c[10], c[11]); w.z = cvtpk(c[12], c[13]); w.w = cvtpk(c[14], c[15]); }
    return __builtin_bit_cast(bf16x8_t, w);
}
#define MFMA32(A, B, C) __builtin_amdgcn_mfma_f32_32x32x16_bf16((A), (B), (C), 0, 0, 0)
__device__ __forceinline__ void hgrn_mfma(const Args& a, LAS unsigned char* lds, int vblk, int nblk) {
    unsigned char* ws = a.ws;
    bf16* QS = (bf16*)(ws + WS_QS); const bf16* VH = (const bf16*)(ws + WS_VH); const unsigned char* GH = ws + WS_GH; const _Float16* LOGF = (const _Float16*)a.out;
    const float* ogain = a.in[4];
    constexpr int RS = 272, TS = 144;
    LAS unsigned char* L_QI = lds; LAS unsigned char* L_QA = lds + 64 * RS; LAS unsigned char* L_KA = lds + 2 * 64 * RS;
    LAS unsigned char* L_KST = lds + 3 * 64 * RS; LAS unsigned char* L_VT = L_KST + 128 * TS;
    LAS float* L_TQ = (LAS float*)(L_VT + 128 * TS); LAS float* L_DEC = L_TQ + 2048;     LAS float* L_SS = L_DEC + 128; LAS float* L_GN = L_SS + 256;
    const int tid = threadIdx.x, lane = tid & 63, wave = __builtin_amdgcn_readfirstlane(tid >> 6);
    const int dp = tid & 63, oct = wave, r32 = lane & 31, hi = lane >> 5, vt = wave & 3, tt = wave >> 2;
    const int kap = 16 * (r32 >> 4) + 8 * ((r32 >> 2) & 1) + 4 * ((r32 >> 3) & 1) + (r32 & 3);
    for (int item = vblk; item < BATCH * 8; item += nblk) {
        const int b = item >> 3, h = item & 7;
        f32x16 C[4];
#pragma unroll
        for (int i = 0; i < 4; ++i)
#pragma unroll
            for (int j = 0; j < 16; ++j) C[i][j] = 0.f;
        if (tid < 128) L_GN[tid] = ogain[h * 128 + tid];
        unsigned gN2[2][8], qN2[2][8], vN2[2][8];
#pragma unroll
        for (int c2 = 0; c2 < 2; ++c2) { const size_t row0 = (size_t)b * SEQ + 64 * c2 + 8 * oct;
#pragma unroll
          for (int i = 0; i < 8; ++i) { gN2[c2][i] = *(const unsigned*)(LOGF + (row0 + i) * 1024 + h * 128 + 2 * dp); qN2[c2][i] = *(const unsigned*)(QS + (row0 + i) * 2048 + h * 128 + 2 * dp); vN2[c2][i] = *(const unsigned*)(VH + (row0 + i) * 1024 + h * 128 + 2 * dp); } }
        { float run0 = 0.f, run1 = 0.f;
#pragma unroll
          for (int i = 0; i < 8; ++i) { run0 += (float)__builtin_bit_cast(_Float16, (unsigned short)(gN2[0][i] & 0xffffu)); run1 += (float)__builtin_bit_cast(_Float16, (unsigned short)(gN2[0][i] >> 16)); }
          *(LAS f32x2_t*)(L_TQ + oct * 128 + 2 * dp) = (f32x2_t){run0, run1}; }
        __syncthreads();
#pragma unroll 2
        for (int n = 0; n < SEQ / 64; ++n) {
            unsigned (&gN)[8] = gN2[n & 1]; unsigned (&qN)[8] = qN2[n & 1]; unsigned (&vN)[8] = vN2[n & 1];
            if (n + 1 < SEQ / 64) { float run0 = 0.f, run1 = 0.f;
#pragma unroll
                for (int i = 0; i < 8; ++i) { const unsigned gw_ = gN2[(n + 1) & 1][i]; run0 += (float)__builtin_bit_cast(_Float16, (unsigned short)(gw_ & 0xffffu)); run1 += (float)__builtin_bit_cast(_Float16, (unsigned short)(gw_ >> 16)); }
                *(LAS f32x2_t*)(L_TQ + ((n + 1) & 1) * 1024 + oct * 128 + 2 * dp) = (f32x2_t){run0, run1}; }
            float off0 = 0.f, off1 = 0.f, cref0 = 0.f, cref1 = 0.f, tot0 = 0.f, tot1 = 0.f;
#pragma unroll
            for (int o = 0; o < 8; ++o) { const f32x2_t tq = *(const LAS f32x2_t*)(L_TQ + (n & 1) * 1024 + o * 128 + 2 * dp);
                if (o < oct) { off0 += tq.x; off1 += tq.y; } if (o < 4) { cref0 += tq.x; cref1 += tq.y; } tot0 += tq.x; tot1 += tq.y; }
            const float xc0 = __expf(tot0), xc1 = __expf(tot1), xa0 = __expf(-cref0), xa1 = __expf(-cref1), xb0 = __expf(cref0), xb1 = __expf(cref1);
            if (oct == 0) *(LAS f32x2_t*)(L_DEC + 2 * dp) = (f32x2_t){xc0, xc1};
            float e0 = __expf(off0), e1 = __expf(off1);
            unsigned ksp0[4], ksp1[4], vsp0[4], vsp1[4];
#pragma unroll
            for (int i = 0; i < 8; ++i) {
                const float f0 = __expf((float)__builtin_bit_cast(_Float16, (unsigned short)(gN[i] & 0xffffu))), f1 = __expf((float)__builtin_bit_cast(_Float16, (unsigned short)(gN[i] >> 16)));
                e0 = fmaxf(e0 * f0, 1e-30f); e1 = fmaxf(e1 * f1, 1e-30f);
                const float r0 = __builtin_amdgcn_rcpf(e0), r1 = __builtin_amdgcn_rcpf(e1);
                const float k0 = 1.0f - f0, k1 = 1.0f - f1, q0 = __builtin_bit_cast(float, qN[i] << 16), q1 = __builtin_bit_cast(float, qN[i] & 0xffff0000u);
                const float qi0 = q0 * e0, qi1 = q1 * e1, kr0 = k0 * r0, kr1 = k1 * r1;
                const int t = 8 * oct + i;
                *(LAS unsigned*)(L_QI + t * RS + 4 * dp) = cvtpk(qi0, qi1);
                *(LAS unsigned*)(L_QA + t * RS + 4 * dp) = cvtpk(qi0 * xa0, qi1 * xa1);
                *(LAS unsigned*)(L_KA + t * RS + 4 * dp) = cvtpk(kr0 * xb0, kr1 * xb1);
                const unsigned ks = cvtpk(kr0 * xc0, kr1 * xc1);
                if (i & 1) { ksp0[i >> 1] |= ks << 16; ksp1[i >> 1] |= ks & 0xffff0000u; vsp0[i >> 1] |= vN[i] << 16; vsp1[i >> 1] |= vN[i] & 0xffff0000u; }
                else { ksp0[i >> 1] = ks & 0xffffu; ksp1[i >> 1] = ks >> 16; vsp0[i >> 1] = vN[i] & 0xffffu; vsp1[i >> 1] = vN[i] >> 16; }
            }
            *(LAS v4u*)(L_KST + (2 * dp) * TS + 16 * oct) = (v4u){ksp0[0], ksp0[1], ksp0[2], ksp0[3]}; *(LAS v4u*)(L_KST + (2 * dp + 1) * TS + 16 * oct) = (v4u){ksp1[0], ksp1[1], ksp1[2], ksp1[3]};
            *(LAS v4u*)(L_VT + (2 * dp) * TS + 16 * oct) = (v4u){vsp0[0], vsp0[1], vsp0[2], vsp0[3]}; *(LAS v4u*)(L_VT + (2 * dp + 1) * TS + 16 * oct) = (v4u){vsp1[0], vsp1[1], vsp1[2], vsp1[3]};
            __syncthreads();
            const size_t m = (size_t)b * SEQ + 64 * n + 32 * tt + r32;
            unsigned gt4[4];
#pragma unroll
            for (int a4 = 0; a4 < 4; ++a4) gt4[a4] = *(const unsigned*)(GH + m * 1024 + h * 128 + 32 * vt + 8 * a4 + 4 * hi);
            if (n + 2 < SEQ / 64) { const size_t row0 = (size_t)b * SEQ + 64 * (n + 2) + 8 * oct;
#pragma unroll
                for (int i = 0; i < 8; ++i) { gN[i] = *(const unsigned*)(LOGF + (row0 + i) * 1024 + h * 128 + 2 * dp); qN[i] = *(const unsigned*)(QS + (row0 + i) * 2048 + h * 128 + 2 * dp); vN[i] = *(const unsigned*)(VH + (row0 + i) * 1024 + h * 128 + 2 * dp); } }
#define SB() __builtin_amdgcn_sched_barrier(0)
            f32x16 O;
#pragma unroll
            for (int j = 0; j < 16; ++j) O[j] = 0.f;
            bf16x8_t Vt[4];
            {
                v4u qf[8];
#pragma unroll
                for (int i = 0; i < 8; ++i) { const LAS unsigned char* qp = L_QI + (32 * tt + r32) * RS + (32 * (i >> 1) + 16 * (i & 1) + 4 * hi) * 2;
                    const u32x2_t lo = *(const LAS u32x2_t*)qp, hi2 = *(const LAS u32x2_t*)(qp + 16); qf[i] = (v4u){lo.x, lo.y, hi2.x, hi2.y}; }
#pragma unroll
                for (int ks = 0; ks < 4; ++ks) Vt[ks] = *(const LAS bf16x8_t*)(L_VT + (32 * vt + r32) * TS + (16 * ks + 8 * hi) * 2);
                SB();
#pragma unroll
                for (int i = 0; i < 8; ++i) O = MFMA32(pack_acc8(C[i >> 1], i & 1), __builtin_bit_cast(bf16x8_t, qf[i]), O);
                SB();
            }
#pragma unroll
            for (int st = 0; st < 2; ++st) if (st <= tt) {
                f32x16 S;
#pragma unroll
                for (int j = 0; j < 16; ++j) S[j] = 0.f;
#pragma unroll
                for (int hb = 0; hb < 2; ++hb) {
                    bf16x8_t A[4], B[4];
#pragma unroll
                    for (int k4 = 0; k4 < 4; ++k4) { const int ks = 4 * hb + k4;
                        A[k4] = *(const LAS bf16x8_t*)(L_KA + (32 * st + kap) * RS + (16 * ks + 8 * hi) * 2);
                        B[k4] = *(const LAS bf16x8_t*)(L_QA + (32 * tt + r32) * RS + (16 * ks + 8 * hi) * 2); }
                    SB();
#pragma unroll
                    for (int k4 = 0; k4 < 4; ++k4) S = MFMA32(A[k4], B[k4], S);
                    SB();
                }
                if (st == tt) {
#pragma unroll
                    for (int j = 0; j < 16; ++j) { const int sl = 16 * (j >> 3) + 8 * hi + (j & 7); if (sl > r32) S[j] = 0.f; }
                }
                O = MFMA32(Vt[2 * st], pack_acc8(S, 0), O); O = MFMA32(Vt[2 * st + 1], pack_acc8(S, 1), O);
            }
#pragma unroll
            for (int dt = 0; dt < 4; ++dt) {
                f32x4 dc[4]; bf16x8_t A[4];
#pragma unroll
                for (int a4 = 0; a4 < 4; ++a4) dc[a4] = *(const LAS f32x4*)(L_DEC + 32 * dt + 8 * a4 + 4 * hi);
#pragma unroll
                for (int ks = 0; ks < 4; ++ks) A[ks] = *(const LAS bf16x8_t*)(L_KST + (32 * dt + r32) * TS + (16 * ks + 8 * hi) * 2);
                SB();
#pragma unroll
                for (int a4 = 0; a4 < 4; ++a4)
#pragma unroll
                    for (int cc = 0; cc < 4; ++cc) C[dt][4 * a4 + cc] *= dc[a4][cc];
#pragma unroll
                for (int ks = 0; ks < 4; ++ks) C[dt] = MFMA32(A[ks], Vt[ks], C[dt]);
                SB();
            }
#undef SB
            float ss = 0.f;
#pragma unroll
            for (int j = 0; j < 16; ++j) ss += O[j] * O[j];
            ss += __shfl_xor(ss, 32);
            if (hi == 0) L_SS[(tt * 4 + vt) * 32 + r32] = ss;
            __syncthreads();
            const float sst = (L_SS[(tt * 4 + 0) * 32 + r32] + L_SS[(tt * 4 + 1) * 32 + r32]) + (L_SS[(tt * 4 + 2) * 32 + r32] + L_SS[(tt * 4 + 3) * 32 + r32]);
            const float rstd = __builtin_amdgcn_rsqf(sst * (1.0f / 128.0f) + EPS);
#pragma unroll
            for (int a4 = 0; a4 < 4; ++a4) { const int v0 = h * 128 + 32 * vt + 8 * a4 + 4 * hi;
                const f32x4 gn = *(const LAS f32x4*)(L_GN + 32 * vt + 8 * a4 + 4 * hi); const unsigned gt = gt4[a4];
                float o[4];
#pragma unroll
                for (int cc = 0; cc < 4; ++cc) o[cc] = O[4 * a4 + cc] * rstd * gn[cc] * ((float)((gt >> (8 * cc)) & 255u) * (1.0f / 255.0f));
                u32x2_t w; w.x = cvtpk(o[0], o[1]); w.y = cvtpk(o[2], o[3]);
                *(u32x2_t*)(QS + m * 2048 + v0) = w; }
        }
        __syncthreads();
    }
}

__device__ __forceinline__ void hgrn_v2(const Args& a, LAS unsigned char* lds, int vblk, int nblk) {
    unsigned char* ws = a.ws;
    bf16* QS = (bf16*)(ws + WS_QS); const bf16* VH = (const bf16*)(ws + WS_VH); const unsigned char* GH = ws + WS_GH; const _Float16* LOGF = (const _Float16*)a.out;
    const float* ogain = a.in[4];
    constexpr int RS = 272, TS = 144, O_KA = 64 * RS, O_KAT = 2 * 64 * RS, O_VT = O_KAT + 128 * TS, BUFB = O_VT + 128 * TS;
    LAS float* L_TQ = (LAS float*)(lds + 2 * BUFB);
    LAS float* L_XS = L_TQ + 1024;
    LAS float* L_SS = L_XS + 512;
    LAS float* L_GN = L_SS + 512;
    const int tid = threadIdx.x, lane = tid & 63, wave = __builtin_amdgcn_readfirstlane(tid >> 6);
    const int r32 = lane & 31, hi = lane >> 5;
    const int kap = 16 * (r32 >> 4) + 8 * ((r32 >> 2) & 1) + 4 * ((r32 >> 3) & 1) + (r32 & 3);
    constexpr int NCH = SEQ / 64;
#define SB() __builtin_amdgcn_sched_barrier(0)
    for (int item = vblk; item < BATCH * 8; item += nblk) {
        const int b = item >> 3, h = item & 7;
        if (tid < 128) L_GN[tid] = ogain[h * 128 + tid];
        if (wave < 4) {
            const int vt = wave;
            f32x16 C[4];
#pragma unroll
            for (int i = 0; i < 4; ++i)
#pragma unroll
                for (int j = 0; j < 16; ++j) C[i][j] = 0.f;
            f32x16 O[2]; unsigned gt4[2][4];
#define HG_EPI(cn) do { _Pragma("unroll") for (int tt = 0; tt < 2; ++tt) { const LAS float* SSb = L_SS + ((cn) & 1) * 256; \
                const float sst = (SSb[(tt * 4 + 0) * 32 + r32] + SSb[(tt * 4 + 1) * 32 + r32]) + (SSb[(tt * 4 + 2) * 32 + r32] + SSb[(tt * 4 + 3) * 32 + r32]); \
                const float rstd = __builtin_amdgcn_rsqf(sst * (1.0f / 128.0f) + EPS); \
                const size_t m = (size_t)b * SEQ + 64 * (cn) + r32 + 32 * tt; \
                _Pragma("unroll") for (int a4 = 0; a4 < 4; ++a4) { const int v0 = h * 128 + 32 * vt + 8 * a4 + 4 * hi; \
                    const f32x4 gn = *(const LAS f32x4*)(L_GN + 32 * vt + 8 * a4 + 4 * hi); const unsigned gt = gt4[tt][a4]; float o[4]; \
                    _Pragma("unroll") for (int cc = 0; cc < 4; ++cc) o[cc] = O[tt][4 * a4 + cc] * rstd * gn[cc] * ((float)((gt >> (8 * cc)) & 255u) * (1.0f / 255.0f)); \
                    u32x2_t w; w.x = cvtpk(o[0], o[1]); w.y = cvtpk(o[2], o[3]); *(u32x2_t*)(QS + m * 2048 + v0) = w; } } } while (0)
            __syncthreads();
#pragma unroll 1
            for (int n = 0; n < NCH; ++n) {
                __syncthreads();
                if (n > 0) HG_EPI(n - 1);
                const LAS unsigned char* T = lds + (n & 1) * BUFB;
                const LAS float* XS = L_XS + (n & 1) * 256;
                const size_t m0 = (size_t)b * SEQ + 64 * n + r32;
#pragma unroll
                for (int tt = 0; tt < 2; ++tt)
#pragma unroll
                    for (int a4 = 0; a4 < 4; ++a4) gt4[tt][a4] = *(const unsigned*)(GH + (m0 + 32 * tt) * 1024 + h * 128 + 32 * vt + 8 * a4 + 4 * hi);
                bf16x8_t Cp[8]; bf16x8_t Vt[4];
#pragma unroll
                for (int ks = 0; ks < 4; ++ks) Vt[ks] = *(const LAS bf16x8_t*)(T + O_VT + (32 * vt + r32) * TS + (16 * ks + 8 * hi) * 2);
#pragma unroll
                for (int dt = 0; dt < 4; ++dt) {
#pragma unroll
                    for (int a4 = 0; a4 < 4; ++a4) { const f32x4 x1 = *(const LAS f32x4*)(XS + 32 * dt + 8 * a4 + 4 * hi);
#pragma unroll
                        for (int cc = 0; cc < 4; ++cc) C[dt][4 * a4 + cc] *= x1[cc]; }
                    Cp[2 * dt] = pack_acc8(C[dt], 0); Cp[2 * dt + 1] = pack_acc8(C[dt], 1);
                }
#pragma unroll
                for (int tt = 0; tt < 2; ++tt) {
#pragma unroll
                    for (int j = 0; j < 16; ++j) O[tt][j] = 0.f;
                    v4u qf[8];
#pragma unroll
                    for (int i = 0; i < 8; ++i) { const LAS unsigned char* qp = T + (32 * tt + r32) * RS + (32 * (i >> 1) + 16 * (i & 1) + 4 * hi) * 2;
                        const u32x2_t lo = *(const LAS u32x2_t*)qp, hi2 = *(const LAS u32x2_t*)(qp + 16); qf[i] = (v4u){lo.x, lo.y, hi2.x, hi2.y}; }
                    SB();
#pragma unroll
                    for (int i = 0; i < 8; ++i) O[tt] = MFMA32(Cp[i], __builtin_bit_cast(bf16x8_t, qf[i]), O[tt]);
                    SB();
#pragma unroll
                    for (int st = 0; st < 2; ++st) if (st <= tt) {
                        f32x16 S;
#pragma unroll
                        for (int j = 0; j < 16; ++j) S[j] = 0.f;
#pragma unroll
                        for (int hb = 0; hb < 2; ++hb) {
                            bf16x8_t A[4], B[4];
#pragma unroll
                            for (int k4 = 0; k4 < 4; ++k4) { const int ks = 4 * hb + k4;
                                A[k4] = *(const LAS bf16x8_t*)(T + O_KA + (32 * st + kap) * RS + (16 * ks + 8 * hi) * 2);
                                B[k4] = *(const LAS bf16x8_t*)(T + (32 * tt + r32) * RS + (16 * ks + 8 * hi) * 2); }
                            SB();
#pragma unroll
                            for (int k4 = 0; k4 < 4; ++k4) S = MFMA32(A[k4], B[k4], S);
                            SB();
                        }
                        if (st == tt) {
#pragma unroll
                            for (int j = 0; j < 16; ++j) { const int sl = 16 * (j >> 3) + 8 * hi + (j & 7); if (sl > r32) S[j] = 0.f; }
                        }
                        O[tt] = MFMA32(Vt[2 * st], pack_acc8(S, 0), O[tt]); O[tt] = MFMA32(Vt[2 * st + 1], pack_acc8(S, 1), O[tt]);
                    }
                    float ss = 0.f;
#pragma unroll
                    for (int j = 0; j < 16; ++j) ss += O[tt][j] * O[tt][j];
                    ss += __shfl_xor(ss, 32);
                    if (hi == 0) L_SS[(n & 1) * 256 + (tt * 4 + vt) * 32 + r32] = ss;
                }
#pragma unroll
                for (int dt = 0; dt < 4; ++dt) {
                    f32x4 x2[4]; bf16x8_t A[4];
#pragma unroll
                    for (int a4 = 0; a4 < 4; ++a4) x2[a4] = *(const LAS f32x4*)(XS + 128 + 32 * dt + 8 * a4 + 4 * hi);
#pragma unroll
                    for (int ks = 0; ks < 4; ++ks) A[ks] = *(const LAS bf16x8_t*)(T + O_KAT + (32 * dt + r32) * TS + (16 * ks + 8 * hi) * 2);
                    SB();
#pragma unroll
                    for (int ks = 0; ks < 4; ++ks) C[dt] = MFMA32(A[ks], Vt[ks], C[dt]);
#pragma unroll
                    for (int a4 = 0; a4 < 4; ++a4)
#pragma unroll
                        for (int cc = 0; cc < 4; ++cc) C[dt][4 * a4 + cc] *= x2[a4][cc];
                    SB();
                }
            }
            __syncthreads();
            HG_EPI(NCH - 1);
#undef HG_EPI
        } else {
            const int ptid = tid - 256, dp = ptid & 63, q4 = ptid >> 6;
            unsigned g2[2][16], q2[2][16], v2[2][16];
#define HG_LOAD(set, c) do { const size_t row0_ = (size_t)b * SEQ + 64 * (c) + 16 * q4; _Pragma("unroll") for (int i = 0; i < 16; ++i) { \
                g2[set][i] = *(const unsigned*)(LOGF + (row0_ + i) * 1024 + h * 128 + 2 * dp); q2[set][i] = *(const unsigned*)(QS + (row0_ + i) * 2048 + h * 128 + 2 * dp); \
                v2[set][i] = *(const unsigned*)(VH + (row0_ + i) * 1024 + h * 128 + 2 * dp); } } while (0)
#define HG_SUMS(set, c) do { float r0_ = 0.f, r1_ = 0.f; _Pragma("unroll") for (int i = 0; i < 16; ++i) { r0_ += (float)__builtin_bit_cast(_Float16, (unsigned short)(g2[set][i] & 0xffffu)); \
                r1_ += (float)__builtin_bit_cast(_Float16, (unsigned short)(g2[set][i] >> 16)); } *(LAS f32x2_t*)(L_TQ + ((c) & 1) * 512 + q4 * 128 + 2 * dp) = (f32x2_t){r0_, r1_}; } while (0)
            float e0, e1, xa0, xa1, xb0, xb1; unsigned kp0[8], kp1[8], vp0[8], vp1[8];
#define HG_BEGIN(c) do { float off0 = 0.f, off1 = 0.f, cref0 = 0.f, cref1 = 0.f, tot0 = 0.f, tot1 = 0.f; \
                _Pragma("unroll") for (int o = 0; o < 4; ++o) { const f32x2_t tq = *(const LAS f32x2_t*)(L_TQ + ((c) & 1) * 512 + o * 128 + 2 * dp); \
                    if (o < q4) { off0 += tq.x; off1 += tq.y; } if (o < 2) { cref0 += tq.x; cref1 += tq.y; } tot0 += tq.x; tot1 += tq.y; } \
                xa0 = __builtin_amdgcn_exp2f(-cref0); xa1 = __builtin_amdgcn_exp2f(-cref1); xb0 = __builtin_amdgcn_exp2f(cref0); xb1 = __builtin_amdgcn_exp2f(cref1); e0 = __builtin_amdgcn_exp2f(off0); e1 = __builtin_amdgcn_exp2f(off1); \
                if (q4 == 0) { *(LAS f32x2_t*)(L_XS + ((c) & 1) * 256 + 2 * dp) = (f32x2_t){xb0, xb1}; *(LAS f32x2_t*)(L_XS + ((c) & 1) * 256 + 128 + 2 * dp) = (f32x2_t){__builtin_amdgcn_exp2f(tot0 - cref0), __builtin_amdgcn_exp2f(tot1 - cref1)}; } } while (0)
#define HG_TOKENS(set, c, i0) do { LAS unsigned char* T_ = lds + ((c) & 1) * BUFB; _Pragma("unroll") for (int i = (i0); i < (i0) + 8; ++i) { \
                const unsigned gw_ = g2[set][i], qw_ = q2[set][i], vw_ = v2[set][i]; \
                const float f0 = __builtin_amdgcn_exp2f((float)__builtin_bit_cast(_Float16, (unsigned short)(gw_ & 0xffffu))), f1 = __builtin_amdgcn_exp2f((float)__builtin_bit_cast(_Float16, (unsigned short)(gw_ >> 16))); \
                e0 = fmaxf(e0 * f0, 1e-30f); e1 = fmaxf(e1 * f1, 1e-30f); \
                const float r0 = __builtin_amdgcn_rcpf(e0), r1 = __builtin_amdgcn_rcpf(e1); \
                const float qq0 = __builtin_bit_cast(float, qw_ << 16), qq1 = __builtin_bit_cast(float, qw_ & 0xffff0000u); \
                const int t = 16 * q4 + i; \
                *(LAS unsigned*)(T_ + t * RS + 4 * dp) = cvtpk(qq0 * e0 * xa0, qq1 * e1 * xa1); \
                const unsigned ka = cvtpk((1.0f - f0) * r0 * xb0, (1.0f - f1) * r1 * xb1); \
                *(LAS unsigned*)(T_ + O_KA + t * RS + 4 * dp) = ka; \
                if (i & 1) { kp0[i >> 1] |= ka << 16; kp1[i >> 1] |= ka & 0xffff0000u; vp0[i >> 1] |= vw_ << 16; vp1[i >> 1] |= vw_ & 0xffff0000u; } \
                else { kp0[i >> 1] = ka & 0xffffu; kp1[i >> 1] = ka >> 16; vp0[i >> 1] = vw_ & 0xffffu; vp1[i >> 1] = vw_ >> 16; } } } while (0)
#define HG_FINISH(c) do { LAS unsigned char* T_ = lds + ((c) & 1) * BUFB; \
                *(LAS v4u*)(T_ + O_KAT + (2 * dp) * TS + 32 * q4) = (v4u){kp0[0], kp0[1], kp0[2], kp0[3]}; *(LAS v4u*)(T_ + O_KAT + (2 * dp) * TS + 32 * q4 + 16) = (v4u){kp0[4], kp0[5], kp0[6], kp0[7]}; \
                *(LAS v4u*)(T_ + O_KAT + (2 * dp + 1) * TS + 32 * q4) = (v4u){kp1[0], kp1[1], kp1[2], kp1[3]}; *(LAS v4u*)(T_ + O_KAT + (2 * dp + 1) * TS + 32 * q4 + 16) = (v4u){kp1[4], kp1[5], kp1[6], kp1[7]}; \
                *(LAS v4u*)(T_ + O_VT + (2 * dp) * TS + 32 * q4) = (v4u){vp0[0], vp0[1], vp0[2], vp0[3]}; *(LAS v4u*)(T_ + O_VT + (2 * dp) * TS + 32 * q4 + 16) = (v4u){vp0[4], vp0[5], vp0[6], vp0[7]}; \
                *(LAS v4u*)(T_ + O_VT + (2 * dp + 1) * TS + 32 * q4) = (v4u){vp1[0], vp1[1], vp1[2], vp1[3]}; *(LAS v4u*)(T_ + O_VT + (2 * dp + 1) * TS + 32 * q4 + 16) = (v4u){vp1[4], vp1[5], vp1[6], vp1[7]}; } while (0)
            HG_LOAD(0, 0); HG_LOAD(1, 1);
            HG_SUMS(0, 0);
            __syncthreads();
            HG_SUMS(1, 1); HG_BEGIN(0); HG_TOKENS(0, 0, 0); HG_TOKENS(0, 0, 8); HG_FINISH(0); HG_LOAD(0, 2);
#pragma unroll 2
            for (int n = 0; n < NCH; ++n) {
                const int c = n + 1;
                __syncthreads();
                if (c < NCH) { if (c + 1 < NCH) HG_SUMS(n & 1, c + 1); HG_BEGIN(c); HG_TOKENS((n + 1) & 1, c, 0); HG_TOKENS((n + 1) & 1, c, 8); HG_FINISH(c); if (c + 2 < NCH) HG_LOAD((n + 1) & 1, c + 2); }
            }
            __syncthreads();
#undef HG_LOAD
#undef HG_SUMS
#undef HG_BEGIN
#undef HG_TOKENS
#undef HG_FINISH
        }
        __syncthreads();
    }
#undef SB
}

template <bool DIAG> __device__ __forceinline__ bool attn_tile(const bf16x8_t (&Kc)[4], const bf16x8_t (&Vc)[4], const bf16x8_t (&Qf)[4], f32x16& O0, f32x16& O1, float& carry, int r32, int hi) {
    f32x16 Sx;
#pragma unroll
    for (int j = 0; j < 16; ++j) Sx[j] = 0.f;
#pragma unroll
    for (int ks = 0; ks < 4; ++ks) Sx = MFMA32(Kc[ks], Qf[ks], Sx);
    float kp[16], sg[16];
#pragma unroll
    for (int j = 0; j < 16; ++j) {
        const float r = __builtin_amdgcn_rcpf(1.0f + __builtin_amdgcn_exp2f(Sx[j]));
        if (DIAG) { const int sl = 16 * (j >> 3) + 8 * hi + (j & 7); const bool valid = sl < r32; kp[j] = valid ? r : 1.f; sg[j] = valid ? 1.0f - r : 0.f; }
        else { kp[j] = r; sg[j] = 1.0f - r; }
    }
#pragma unroll
    for (int j = 6; j >= 0; --j) { sg[j] *= kp[j + 1]; kp[j] *= kp[j + 1]; sg[8 + j] *= kp[8 + j + 1]; kp[8 + j] *= kp[8 + j + 1]; }
    const float G0 = kp[0], G1 = kp[8];
    const float P0 = __shfl_xor(G0, 32), P1 = __shfl_xor(G1, 32);
    const float after0 = (hi == 0 ? P0 : 1.f) * P1 * G1 * carry, after1 = (hi == 0 ? P1 : 1.f) * carry;
#pragma unroll
    for (int j = 0; j < 16; ++j) sg[j] *= (j < 8 ? after0 : after1);
    carry *= (G0 * G1) * (P0 * P1);
    v4u w0, w1; w0.x = cvtpk(sg[0], sg[1]); w0.y = cvtpk(sg[2], sg[3]); w0.z = cvtpk(sg[4], sg[5]); w0.w = cvtpk(sg[6], sg[7]);
    w1.x = cvtpk(sg[8], sg[9]); w1.y = cvtpk(sg[10], sg[11]); w1.z = cvtpk(sg[12], sg[13]); w1.w = cvtpk(sg[14], sg[15]);
    const bf16x8_t Pb0 = __builtin_bit_cast(bf16x8_t, w0), Pb1 = __builtin_bit_cast(bf16x8_t, w1);
    O0 = MFMA32(Vc[0], Pb0, O0); O0 = MFMA32(Vc[1], Pb1, O0);
    O1 = MFMA32(Vc[2], Pb0, O1); O1 = MFMA32(Vc[3], Pb1, O1);
    return __all(carry < 0x1p-134f);
}
__device__ __forceinline__ void attn_mfma(const Args& a, int u0, int ucnt, int ustride) {
    unsigned char* ws = a.ws;
    bf16* QS = (bf16*)(ws + WS_QS); const bf16* SK = (const bf16*)(ws + WS_SK); const bf16* VT = (const bf16*)((unsigned char*)a.out + 32 * MiB);
    const int lane = threadIdx.x & 63, r32 = lane & 31, hi = lane >> 5;
    const int kap = 16 * (r32 >> 4) + 8 * ((r32 >> 2) & 1) + 4 * ((r32 >> 3) & 1) + (r32 & 3);
    for (int uk = 0; uk < ucnt; ++uk) { const int u = u0 + uk * ustride;
        const int qb = u & 63, bh = u >> 6, h = bh & 15, b = bh >> 4;
        const size_t rowq = (size_t)b * SEQ + 32 * qb + r32;
        bf16* qp = QS + rowq * 2048 + 1024 + 64 * h;
        const bf16* kbase = SK + ((size_t)b * SEQ + kap) * 1024 + 64 * h + 8 * hi;
        const bf16* vbase = VT + ((size_t)bh * 64 + r32) * 2048 + 8 * hi;
        bf16x8_t Qf[4];
#pragma unroll
        for (int ks = 0; ks < 4; ++ks) Qf[ks] = *(const bf16x8_t*)(qp + 16 * ks + 8 * hi);
        f32x16 O0, O1;
#pragma unroll
        for (int j = 0; j < 16; ++j) { O0[j] = 0.f; O1[j] = 0.f; }
        float carry = 1.f;
        bf16x8_t KA[4], VA[4], KB[4], VB[4];
#define ATT_LOAD(K_, V_, kb_) do { _Pragma("unroll") for (int ks = 0; ks < 4; ++ks) K_[ks] = *(const bf16x8_t*)(kbase + (size_t)(32 * (kb_)) * 1024 + 16 * ks); \
        _Pragma("unroll") for (int i = 0; i < 4; ++i) V_[i] = *(const bf16x8_t*)(vbase + (size_t)(32 * (i >> 1)) * 2048 + 32 * (kb_) + 16 * (i & 1)); } while (0)
        ATT_LOAD(KA, VA, qb);
        int kb = qb;
        ATT_LOAD(KB, VB, kb > 0 ? kb - 1 : 0);
        if (!(attn_tile<true>(KA, VA, Qf, O0, O1, carry, r32, hi) || kb == 0)) {
            --kb;
#pragma unroll 1
            for (;;) {
                ATT_LOAD(KA, VA, kb > 0 ? kb - 1 : 0);
                if (attn_tile<false>(KB, VB, Qf, O0, O1, carry, r32, hi) || kb == 0) break;
                --kb;
                ATT_LOAD(KB, VB, kb > 0 ? kb - 1 : 0);
                if (attn_tile<false>(KA, VA, Qf, O0, O1, carry, r32, hi) || kb == 0) break;
                --kb;
            }
        }
#undef ATT_LOAD
#pragma unroll
        for (int a4 = 0; a4 < 4; ++a4) {
            u32x2_t x0, x1; x0.x = cvtpk(O0[4 * a4], O0[4 * a4 + 1]); x0.y = cvtpk(O0[4 * a4 + 2], O0[4 * a4 + 3]); x1.x = cvtpk(O1[4 * a4], O1[4 * a4 + 1]); x1.y = cvtpk(O1[4 * a4 + 2], O1[4 * a4 + 3]);
            *(u32x2_t*)(qp + 8 * a4 + 4 * hi) = x0; *(u32x2_t*)(qp + 32 + 8 * a4 + 4 * hi) = x1; }
    }
}

#define XB_TMO      128
#define XB_XCNT(j)  (256  + 64 * (j))
#define XB_XSUB(j)  (1280 + 64 * (j))
#define XB_XGEN(j)  (2304 + 64 * (j))
#define XB_TOP      3328
#define XB_TOPGEN   3392
#define XCD_BAR_WORDS 3456
#define XB_SPIN_CAP (1u << 18)

__device__ __forceinline__ unsigned xb_ld(unsigned* p)              { return __hip_atomic_load(p, __ATOMIC_RELAXED, __HIP_MEMORY_SCOPE_AGENT); }
__device__ __forceinline__ unsigned xb_add(unsigned* p, unsigned v) { return __hip_atomic_fetch_add(p, v, __ATOMIC_RELAXED, __HIP_MEMORY_SCOPE_AGENT); }
__device__ __forceinline__ unsigned xb_xcc_id() { return (unsigned)__builtin_amdgcn_s_getreg((3 << 11) | 20) & 0xFu; }
#define XB_SPIN(cond, bar) do { unsigned _sp = 0; while (cond) { __builtin_amdgcn_s_sleep(1); \
    if ((++_sp & 255u) == 0u) { if (xb_ld(&(bar)[XB_TMO])) break; if (_sp > XB_SPIN_CAP) { atomicAdd(&(bar)[XB_TMO], 1u); break; } } } } while (0)

struct XcdBarrier {
    unsigned* bar; unsigned x;
    volatile LAS unsigned* st;
};

__device__ __forceinline__ XcdBarrier xcd_barrier_post(unsigned* bar, volatile LAS unsigned* st) {
    XcdBarrier b; b.bar = bar; b.x = xb_xcc_id(); b.st = st;
    if (threadIdx.x == 0) (void)xb_add(&bar[XB_XCNT(b.x)], 1u);
    return b;
}
__device__ __forceinline__ void xcd_barrier_complete(unsigned* bar, unsigned x, unsigned& nloc, unsigned& nx) {
    const unsigned G = gridDim.x * gridDim.y * gridDim.z;
    unsigned sum, cnt, mine, sp = 0u;
    for (;;) {
        sum = 0u; cnt = 0u; mine = 0u;
#pragma unroll
        for (unsigned j = 0; j < 16; ++j) { const unsigned c = xb_ld(&bar[XB_XCNT(j)]); sum += c; cnt += (c > 0u) ? 1u : 0u; mine = (j == x) ? c : mine; }
        if (sum == G) break;
        __builtin_amdgcn_s_sleep(1);
        if ((++sp & 255u) == 0u) { if (xb_ld(&bar[XB_TMO])) break; if (sp > XB_SPIN_CAP) { atomicAdd(&bar[XB_TMO], 1u); break; } }
    }
    nloc = mine > 0u ? mine : 1u; nx = cnt > 0u ? cnt : 1u;
}

__device__ __forceinline__ void xcd_barrier(const XcdBarrier& b) {
    asm volatile("s_waitcnt vmcnt(0)" ::: "memory");
    __syncthreads();
    if (threadIdx.x == 0) {
        unsigned* bar = b.bar;
        __builtin_amdgcn_s_waitcnt(0);
        unsigned nloc = b.st[0], nx = b.st[1];
        if (nloc == 0u) { xcd_barrier_complete(bar, b.x, nloc, nx); b.st[0] = nloc; b.st[1] = nx; }
        const unsigned old = xb_add(&bar[XB_XSUB(b.x)], 1u);
        const unsigned gen = old / nloc;
        if (old + 1u == (gen + 1u) * nloc) {
            __builtin_amdgcn_fence(__ATOMIC_RELEASE, "agent");
            asm volatile("s_waitcnt vmcnt(0)" ::: "memory");
            const unsigned og = xb_add(&bar[XB_TOP], 1u);
            const unsigned tg = og / nx;
            if (og + 1u == (tg + 1u) * nx) xb_add(&bar[XB_TOPGEN], 1u);
            else XB_SPIN(xb_ld(&bar[XB_TOPGEN]) == tg, bar);
            __builtin_amdgcn_fence(__ATOMIC_ACQUIRE, "agent");
            xb_add(&bar[XB_XGEN(b.x)], 1u);
            asm volatile("s_waitcnt vmcnt(0)" ::: "memory");
        } else {
            XB_SPIN(xb_ld(&bar[XB_XGEN(b.x)]) == gen, bar);
            __builtin_amdgcn_fence(__ATOMIC_ACQUIRE, "agent");
            asm volatile("s_waitcnt vmcnt(0)" ::: "memory");
        }
    }
    __syncthreads();
}

__global__ void __launch_bounds__(NTHREADS, 2) hybrid_fwd(Args args) {
    extern __shared__ __attribute__((aligned(16))) unsigned char lds_raw[];
    LAS unsigned char* lds = (LAS unsigned char*)lds_raw;
    cg::grid_group grid = cg::this_grid();
    const int tid = threadIdx.x, lane = tid & 63, wave = __builtin_amdgcn_readfirstlane(tid >> 6);
    const int G = gridDim.x;
    unsigned char* ws = args.ws;
    const int lo = args.ph_lo, hi = args.ph_hi;
    volatile LAS unsigned* MISC = (volatile LAS unsigned*)(lds + MISC_OFF);
    if (tid < 2) MISC[tid] = 0u;
    __syncthreads();
    const XcdBarrier bar = xcd_barrier_post((unsigned*)ws, MISC);
#define IN(k) (lo <= (k) && (k) < hi)
#define SEAM(k) do { if (IN(k) && IN((k) + 1)) { xcd_barrier(bar); } } while (0)
    if (lo < 0) grid.sync();
    if (IN(0)) { p0_prologue<0>(args, lds, wave, lane, (int)blockIdx.x * NWAVES + wave, G * NWAVES); asm volatile("s_waitcnt vmcnt(0) lgkmcnt(0)" ::: "memory"); __syncthreads(); }
    SEAM(0);
    if (IN(1)) {
        pg8::Gemm g{(const pg8::bf16_t*)(ws + WS_H), (const pg8::bf16_t*)(ws + WS_WIN), M, 6144, D, D}; pg8::StaticOrder S; S.init(M, 6144, G, (int)blockIdx.x);
        pg8::EpiProj E{(pg8::bf16_t*)(ws + WS_QS), (pg8::bf16_t*)(ws + WS_VH), (pg8::bf16_t*)(ws + WS_SK), (pg8::bf16_t*)((unsigned char*)args.out + 32 * MiB), ws + WS_GH, ws + WS_GA, ws + WS_GB, (_Float16*)args.out,
                       args.in[3], args.in[5], args.in[6], 0};
        pg8::gemm_phase<pg8::EpiProj, pg8::StaticOrder, true, true>(lds, g, S, E);
        pg8::Gemm g2{(const pg8::bf16_t*)(ws + WS_WIN) + (size_t)6144 * 1024, (const pg8::bf16_t*)(ws + WS_H), 1024, M, D, D}; pg8::StaticOrder S2; S2.init(1024, M, G, (int)blockIdx.x);
        pg8::EpiVT E2{(pg8::bf16_t*)((unsigned char*)args.out + 32 * MiB)};
        pg8::gemm_phase<pg8::EpiVT, pg8::StaticOrder, true, true>(lds, g2, S2, E2);
    }
    SEAM(1);
    if (IN(2)) {
        const pg8::Gemm gg{(const pg8::bf16_t*)(ws + WS_H), (const pg8::bf16_t*)(ws + WS_WIN) + (size_t)7168 * 1024, M, 2048, D, D};
        const pg8::EpiProj EG{(pg8::bf16_t*)(ws + WS_QS), (pg8::bf16_t*)(ws + WS_VH), (pg8::bf16_t*)(ws + WS_SK), (pg8::bf16_t*)((unsigned char*)args.out + 32 * MiB), ws + WS_GH, ws + WS_GA, ws + WS_GB, (_Float16*)args.out,
                              args.in[3], args.in[5], args.in[6], 28};
        constexpr int NUNITS = BATCH * 16 * (SEQ / 32);
        if (G == 256) {
            pg8::ListOrder S; S.s.init(M, 2048, 256, 0);
            if ((int)blockIdx.x < 64) { hgrn_v2(args, lds, (int)blockIdx.x, 64); p0_prologue<1>(args, lds, wave, lane, 2048 + 512 + (int)blockIdx.x * NWAVES + wave, 1024); S.l0 = -1; S.l1 = -1; S.l2 = -1; }
            else { const int idx = (int)blockIdx.x - 64;
                if (idx < 128) attn_mfma(args, idx * 40 + wave, 5, NWAVES); else attn_mfma(args, 5120 + (idx - 128) * 48 + wave, 6, NWAVES);
                if (idx < 128) p0_prologue<1>(args, lds, wave, lane, idx * NWAVES + wave, 1024, 2048);
                else p0_prologue<1>(args, lds, wave, lane, 2048 + (idx - 128) * NWAVES + wave, 1024);
                S.l0 = idx; S.l1 = 192 + idx; S.l2 = idx < 128 ? 384 + idx : -1; }
            asm volatile("s_waitcnt vmcnt(0) lgkmcnt(0)" ::: "memory"); __syncthreads();
            pg8::gemm_phase<pg8::EpiProj, pg8::ListOrder, true, true>(lds, gg, S, EG);
        } else {
            const int gw = (int)blockIdx.x * NWAVES + wave, ngw = G * NWAVES;
            hgrn_v2(args, lds, (int)blockIdx.x, G); attn_mfma(args, gw, (NUNITS - gw + ngw - 1) / ngw, ngw); p0_prologue<1>(args, lds, wave, lane, gw, ngw);
            asm volatile("s_waitcnt vmcnt(0) lgkmcnt(0)" ::: "memory"); __syncthreads();
            pg8::StaticOrder S; S.init(M, 2048, G, (int)blockIdx.x);
            pg8::gemm_phase<pg8::EpiProj, pg8::StaticOrder, true, true>(lds, gg, S, EG);
        }
        __syncthreads();
    }
    SEAM(2);
    if (IN(3)) {
        pg8::Gemm g{(const pg8::bf16_t*)(ws + WS_QS), (const pg8::bf16_t*)(ws + WS_WHS), M, D, 1024, 2048}; pg8::SplitOrder S; S.s.init(M, D, G, (int)blockIdx.x);
        pg8::EpiMix E{ws + WS_GA, ws + WS_GB, (pg8::bf16_t*)(ws + WS_MIXED)};
        pg8::gemm_phase<pg8::EpiMix, pg8::SplitOrder, true, true>(lds, g, S, E);
    }
    SEAM(3);
    if (IN(4)) {
        pg8::Gemm g{(const pg8::bf16_t*)(ws + WS_MIXED), (const pg8::bf16_t*)(ws + WS_WO), M, D, D, D}; pg8::StaticOrder S; S.init(M, D, G, (int)blockIdx.x);
        pg8::EpiRes1 E{args.in[0], (pg8::bf16_t*)(ws + WS_GA), (pg8::bf16_t*)(ws + WS_X1B), (float*)(ws + WS_SSQ)};
        pg8::gemm_phase<pg8::EpiRes1, pg8::StaticOrder, true, true>(lds, g, S, E);
    }
    SEAM(4);
    if (IN(5)) {
        pg8::Gemm g{(const pg8::bf16_t*)(ws + WS_X1B), (const pg8::bf16_t*)(ws + WS_WF1), M, 2 * FFH, D, D}; pg8::StaticOrder S; S.init(M, 2 * FFH, G, (int)blockIdx.x);
        pg8::EpiSwiglu E{(const float*)(ws + WS_SSQ), (pg8::bf16_t*)(ws + WS_ACT)};
        pg8::gemm_phase<pg8::EpiSwiglu, pg8::StaticOrder, true, true>(lds, g, S, E);
    }
    SEAM(5);
    if (IN(6)) {
        pg8::Gemm g{(const pg8::bf16_t*)(ws + WS_ACT), (const pg8::bf16_t*)(ws + WS_WF2), M, D, FFH, FFH}; pg8::StaticOrder S; S.init(M, D, G, (int)blockIdx.x);
        pg8::EpiRes2 E{args.in[0], (const pg8::bf16_t*)(ws + WS_GA), args.out};
        pg8::gemm_phase<pg8::EpiRes2, pg8::StaticOrder, true, true>(lds, g, S, E);
    }
#undef IN
#undef SEAM
}

#ifndef MK_N_LAUNCHES
#define MK_N_LAUNCHES 1
#endif
extern "C" void kernel_launch(void* const* d_in, const int* in_sizes, int n_in, void* d_out, int out_size, void* d_ws, size_t ws_size, hipStream_t stream) {
    static int grid = 0;
    if (grid == 0) {
        int dev = 0, cus = 0, per_cu = 0;
        if (n_in != 13 || ws_size < WS_END) { fprintf(stderr, "kernel_launch: unexpected inputs / workspace (%d, %zu)\n", n_in, ws_size); grid = -1; return; }
        hipGetDevice(&dev); hipDeviceGetAttribute(&cus, hipDeviceAttributeMultiprocessorCount, dev);
        if (hipFuncSetAttribute((const void*)hybrid_fwd, hipFuncAttributeMaxDynamicSharedMemorySize, LDS_BYTES) != hipSuccess) { fprintf(stderr, "kernel_launch: hipFuncSetAttribute failed\n"); grid = -1; return; }
        if (hipOccupancyMaxActiveBlocksPerMultiprocessor(&per_cu, (const void*)hybrid_fwd, NTHREADS, LDS_BYTES) != hipSuccess || per_cu < 1) { fprintf(stderr, "kernel_launch: occupancy query says %d\n", per_cu); per_cu = 1; }
        (void)hipGetLastError();
        grid = cus * per_cu;
    }
    if (grid < 0) return;
    if (hipMemsetAsync(d_ws, 0, 16384, stream) != hipSuccess) { fprintf(stderr, "kernel_launch: memset of the barrier words failed\n"); return; }
    Args a{};
    for (int i = 0; i < 13; ++i) a.in[i] = (const float*)d_in[i];
    a.out = (float*)d_out; a.ws = (unsigned char*)d_ws;
#if MK_N_LAUNCHES == 1
    a.ph_lo = 0; a.ph_hi = 7;
    void* kargs[] = {&a};
    hipError_t e = hipLaunchCooperativeKernel((const void*)hybrid_fwd, dim3(grid), dim3(NTHREADS), kargs, LDS_BYTES, stream);
    if (e != hipSuccess) fprintf(stderr, "cooperative launch failed: %s (grid %d)\n", hipGetErrorString(e), grid);
#else
    for (int p = 0; p < 7; ++p) { a.ph_lo = p; a.ph_hi = p + 1; hipLaunchKernelGGL(hybrid_fwd, dim3(grid), dim3(NTHREADS), LDS_BYTES, stream, a); }
#endif
}
```

```cpp
#include <hip/hip_runtime.h>
#include <hip/hip_cooperative_groups.h>
#include <cstdio>
#include <cstdint>
namespace cg = cooperative_groups;
namespace pg8 {
#define PG8_LAS __attribute__((address_space(3)))
typedef unsigned short bf16_t;
typedef short bf16x8 __attribute__((ext_vector_type(8)));
typedef float f32x4 __attribute__((ext_vector_type(4)));
typedef unsigned u32x4 __attribute__((ext_vector_type(4)));
constexpr int BM = 256, BK = 64, HALF = 128, HTB = HALF * BK * 2  , STAGE_BYTES = 8 * HTB, NXCD = 8, WGM = 8;

__host__ __device__ __forceinline__ int lds_byte(int r, int c) { const int st = (r >> 4) * 2 + (c >> 5), rr = r & 15, cc = c & 31, ob = rr * 64 + cc * 2; return st * 1024 + (ob ^ (((ob >> 9) & 1) << 5)); }
__host__ __device__ __forceinline__ void stage_rc(int b, int& R, int& C) { const int st = b / 1024, sb = b % 1024, swz = sb ^ (((sb >> 9) & 1) << 5); R = (st >> 1) * 16 + swz / 64; C = (st & 1) * 32 + (swz % 64) / 2; }
__host__ __device__ __forceinline__ int perm32(int rho) { const int n = rho >> 4, i = rho & 15; return 8 * (i >> 2) + 4 * n + (i & 3); }

struct Unit { int pm, pn, kh; };
struct Gemm { const bf16_t* A; const bf16_t* Bt; int M, N, K, ld; };

struct StaticOrder {
    int nM, nN, nwg, G, c;
    __host__ __device__ void init(int M, int N, int G_, int c_) { nM = M / BM; nN = N / BM; nwg = nM * nN; G = G_; c = c_; }
    __host__ __device__ bool next(int i, Unit& u) const { const long L = (long)i * G + c; if (L >= nwg) return false; return unit_of((int)L, u); }
    __host__ __device__ bool unit_of(int L, Unit& u) const {
        int wgid = L; { const int q = nwg / NXCD, r = nwg % NXCD, xcd = wgid % NXCD, off = wgid / NXCD; wgid = (xcd < r ? xcd * (q + 1) : r * (q + 1) + (xcd - r) * q) + off; }
        const int nig = WGM * nN, gid = wgid / nig, fm = gid * WGM, gsz = (nM - fm) < WGM ? (nM - fm) : WGM;
        u.pm = fm + ((wgid % nig) % gsz); u.pn = (wgid % nig) / gsz; u.kh = 0; return true;
    }
    __device__ __forceinline__ void a_ready(const Unit&) const {}
    __device__ __forceinline__ void done(const Unit&) const {}
};
struct ListOrder {
    StaticOrder s; int l0, l1, l2;
    __host__ __device__ bool next(int i, Unit& u) const { const int L = i == 0 ? l0 : (i == 1 ? l1 : (i == 2 ? l2 : -1)); if (L < 0 || L >= s.nwg) return false; return s.unit_of(L, u); }
    __device__ __forceinline__ void a_ready(const Unit&) const {}
    __device__ __forceinline__ void done(const Unit&) const {}
};
struct SplitOrder {
    StaticOrder s;
    __host__ __device__ bool next(int i, Unit& u) const { const bool ok = s.next(i >> 1, u); u.kh = i & 1; return ok; }
    __device__ __forceinline__ void a_ready(const Unit&) const {}
    __device__ __forceinline__ void done(const Unit&) const {}
};
typedef float f32x2_cv __attribute__((ext_vector_type(2))); typedef __bf16 bf16x2_cvv __attribute__((ext_vector_type(2)));
__device__ __forceinline__ unsigned cvt_pk_bf16(float lo, float hi) { const f32x2_cv v = {lo, hi}; return __builtin_bit_cast(unsigned, __builtin_convertvector(v, bf16x2_cvv)); }
typedef float f32x2 __attribute__((ext_vector_type(2)));
typedef _Float16 f16x8 __attribute__((ext_vector_type(8)));
typedef unsigned u32x2 __attribute__((ext_vector_type(2)));
__device__ __forceinline__ float sigm(float x) { return __builtin_amdgcn_rcpf(1.0f + __expf(-x)); }
__device__ __forceinline__ unsigned q8(float s) { float q = s * 255.0f + 0.5f; q = q < 1.0f ? 1.0f : (q > 255.0f ? 255.0f : q); return (unsigned)q; }
__device__ __forceinline__ u32x4 pack8_bf16(const float (&o)[8]) { u32x4 w; w.x = cvt_pk_bf16(o[0], o[1]); w.y = cvt_pk_bf16(o[2], o[3]); w.z = cvt_pk_bf16(o[4], o[5]); w.w = cvt_pk_bf16(o[6], o[7]); return w; }
__device__ __forceinline__ u32x2 pack8_u8(const float (&o)[8]) { u32x2 w; unsigned a = 0u, c = 0u;
#pragma unroll
    for (int k = 0; k < 4; ++k) { a = __builtin_amdgcn_cvt_pk_u8_f32(fmaxf(o[k] * 255.0f, 1.0f), k, a); c = __builtin_amdgcn_cvt_pk_u8_f32(fmaxf(o[4 + k] * 255.0f, 1.0f), k, c); }
    w.x = a; w.y = c; return w; }

struct EpiProj {
    static constexpr bool PERM = true, AFTER_DRAIN = false, KSPLIT = false;
    bf16_t* QS; bf16_t* VH; bf16_t* SK; bf16_t* SV; unsigned char* GH; unsigned char* GA; unsigned char* GB; _Float16* LOGF;
    const float* lbl; const float* qg; const float* kg; int pn0;
    __device__ __forceinline__ void operator()(const f32x4 (&acc)[2][2][4][2], const Unit& u, int wr, int wc, int fr, int fq) const {
        const int sec = (u.pn + pn0) >> 2, ct = (u.pn & 3) * 256;
        const int row0 = u.pm * BM + wr * 64 + fr;
        if (sec == 4 || sec == 5) {
            const int head = (u.pn & 3) * 4 + wc; const float* gp = (sec == 4 ? qg : kg) + head * 64 + 8 * fq;
            float gn[2][8];
#pragma unroll
            for (int bj = 0; bj < 2; ++bj) { const f32x4 a = *(const f32x4*)(gp + 32 * bj), b = *(const f32x4*)(gp + 32 * bj + 4);
                gn[bj][0] = a[0]; gn[bj][1] = a[1]; gn[bj][2] = a[2]; gn[bj][3] = a[3]; gn[bj][4] = b[0]; gn[bj][5] = b[1]; gn[bj][6] = b[2]; gn[bj][7] = b[3]; }
            const float sc = (sec == 4) ? 0.125f * 1.4426950408889634f : 1.0f;
#pragma unroll
            for (int ai = 0; ai < 2; ++ai)
#pragma unroll
                for (int m = 0; m < 4; ++m) {
                    float ss = 0.f;
#pragma unroll
                    for (int bj = 0; bj < 2; ++bj)
#pragma unroll
                        for (int n = 0; n < 2; ++n) { const f32x4 x = acc[ai][bj][m][n]; ss += (x[0] * x[0] + x[1] * x[1]) + (x[2] * x[2] + x[3] * x[3]); }
                    ss += __shfl_xor(ss, 16); ss += __shfl_xor(ss, 32);
                    const float rstd = __builtin_amdgcn_rsqf(ss * (1.0f / 64.0f) + 1e-6f) * sc;
                    const size_t row = (size_t)(row0 + ai * HALF + m * 16);
#pragma unroll
                    for (int bj = 0; bj < 2; ++bj) { float o[8];
#pragma unroll
                        for (int k = 0; k < 8; ++k) o[k] = acc[ai][bj][m][k >> 2][k & 3] * rstd * gn[bj][k];
                        bf16_t* dst = (sec == 4) ? (QS + row * 2048 + 1024 + head * 64 + 32 * bj + 8 * fq) : (SK + row * 1024 + head * 64 + 32 * bj + 8 * fq);
                        *(u32x4*)dst = pack8_bf16(o); }
                }
            return;
        }
        switch (sec) {
            case 0: store_kind<0>(acc, row0, ct, wc, fq, nullptr); break;
            case 1: store_kind<1>(acc, row0, ct, wc, fq, nullptr); break;
            case 2: store_kind<2>(acc, row0, ct, wc, fq, nullptr); break;
            case 3: store_kind<3>(acc, row0, ct, wc, fq, GH); break;
            case 6: store_kind<6>(acc, row0, ct, wc, fq, nullptr); break;
            case 7: store_kind<3>(acc, row0, ct, wc, fq, GA); break;
            default: store_kind<3>(acc, row0, ct, wc, fq, GB); break;
        }
    }
    template <int KIND> __device__ __forceinline__ void store_kind(const f32x4 (&acc)[2][2][4][2], int row0, int ct, int wc, int fq, unsigned char* g8) const {
#pragma unroll
        for (int bj = 0; bj < 2; ++bj) {
            const int col = ct + bj * HALF + wc * 32 + 8 * fq;
            float lb[8];
            if (KIND == 1) {
#pragma unroll
                for (int k = 0; k < 8; ++k) lb[k] = __builtin_amdgcn_rcpf(1.0f + __expf(lbl[1024 + col + k] - lbl[col + k]));
            }
#pragma unroll
            for (int ai = 0; ai < 2; ++ai)
#pragma unroll
                for (int m = 0; m < 4; ++m) {
                    const size_t row = (size_t)(row0 + ai * HALF + m * 16);
                    float o[8];
#pragma unroll
                    for (int k = 0; k < 8; ++k) o[k] = acc[ai][bj][m][k >> 2][k & 3];
                    if (KIND == 0) { *(u32x4*)(QS + row * 2048 + col) = pack8_bf16(o); }
                    else if (KIND == 2) { *(u32x4*)(VH + row * 1024 + col) = pack8_bf16(o); }
                    else if (KIND == 6) { bf16_t* vt = SV + ((size_t)((row >> 11) * 16 + (col >> 6)) * 64 + (col & 63)) * 2048 + (row & 2047);
#pragma unroll
                        for (int k = 0; k < 8; ++k) vt[(size_t)k * 2048] = (bf16_t)(cvt_pk_bf16(o[k], o[k]) & 0xffffu); }
                    else if (KIND == 1) { f16x8 g;
#pragma unroll
                        for (int k = 0; k < 8; ++k) g[k] = (_Float16)__builtin_amdgcn_logf(lb[k] + (1.0f - lb[k]) * sigm(o[k]));
                        *(f16x8*)(LOGF + row * 1024 + col) = g; }
                    else {
#pragma unroll
                        for (int k = 0; k < 8; ++k) o[k] = __builtin_amdgcn_rcpf(1.0f + __builtin_amdgcn_exp2f(o[k]));
                        *(u32x2*)(g8 + row * 1024 + col) = pack8_u8(o); }
                }
        }
    }
};

struct EpiVT {
    static constexpr bool PERM = true, AFTER_DRAIN = false, KSPLIT = false;
    bf16_t* VT;
    __device__ __forceinline__ void operator()(const f32x4 (&acc)[2][2][4][2], const Unit& u, int wr, int wc, int fr, int fq) const {
        const int row0 = u.pm * BM + wr * 64 + fr;
#pragma unroll
        for (int ai = 0; ai < 2; ++ai)
#pragma unroll
            for (int m = 0; m < 4; ++m)
#pragma unroll
                for (int bj = 0; bj < 2; ++bj) {
                    const int r = row0 + ai * HALF + m * 16, c = u.pn * BM + bj * HALF + wc * 32 + 8 * fq;
                    float o[8];
#pragma unroll
                    for (int k = 0; k < 8; ++k) o[k] = acc[ai][bj][m][k >> 2][k & 3];
                    *(u32x4*)(VT + ((size_t)((c >> 11) * 16 + (r >> 6)) * 64 + (r & 63)) * 2048 + (c & 2047)) = pack8_bf16(o);
                }
    }
};
struct EpiMix {
    static constexpr bool PERM = true, AFTER_DRAIN = false, KSPLIT = true;
    const unsigned char* GA; const unsigned char* GB; bf16_t* MIXED;
    __device__ __forceinline__ void half0(f32x4 (&acc)[2][2][4][2], const Unit& u, int wr, int wc, int fr, int fq) const {
        const int row0 = u.pm * BM + wr * 64 + fr;
#pragma unroll
        for (int ai = 0; ai < 2; ++ai)
#pragma unroll
            for (int m = 0; m < 4; ++m)
#pragma unroll
                for (int bj = 0; bj < 2; ++bj) {
                    const size_t off = (size_t)(row0 + ai * HALF + m * 16) * 1024 + u.pn * BM + bj * HALF + wc * 32 + 8 * fq;
                    const u32x2 a = *(const u32x2*)(GA + off), b = *(const u32x2*)(GB + off);
#pragma unroll
                    for (int k = 0; k < 8; ++k) { const float qa = (float)((a[k >> 2] >> (8 * (k & 3))) & 255u), qb = (float)((b[k >> 2] >> (8 * (k & 3))) & 255u);
                        acc[ai][bj][m][k >> 2][k & 3] *= qa * __builtin_amdgcn_rcpf(qb); }
                    if (bj == 1 && (m & 1)) asm volatile("" ::: "memory");
                }
    }
    __device__ __forceinline__ void operator()(f32x4 (&acc)[2][2][4][2], const Unit& u, int wr, int wc, int fr, int fq) const {
        if (u.kh == 0) { half0(acc, u, wr, wc, fr, fq); return; }
        const int row0 = u.pm * BM + wr * 64 + fr;
        u32x2 gbv[2][4][2];
#pragma unroll
        for (int ai = 0; ai < 2; ++ai)
#pragma unroll
            for (int m = 0; m < 4; ++m)
#pragma unroll
                for (int bj = 0; bj < 2; ++bj) gbv[ai][m][bj] = *(const u32x2*)(GB + (size_t)(row0 + ai * HALF + m * 16) * 1024 + u.pn * BM + bj * HALF + wc * 32 + 8 * fq);
#pragma unroll
        for (int ai = 0; ai < 2; ++ai)
#pragma unroll
            for (int m = 0; m < 4; ++m)
#pragma unroll
                for (int bj = 0; bj < 2; ++bj) {
                    const size_t off = (size_t)(row0 + ai * HALF + m * 16) * 1024 + u.pn * BM + bj * HALF + wc * 32 + 8 * fq;
                    const u32x2 b = gbv[ai][m][bj]; float o[8];
#pragma unroll
                    for (int k = 0; k < 8; ++k) { const float qb = (float)((b[k >> 2] >> (8 * (k & 3))) & 255u); o[k] = acc[ai][bj][m][k >> 2][k & 3] * (qb * (1.0f / 255.0f)); }
                    *(u32x4*)(MIXED + off) = pack8_bf16(o);
                }
    }
};
struct EpiRes1 {
    static constexpr bool PERM = true, AFTER_DRAIN = false, KSPLIT = false;
    const float* x; bf16_t* DL; bf16_t* X1B; float* SSQ;
    __device__ __forceinline__ void operator()(const f32x4 (&acc)[2][2][4][2], const Unit& u, int wr, int wc, int fr, int fq) const {
        const int row0 = u.pm * BM + wr * 64 + fr;
#pragma unroll
        for (int ai = 0; ai < 2; ++ai)
#pragma unroll
            for (int mp = 0; mp < 2; ++mp) {
                f32x4 xv[2][2][2];
#pragma unroll
                for (int mm = 0; mm < 2; ++mm)
#pragma unroll
                    for (int bj = 0; bj < 2; ++bj) { const size_t off = (size_t)(row0 + ai * HALF + (2 * mp + mm) * 16) * 1024 + u.pn * BM + bj * HALF + wc * 32 + 8 * fq;
                        xv[mm][bj][0] = *(const f32x4*)(x + off); xv[mm][bj][1] = *(const f32x4*)(x + off + 4); }
#pragma unroll
                for (int mm = 0; mm < 2; ++mm) {
                    const int m = 2 * mp + mm; const int row = row0 + ai * HALF + m * 16; float ss = 0.f;
#pragma unroll
                    for (int bj = 0; bj < 2; ++bj) {
                        const size_t off = (size_t)row * 1024 + u.pn * BM + bj * HALF + wc * 32 + 8 * fq;
                        const f32x4 a0 = acc[ai][bj][m][0], a1 = acc[ai][bj][m][1];
                        const f32x4 v0 = xv[mm][bj][0] + a0, v1 = xv[mm][bj][1] + a1;
                        u32x4 dw; dw.x = cvt_pk_bf16(a0[0], a0[1]); dw.y = cvt_pk_bf16(a0[2], a0[3]); dw.z = cvt_pk_bf16(a1[0], a1[1]); dw.w = cvt_pk_bf16(a1[2], a1[3]); *(u32x4*)(DL + off) = dw;
                        u32x4 w; w.x = cvt_pk_bf16(v0[0], v0[1]); w.y = cvt_pk_bf16(v0[2], v0[3]); w.z = cvt_pk_bf16(v1[0], v1[1]); w.w = cvt_pk_bf16(v1[2], v1[3]);
                        *(u32x4*)(X1B + off) = w;
                        ss += (v0[0] * v0[0] + v0[1] * v0[1]) + (v0[2] * v0[2] + v0[3] * v0[3]) + (v1[0] * v1[0] + v1[1] * v1[1]) + (v1[2] * v1[2] + v1[3] * v1[3]);
                    }
                    ss += __shfl_xor(ss, 16); ss += __shfl_xor(ss, 32);
                    if (fq == 0) SSQ[(size_t)row * 16 + u.pn * 4 + wc] = ss;
                }
            }
    }
};
struct EpiSwiglu {
    static constexpr bool PERM = true, AFTER_DRAIN = false, KSPLIT = false;
    const float* SSQ; bf16_t* ACT;
    __device__ __forceinline__ void operator()(const f32x4 (&acc)[2][2][4][2], const Unit& u, int wr, int wc, int fr, int fq) const {
        const int row0 = u.pm * BM + wr * 64 + fr;
        f32x4 sq[2][4];
#pragma unroll
        for (int ai = 0; ai < 2; ++ai)
#pragma unroll
            for (int m = 0; m < 4; ++m) sq[ai][m] = *(const f32x4*)(SSQ + (size_t)(row0 + ai * HALF + m * 16) * 16 + 4 * fq);
#pragma unroll
        for (int ai = 0; ai < 2; ++ai)
#pragma unroll
            for (int m = 0; m < 4; ++m) {
                const int row = row0 + ai * HALF + m * 16;
                float ss = (sq[ai][m][0] + sq[ai][m][1]) + (sq[ai][m][2] + sq[ai][m][3]);
                ss += __shfl_xor(ss, 16); ss += __shfl_xor(ss, 32);
                const float rstd = __builtin_amdgcn_rsqf(ss * (1.0f / 1024.0f) + 1e-6f);
                float o[8];
#pragma unroll
                for (int k = 0; k < 8; ++k) { const float g = acc[ai][0][m][k >> 2][k & 3] * rstd, up = acc[ai][1][m][k >> 2][k & 3] * rstd; o[k] = g * sigm(g) * up; }
                *(u32x4*)(ACT + (size_t)row * 2816 + u.pn * 128 + wc * 32 + 8 * fq) = pack8_bf16(o);
            }
    }
};
struct EpiRes2 {
    static constexpr bool PERM = true, AFTER_DRAIN = false, KSPLIT = false;
    const float* x; const bf16_t* DL; float* out;
    __device__ __forceinline__ void operator()(const f32x4 (&acc)[2][2][4][2], const Unit& u, int wr, int wc, int fr, int fq) const {
        const int row0 = u.pm * BM + wr * 64 + fr;
#pragma unroll
        for (int ai = 0; ai < 2; ++ai)
#pragma unroll
            for (int mp = 0; mp < 2; ++mp) {
                f32x4 xv[2][2][2]; u32x4 dv[2][2];
#pragma unroll
                for (int mm = 0; mm < 2; ++mm)
#pragma unroll
                    for (int bj = 0; bj < 2; ++bj) { const size_t off = (size_t)(row0 + ai * HALF + (2 * mp + mm) * 16) * 1024 + u.pn * BM + bj * HALF + wc * 32 + 8 * fq;
                        xv[mm][bj][0] = *(const f32x4*)(x + off); xv[mm][bj][1] = *(const f32x4*)(x + off + 4); dv[mm][bj] = *(const u32x4*)(DL + off); }
#pragma unroll
                for (int mm = 0; mm < 2; ++mm)
#pragma unroll
                    for (int bj = 0; bj < 2; ++bj) { const int m = 2 * mp + mm;
                        const size_t off = (size_t)(row0 + ai * HALF + m * 16) * 1024 + u.pn * BM + bj * HALF + wc * 32 + 8 * fq;
                        const u32x4 dw = dv[mm][bj];
                        f32x4 d0, d1; d0[0] = __builtin_bit_cast(float, dw.x << 16); d0[1] = __builtin_bit_cast(float, dw.x & 0xffff0000u); d0[2] = __builtin_bit_cast(float, dw.y << 16); d0[3] = __builtin_bit_cast(float, dw.y & 0xffff0000u);
                        d1[0] = __builtin_bit_cast(float, dw.z << 16); d1[1] = __builtin_bit_cast(float, dw.z & 0xffff0000u); d1[2] = __builtin_bit_cast(float, dw.w << 16); d1[3] = __builtin_bit_cast(float, dw.w & 0xffff0000u);
                        const f32x4 v0 = (xv[mm][bj][0] + d0) + acc[ai][bj][m][0], v1 = (xv[mm][bj][1] + d1) + acc[ai][bj][m][1];
                        *(f32x4*)(out + off) = v0; *(f32x4*)(out + off + 4) = v1; }
            }
    }
};

template <class Epi, class Sched, bool ALIGN_EPI = false, bool SP2 = false>
__device__ __forceinline__ void gemm_phase(PG8_LAS unsigned char* lds, const Gemm g, const Sched& S, const Epi& E) {
    int tid_ = threadIdx.x; asm volatile("" : "+v"(tid_));
    const int tid = tid_, wid = __builtin_amdgcn_readfirstlane(tid >> 6), lane = tid & 63, wr = wid >> 2, wc = wid & 3, fr = lane & 15, fq = lane >> 4;
    const int K = g.K, nt = K / BK;
    unsigned voffA[2], voffB[2];
#pragma unroll
    for (int i = 0; i < 2; ++i) { int R, C; stage_rc(tid * 16 + i * 8192, R, C); const int Rb = Epi::PERM ? ((R & ~31) + perm32(R & 31)) : R;
        voffA[i] = (unsigned)(R * g.ld + C) * 2u; voffB[i] = (unsigned)(Rb * g.ld + C) * 2u; }
    const size_t kstep = (size_t)(BK * 2);
    const size_t hstep = (size_t)HALF * g.ld * 2; const size_t khb = (size_t)K * 2;
    const size_t tstep = 2 * hstep;
    const unsigned ldsw = (unsigned)wid * 1024u;
    const int aoff = lds_byte(wr * 64 + fr, fq * 8), boff = lds_byte(wc * 32 + fr, fq * 8);
#define PG8_SA(b, h) (((b) * 2 + (h)) * HTB)
#define PG8_SB(b, h) ((4 + (b) * 2 + (h)) * HTB)
#define PG8_STAGE(bufoff, gbase, voff) do { _Pragma("unroll") for (int _i = 0; _i < 2; ++_i) \
        __builtin_amdgcn_global_load_lds((const unsigned*)((const char*)(gbase) + (voff)[_i]), (PG8_LAS unsigned*)(lds + (bufoff) + ldsw + _i * 8192), 16, 0, 0); } while (0)
#define PG8_LDA(dst, b, h) do { _Pragma("unroll") for (int m = 0; m < 4; ++m) _Pragma("unroll") for (int k = 0; k < 2; ++k) dst[m][k] = *(const PG8_LAS bf16x8*)(lds + PG8_SA(b, h) + aoff + m * 2048 + k * 1024); } while (0)
#define PG8_LDB(dst, b, h) do { _Pragma("unroll") for (int n = 0; n < 2; ++n) _Pragma("unroll") for (int k = 0; k < 2; ++k) dst[n][k] = *(const PG8_LAS bf16x8*)(lds + PG8_SB(b, h) + boff + n * 2048 + k * 1024); } while (0)
#define PG8_MMA(ai, bj, At, Bt) do { __builtin_amdgcn_s_setprio(1); _Pragma("unroll") for (int m = 0; m < 4; ++m) _Pragma("unroll") for (int n = 0; n < 2; ++n) _Pragma("unroll") for (int k = 0; k < 2; ++k) \
        acc[ai][bj][m][n] = __builtin_amdgcn_mfma_f32_16x16x32_bf16(Bt[n][k], At[m][k], acc[ai][bj][m][n], 0, 0, 0); __builtin_amdgcn_s_setprio(0); } while (0)
#define PG8_WAIT_V(n) asm volatile("s_waitcnt vmcnt(" #n ")" ::: "memory")
#define PG8_WAIT_L(n) asm volatile("s_waitcnt lgkmcnt(" #n ")" ::: "memory")
#define PG8_BAR __builtin_amdgcn_s_barrier()
#define PG8_SCHED __builtin_amdgcn_sched_barrier(0)
    Unit cur, nxt; int ui = 0;
    if (!S.next(0, cur)) return;
    f32x4 acc[2][2][4][2];
#pragma unroll
    for (int a = 0; a < 2; ++a)
#pragma unroll
        for (int b = 0; b < 2; ++b)
#pragma unroll
            for (int m = 0; m < 4; ++m)
#pragma unroll
                for (int n = 0; n < 2; ++n) acc[a][b][m][n] = (f32x4){0.f, 0.f, 0.f, 0.f};
    bf16x8 At[4][2], B0[2][2], B1[2][2];
    const char* cA = (const char*)g.A + (size_t)cur.pm * tstep + cur.kh * khb; const char* cB = (const char*)g.Bt + (size_t)cur.pn * tstep + cur.kh * khb;
    S.a_ready(cur);
    if constexpr (SP2) {
        PG8_STAGE(PG8_SB(0, 0), cB, voffB); PG8_STAGE(PG8_SB(0, 1), cB + hstep, voffB); PG8_STAGE(PG8_SA(0, 0), cA, voffA); PG8_STAGE(PG8_SA(0, 1), cA + hstep, voffA);
        if (wr == 1) PG8_BAR;
        PG8_WAIT_V(2); PG8_BAR;
        PG8_STAGE(PG8_SB(1, 0), cB + kstep, voffB); PG8_STAGE(PG8_SA(1, 0), cA + kstep, voffA); PG8_STAGE(PG8_SB(1, 1), cB + hstep + kstep, voffB);
        PG8_WAIT_V(6); PG8_BAR;
    } else {
        PG8_STAGE(PG8_SB(0, 0), cB, voffB); PG8_STAGE(PG8_SA(0, 0), cA, voffA); PG8_STAGE(PG8_SB(0, 1), cB + hstep, voffB); PG8_STAGE(PG8_SA(0, 1), cA + hstep, voffA);
        if (wr == 1) PG8_BAR;
        PG8_WAIT_V(4); PG8_BAR;
        PG8_STAGE(PG8_SB(1, 0), cB + kstep, voffB); PG8_STAGE(PG8_SA(1, 0), cA + kstep, voffA); PG8_STAGE(PG8_SB(1, 1), cB + hstep + kstep, voffB);
        PG8_WAIT_V(6); PG8_BAR;
    }
    for (;;) {
        const bool has_next = S.next(ui + 1, nxt);
        const char* nA = has_next ? (const char*)g.A + (size_t)nxt.pm * tstep + nxt.kh * khb : cA; const char* nB = has_next ? (const char*)g.Bt + (size_t)nxt.pn * tstep + nxt.kh * khb : cB;
        for (int t = 0; t < nt; t += 2) {
            const bool last = (t == nt - 2);
            const char* a1 = cA + (size_t)(t + 1) * kstep;
            const char* a2 = last ? nA : cA + (size_t)(t + 2) * kstep; const char* b2 = last ? nB : cB + (size_t)(t + 2) * kstep;
            const char* a3 = a2 + kstep; const char* b3 = b2 + kstep;
            if (last && has_next) S.a_ready(nxt);
            if constexpr (SP2) {
            PG8_LDB(B0, 0, 0); PG8_LDB(B1, 0, 1); PG8_SCHED; PG8_LDA(At, 0, 0); PG8_STAGE(PG8_SA(1, 1), a1 + hstep, voffA);
            PG8_WAIT_V(8); PG8_WAIT_L(0); PG8_BAR; PG8_MMA(0, 0, At, B0); PG8_MMA(0, 1, At, B1); PG8_BAR; PG8_SCHED;
            PG8_LDA(At, 0, 1); PG8_STAGE(PG8_SB(0, 0), b2, voffB); PG8_STAGE(PG8_SB(0, 1), b2 + hstep, voffB); PG8_STAGE(PG8_SA(0, 0), a2, voffA);
            PG8_WAIT_V(8); PG8_WAIT_L(0); PG8_BAR; PG8_MMA(1, 0, At, B0); PG8_MMA(1, 1, At, B1); PG8_BAR; PG8_SCHED;
            PG8_LDB(B0, 1, 0); PG8_LDB(B1, 1, 1); PG8_SCHED; PG8_LDA(At, 1, 0); PG8_STAGE(PG8_SA(0, 1), a2 + hstep, voffA);
            PG8_WAIT_V(8); PG8_WAIT_L(0); PG8_BAR; PG8_MMA(0, 0, At, B0); PG8_MMA(0, 1, At, B1); PG8_BAR; PG8_SCHED;
            PG8_LDA(At, 1, 1); PG8_STAGE(PG8_SB(1, 0), b3, voffB); PG8_STAGE(PG8_SB(1, 1), b3 + hstep, voffB); PG8_STAGE(PG8_SA(1, 0), a3, voffA);
            PG8_WAIT_V(8); PG8_WAIT_L(0); PG8_BAR; PG8_MMA(1, 0, At, B0); PG8_MMA(1, 1, At, B1); PG8_BAR; PG8_SCHED;
            } else {
            PG8_LDB(B0, 0, 0); PG8_SCHED; PG8_LDA(At, 0, 0); PG8_STAGE(PG8_SA(1, 1), a1 + hstep, voffA);
            PG8_WAIT_L(8); PG8_BAR; PG8_WAIT_L(0); PG8_MMA(0, 0, At, B0); PG8_BAR; PG8_SCHED;
            PG8_LDB(B1, 0, 1); PG8_STAGE(PG8_SB(0, 0), b2, voffB);
            PG8_BAR; PG8_WAIT_L(0); PG8_MMA(0, 1, At, B1); PG8_BAR;
            PG8_LDA(At, 0, 1); PG8_STAGE(PG8_SA(0, 0), a2, voffA);
            PG8_BAR; PG8_WAIT_L(0); PG8_MMA(1, 0, At, B0); PG8_BAR; PG8_SCHED;
            PG8_STAGE(PG8_SB(0, 1), b2 + hstep, voffB);
            PG8_WAIT_V(6); PG8_BAR; PG8_MMA(1, 1, At, B1); PG8_BAR;
            PG8_LDB(B0, 1, 0); PG8_SCHED; PG8_LDA(At, 1, 0); PG8_STAGE(PG8_SA(0, 1), a2 + hstep, voffA);
            PG8_WAIT_L(8); PG8_BAR; PG8_WAIT_L(0); PG8_MMA(0, 0, At, B0); PG8_BAR; PG8_SCHED;
            PG8_LDB(B1, 1, 1); PG8_STAGE(PG8_SB(1, 0), b3, voffB);
            PG8_BAR; PG8_WAIT_L(0); PG8_MMA(0, 1, At, B1); PG8_BAR;
            PG8_LDA(At, 1, 1); PG8_STAGE(PG8_SA(1, 0), a3, voffA);
            PG8_BAR; PG8_WAIT_L(0); PG8_MMA(1, 0, At, B0); PG8_BAR; PG8_SCHED;
            PG8_STAGE(PG8_SB(1, 1), b3 + hstep, voffB);
            PG8_WAIT_V(6); PG8_BAR; PG8_MMA(1, 1, At, B1); PG8_BAR;
            }
        }
        if constexpr (ALIGN_EPI) { if (wr == 0) PG8_BAR; }
        if constexpr (!Epi::AFTER_DRAIN) { E(acc, cur, wr, wc, fr, fq); S.done(cur); }
        if (!has_next) break;
        if (!(Epi::KSPLIT && cur.kh == 0))
#pragma unroll
        for (int a = 0; a < 2; ++a)
#pragma unroll
            for (int b = 0; b < 2; ++b)
#pragma unroll
                for (int m = 0; m < 4; ++m)
#pragma unroll
                    for (int n = 0; n < 2; ++n) acc[a][b][m][n] = (f32x4){0.f, 0.f, 0.f, 0.f};
        cur = nxt; cA = nA; cB = nB; ++ui;
        if constexpr (ALIGN_EPI) { if (wr == 1) PG8_BAR; }
    }
    PG8_WAIT_V(0);
    if constexpr (!ALIGN_EPI) { if (wr == 0) PG8_BAR; }
    PG8_BAR;
    if constexpr (Epi::AFTER_DRAIN) { E.fused(acc, cur, wr, wc, fr, fq, lds, wid, lane); S.done(cur); }
#undef PG8_SA
#undef PG8_SB
#undef PG8_STAGE
#undef PG8_LDA
#undef PG8_LDB
#undef PG8_MMA
#undef PG8_WAIT_V
#undef PG8_WAIT_L
#undef PG8_BAR
#undef PG8_SCHED
}
}

constexpr int NWAVES = 8, NTHREADS = 512;
constexpr int BATCH = 8, SEQ = 2048, D = 1024, M = BATCH * SEQ, INW = 9216, FFH = 2816;
constexpr float EPS = 1e-6f;
constexpr size_t MiB = 1u << 20;
constexpr size_t WS_SSQ = 1 * MiB;
constexpr size_t WS_WIN = 2 * MiB;
constexpr size_t WS_WHS = 20 * MiB;
constexpr size_t WS_WO = 24 * MiB;
constexpr size_t WS_WF1 = 26 * MiB;
constexpr size_t WS_WF2 = 37 * MiB;
constexpr size_t WS_H = 43 * MiB;
constexpr size_t WS_MIXED = WS_H;
constexpr size_t WS_QS = 75 * MiB;
constexpr size_t WS_VH = 139 * MiB;
constexpr size_t WS_SK = 171 * MiB;
constexpr size_t WS_X1B = WS_SK;
constexpr size_t WS_GH = 203 * MiB, WS_GA = 219 * MiB, WS_GB = 235 * MiB;
constexpr size_t WS_ACT = 75 * MiB;
constexpr size_t WS_END = 251 * MiB;
static_assert(WS_ACT + (size_t)M * FFH * 2 <= WS_X1B, "ACT overlay");
constexpr int RING_BYTES = 131072, LDS_BYTES = 157696, MISC_OFF = LDS_BYTES - 256;

#define LAS __attribute__((address_space(3)))
typedef unsigned short bf16;
typedef unsigned v4u __attribute__((ext_vector_type(4)));
typedef float f32x4 __attribute__((ext_vector_type(4)));
__device__ __forceinline__ unsigned f2bf(float f) { unsigned u = __builtin_bit_cast(unsigned, f); return (u + 0x7fffu + ((u >> 16) & 1u)) >> 16; }
__device__ __forceinline__ unsigned pk2(float lo, float hi) { return f2bf(lo) | (f2bf(hi) << 16); }
__device__ __forceinline__ float bf2f(unsigned short b) { return __builtin_bit_cast(float, (unsigned)b << 16); }
__device__ __forceinline__ float wave_sum(float v) {
#pragma unroll
    for (int o = 1; o < 64; o <<= 1) v += __shfl_xor(v, o);
    return v;
}
struct Args { const float* in[13]; float* out; unsigned char* ws; int ph_lo, ph_hi; };

struct ConvItem { const float* W; bf16* WT; const float* ks; int N, ldT, koff, k0, n0d, n0s; float cs; };
__device__ __forceinline__ ConvItem conv_item(const Args& a, unsigned char* ws, int it) {
    constexpr int I_IN = 16 * (INW / 32), I_SQ = 16 * 32, I_F1 = 16 * (2 * FFH / 32);
    ConvItem p; int r = it; p.ks = nullptr; p.koff = 0; p.cs = 1.0f;
    if (r < I_IN) { const int nblk = INW / 32, kb = r / nblk, nb = r % nblk, n0d = 32 * nb; const int sec = n0d >> 10; int n0s = n0d;
        if (sec == 4 || sec == 5) { const int q = n0d & 255; n0s = (n0d - q) + 64 * ((q >> 5) & 3) + 32 * (q >> 7); }
        p.W = a.in[2]; p.N = INW; p.WT = (bf16*)(ws + WS_WIN); p.ldT = 1024; p.k0 = 64 * kb; p.n0d = n0d; p.n0s = n0s; if (sec == 3 || sec >= 7) p.cs = -1.4426950408889634f; return p; } r -= I_IN;
    if (r < I_SQ) { p.W = a.in[7]; p.N = 1024; p.WT = (bf16*)(ws + WS_WHS); p.ldT = 2048; p.k0 = 64 * (r / 32); p.n0d = p.n0s = 32 * (r % 32); return p; } r -= I_SQ;
    if (r < I_SQ) { p.W = a.in[8]; p.N = 1024; p.WT = (bf16*)(ws + WS_WHS); p.ldT = 2048; p.koff = 1024; p.k0 = 64 * (r / 32); p.n0d = p.n0s = 32 * (r % 32); return p; } r -= I_SQ;
    if (r < I_SQ) { p.W = a.in[9]; p.N = 1024; p.WT = (bf16*)(ws + WS_WO); p.ldT = 1024; p.k0 = 64 * (r / 32); p.n0d = p.n0s = 32 * (r % 32); return p; } r -= I_SQ;
    if (r < I_F1) { const int nblk = 2 * FFH / 32, kb = r / nblk, nb = r % nblk, n0d = 32 * nb, pn = n0d >> 8, q = n0d & 255;
        p.W = a.in[11]; p.N = 2 * FFH; p.WT = (bf16*)(ws + WS_WF1); p.ldT = 1024; p.k0 = 64 * kb; p.n0d = n0d; p.n0s = (q >> 7) * FFH + 128 * pn + (q & 127); p.ks = a.in[10]; return p; } r -= I_F1;
    p.W = a.in[12]; p.N = 1024; p.WT = (bf16*)(ws + WS_WF2); p.ldT = FFH; p.k0 = 64 * (r / 32); p.n0d = p.n0s = 32 * (r % 32); return p;
}
__device__ __forceinline__ void conv_load(const ConvItem& p, float (&wv)[32], f32x4 (&kv)[2], int lane) {
    const float* wp = p.W + (size_t)(p.k0 + (lane >> 5)) * p.N + p.n0s + (lane & 31);
#pragma unroll
    for (int i = 0; i < 32; ++i) wv[i] = wp[(size_t)(2 * i) * p.N];
    if (p.ks) { kv[0] = *(const f32x4*)(p.ks + p.k0 + 8 * (lane & 7)); kv[1] = *(const f32x4*)(p.ks + p.k0 + 8 * (lane & 7) + 4); }
    else { kv[0] = (f32x4){p.cs, p.cs, p.cs, p.cs}; kv[1] = kv[0]; }
}
__device__ __forceinline__ void conv_finish(const ConvItem& p, const float (&wv)[32], const f32x4 (&kv)[2], LAS float* scr, int lane) {
#pragma unroll
    for (int i = 0; i < 32; ++i) scr[(2 * i + (lane >> 5)) * 33 + (lane & 31)] = wv[i];
    asm volatile("s_waitcnt lgkmcnt(0)" ::: "memory");
    const int c = lane & 7;
#pragma unroll
    for (int j = 0; j < 4; ++j) { const int n = (lane >> 3) + 8 * j; const LAS float* s = scr + (8 * c) * 33 + n;
        v4u o; o.x = pk2(s[0 * 33] * kv[0][0], s[1 * 33] * kv[0][1]); o.y = pk2(s[2 * 33] * kv[0][2], s[3 * 33] * kv[0][3]); o.z = pk2(s[4 * 33] * kv[1][0], s[5 * 33] * kv[1][1]); o.w = pk2(s[6 * 33] * kv[1][2], s[7 * 33] * kv[1][3]);
        *(v4u*)(p.WT + (size_t)(p.n0d + n) * p.ldT + p.koff + p.k0 + 8 * c) = o; }
    asm volatile("s_waitcnt lgkmcnt(0)" ::: "memory");
}
template <int PART> __device__ __forceinline__ void p0_prologue(const Args& a, LAS unsigned char* lds, int wave, int lane, int gw, int NGW, int it_last = 1 << 30) {
    LAS float* scr = (LAS float*)(lds + wave * 16384);
    unsigned char* ws = a.ws;
    constexpr int I_IN = 16 * (INW / 32), I_SQ = 16 * 32, I_F1 = 16 * (2 * FFH / 32), I_F2 = (FFH / 64) * 32;
    constexpr int NITEMS = I_IN + 3 * I_SQ + I_F1 + I_F2;
    { int it = (PART == 0 ? gw : I_IN + gw); const int end = (PART == 0 ? I_IN : (I_IN + it_last < NITEMS ? I_IN + it_last : NITEMS));
      if (it < end) {
        ConvItem pa = conv_item(a, ws, it), pb = pa; float wa[32], wb[32]; f32x4 ka[2], kb[2];
        conv_load(pa, wa, ka, lane);
        for (;;) {
            const bool hb = it + NGW < end; if (hb) { pb = conv_item(a, ws, it + NGW); conv_load(pb, wb, kb, lane); }
            conv_finish(pa, wa, ka, scr, lane);
            if (!hb) break; it += NGW;
            const bool ha = it + NGW < end; if (ha) { pa = conv_item(a, ws, it + NGW); conv_load(pa, wa, ka, lane); }
            conv_finish(pb, wb, kb, scr, lane);
            if (!ha) break; it += NGW;
        }
      }
    }
    if (PART != 0) return;
    const float* g1 = a.in[1];
    f32x4 gv[4];
#pragma unroll
    for (int j = 0; j < 4; ++j) gv[j] = ((const f32x4*)g1)[lane + 64 * j];
    for (int m = gw; m < M; m += NGW) {
        const f32x4* xr = (const f32x4*)(a.in[0] + (size_t)m * D) + lane;
        f32x4 v[4]; float s = 0.f;
#pragma unroll
        for (int j = 0; j < 4; ++j) { v[j] = xr[64 * j]; s += (v[j].x * v[j].x + v[j].y * v[j].y) + (v[j].z * v[j].z + v[j].w * v[j].w); }
        const float rstd = __builtin_amdgcn_rsqf(wave_sum(s) * (1.f / D) + EPS);
        unsigned long long* o8 = (unsigned long long*)((bf16*)(ws + WS_H) + (size_t)m * D) + lane;
#pragma unroll
        for (int j = 0; j < 4; ++j) { const f32x4 y = v[j] * rstd * gv[j]; o8[64 * j] = (unsigned long long)pk2(y.x, y.y) | ((unsigned long long)pk2(y.z, y.w) << 32); }
    }
}

typedef short bf16x8_t __attribute__((ext_vector_type(8)));
typedef float f32x16 __attribute__((ext_vector_type(16)));
typedef unsigned u32x2_t __attribute__((ext_vector_type(2)));
typedef float f32x2_t __attribute__((ext_vector_type(2)));
typedef __bf16 bf16x2_cv __attribute__((ext_vector_type(2)));
__device__ __forceinline__ unsigned cvtpk(float lo, float hi) { const f32x2_t v = {lo, hi}; return __builtin_bit_cast(unsigned, __builtin_convertvector(v, bf16x2_cv)); }
__device__ __forceinline__ bf16x8_t pack_acc8(const f32x16& c, int p) {
    v4u w; if (p == 0) { w.x = cvtpk(c[0], c[1]); w.y = cvtpk(c[2], c[3]); w.z = cvtpk(c[4], c[5]); w.w = cvtpk(c[6], c[7]); }
    else { w.x = cvtpk(c[8], c[9]); w.y = cvtpk(c[10], c[11]); w.z = cvtpk(c[12], c[13]); w.w = cvtpk(c[14], c[15]); }
    return __builtin_bit_cast(bf16x8_t, w);
}
#define MFMA32(A, B, C) __builtin_amdgcn_mfma_f32_32x32x16_bf16((A), (B), (C), 0, 0, 0)
__device__ __forceinline__ void hgrn_mfma(const Args& a, LAS unsigned char* lds, int vblk, int nblk) {
    unsigned char* ws = a.ws;
    bf16* QS = (bf16*)(ws + WS_QS); const bf16* VH = (const bf16*)(ws + WS_VH); const unsigned char* GH = ws + WS_GH; const _Float16* LOGF = (const _Float16*)a.out;
    const float* ogain = a.in[4];
    constexpr int RS = 272, TS = 144;
    LAS unsigned char* L_QI = lds; LAS unsigned char* L_QA = lds + 64 * RS; LAS unsigned char* L_KA = lds + 2 * 64 * RS;
    LAS unsigned char* L_KST = lds + 3 * 64 * RS; LAS unsigned char* L_VT = L_KST + 128 * TS;
    LAS float* L_TQ = (LAS float*)(L_VT + 128 * TS); LAS float* L_DEC = L_TQ + 2048;     LAS float* L_SS = L_DEC + 128; LAS float* L_GN = L_SS + 256;
    const int tid = threadIdx.x, lane = tid & 63, wave = __builtin_amdgcn_readfirstlane(tid >> 6);
    const int dp = tid & 63, oct = wave, r32 = lane & 31, hi = lane >> 5, vt = wave & 3, tt = wave >> 2;
    const int kap = 16 * (r32 >> 4) + 8 * ((r32 >> 2) & 1) + 4 * ((r32 >> 3) & 1) + (r32 & 3);
    for (int item = vblk; item < BATCH * 8; item += nblk) {
        const int b = item >> 3, h = item & 7;
        f32x16 C[4];
#pragma unroll
        for (int i = 0; i < 4; ++i)
#pragma unroll
            for (int j = 0; j < 16; ++j) C[i][j] = 0.f;
        if (tid < 128) L_GN[tid] = ogain[h * 128 + tid];
        unsigned gN2[2][8], qN2[2][8], vN2[2][8];
#pragma unroll
        for (int c2 = 0; c2 < 2; ++c2) { const size_t row0 = (size_t)b * SEQ + 64 * c2 + 8 * oct;
#pragma unroll
          for (int i = 0; i < 8; ++i) { gN2[c2][i] = *(const unsigned*)(LOGF + (row0 + i) * 1024 + h * 128 + 2 * dp); qN2[c2][i] = *(const unsigned*)(QS + (row0 + i) * 2048 + h * 128 + 2 * dp); vN2[c2][i] = *(const unsigned*)(VH + (row0 + i) * 1024 + h * 128 + 2 * dp); } }
        { float run0 = 0.f, run1 = 0.f;
#pragma unroll
          for (int i = 0; i < 8; ++i) { run0 += (float)__builtin_bit_cast(_Float16, (unsigned short)(gN2[0][i] & 0xffffu)); run1 += (float)__builtin_bit_cast(_Float16, (unsigned short)(gN2[0][i] >> 16)); }
          *(LAS f32x2_t*)(L_TQ + oct * 128 + 2 * dp) = (f32x2_t){run0, run1}; }
        __syncthreads();
#pragma unroll 2
        for (int n = 0; n < SEQ / 64; ++n) {
            unsigned (&gN)[8] = gN2[n & 1]; unsigned (&qN)[8] = qN2[n & 1]; unsigned (&vN)[8] = vN2[n & 1];
            if (n + 1 < SEQ / 64) { float run0 = 0.f, run1 = 0.f;
#pragma unroll
                for (int i = 0; i < 8; ++i) { const unsigned gw_ = gN2[(n + 1) & 1][i]; run0 += (float)__builtin_bit_cast(_Float16, (unsigned short)(gw_ & 0xffffu)); run1 += (float)__builtin_bit_cast(_Float16, (unsigned short)(gw_ >> 16)); }
                *(LAS f32x2_t*)(L_TQ + ((n + 1) & 1) * 1024 + oct * 128 + 2 * dp) = (f32x2_t){run0, run1}; }
            float off0 = 0.f, off1 = 0.f, cref0 = 0.f, cref1 = 0.f, tot0 = 0.f, tot1 = 0.f;
#pragma unroll
            for (int o = 0; o < 8; ++o) { const f32x2_t tq = *(const LAS f32x2_t*)(L_TQ + (n & 1) * 1024 + o * 128 + 2 * dp);
                if (o < oct) { off0 += tq.x; off1 += tq.y; } if (o < 4) { cref0 += tq.x; cref1 += tq.y; } tot0 += tq.x; tot1 += tq.y; }
            const float xc0 = __expf(tot0), xc1 = __expf(tot1), xa0 = __expf(-cref0), xa1 = __expf(-cref1), xb0 = __expf(cref0), xb1 = __expf(cref1);
            if (oct == 0) *(LAS f32x2_t*)(L_DEC + 2 * dp) = (f32x2_t){xc0, xc1};
            float e0 = __expf(off0), e1 = __expf(off1);
            unsigned ksp0[4], ksp1[4], vsp0[4], vsp1[4];
#pragma unroll
            for (int i = 0; i < 8; ++i) {
                const float f0 = __expf((float)__builtin_bit_cast(_Float16, (unsigned short)(gN[i] & 0xffffu))), f1 = __expf((float)__builtin_bit_cast(_Float16, (unsigned short)(gN[i] >> 16)));
                e0 = fmaxf(e0 * f0, 1e-30f); e1 = fmaxf(e1 * f1, 1e-30f);
                const float r0 = __builtin_amdgcn_rcpf(e0), r1 = __builtin_amdgcn_rcpf(e1);
                const float k0 = 1.0f - f0, k1 = 1.0f - f1, q0 = __builtin_bit_cast(float, qN[i] << 16), q1 = __builtin_bit_cast(float, qN[i] & 0xffff0000u);
                const float qi0 = q0 * e0, qi1 = q1 * e1, kr0 = k0 * r0, kr1 = k1 * r1;
                const int t = 8 * oct + i;
                *(LAS unsigned*)(L_QI + t * RS + 4 * dp) = cvtpk(qi0, qi1);
                *(LAS unsigned*)(L_QA + t * RS + 4 * dp) = cvtpk(qi0 * xa0, qi1 * xa1);
                *(LAS unsigned*)(L_KA + t * RS + 4 * dp) = cvtpk(kr0 * xb0, kr1 * xb1);
                const unsigned ks = cvtpk(kr0 * xc0, kr1 * xc1);
                if (i & 1) { ksp0[i >> 1] |= ks << 16; ksp1[i >> 1] |= ks & 0xffff0000u; vsp0[i >> 1] |= vN[i] << 16; vsp1[i >> 1] |= vN[i] & 0xffff0000u; }
                else { ksp0[i >> 1] = ks & 0xffffu; ksp1[i >> 1] = ks >> 16; vsp0[i >> 1] = vN[i] & 0xffffu; vsp1[i >> 1] = vN[i] >> 16; }
            }
            *(LAS v4u*)(L_KST + (2 * dp) * TS + 16 * oct) = (v4u){ksp0[0], ksp0[1], ksp0[2], ksp0[3]}; *(LAS v4u*)(L_KST + (2 * dp + 1) * TS + 16 * oct) = (v4u){ksp1[0], ksp1[1], ksp1[2], ksp1[3]};
            *(LAS v4u*)(L_VT + (2 * dp) * TS + 16 * oct) = (v4u){vsp0[0], vsp0[1], vsp0[2], vsp0[3]}; *(LAS v4u*)(L_VT + (2 * dp + 1) * TS + 16 * oct) = (v4u){vsp1[0], vsp1[1], vsp1[2], vsp1[3]};
            __syncthreads();
            const size_t m = (size_t)b * SEQ + 64 * n + 32 * tt + r32;
            unsigned gt4[4];
#pragma unroll
            for (int a4 = 0; a4 < 4; ++a4) gt4[a4] = *(const unsigned*)(GH + m * 1024 + h * 128 + 32 * vt + 8 * a4 + 4 * hi);
            if (n + 2 < SEQ / 64) { const size_t row0 = (size_t)b * SEQ + 64 * (n + 2) + 8 * oct;
#pragma unroll
                for (int i = 0; i < 8; ++i) { gN[i] = *(const unsigned*)(LOGF + (row0 + i) * 1024 + h * 128 + 2 * dp); qN[i] = *(const unsigned*)(QS + (row0 + i) * 2048 + h * 128 + 2 * dp); vN[i] = *(const unsigned*)(VH + (row0 + i) * 1024 + h * 128 + 2 * dp); } }
#define SB() __builtin_amdgcn_sched_barrier(0)
            f32x16 O;
#pragma unroll
            for (int j = 0; j < 16; ++j) O[j] = 0.f;
            bf16x8_t Vt[4];
            {
                v4u qf[8];
#pragma unroll
                for (int i = 0; i < 8; ++i) { const LAS unsigned char* qp = L_QI + (32 * tt + r32) * RS + (32 * (i >> 1) + 16 * (i & 1) + 4 * hi) * 2;
                    const u32x2_t lo = *(const LAS u32x2_t*)qp, hi2 = *(const LAS u32x2_t*)(qp + 16); qf[i] = (v4u){lo.x, lo.y, hi2.x, hi2.y}; }
#pragma unroll
                for (int ks = 0; ks < 4; ++ks) Vt[ks] = *(const LAS bf16x8_t*)(L_VT + (32 * vt + r32) * TS + (16 * ks + 8 * hi) * 2);
                SB();
#pragma unroll
                for (int i = 0; i < 8; ++i) O = MFMA32(pack_acc8(C[i >> 1], i & 1), __builtin_bit_cast(bf16x8_t, qf[i]), O);
                SB();
            }
#pragma unroll
            for (int st = 0; st < 2; ++st) if (st <= tt) {
                f32x16 S;
#pragma unroll
                for (int j = 0; j < 16; ++j) S[j] = 0.f;
#pragma unroll
                for (int hb = 0; hb < 2; ++hb) {
                    bf16x8_t A[4], B[4];
#pragma unroll
                    for (int k4 = 0; k4 < 4; ++k4) { const int ks = 4 * hb + k4;
                        A[k4] = *(const LAS bf16x8_t*)(L_KA + (32 * st + kap) * RS + (16 * ks + 8 * hi) * 2);
                        B[k4] = *(const LAS bf16x8_t*)(L_QA + (32 * tt + r32) * RS + (16 * ks + 8 * hi) * 2); }
                    SB();
#pragma unroll
                    for (int k4 = 0; k4 < 4; ++k4) S = MFMA32(A[k4], B[k4], S);
                    SB();
                }
                if (st == tt) {
#pragma unroll
                    for (int j = 0; j < 16; ++j) { const int sl = 16 * (j >> 3) + 8 * hi + (j & 7); if (sl > r32) S[j] = 0.f; }
                }
                O = MFMA32(Vt[2 * st], pack_acc8(S, 0), O); O = MFMA32(Vt[2 * st + 1], pack_acc8(S, 1), O);
            }
#pragma unroll
            for (int dt = 0; dt < 4; ++dt) {
                f32x4 dc[4]; bf16x8_t A[4];
#pragma unroll
                for (int a4 = 0; a4 < 4; ++a4) dc[a4] = *(const LAS f32x4*)(L_DEC + 32 * dt + 8 * a4 + 4 * hi);
#pragma unroll
                for (int ks = 0; ks < 4; ++ks) A[ks] = *(const LAS bf16x8_t*)(L_KST + (32 * dt + r32) * TS + (16 * ks + 8 * hi) * 2);
                SB();
#pragma unroll
                for (int a4 = 0; a4 < 4; ++a4)
#pragma unroll
                    for (int cc = 0; cc < 4; ++cc) C[dt][4 * a4 + cc] *= dc[a4][cc];
#pragma unroll
                for (int ks = 0; ks < 4; ++ks) C[dt] = MFMA32(A[ks], Vt[ks], C[dt]);
                SB();
            }
#undef SB
            float ss = 0.f;
#pragma unroll
            for (int j = 0; j < 16; ++j) ss += O[j] * O[j];
            ss += __shfl_xor(ss, 32);
            if (hi == 0) L_SS[(tt * 4 + vt) * 32 + r32] = ss;
            __syncthreads();
            const float sst = (L_SS[(tt * 4 + 0) * 32 + r32] + L_SS[(tt * 4 + 1) * 32 + r32]) + (L_SS[(tt * 4 + 2) * 32 + r32] + L_SS[(tt * 4 + 3) * 32 + r32]);
            const float rstd = __builtin_amdgcn_rsqf(sst * (1.0f / 128.0f) + EPS);
#pragma unroll
            for (int a4 = 0; a4 < 4; ++a4) { const int v0 = h * 128 + 32 * vt + 8 * a4 + 4 * hi;
                const f32x4 gn = *(const LAS f32x4*)(L_GN + 32 * vt + 8 * a4 + 4 * hi); const unsigned gt = gt4[a4];
                float o[4];
#pragma unroll
                for (int cc = 0; cc < 4; ++cc) o[cc] = O[4 * a4 + cc] * rstd * gn[cc] * ((float)((gt >> (8 * cc)) & 255u) * (1.0f / 255.0f));
                u32x2_t w; w.x = cvtpk(o[0], o[1]); w.y = cvtpk(o[2], o[3]);
                *(u32x2_t*)(QS + m * 2048 + v0) = w; }
        }
        __syncthreads();
    }
}

__device__ __forceinline__ void hgrn_v2(const Args& a, LAS unsigned char* lds, int vblk, int nblk) {
    unsigned char* ws = a.ws;
    bf16* QS = (bf16*)(ws + WS_QS); const bf16* VH = (const bf16*)(ws + WS_VH); const unsigned char* GH = ws + WS_GH; const _Float16* LOGF = (const _Float16*)a.out;
    const float* ogain = a.in[4];
    constexpr int RS = 272, TS = 144, O_KA = 64 * RS, O_KAT = 2 * 64 * RS, O_VT = O_KAT + 128 * TS, BUFB = O_VT + 128 * TS;
    LAS float* L_TQ = (LAS float*)(lds + 2 * BUFB);
    LAS float* L_XS = L_TQ + 1024;
    LAS float* L_SS = L_XS + 512;
    LAS float* L_GN = L_SS + 512;
    const int tid = threadIdx.x, lane = tid & 63, wave = __builtin_amdgcn_readfirstlane(tid >> 6);
    const int r32 = lane & 31, hi = lane >> 5;
    const int kap = 16 * (r32 >> 4) + 8 * ((r32 >> 2) & 1) + 4 * ((r32 >> 3) & 1) + (r32 & 3);
    constexpr int NCH = SEQ / 64;
#define SB() __builtin_amdgcn_sched_barrier(0)
    for (int item = vblk; item < BATCH * 8; item += nblk) {
        const int b = item >> 3, h = item & 7;
        if (tid < 128) L_GN[tid] = ogain[h * 128 + tid];
        if (wave < 4) {
            const int vt = wave;
            f32x16 C[4];
#pragma unroll
            for (int i = 0; i < 4; ++i)
#pragma unroll
                for (int j = 0; j < 16; ++j) C[i][j] = 0.f;
            f32x16 O[2]; unsigned gt4[2][4];
#define HG_EPI(cn) do { _Pragma("unroll") for (int tt = 0; tt < 2; ++tt) { const LAS float* SSb = L_SS + ((cn) & 1) * 256; \
                const float sst = (SSb[(tt * 4 + 0) * 32 + r32] + SSb[(tt * 4 + 1) * 32 + r32]) + (SSb[(tt * 4 + 2) * 32 + r32] + SSb[(tt * 4 + 3) * 32 + r32]); \
                const float rstd = __builtin_amdgcn_rsqf(sst * (1.0f / 128.0f) + EPS); \
                const size_t m = (size_t)b * SEQ + 64 * (cn) + r32 + 32 * tt; \
                _Pragma("unroll") for (int a4 = 0; a4 < 4; ++a4) { const int v0 = h * 128 + 32 * vt + 8 * a4 + 4 * hi; \
                    const f32x4 gn = *(const LAS f32x4*)(L_GN + 32 * vt + 8 * a4 + 4 * hi); const unsigned gt = gt4[tt][a4]; float o[4]; \
                    _Pragma("unroll") for (int cc = 0; cc < 4; ++cc) o[cc] = O[tt][4 * a4 + cc] * rstd * gn[cc] * ((float)((gt >> (8 * cc)) & 255u) * (1.0f / 255.0f)); \
                    u32x2_t w; w.x = cvtpk(o[0], o[1]); w.y = cvtpk(o[2], o[3]); *(u32x2_t*)(QS + m * 2048 + v0) = w; } } } while (0)
            __syncthreads();
#pragma unroll 1
            for (int n = 0; n < NCH; ++n) {
                __syncthreads();
                if (n > 0) HG_EPI(n - 1);
                const LAS unsigned char* T = lds + (n & 1) * BUFB;
                const LAS float* XS = L_XS + (n & 1) * 256;
                const size_t m0 = (size_t)b * SEQ + 64 * n + r32;
#pragma unroll
                for (int tt = 0; tt < 2; ++tt)
#pragma unroll
                    for (int a4 = 0; a4 < 4; ++a4) gt4[tt][a4] = *(const unsigned*)(GH + (m0 + 32 * tt) * 1024 + h * 128 + 32 * vt + 8 * a4 + 4 * hi);
                bf16x8_t Cp[8]; bf16x8_t Vt[4];
#pragma unroll
                for (int ks = 0; ks < 4; ++ks) Vt[ks] = *(const LAS bf16x8_t*)(T + O_VT + (32 * vt + r32) * TS + (16 * ks + 8 * hi) * 2);
#pragma unroll
                for (int dt = 0; dt < 4; ++dt) {
#pragma unroll
                    for (int a4 = 0; a4 < 4; ++a4) { const f32x4 x1 = *(const LAS f32x4*)(XS + 32 * dt + 8 * a4 + 4 * hi);
#pragma unroll
                        for (int cc = 0; cc < 4; ++cc) C[dt][4 * a4 + cc] *= x1[cc]; }
                    Cp[2 * dt] = pack_acc8(C[dt], 0); Cp[2 * dt + 1] = pack_acc8(C[dt], 1);
                }
#pragma unroll
                for (int tt = 0; tt < 2; ++tt) {
#pragma unroll
                    for (int j = 0; j < 16; ++j) O[tt][j] = 0.f;
                    v4u qf[8];
#pragma unroll
                    for (int i = 0; i < 8; ++i) { const LAS unsigned char* qp = T + (32 * tt + r32) * RS + (32 * (i >> 1) + 16 * (i & 1) + 4 * hi) * 2;
                        const u32x2_t lo = *(const LAS u32x2_t*)qp, hi2 = *(const LAS u32x2_t*)(qp + 16); qf[i] = (v4u){lo.x, lo.y, hi2.x, hi2.y}; }
                    SB();
#pragma unroll
                    for (int i = 0; i < 8; ++i) O[tt] = MFMA32(Cp[i], __builtin_bit_cast(bf16x8_t, qf[i]), O[tt]);
                    SB();
#pragma unroll
                    for (int st = 0; st < 2; ++st) if (st <= tt) {
                        f32x16 S;
#pragma unroll
                        for (int j = 0; j < 16; ++j) S[j] = 0.f;
#pragma unroll
                        for (int hb = 0; hb < 2; ++hb) {
                            bf16x8_t A[4], B[4];
#pragma unroll
                            for (int k4 = 0; k4 < 4; ++k4) { const int ks = 4 * hb + k4;
                                A[k4] = *(const LAS bf16x8_t*)(T + O_KA + (32 * st + kap) * RS + (16 * ks + 8 * hi) * 2);
                                B[k4] = *(const LAS bf16x8_t*)(T + (32 * tt + r32) * RS + (16 * ks + 8 * hi) * 2); }
                            SB();
#pragma unroll
                            for (int k4 = 0; k4 < 4; ++k4) S = MFMA32(A[k4], B[k4], S);
                            SB();
                        }
                        if (st == tt) {
#pragma unroll
                            for (int j = 0; j < 16; ++j) { const int sl = 16 * (j >> 3) + 8 * hi + (j & 7); if (sl > r32) S[j] = 0.f; }
                        }
                        O[tt] = MFMA32(Vt[2 * st], pack_acc8(S, 0), O[tt]); O[tt] = MFMA32(Vt[2 * st + 1], pack_acc8(S, 1), O[tt]);
                    }
                    float ss = 0.f;
#pragma unroll
                    for (int j = 0; j < 16; ++j) ss += O[tt][j] * O[tt][j];
                    ss += __shfl_xor(ss, 32);
                    if (hi == 0) L_SS[(n & 1) * 256 + (tt * 4 + vt) * 32 + r32] = ss;
                }
#pragma unroll
                for (int dt = 0; dt < 4; ++dt) {
                    f32x4 x2[4]; bf16x8_t A[4];
#pragma unroll
                    for (int a4 = 0; a4 < 4; ++a4) x2[a4] = *(const LAS f32x4*)(XS + 128 + 32 * dt + 8 * a4 + 4 * hi);
#pragma unroll
                    for (int ks = 0; ks < 4; ++ks) A[ks] = *(const LAS bf16x8_t*)(T + O_KAT + (32 * dt + r32) * TS + (16 * ks + 8 * hi) * 2);
                    SB();
#pragma unroll
                    for (int ks = 0; ks < 4; ++ks) C[dt] = MFMA32(A[ks], Vt[ks], C[dt]);
#pragma unroll
                    for (int a4 = 0; a4 < 4; ++a4)
#pragma unroll
                        for (int cc = 0; cc < 4; ++cc) C[dt][4 * a4 + cc] *= x2[a4][cc];
                    SB();
                }
            }
            __syncthreads();
            HG_EPI(NCH - 1);
#undef HG_EPI
        } else {
            const int ptid = tid - 256, dp = ptid & 63, q4 = ptid >> 6;
            unsigned g2[2][16], q2[2][16], v2[2][16];
#define HG_LOAD(set, c) do { const size_t row0_ = (size_t)b * SEQ + 64 * (c) + 16 * q4; _Pragma("unroll") for (int i = 0; i < 16; ++i) { \
                g2[set][i] = *(const unsigned*)(LOGF + (row0_ + i) * 1024 + h * 128 + 2 * dp); q2[set][i] = *(const unsigned*)(QS + (row0_ + i) * 2048 + h * 128 + 2 * dp); \
                v2[set][i] = *(const unsigned*)(VH + (row0_ + i) * 1024 + h * 128 + 2 * dp); } } while (0)
#define HG_SUMS(set, c) do { float r0_ = 0.f, r1_ = 0.f; _Pragma("unroll") for (int i = 0; i < 16; ++i) { r0_ += (float)__builtin_bit_cast(_Float16, (unsigned short)(g2[set][i] & 0xffffu)); \
                r1_ += (float)__builtin_bit_cast(_Float16, (unsigned short)(g2[set][i] >> 16)); } *(LAS f32x2_t*)(L_TQ + ((c) & 1) * 512 + q4 * 128 + 2 * dp) = (f32x2_t){r0_, r1_}; } while (0)
            float e0, e1, xa0, xa1, xb0, xb1; unsigned kp0[8], kp1[8], vp0[8], vp1[8];
#define HG_BEGIN(c) do { float off0 = 0.f, off1 = 0.f, cref0 = 0.f, cref1 = 0.f, tot0 = 0.f, tot1 = 0.f; \
                _Pragma("unroll") for (int o = 0; o < 4; ++o) { const f32x2_t tq = *(const LAS f32x2_t*)(L_TQ + ((c) & 1) * 512 + o * 128 + 2 * dp); \
                    if (o < q4) { off0 += tq.x; off1 += tq.y; } if (o < 2) { cref0 += tq.x; cref1 += tq.y; } tot0 += tq.x; tot1 += tq.y; } \
                xa0 = __builtin_amdgcn_exp2f(-cref0); xa1 = __builtin_amdgcn_exp2f(-cref1); xb0 = __builtin_amdgcn_exp2f(cref0); xb1 = __builtin_amdgcn_exp2f(cref1); e0 = __builtin_amdgcn_exp2f(off0); e1 = __builtin_amdgcn_exp2f(off1); \
                if (q4 == 0) { *(LAS f32x2_t*)(L_XS + ((c) & 1) * 256 + 2 * dp) = (f32x2_t){xb0, xb1}; *(LAS f32x2_t*)(L_XS + ((c) & 1) * 256 + 128 + 2 * dp) = (f32x2_t){__builtin_amdgcn_exp2f(tot0 - cref0), __builtin_amdgcn_exp2f(tot1 - cref1)}; } } while (0)
#define HG_TOKENS(set, c, i0) do { LAS unsigned char* T_ = lds + ((c) & 1) * BUFB; _Pragma("unroll") for (int i = (i0); i < (i0) + 8; ++i) { \
                const unsigned gw_ = g2[set][i], qw_ = q2[set][i], vw_ = v2[set][i]; \
                const float f0 = __builtin_amdgcn_exp2f((float)__builtin_bit_cast(_Float16, (unsigned short)(gw_ & 0xffffu))), f1 = __builtin_amdgcn_exp2f((float)__builtin_bit_cast(_Float16, (unsigned short)(gw_ >> 16))); \
                e0 = fmaxf(e0 * f0, 1e-30f); e1 = fmaxf(e1 * f1, 1e-30f); \
                const float r0 = __builtin_amdgcn_rcpf(e0), r1 = __builtin_amdgcn_rcpf(e1); \
                const float qq0 = __builtin_bit_cast(float, qw_ << 16), qq1 = __builtin_bit_cast(float, qw_ & 0xffff0000u); \
                const int t = 16 * q4 + i; \
                *(LAS unsigned*)(T_ + t * RS + 4 * dp) = cvtpk(qq0 * e0 * xa0, qq1 * e1 * xa1); \
                const unsigned ka = cvtpk((1.0f - f0) * r0 * xb0, (1.0f - f1) * r1 * xb1); \
                *(LAS unsigned*)(T_ + O_KA + t * RS + 4 * dp) = ka; \
                if (i & 1) { kp0[i >> 1] |= ka << 16; kp1[i >> 1] |= ka & 0xffff0000u; vp0[i >> 1] |= vw_ << 16; vp1[i >> 1] |= vw_ & 0xffff0000u; } \
                else { kp0[i >> 1] = ka & 0xffffu; kp1[i >> 1] = ka >> 16; vp0[i >> 1] = vw_ & 0xffffu; vp1[i >> 1] = vw_ >> 16; } } } while (0)
#define HG_FINISH(c) do { LAS unsigned char* T_ = lds + ((c) & 1) * BUFB; \
                *(LAS v4u*)(T_ + O_KAT + (2 * dp) * TS + 32 * q4) = (v4u){kp0[0], kp0[1], kp0[2], kp0[3]}; *(LAS v4u*)(T_ + O_KAT + (2 * dp) * TS + 32 * q4 + 16) = (v4u){kp0[4], kp0[5], kp0[6], kp0[7]}; \
                *(LAS v4u*)(T_ + O_KAT + (2 * dp + 1) * TS + 32 * q4) = (v4u){kp1[0], kp1[1], kp1[2], kp1[3]}; *(LAS v4u*)(T_ + O_KAT + (2 * dp + 1) * TS + 32 * q4 + 16) = (v4u){kp1[4], kp1[5], kp1[6], kp1[7]}; \
                *(LAS v4u*)(T_ + O_VT + (2 * dp) * TS + 32 * q4) = (v4u){vp0[0], vp0[1], vp0[2], vp0[3]}; *(LAS v4u*)(T_ + O_VT + (2 * dp) * TS + 32 * q4 + 16) = (v4u){vp0[4], vp0[5], vp0[6], vp0[7]}; \
                *(LAS v4u*)(T_ + O_VT + (2 * dp + 1) * TS + 32 * q4) = (v4u){vp1[0], vp1[1], vp1[2], vp1[3]}; *(LAS v4u*)(T_ + O_VT + (2 * dp + 1) * TS + 32 * q4 + 16) = (v4u){vp1[4], vp1[5], vp1[6], vp1[7]}; } while (0)
            HG_LOAD(0, 0); HG_LOAD(1, 1);
            HG_SUMS(0, 0);
            __syncthreads();
            HG_SUMS(1, 1); HG_BEGIN(0); HG_TOKENS(0, 0, 0); HG_TOKENS(0, 0, 8); HG_FINISH(0); HG_LOAD(0, 2);
#pragma unroll 2
            for (int n = 0; n < NCH; ++n) {
                const int c = n + 1;
                __syncthreads();
                if (c < NCH) { if (c + 1 < NCH) HG_SUMS(n & 1, c + 1); HG_BEGIN(c); HG_TOKENS((n + 1) & 1, c, 0); HG_TOKENS((n + 1) & 1, c, 8); HG_FINISH(c); if (c + 2 < NCH) HG_LOAD((n + 1) & 1, c + 2); }
            }
            __syncthreads();
#undef HG_LOAD
#undef HG_SUMS
#undef HG_BEGIN
#undef HG_TOKENS
#undef HG_FINISH
        }
        __syncthreads();
    }
#undef SB
}

template <bool DIAG> __device__ __forceinline__ bool attn_tile(const bf16x8_t (&Kc)[4], const bf16x8_t (&Vc)[4], const bf16x8_t (&Qf)[4], f32x16& O0, f32x16& O1, float& carry, int r32, int hi) {
    f32x16 Sx;
#pragma unroll
    for (int j = 0; j < 16; ++j) Sx[j] = 0.f;
#pragma unroll
    for (int ks = 0; ks < 4; ++ks) Sx = MFMA32(Kc[ks], Qf[ks], Sx);
    float kp[16], sg[16];
#pragma unroll
    for (int j = 0; j < 16; ++j) {
        const float r = __builtin_amdgcn_rcpf(1.0f + __builtin_amdgcn_exp2f(Sx[j]));
        if (DIAG) { const int sl = 16 * (j >> 3) + 8 * hi + (j & 7); const bool valid = sl < r32; kp[j] = valid ? r : 1.f; sg[j] = valid ? 1.0f - r : 0.f; }
        else { kp[j] = r; sg[j] = 1.0f - r; }
    }
#pragma unroll
    for (int j = 6; j >= 0; --j) { sg[j] *= kp[j + 1]; kp[j] *= kp[j + 1]; sg[8 + j] *= kp[8 + j + 1]; kp[8 + j] *= kp[8 + j + 1]; }
    const float G0 = kp[0], G1 = kp[8];
    const float P0 = __shfl_xor(G0, 32), P1 = __shfl_xor(G1, 32);
    const float after0 = (hi == 0 ? P0 : 1.f) * P1 * G1 * carry, after1 = (hi == 0 ? P1 : 1.f) * carry;
#pragma unroll
    for (int j = 0; j < 16; ++j) sg[j] *= (j < 8 ? after0 : after1);
    carry *= (G0 * G1) * (P0 * P1);
    v4u w0, w1; w0.x = cvtpk(sg[0], sg[1]); w0.y = cvtpk(sg[2], sg[3]); w0.z = cvtpk(sg[4], sg[5]); w0.w = cvtpk(sg[6], sg[7]);
    w1.x = cvtpk(sg[8], sg[9]); w1.y = cvtpk(sg[10], sg[11]); w1.z = cvtpk(sg[12], sg[13]); w1.w = cvtpk(sg[14], sg[15]);
    const bf16x8_t Pb0 = __builtin_bit_cast(bf16x8_t, w0), Pb1 = __builtin_bit_cast(bf16x8_t, w1);
    O0 = MFMA32(Vc[0], Pb0, O0); O0 = MFMA32(Vc[1], Pb1, O0);
    O1 = MFMA32(Vc[2], Pb0, O1); O1 = MFMA32(Vc[3], Pb1, O1);
    return __all(carry < 0x1p-134f);
}
__device__ __forceinline__ void attn_mfma(const Args& a, int u0, int ucnt, int ustride) {
    unsigned char* ws = a.ws;
    bf16* QS = (bf16*)(ws + WS_QS); const bf16* SK = (const bf16*)(ws + WS_SK); const bf16* VT = (const bf16*)((unsigned char*)a.out + 32 * MiB);
    const int lane = threadIdx.x & 63, r32 = lane & 31, hi = lane >> 5;
    const int kap = 16 * (r32 >> 4) + 8 * ((r32 >> 2) & 1) + 4 * ((r32 >> 3) & 1) + (r32 & 3);
    for (int uk = 0; uk < ucnt; ++uk) { const int u = u0 + uk * ustride;
        const int qb = u & 63, bh = u >> 6, h = bh & 15, b = bh >> 4;
        const size_t rowq = (size_t)b * SEQ + 32 * qb + r32;
        bf16* qp = QS + rowq * 2048 + 1024 + 64 * h;
        const bf16* kbase = SK + ((size_t)b * SEQ + kap) * 1024 + 64 * h + 8 * hi;
        const bf16* vbase = VT + ((size_t)bh * 64 + r32) * 2048 + 8 * hi;
        bf16x8_t Qf[4];
#pragma unroll
        for (int ks = 0; ks < 4; ++ks) Qf[ks] = *(const bf16x8_t*)(qp + 16 * ks + 8 * hi);
        f32x16 O0, O1;
#pragma unroll
        for (int j = 0; j < 16; ++j) { O0[j] = 0.f; O1[j] = 0.f; }
        float carry = 1.f;
        bf16x8_t KA[4], VA[4], KB[4], VB[4];
#define ATT_LOAD(K_, V_, kb_) do { _Pragma("unroll") for (int ks = 0; ks < 4; ++ks) K_[ks] = *(const bf16x8_t*)(kbase + (size_t)(32 * (kb_)) * 1024 + 16 * ks); \
        _Pragma("unroll") for (int i = 0; i < 4; ++i) V_[i] = *(const bf16x8_t*)(vbase + (size_t)(32 * (i >> 1)) * 2048 + 32 * (kb_) + 16 * (i & 1)); } while (0)
        ATT_LOAD(KA, VA, qb);
        int kb = qb;
        ATT_LOAD(KB, VB, kb > 0 ? kb - 1 : 0);
        if (!(attn_tile<true>(KA, VA, Qf, O0, O1, carry, r32, hi) || kb == 0)) {
            --kb;
#pragma unroll 1
            for (;;) {
                ATT_LOAD(KA, VA, kb > 0 ? kb - 1 : 0);
                if (attn_tile<false>(KB, VB, Qf, O0, O1, carry, r32, hi) || kb == 0) break;
                --kb;
                ATT_LOAD(KB, VB, kb > 0 ? kb - 1 : 0);
                if (attn_tile<false>(KA, VA, Qf, O0, O1, carry, r32, hi) || kb == 0) break;
                --kb;
            }
        }
#undef ATT_LOAD
#pragma unroll
        for (int a4 = 0; a4 < 4; ++a4) {
            u32x2_t x0, x1; x0.x = cvtpk(O0[4 * a4], O0[4 * a4 + 1]); x0.y = cvtpk(O0[4 * a4 + 2], O0[4 * a4 + 3]); x1.x = cvtpk(O1[4 * a4], O1[4 * a4 + 1]); x1.y = cvtpk(O1[4 * a4 + 2], O1[4 * a4 + 3]);
            *(u32x2_t*)(qp + 8 * a4 + 4 * hi) = x0; *(u32x2_t*)(qp + 32 + 8 * a4 + 4 * hi) = x1; }
    }
}

#define XB_TMO      128
#define XB_XCNT(j)  (256  + 64 * (j))
#define XB_XSUB(j)  (1280 + 64 * (j))
#define XB_XGEN(j)  (2304 + 64 * (j))
#define XB_TOP      3328
#define XB_TOPGEN   3392
#define XCD_BAR_WORDS 3456
#define XB_SPIN_CAP (1u << 18)

__device__ __forceinline__ unsigned xb_ld(unsigned* p)              { return __hip_atomic_load(p, __ATOMIC_RELAXED, __HIP_MEMORY_SCOPE_AGENT); }
__device__ __forceinline__ unsigned xb_add(unsigned* p, unsigned v) { return __hip_atomic_fetch_add(p, v, __ATOMIC_RELAXED, __HIP_MEMORY_SCOPE_AGENT); }
__device__ __forceinline__ unsigned xb_xcc_id() { return (unsigned)__builtin_amdgcn_s_getreg((3 << 11) | 20) & 0xFu; }
#define XB_SPIN(cond, bar) do { unsigned _sp = 0; while (cond) { __builtin_amdgcn_s_sleep(1); \
    if ((++_sp & 255u) == 0u) { if (xb_ld(&(bar)[XB_TMO])) break; if (_sp > XB_SPIN_CAP) { atomicAdd(&(bar)[XB_TMO], 1u); break; } } } } while (0)

struct XcdBarrier {
    unsigned* bar; unsigned x;
    volatile LAS unsigned* st;
};

__device__ __forceinline__ XcdBarrier xcd_barrier_post(unsigned* bar, volatile LAS unsigned* st) {
    XcdBarrier b; b.bar = bar; b.x = xb_xcc_id(); b.st = st;
    if (threadIdx.x == 0) (void)xb_add(&bar[XB_XCNT(b.x)], 1u);
    return b;
}
__device__ __forceinline__ void xcd_barrier_complete(unsigned* bar, unsigned x, unsigned& nloc, unsigned& nx) {
    const unsigned G = gridDim.x * gridDim.y * gridDim.z;
    unsigned sum, cnt, mine, sp = 0u;
    for (;;) {
        sum = 0u; cnt = 0u; mine = 0u;
#pragma unroll
        for (unsigned j = 0; j < 16; ++j) { const unsigned c = xb_ld(&bar[XB_XCNT(j)]); sum += c; cnt += (c > 0u) ? 1u : 0u; mine = (j == x) ? c : mine; }
        if (sum == G) break;
        __builtin_amdgcn_s_sleep(1);
        if ((++sp & 255u) == 0u) { if (xb_ld(&bar[XB_TMO])) break; if (sp > XB_SPIN_CAP) { atomicAdd(&bar[XB_TMO], 1u); break; } }
    }
    nloc = mine > 0u ? mine : 1u; nx = cnt > 0u ? cnt : 1u;
}

__device__ __forceinline__ void xcd_barrier(const XcdBarrier& b) {
    asm volatile("s_waitcnt vmcnt(0)" ::: "memory");
    __syncthreads();
    if (threadIdx.x == 0) {
        unsigned* bar = b.bar;
        __builtin_amdgcn_s_waitcnt(0);
        unsigned nloc = b.st[0], nx = b.st[1];
        if (nloc == 0u) { xcd_barrier_complete(bar, b.x, nloc, nx); b.st[0] = nloc; b.st[1] = nx; }
        const unsigned old = xb_add(&bar[XB_XSUB(b.x)], 1u);
        const unsigned gen = old / nloc;
        if (old + 1u == (gen + 1u) * nloc) {
            __builtin_amdgcn_fence(__ATOMIC_RELEASE, "agent");
            asm volatile("s_waitcnt vmcnt(0)" ::: "memory");
            const unsigned og = xb_add(&bar[XB_TOP], 1u);
            const unsigned tg = og / nx;
            if (og + 1u == (tg + 1u) * nx) xb_add(&bar[XB_TOPGEN], 1u);
            else XB_SPIN(xb_ld(&bar[XB_TOPGEN]) == tg, bar);
            __builtin_amdgcn_fence(__ATOMIC_ACQUIRE, "agent");
            xb_add(&bar[XB_XGEN(b.x)], 1u);
            asm volatile("s_waitcnt vmcnt(0)" ::: "memory");
        } else {
            XB_SPIN(xb_ld(&bar[XB_XGEN(b.x)]) == gen, bar);
            __builtin_amdgcn_fence(__ATOMIC_ACQUIRE, "agent");
            asm volatile("s_waitcnt vmcnt(0)" ::: "memory");
        }
    }
    __syncthreads();
}

__global__ void __launch_bounds__(NTHREADS, 2) hybrid_fwd(Args args) {
    extern __shared__ __attribute__((aligned(16))) unsigned char lds_raw[];
    LAS unsigned char* lds = (LAS unsigned char*)lds_raw;
    cg::grid_group grid = cg::this_grid();
    const int tid = threadIdx.x, lane = tid & 63, wave = __builtin_amdgcn_readfirstlane(tid >> 6);
    const int G = gridDim.x;
    unsigned char* ws = args.ws;
    const int lo = args.ph_lo, hi = args.ph_hi;
    volatile LAS unsigned* MISC = (volatile LAS unsigned*)(lds + MISC_OFF);
    if (tid < 2) MISC[tid] = 0u;
    __syncthreads();
    const XcdBarrier bar = xcd_barrier_post((unsigned*)ws, MISC);
#define IN(k) (lo <= (k) && (k) < hi)
#define SEAM(k) do { if (IN(k) && IN((k) + 1)) { xcd_barrier(bar); } } while (0)
    if (lo < 0) grid.sync();
    if (IN(0)) { p0_prologue<0>(args, lds, wave, lane, (int)blockIdx.x * NWAVES + wave, G * NWAVES); asm volatile("s_waitcnt vmcnt(0) lgkmcnt(0)" ::: "memory"); __syncthreads(); }
    SEAM(0);
    if (IN(1)) {
        pg8::Gemm g{(const pg8::bf16_t*)(ws + WS_H), (const pg8::bf16_t*)(ws + WS_WIN), M, 6144, D, D}; pg8::StaticOrder S; S.init(M, 6144, G, (int)blockIdx.x);
        pg8::EpiProj E{(pg8::bf16_t*)(ws + WS_QS), (pg8::bf16_t*)(ws + WS_VH), (pg8::bf16_t*)(ws + WS_SK), (pg8::bf16_t*)((unsigned char*)args.out + 32 * MiB), ws + WS_GH, ws + WS_GA, ws + WS_GB, (_Float16*)args.out,
                       args.in[3], args.in[5], args.in[6], 0};
        pg8::gemm_phase<pg8::EpiProj, pg8::StaticOrder, true, true>(lds, g, S, E);
        pg8::Gemm g2{(const pg8::bf16_t*)(ws + WS_WIN) + (size_t)6144 * 1024, (const pg8::bf16_t*)(ws + WS_H), 1024, M, D, D}; pg8::StaticOrder S2; S2.init(1024, M, G, (int)blockIdx.x);
        pg8::EpiVT E2{(pg8::bf16_t*)((unsigned char*)args.out + 32 * MiB)};
        pg8::gemm_phase<pg8::EpiVT, pg8::StaticOrder, true, true>(lds, g2, S2, E2);
    }
    SEAM(1);
    if (IN(2)) {
        const pg8::Gemm gg{(const pg8::bf16_t*)(ws + WS_H), (const pg8::bf16_t*)(ws + WS_WIN) + (size_t)7168 * 1024, M, 2048, D, D};
        const pg8::EpiProj EG{(pg8::bf16_t*)(ws + WS_QS), (pg8::bf16_t*)(ws + WS_VH), (pg8::bf16_t*)(ws + WS_SK), (pg8::bf16_t*)((unsigned char*)args.out + 32 * MiB), ws + WS_GH, ws + WS_GA, ws + WS_GB, (_Float16*)args.out,
                              args.in[3], args.in[5], args.in[6], 28};
        constexpr int NUNITS = BATCH * 16 * (SEQ / 32);
        if (G == 256) {
            pg8::ListOrder S; S.s.init(M, 2048, 256, 0);
            if ((int)blockIdx.x < 64) { hgrn_v2(args, lds, (int)blockIdx.x, 64); p0_prologue<1>(args, lds, wave, lane, 2048 + 512 + (int)blockIdx.x * NWAVES + wave, 1024); S.l0 = -1; S.l1 = -1; S.l2 = -1; }
            else { const int idx = (int)blockIdx.x - 64;
                if (idx < 128) attn_mfma(args, idx * 40 + wave, 5, NWAVES); else attn_mfma(args, 5120 + (idx - 128) * 48 + wave, 6, NWAVES);
                if (idx < 128) p0_prologue<1>(args, lds, wave, lane, idx * NWAVES + wave, 1024, 2048);
                else p0_prologue<1>(args, lds, wave, lane, 2048 + (idx - 128) * NWAVES + wave, 1024);
                S.l0 = idx; S.l1 = 192 + idx; S.l2 = idx < 128 ? 384 + idx : -1; }
            asm volatile("s_waitcnt vmcnt(0) lgkmcnt(0)" ::: "memory"); __syncthreads();
            pg8::gemm_phase<pg8::EpiProj, pg8::ListOrder, true, true>(lds, gg, S, EG);
        } else {
            const int gw = (int)blockIdx.x * NWAVES + wave, ngw = G * NWAVES;
            hgrn_v2(args, lds, (int)blockIdx.x, G); attn_mfma(args, gw, (NUNITS - gw + ngw - 1) / ngw, ngw); p0_prologue<1>(args, lds, wave, lane, gw, ngw);
            asm volatile("s_waitcnt vmcnt(0) lgkmcnt(0)" ::: "memory"); __syncthreads();
            pg8::StaticOrder S; S.init(M, 2048, G, (int)blockIdx.x);
            pg8::gemm_phase<pg8::EpiProj, pg8::StaticOrder, true, true>(lds, gg, S, EG);
        }
        __syncthreads();
    }
    SEAM(2);
    if (IN(3)) {
        pg8::Gemm g{(const pg8::bf16_t*)(ws + WS_QS), (const pg8::bf16_t*)(ws + WS_WHS), M, D, 1024, 2048}; pg8::SplitOrder S; S.s.init(M, D, G, (int)blockIdx.x);
        pg8::EpiMix E{ws + WS_GA, ws + WS_GB, (pg8::bf16_t*)(ws + WS_MIXED)};
        pg8::gemm_phase<pg8::EpiMix, pg8::SplitOrder, true, true>(lds, g, S, E);
    }
    SEAM(3);
    if (IN(4)) {
        pg8::Gemm g{(const pg8::bf16_t*)(ws + WS_MIXED), (const pg8::bf16_t*)(ws + WS_WO), M, D, D, D}; pg8::StaticOrder S; S.init(M, D, G, (int)blockIdx.x);
        pg8::EpiRes1 E{args.in[0], (pg8::bf16_t*)(ws + WS_GA), (pg8::bf16_t*)(ws + WS_X1B), (float*)(ws + WS_SSQ)};
        pg8::gemm_phase<pg8::EpiRes1, pg8::StaticOrder, true, true>(lds, g, S, E);
    }
    SEAM(4);
    if (IN(5)) {
        pg8::Gemm g{(const pg8::bf16_t*)(ws + WS_X1B), (const pg8::bf16_t*)(ws + WS_WF1), M, 2 * FFH, D, D}; pg8::StaticOrder S; S.init(M, 2 * FFH, G, (int)blockIdx.x);
        pg8::EpiSwiglu E{(const float*)(ws + WS_SSQ), (pg8::bf16_t*)(ws + WS_ACT)};
        pg8::gemm_phase<pg8::EpiSwiglu, pg8::StaticOrder, true, true>(lds, g, S, E);
    }
    SEAM(5);
    if (IN(6)) {
        pg8::Gemm g{(const pg8::bf16_t*)(ws + WS_ACT), (const pg8::bf16_t*)(ws + WS_WF2), M, D, FFH, FFH}; pg8::StaticOrder S; S.init(M, D, G, (int)blockIdx.x);
        pg8::EpiRes2 E{args.in[0], (const pg8::bf16_t*)(ws + WS_GA), args.out};
        pg8::gemm_phase<pg8::EpiRes2, pg8::StaticOrder, true, true>(lds, g, S, E);
    }
#undef IN
#undef SEAM
}

#ifndef MK_N_LAUNCHES
#define MK_N_LAUNCHES 1
#endif
extern "C" void kernel_launch(void* const* d_in, const int* in_sizes, int n_in, void* d_out, int out_size, void* d_ws, size_t ws_size, hipStream_t stream) {
    static int grid = 0;
    if (grid == 0) {
        int dev = 0, cus = 0, per_cu = 0;
        if (n_in != 13 || ws_size < WS_END) { fprintf(stderr, "kernel_launch: unexpected inputs / workspace (%d, %zu)\n", n_in, ws_size); grid = -1; return; }
        hipGetDevice(&dev); hipDeviceGetAttribute(&cus, hipDeviceAttributeMultiprocessorCount, dev);
        if (hipFuncSetAttribute((const void*)hybrid_fwd, hipFuncAttributeMaxDynamicSharedMemorySize, LDS_BYTES) != hipSuccess) { fprintf(stderr, "kernel_launch: hipFuncSetAttribute failed\n"); grid = -1; return; }
        if (hipOccupancyMaxActiveBlocksPerMultiprocessor(&per_cu, (const void*)hybrid_fwd, NTHREADS, LDS_BYTES) != hipSuccess || per_cu < 1) { fprintf(stderr, "kernel_launch: occupancy query says %d\n", per_cu); per_cu = 1; }
        (void)hipGetLastError();
        grid = cus * per_cu;
    }
    if (grid < 0) return;
    if (hipMemsetAsync(d_ws, 0, 16384, stream) != hipSuccess) { fprintf(stderr, "kernel_launch: memset of the barrier words failed\n"); return; }
    Args a{};
    for (int i = 0; i < 13; ++i) a.in[i] = (const float*)d_in[i];
    a.out = (float*)d_out; a.ws = (unsigned char*)d_ws;
#if MK_N_LAUNCHES == 1
    a.ph_lo = 0; a.ph_hi = 7;
    void* kargs[] = {&a};
    hipError_t e = hipLaunchCooperativeKernel((const void*)hybrid_fwd, dim3(grid), dim3(NTHREADS), kargs, LDS_BYTES, stream);
    if (e != hipSuccess) fprintf(stderr, "cooperative launch failed: %s (grid %d)\n", hipGetErrorString(e), grid);
#else
    for (int p = 0; p < 7; ++p) { a.ph_lo = p; a.ph_hi = p + 1; hipLaunchKernelGGL(hybrid_fwd, dim3(grid), dim3(NTHREADS), LDS_BYTES, stream, a); }
#endif
}
```
